# Optimizing an MI355X kernel written in HIP

```python
import math
import jax
import jax.numpy as jnp
from jax import lax
import numpy as np

D_MODEL = 1024
BATCH = 2
SEQ = 8192
DEPTH = 2

GRID_W = 64
CTX_LEN = 256
FOUR_GROUPS = 4
FOUR_GROUP_W = D_MODEL // 16
FOUR_WIDTH = FOUR_GROUPS * FOUR_GROUP_W
RET_HEADS = 4
RET_HEAD_DIM = (3 * D_MODEL // 8) // 4
RET_WIDTH = RET_HEADS * RET_HEAD_DIM
NA_HEADS = 6
NA_HEAD_DIM = (3 * D_MODEL // 8) // 6
NA_WIDTH = NA_HEADS * NA_HEAD_DIM
PROJ_WIDTH = FOUR_WIDTH + 4 * RET_WIDTH + 3 * NA_WIDTH
SPLIT_IDX = (FOUR_WIDTH,
             FOUR_WIDTH + RET_WIDTH,
             FOUR_WIDTH + 2 * RET_WIDTH,
             FOUR_WIDTH + 3 * RET_WIDTH,
             FOUR_WIDTH + 4 * RET_WIDTH,
             FOUR_WIDTH + 4 * RET_WIDTH + NA_WIDTH,
             FOUR_WIDTH + 4 * RET_WIDTH + 2 * NA_WIDTH)
RET_CHUNK = 128
NA_WIN_ROWS = 8
NA_WIN_COLS = 16
NA_QBLOCK_COLS = 16
NA_KBLOCK_COLS = NA_QBLOCK_COLS + NA_WIN_COLS
D_FF = ((8 * D_MODEL // 3 + 255) // 256) * 256
ROPE_BASE = 10000.0
NORM_EPS = 1e-6
NEG_INF = -1e30

kernel_name = "hymba_fnet_retnet_natten_dit"


def rmsnorm(x, g):
    x32 = x.astype(jnp.float32)
    y = x32 * lax.rsqrt(jnp.mean(x32 * x32, axis=-1, keepdims=True) + NORM_EPS)
    return (y * g.astype(jnp.float32)).astype(x.dtype)


def ada_params(cvec, w, b):
    return jnp.split(jax.nn.silu(cvec) @ w + b, 6, axis=-1)


def swiglu(h, w1, w3, w2):
    return (jax.nn.silu(h @ w1) * (h @ w3)) @ w2


def rope_1d(x, pos):
    half = x.shape[-1] // 2
    inv = ROPE_BASE ** (-jnp.arange(half, dtype=jnp.float32) / half)
    ang = pos.astype(jnp.float32)[:, None] * inv[None, :]
    cos, sin = jnp.cos(ang), jnp.sin(ang)
    x1, x2 = x[..., :half], x[..., half:]
    return jnp.concatenate([x1 * cos - x2 * sin, x1 * sin + x2 * cos], axis=-1).astype(x.dtype)


def rope_2d(x, rows, cols):
    d = x.shape[-1] // 2
    return jnp.concatenate([rope_1d(x[..., :d], rows), rope_1d(x[..., d:], cols)], axis=-1)


def fourier_mix(u, w_four):
    B, L, _ = u.shape
    g = u.astype(jnp.float32).reshape(B, L, FOUR_GROUPS, FOUR_GROUP_W)
    f = jnp.fft.fft2(g, axes=(1, 3), norm="ortho").real
    return f.reshape(B, L, FOUR_WIDTH).astype(u.dtype) @ w_four


def retention_final_state(k, v, log_gamma):
    L = k.shape[2]
    w = jnp.exp((L - 1 - jnp.arange(L, dtype=jnp.float32))[None, :] * log_gamma[:, None])
    return jnp.einsum('bhld,bhle->bhde', k * w[None, :, :, None], v)


def retention_chunkwise(q, k, v, log_gamma, state0):
    B, H, L, dk = q.shape
    dv = v.shape[-1]
    C = RET_CHUNK
    N = L // C
    qc = q.reshape(B, H, N, C, dk)
    kc = k.reshape(B, H, N, C, dk)
    vc = v.reshape(B, H, N, C, dv)
    idx = jnp.arange(C, dtype=jnp.float32)
    diff = idx[:, None] - idx[None, :]
    intra_decay = jnp.where(diff >= 0, jnp.exp(jnp.maximum(diff, 0.0)[None] * log_gamma[:, None, None]), 0.0)
    s = jnp.einsum('bhnid,bhnjd->bhnij', qc, kc) * intra_decay[None, :, None]
    intra = jnp.einsum('bhnij,bhnje->bhnie', s, vc)
    q_decay = jnp.exp((idx + 1.0)[None, :] * log_gamma[:, None])
    k_decay = jnp.exp((C - 1.0 - idx)[None, :] * log_gamma[:, None])
    kv = jnp.einsum('bhnjd,bhnje->nbhde', kc * k_decay[None, :, None, :, None], vc)
    chunk_decay = jnp.exp(C * log_gamma)[None, :, None, None]

    def step(state, kv_n):
        return chunk_decay * state + kv_n, state

    _, s_prev = lax.scan(step, state0, kv)
    cross = jnp.einsum('bhnid,nbhde->bhnie', qc, s_prev) * q_decay[None, :, None, :, None]
    return (intra + cross).reshape(B, H, L, dv)


def bidirectional_retention(q_lat, k_lat, v_lat, q_ctx, k_ctx, v_ctx, log_gamma, with_ctx_out):
    flip = lambda t: t[:, :, ::-1]
    s_fwd = retention_final_state(k_ctx, v_ctx, log_gamma[0])
    s_bwd = retention_final_state(flip(k_ctx), flip(v_ctx), log_gamma[1])
    o_lat = (retention_chunkwise(q_lat, k_lat, v_lat, log_gamma[0], s_fwd)
             + flip(retention_chunkwise(flip(q_lat), flip(k_lat), flip(v_lat), log_gamma[1], s_bwd)))
    if not with_ctx_out:
        return o_lat, None
    zero = jnp.zeros_like(s_fwd)
    o_ctx = (retention_chunkwise(q_ctx, k_ctx, v_ctx, log_gamma[0], zero)
             + flip(retention_chunkwise(flip(q_ctx), flip(k_ctx), flip(v_ctx), log_gamma[1], zero)))
    return o_lat, o_ctx


def retention_readout(o, gate, gain):
    B, H, L, dv = o.shape
    o = o * lax.rsqrt(jnp.mean(o * o, axis=-1, keepdims=True) + NORM_EPS)
    o = o.transpose(0, 2, 1, 3).reshape(B, L, H * dv) * gain.astype(jnp.float32)
    return (o * jax.nn.silu(gate.astype(jnp.float32))).astype(gate.dtype)


def neighborhood_attention(q, k, v, k_ctx, v_ctx, rpb):
    B, L, H, d = q.shape
    rows = L // GRID_W
    wr = min(NA_WIN_ROWS, rows)
    nj = GRID_W // NA_QBLOCK_COLS
    r = jnp.arange(rows)
    ridx = jnp.clip(r - wr // 2, 0, rows - wr)[:, None] + jnp.arange(wr)[None, :]
    j = jnp.arange(nj)
    cidx = jnp.clip(j * NA_QBLOCK_COLS - NA_WIN_COLS // 2, 0, GRID_W - NA_KBLOCK_COLS)[:, None] \
        + jnp.arange(NA_KBLOCK_COLS)[None, :]
    tok = (ridx[:, None, :, None] * GRID_W + cidx[None, :, None, :]).reshape(rows, nj, wr * NA_KBLOCK_COLS)
    kg = jnp.take(k, tok, axis=1)
    vg = jnp.take(v, tok, axis=1)
    qb = q.reshape(B, rows, nj, NA_QBLOCK_COLS, H, d)
    qcol = j[:, None] * NA_QBLOCK_COLS + jnp.arange(NA_QBLOCK_COLS)[None, :]
    win_start = jnp.clip(qcol - NA_WIN_COLS // 2, 0, GRID_W - NA_WIN_COLS)
    kcol = cidx[:, None, :]
    col_ok = (kcol >= win_start[..., None]) & (kcol < win_start[..., None] + NA_WIN_COLS)
    dr = ridx - r[:, None] + NA_WIN_ROWS - 1
    dc = jnp.clip(kcol - qcol[..., None] + NA_WIN_COLS - 1, 0, 2 * NA_WIN_COLS - 2)
    bias = rpb[:, dr[:, None, None, :, None], dc[None, :, :, None, :]]
    nk = wr * NA_KBLOCK_COLS
    bias = bias.reshape(H, rows, nj, NA_QBLOCK_COLS, nk).astype(jnp.float32)
    mask = jnp.broadcast_to(col_ok[:, :, None, :], (nj, NA_QBLOCK_COLS, wr, NA_KBLOCK_COLS)).reshape(nj, NA_QBLOCK_COLS, nk)
    bias = jnp.where(mask[None, None], bias, NEG_INF)
    scale = d ** -0.5
    s_lat = jnp.einsum('brjqhd,brjkhd->bhrjqk', qb, kg).astype(jnp.float32) * scale + bias[None]
    s_ctx = jnp.einsum('brjqhd,bchd->bhrjqc', qb, k_ctx).astype(jnp.float32) * scale
    p = jax.nn.softmax(jnp.concatenate([s_lat, s_ctx], axis=-1), axis=-1)
    p_lat, p_ctx = p[..., :nk].astype(v.dtype), p[..., nk:].astype(v.dtype)
    out = (jnp.einsum('bhrjqk,brjkhd->brjqhd', p_lat, vg)
           + jnp.einsum('bhrjqc,bchd->brjqhd', p_ctx, v_ctx))
    return out.reshape(B, L, H * d)


def context_attention(q, k, v):
    B, Lc, H, d = q.shape
    s = jnp.einsum('bqhd,bkhd->bhqk', q, k).astype(jnp.float32) * d ** -0.5
    p = jax.nn.softmax(s, axis=-1).astype(v.dtype)
    return jnp.einsum('bhqk,bkhd->bqhd', p, v).reshape(B, Lc, H * d)


def token_mixer(h_lat, h_ctx, w_in, decay_logit, ret_g, w_four, rpb, w_out, with_ctx_out):
    B, L, _ = h_lat.shape
    Lc = h_ctx.shape[1]
    f_l, rq_l, rk_l, rv_l, rg_l, nq_l, nk_l, nv_l = jnp.split(h_lat @ w_in, SPLIT_IDX, axis=-1)
    f_c, rq_c, rk_c, rv_c, rg_c, nq_c, nk_c, nv_c = jnp.split(h_ctx @ w_in, SPLIT_IDX, axis=-1)
    pos = jnp.arange(L)
    prow, pcol = pos // GRID_W, pos % GRID_W

    def ret_heads(t, n):
        return t.reshape(B, n, RET_HEADS, RET_HEAD_DIM).transpose(0, 2, 1, 3).astype(jnp.float32)

    k_scale = RET_HEAD_DIM ** -0.5
    rq = rope_2d(ret_heads(rq_l, L), prow, pcol)
    rk = rope_2d(ret_heads(rk_l, L), prow, pcol) * k_scale
    rv = ret_heads(rv_l, L)
    rq_ctx = ret_heads(rq_c, Lc) if with_ctx_out else None
    rk_ctx = ret_heads(rk_c, Lc) * k_scale
    rv_ctx = ret_heads(rv_c, Lc)
    log_gamma = jax.nn.log_sigmoid(decay_logit.astype(jnp.float32))
    o_lat, o_ctx = bidirectional_retention(rq, rk, rv, rq_ctx, rk_ctx, rv_ctx, log_gamma, with_ctx_out)

    na_heads = lambda t, n: t.reshape(B, n, NA_HEADS, NA_HEAD_DIM)
    nk_ctx, nv_ctx = na_heads(nk_c, Lc), na_heads(nv_c, Lc)
    y_lat = jnp.concatenate([
        fourier_mix(f_l, w_four),
        retention_readout(o_lat, rg_l, ret_g),
        neighborhood_attention(na_heads(nq_l, L), na_heads(nk_l, L), na_heads(nv_l, L), nk_ctx, nv_ctx, rpb),
    ], axis=-1) @ w_out
    if not with_ctx_out:
        return y_lat, None
    y_ctx = jnp.concatenate([
        fourier_mix(f_c, w_four),
        retention_readout(o_ctx, rg_c, ret_g),
        context_attention(na_heads(nq_c, Lc), nk_ctx, nv_ctx),
    ], axis=-1) @ w_out
    return y_lat, y_ctx


def setup_inputs(seed: int = 0) -> dict:
    key = jax.random.key(seed)
    ks = jax.random.split(key, 20)
    nrm = lambda k, shape, s: jax.random.normal(k, shape, jnp.float32) * s
    gamma0 = 1.0 - 2.0 ** (-5.0 - np.arange(RET_HEADS))
    logit0 = jnp.asarray(np.log(gamma0 / (1.0 - gamma0)).astype(np.float32))
    return {
        "x": nrm(ks[0], (BATCH, SEQ, D_MODEL), 1.0),
        "c": nrm(ks[1], (BATCH, D_MODEL), 1.0),
        "ctx": nrm(ks[2], (BATCH, CTX_LEN, D_MODEL), 1.0),
        "c_ctx": nrm(ks[3], (D_MODEL,), 1.0),
        "w_ada": nrm(ks[4], (DEPTH, D_MODEL, 6 * D_MODEL), 0.5 * D_MODEL ** -0.5),
        "b_ada": nrm(ks[5], (DEPTH, 6 * D_MODEL), 0.01),
        "g_mix": 1.0 + nrm(ks[6], (DEPTH, D_MODEL), 0.05),
        "w_in": nrm(ks[7], (DEPTH, D_MODEL, PROJ_WIDTH), D_MODEL ** -0.5),
        "ret_decay_logit": logit0[None, None, :] + nrm(ks[8], (DEPTH, 2, RET_HEADS), 0.1),
        "ret_norm_g": 1.0 + nrm(ks[9], (DEPTH, RET_WIDTH), 0.05),
        "w_four": nrm(ks[10], (DEPTH, FOUR_WIDTH, FOUR_WIDTH), FOUR_WIDTH ** -0.5),
        "na_rpb": nrm(ks[11], (DEPTH, NA_HEADS, 2 * NA_WIN_ROWS - 1, 2 * NA_WIN_COLS - 1), 0.1),
        "w_out": nrm(ks[12], (DEPTH, D_MODEL, D_MODEL), D_MODEL ** -0.5),
        "g_ffn": 1.0 + nrm(ks[13], (DEPTH, D_MODEL), 0.05),
        "w1": nrm(ks[14], (DEPTH, D_MODEL, D_FF), D_MODEL ** -0.5),
        "w3": nrm(ks[15], (DEPTH, D_MODEL, D_FF), D_MODEL ** -0.5),
        "w2": nrm(ks[16], (DEPTH, D_FF, D_MODEL), D_FF ** -0.5),
        "g_final": 1.0 + nrm(ks[17], (D_MODEL,), 0.05),
    }


def reference(x, c, ctx, c_ctx, w_ada, b_ada, g_mix, w_in, ret_decay_logit, ret_norm_g, w_four,
              na_rpb, w_out, g_ffn, w1, w3, w2, g_final):
    for i in range(DEPTH):
        last = i == DEPTH - 1
        sh_a, sc_a, ga_a, sh_f, sc_f, ga_f = [m[:, None, :] for m in ada_params(c, w_ada[i], b_ada[i])]
        csh_a, csc_a, cga_a, csh_f, csc_f, cga_f = ada_params(c_ctx, w_ada[i], b_ada[i])
        h = rmsnorm(x, g_mix[i]) * (1.0 + sc_a) + sh_a
        hc = rmsnorm(ctx, g_mix[i]) * (1.0 + csc_a) + csh_a
        y, yc = token_mixer(h, hc, w_in[i], ret_decay_logit[i], ret_norm_g[i], w_four[i], na_rpb[i],
                            w_out[i], not last)
        x = x + ga_a * y
        x = x + ga_f * swiglu(rmsnorm(x, g_ffn[i]) * (1.0 + sc_f) + sh_f, w1[i], w3[i], w2[i])
        if not last:
            ctx = ctx + cga_a * yc
            ctx = ctx + cga_f * swiglu(rmsnorm(ctx, g_ffn[i]) * (1.0 + csc_f) + csh_f, w1[i], w3[i], w2[i])
    return rmsnorm(x, g_final)
```

```cpp
#include <hip/hip_runtime.h>
#include <hip/hip_cooperative_groups.h>
#include <cstdio>
#include <cstdint>
namespace cg = cooperative_groups;

#define LAS __attribute__((address_space(3)))
#define GAS __attribute__((address_space(1)))
typedef unsigned short bf16_t;
typedef short bf16x8 __attribute__((ext_vector_type(8)));
typedef short bf16x4 __attribute__((ext_vector_type(4)));
typedef float f32x4 __attribute__((ext_vector_type(4)));
typedef float f32x2 __attribute__((ext_vector_type(2)));
typedef unsigned u32x4 __attribute__((ext_vector_type(4)));
typedef unsigned u32x2 __attribute__((ext_vector_type(2)));

__device__ __forceinline__ unsigned f2bf(float f) { unsigned u = __builtin_bit_cast(unsigned, f); return (u + 0x7fffu + ((u >> 16) & 1u)) >> 16; }
__device__ __forceinline__ unsigned pk2(float lo, float hi) { return f2bf(lo) | (f2bf(hi) << 16); }
__device__ __forceinline__ float bf2f(unsigned h) { return __builtin_bit_cast(float, h << 16); }
__device__ __forceinline__ float bflo(unsigned w) { return __builtin_bit_cast(float, w << 16); }
__device__ __forceinline__ float bfhi(unsigned w) { return __builtin_bit_cast(float, w & 0xffff0000u); }
__device__ __forceinline__ float silu_f(float a) { return a * __builtin_amdgcn_rcpf(1.0f + __expf(-a)); }

constexpr int NB = 2, SEQ = 8192, DM = 1024, CTXL = 256, MLAT = NB * SEQ, MCTX = NB * CTXL, MTOT = MLAT + MCTX;
constexpr int PW = 2944, PWP = 3072, FF = 2816, FF2 = 5632;
constexpr int C_RQ = 256, C_RK = 640, C_RV = 1024, C_RG = 1408, C_NQ = 1792, C_NK = 2176, C_NV = 2560;
constexpr float NORM_EPS = 1e-6f;

namespace pg8 {
#define PG8_LAS __attribute__((address_space(3)))
constexpr int BM = 256, BK = 64, HALF = 128, HTB = HALF * BK * 2, STAGE_BYTES = 8 * HTB, NXCD = 8, WGM = 8;
__host__ __device__ __forceinline__ int lds_byte(int r, int c) { const int st = (r >> 4) * 2 + (c >> 5), rr = r & 15, cc = c & 31, ob = rr * 64 + cc * 2; return st * 1024 + (ob ^ (((ob >> 9) & 1) << 5)); }
__host__ __device__ __forceinline__ void stage_rc(int b, int& R, int& C) { const int st = b / 1024, sb = b % 1024, swz = sb ^ (((sb >> 9) & 1) << 5); R = (st >> 1) * 16 + swz / 64; C = (st & 1) * 32 + (swz % 64) / 2; }
__host__ __device__ __forceinline__ int perm32(int rho) { const int n = rho >> 4, i = rho & 15; return 8 * (i >> 2) + 4 * n + (i & 3); }
struct Unit { int pm, pn; };
struct Gemm { const bf16_t* A; const bf16_t* Bt; int M, N, K; };
struct StaticOrder {
    int nM, nN, nwg, G, c;
    __host__ __device__ void init(int M, int N, int G_, int c_) { nM = M / BM; nN = N / BM; nwg = nM * nN; G = G_; c = c_; }
    __host__ __device__ bool next(int i, Unit& u) const {
        const long L = (long)i * G + c; if (L >= nwg) return false;
        int wgid = (int)L; { const int q = nwg / NXCD, r = nwg % NXCD, xcd = wgid % NXCD, off = wgid / NXCD; wgid = (xcd < r ? xcd * (q + 1) : r * (q + 1) + (xcd - r) * q) + off; }
        const int nig = WGM * nN, gid = wgid / nig, fm = gid * WGM, gsz = (nM - fm) < WGM ? (nM - fm) : WGM;
        u.pm = fm + ((wgid % nig) % gsz); u.pn = (wgid % nig) / gsz; return true;
    }
    __device__ __forceinline__ void a_ready(const Unit&) const {}
    __device__ __forceinline__ void done(const Unit&) const {}
};
__device__ __forceinline__ unsigned cvt_pk_bf16(float lo, float hi) { unsigned r; asm volatile("v_cvt_pk_bf16_f32 %0, %1, %2" : "=v"(r) : "v"(lo), "v"(hi)); return r; }

__device__ __forceinline__ float row_rinv(const float* ssq, int row) {
    const f32x4* p = (const f32x4*)(ssq + (size_t)row * 16);
    const f32x4 a = p[0], b = p[1], c = p[2], d = p[3];
    const float s = (((a[0] + a[1]) + (a[2] + a[3])) + ((b[0] + b[1]) + (b[2] + b[3]))) + (((c[0] + c[1]) + (c[2] + c[3])) + ((d[0] + d[1]) + (d[2] + d[3])));
    return rsqrtf(s * (1.0f / 1024.0f) + NORM_EPS);
}
__device__ __forceinline__ int row_set(int pm) { return pm < 32 ? 0 : (pm < 64 ? 1 : 2); }

struct EpiProj {
    static constexpr bool PERM = true, AFTER_DRAIN = false;
    bf16_t* O; const float* ssq; const float* shw;
    __device__ __forceinline__ void operator()(const f32x4 (&acc)[2][2][4][2], const Unit& u, int wr, int wc, int fr, int fq) const {
        const int row0 = u.pm * BM + wr * 64 + fr, col0 = u.pn * BM + wc * 32 + 8 * fq; const int set = row_set(u.pm);
        f32x4 bv[2][2];
#pragma unroll
        for (int bj = 0; bj < 2; ++bj)
#pragma unroll
            for (int n = 0; n < 2; ++n) bv[bj][n] = *(const f32x4*)(shw + set * PWP + col0 + bj * HALF + 4 * n);
#pragma unroll
        for (int ai = 0; ai < 2; ++ai)
#pragma unroll
            for (int m = 0; m < 4; ++m) { const int r = row0 + ai * HALF + m * 16; const float ri = row_rinv(ssq, r); bf16_t* rowp = O + (size_t)r * PW + col0;
#pragma unroll
                for (int bj = 0; bj < 2; ++bj) { if (col0 + bj * HALF < PW) { const f32x4 v0 = acc[ai][bj][m][0] * ri + bv[bj][0], v1 = acc[ai][bj][m][1] * ri + bv[bj][1];
                    u32x4 w; w.x = cvt_pk_bf16(v0[0], v0[1]); w.y = cvt_pk_bf16(v0[2], v0[3]); w.z = cvt_pk_bf16(v1[0], v1[1]); w.w = cvt_pk_bf16(v1[2], v1[3]);
                    *(u32x4*)(rowp + bj * HALF) = w; } } }
    }
};
struct EpiSwiGLU {
    static constexpr bool PERM = true, AFTER_DRAIN = false;
    bf16_t* O; const float* ssq; const float* shw;
    __device__ __forceinline__ void operator()(const f32x4 (&acc)[2][2][4][2], const Unit& u, int wr, int wc, int fr, int fq) const {
        const int row0 = u.pm * BM + wr * 64 + fr, col0 = u.pn * BM + wc * 32 + 8 * fq, ocol = u.pn * HALF + wc * 32 + 8 * fq; const int set = row_set(u.pm);
        f32x4 ba[2], bb[2];
#pragma unroll
        for (int n = 0; n < 2; ++n) { ba[n] = *(const f32x4*)(shw + set * FF2 + col0 + 4 * n); bb[n] = *(const f32x4*)(shw + set * FF2 + col0 + HALF + 4 * n); }
#pragma unroll
        for (int ai = 0; ai < 2; ++ai)
#pragma unroll
            for (int m = 0; m < 4; ++m) { const int r = row0 + ai * HALF + m * 16; const float ri = row_rinv(ssq, r);
                float hv[8];
#pragma unroll
                for (int n = 0; n < 2; ++n) { const f32x4 a = acc[ai][0][m][n] * ri + ba[n], b = acc[ai][1][m][n] * ri + bb[n];
#pragma unroll
                    for (int e = 0; e < 4; ++e) hv[4 * n + e] = silu_f(a[e]) * b[e]; }
                u32x4 w; w.x = cvt_pk_bf16(hv[0], hv[1]); w.y = cvt_pk_bf16(hv[2], hv[3]); w.z = cvt_pk_bf16(hv[4], hv[5]); w.w = cvt_pk_bf16(hv[6], hv[7]);
                *(u32x4*)(O + (size_t)r * FF + ocol) = w; }
    }
};
struct EpiRes {
    static constexpr bool PERM = false, AFTER_DRAIN = false;
    const float* src_lat; const float* src_ctx; float* dst_lat; float* dst_ctx; bf16_t* XN; float* ssq; const float* gate; const float* sc; const float* g;
    __device__ __forceinline__ void operator()(const f32x4 (&acc)[2][2][4][2], const Unit& u, int wr, int wc, int fr, int fq) const {
        const bool lat = u.pm < 64; const int set = row_set(u.pm);
        const int rg0 = u.pm * BM + wr * 64 + fr, rl0 = (lat ? u.pm : u.pm - 64) * BM + wr * 64 + fr;
        const float* src = lat ? src_lat : src_ctx; float* dst = lat ? dst_lat : dst_ctx;
        const int col0 = u.pn * BM + wc * 32 + 4 * fq;
        float ss[2][4];
#pragma unroll
        for (int ai = 0; ai < 2; ++ai)
#pragma unroll
            for (int m = 0; m < 4; ++m) ss[ai][m] = 0.f;
#pragma unroll
        for (int bj = 0; bj < 2; ++bj)
#pragma unroll
            for (int n = 0; n < 2; ++n) { const int c = col0 + bj * HALF + n * 16;
                const f32x4 ga = *(const f32x4*)(gate + set * 6144 + c); f32x4 gs = {0.f, 0.f, 0.f, 0.f};
                if (XN) { const f32x4 s4 = *(const f32x4*)(sc + set * 6144 + c), g4 = *(const f32x4*)(g + c); gs = g4 * (s4 + 1.0f); }
#pragma unroll
                for (int ai = 0; ai < 2; ++ai)
#pragma unroll
                    for (int m = 0; m < 4; ++m) { const size_t ol = (size_t)(rl0 + ai * HALF + m * 16) * DM + c, og = (size_t)(rg0 + ai * HALF + m * 16) * DM + c;
                        const f32x4 x1 = *(const f32x4*)(src + ol) + ga * acc[ai][bj][m][n];
                        *(f32x4*)(dst + ol) = x1; ss[ai][m] += (x1[0] * x1[0] + x1[1] * x1[1]) + (x1[2] * x1[2] + x1[3] * x1[3]);
                        if (XN) { const f32x4 xn = x1 * gs; u32x2 w; w.x = cvt_pk_bf16(xn[0], xn[1]); w.y = cvt_pk_bf16(xn[2], xn[3]); *(u32x2*)(XN + og) = w; } } }
#pragma unroll
        for (int ai = 0; ai < 2; ++ai)
#pragma unroll
            for (int m = 0; m < 4; ++m) { float s = ss[ai][m]; s += __shfl_xor(s, 16); s += __shfl_xor(s, 32);
                if (fq == 0) ssq[(size_t)(rg0 + ai * HALF + m * 16) * 16 + u.pn * 4 + wc] = s; }
    }
};
template <class Epi, class Sched, bool ALIGN_EPI = false, bool SP2 = false>
__device__ __forceinline__ void gemm_phase(PG8_LAS unsigned char* lds, const Gemm g, const Sched& S, const Epi& E) {
    int tid_ = threadIdx.x; asm volatile("" : "+v"(tid_));
    const int tid = tid_, wid = __builtin_amdgcn_readfirstlane(tid >> 6), lane = tid & 63, wr = wid >> 2, wc = wid & 3, fr = lane & 15, fq = lane >> 4;
    const int K = g.K, nt = K / BK;
    unsigned voffA[2], voffB[2];
#pragma unroll
    for (int i = 0; i < 2; ++i) { int R, C; stage_rc(tid * 16 + i * 8192, R, C); const int Rb = Epi::PERM ? ((R & ~31) + perm32(R & 31)) : R;
        voffA[i] = (unsigned)(R * K + C) * 2u; voffB[i] = (unsigned)(Rb * K + C) * 2u; }
    const size_t kstep = (size_t)(BK * 2);
    const size_t hstep = (size_t)HALF * K * 2;
    const size_t tstep = 2 * hstep;
    const unsigned ldsw = (unsigned)wid * 1024u;
    const int aoff = lds_byte(wr * 64 + fr, fq * 8), boff = lds_byte(wc * 32 + fr, fq * 8);
#define PG8_SA(b, h) (((b) * 2 + (h)) * HTB)
#define PG8_SB(b, h) ((4 + (b) * 2 + (h)) * HTB)
#define PG8_STAGE(bufoff, gbase, voff) do { _Pragma("unroll") for (int _i = 0; _i < 2; ++_i) \
        __builtin_amdgcn_global_load_lds((const unsigned*)((const char*)(gbase) + (voff)[_i]), (PG8_LAS unsigned*)(lds + (bufoff) + ldsw + _i * 8192), 16, 0, 0); } while (0)
#define PG8_LDA(dst, b, h) do { _Pragma("unroll") for (int m = 0; m < 4; ++m) _Pragma("unroll") for (int k = 0; k < 2; ++k) dst[m][k] = *(const PG8_LAS bf16x8*)(lds + PG8_SA(b, h) + aoff + m * 2048 + k * 1024); } while (0)
#define PG8_LDB(dst, b, h) do { _Pragma("unroll") for (int n = 0; n < 2; ++n) _Pragma("unroll") for (int k = 0; k < 2; ++k) dst[n][k] = *(const PG8_LAS bf16x8*)(lds + PG8_SB(b, h) + boff + n * 2048 + k * 1024); } while (0)
#define PG8_MMA(ai, bj, At, Bt) do { __builtin_amdgcn_s_setprio(1); _Pragma("unroll") for (int m = 0; m < 4; ++m) _Pragma("unroll") for (int n = 0; n < 2; ++n) _Pragma("unroll") for (int k = 0; k < 2; ++k) \
        acc[ai][bj][m][n] = __builtin_amdgcn_mfma_f32_16x16x32_bf16(Bt[n][k], At[m][k], acc[ai][bj][m][n], 0, 0, 0); __builtin_amdgcn_s_setprio(0); } while (0)
#define PG8_WAIT_V(n) asm volatile("s_waitcnt vmcnt(" #n ")" ::: "memory")
#define PG8_WAIT_L(n) asm volatile("s_waitcnt lgkmcnt(" #n ")" ::: "memory")
#define PG8_BAR __builtin_amdgcn_s_barrier()
#define PG8_SCHED __builtin_amdgcn_sched_barrier(0)
    Unit cur, nxt; int ui = 0;
    if (!S.next(0, cur)) return;
    f32x4 acc[2][2][4][2];
#pragma unroll
    for (int a = 0; a < 2; ++a)
#pragma unroll
        for (int b = 0; b < 2; ++b)
#pragma unroll
            for (int m = 0; m < 4; ++m)
#pragma unroll
                for (int n = 0; n < 2; ++n) acc[a][b][m][n] = (f32x4){0.f, 0.f, 0.f, 0.f};
    bf16x8 At[4][2], B0[2][2], B1[2][2];
    const char* cA = (const char*)g.A + (size_t)cur.pm * tstep; const char* cB = (const char*)g.Bt + (size_t)cur.pn * tstep;
    S.a_ready(cur);
    if constexpr (SP2) {
        PG8_STAGE(PG8_SB(0, 0), cB, voffB); PG8_STAGE(PG8_SB(0, 1), cB + hstep, voffB); PG8_STAGE(PG8_SA(0, 0), cA, voffA); PG8_STAGE(PG8_SA(0, 1), cA + hstep, voffA);
        if (wr == 1) PG8_BAR;
        PG8_WAIT_V(2); PG8_BAR;
        PG8_STAGE(PG8_SB(1, 0), cB + kstep, voffB); PG8_STAGE(PG8_SA(1, 0), cA + kstep, voffA); PG8_STAGE(PG8_SB(1, 1), cB + hstep + kstep, voffB);
        PG8_WAIT_V(6); PG8_BAR;
    } else {
        PG8_STAGE(PG8_SB(0, 0), cB, voffB); PG8_STAGE(PG8_SA(0, 0), cA, voffA); PG8_STAGE(PG8_SB(0, 1), cB + hstep, voffB); PG8_STAGE(PG8_SA(0, 1), cA + hstep, voffA);
        if (wr == 1) PG8_BAR;
        PG8_WAIT_V(4); PG8_BAR;
        PG8_STAGE(PG8_SB(1, 0), cB + kstep, voffB); PG8_STAGE(PG8_SA(1, 0), cA + kstep, voffA); PG8_STAGE(PG8_SB(1, 1), cB + hstep + kstep, voffB);
        PG8_WAIT_V(6); PG8_BAR;
    }
    for (;;) {
        const bool has_next = S.next(ui + 1, nxt);
        const char* nA = has_next ? (const char*)g.A + (size_t)nxt.pm * tstep : cA; const char* nB = has_next ? (const char*)g.Bt + (size_t)nxt.pn * tstep : cB;
        for (int t = 0; t < nt; t += 2) {
            const bool last = (t == nt - 2);
            const char* a1 = cA + (size_t)(t + 1) * kstep;
            const char* a2 = last ? nA : cA + (size_t)(t + 2) * kstep; const char* b2 = last ? nB : cB + (size_t)(t + 2) * kstep;
            const char* a3 = a2 + kstep; const char* b3 = b2 + kstep;
            if (last && has_next) S.a_ready(nxt);
            if constexpr (SP2) {
            PG8_LDB(B0, 0, 0); PG8_LDB(B1, 0, 1); PG8_SCHED; PG8_LDA(At, 0, 0); PG8_STAGE(PG8_SA(1, 1), a1 + hstep, voffA);
            PG8_WAIT_V(8); PG8_WAIT_L(0); PG8_BAR; PG8_MMA(0, 0, At, B0); PG8_MMA(0, 1, At, B1); PG8_BAR; PG8_SCHED;
            PG8_LDA(At, 0, 1); PG8_STAGE(PG8_SB(0, 0), b2, voffB); PG8_STAGE(PG8_SB(0, 1), b2 + hstep, voffB); PG8_STAGE(PG8_SA(0, 0), a2, voffA);
            PG8_WAIT_V(8); PG8_WAIT_L(0); PG8_BAR; PG8_MMA(1, 0, At, B0); PG8_MMA(1, 1, At, B1); PG8_BAR; PG8_SCHED;
            PG8_LDB(B0, 1, 0); PG8_LDB(B1, 1, 1); PG8_SCHED; PG8_LDA(At, 1, 0); PG8_STAGE(PG8_SA(0, 1), a2 + hstep, voffA);
            PG8_WAIT_V(8); PG8_WAIT_L(0); PG8_BAR; PG8_MMA(0, 0, At, B0); PG8_MMA(0, 1, At, B1); PG8_BAR; PG8_SCHED;
            PG8_LDA(At, 1, 1); PG8_STAGE(PG8_SB(1, 0), b3, voffB); PG8_STAGE(PG8_SB(1, 1), b3 + hstep, voffB); PG8_STAGE(PG8_SA(1, 0), a3, voffA);
            PG8_WAIT_V(8); PG8_WAIT_L(0); PG8_BAR; PG8_MMA(1, 0, At, B0); PG8_MMA(1, 1, At, B1); PG8_BAR; PG8_SCHED;
            } else {
            PG8_LDB(B0, 0, 0); PG8_SCHED; PG8_LDA(At, 0, 0); PG8_STAGE(PG8_SA(1, 1), a1 + hstep, voffA);
            PG8_WAIT_L(8); PG8_BAR; PG8_WAIT_L(0); PG8_MMA(0, 0, At, B0); PG8_BAR; PG8_SCHED;
            PG8_LDB(B1, 0, 1); PG8_STAGE(PG8_SB(0, 0), b2, voffB);
            PG8_BAR; PG8_WAIT_L(0); PG8_MMA(0, 1, At, B1); PG8_BAR;
            PG8_LDA(At, 0, 1); PG8_STAGE(PG8_SA(0, 0), a2, voffA);
            PG8_BAR; PG8_WAIT_L(0); PG8_MMA(1, 0, At, B0); PG8_BAR; PG8_SCHED;
            PG8_STAGE(PG8_SB(0, 1), b2 + hstep, voffB);
            PG8_WAIT_V(6); PG8_BAR; PG8_MMA(1, 1, At, B1); PG8_BAR;
            PG8_LDB(B0, 1, 0); PG8_SCHED; PG8_LDA(At, 1, 0); PG8_STAGE(PG8_SA(0, 1), a2 + hstep, voffA);
            PG8_WAIT_L(8); PG8_BAR; PG8_WAIT_L(0); PG8_MMA(0, 0, At, B0); PG8_BAR; PG8_SCHED;
            PG8_LDB(B1, 1, 1); PG8_STAGE(PG8_SB(1, 0), b3, voffB);
            PG8_BAR; PG8_WAIT_L(0); PG8_MMA(0, 1, At, B1); PG8_BAR;
            PG8_LDA(At, 1, 1); PG8_STAGE(PG8_SA(1, 0), a3, voffA);
            PG8_BAR; PG8_WAIT_L(0); PG8_MMA(1, 0, At, B0); PG8_BAR; PG8_SCHED;
            PG8_STAGE(PG8_SB(1, 1), b3 + hstep, voffB);
            PG8_WAIT_V(6); PG8_BAR; PG8_MMA(1, 1, At, B1); PG8_BAR;
            }
        }
        if constexpr (ALIGN_EPI) { if (wr == 0) PG8_BAR; }
        if constexpr (!Epi::AFTER_DRAIN) { E(acc, cur, wr, wc, fr, fq); S.done(cur); }
        if (!has_next) break;
#pragma unroll
        for (int a = 0; a < 2; ++a)
#pragma unroll
            for (int b = 0; b < 2; ++b)
#pragma unroll
                for (int m = 0; m < 4; ++m)
#pragma unroll
                    for (int n = 0; n < 2; ++n) acc[a][b][m][n] = (f32x4){0.f, 0.f, 0.f, 0.f};
        cur = nxt; cA = nA; cB = nB; ++ui;
        if constexpr (ALIGN_EPI) { if (wr == 1) PG8_BAR; }
    }
    PG8_WAIT_V(0);
    if constexpr (!ALIGN_EPI) { if (wr == 0) PG8_BAR; }
    PG8_BAR;
    if constexpr (Epi::AFTER_DRAIN) { E.fused(acc, cur, wr, wc, fr, fq, lds, wid, lane); S.done(cur); }
#undef PG8_SA
#undef PG8_SB
#undef PG8_STAGE
#undef PG8_LDA
#undef PG8_LDB
#undef PG8_MMA
#undef PG8_WAIT_V
#undef PG8_WAIT_L
#undef PG8_BAR
#undef PG8_SCHED
}
}

constexpr int NWAVES = 8, NTHR = 512;
constexpr size_t MiB = 1u << 20;
constexpr size_t WS_CTL = 0, CTL_ZERO_BYTES = 64 * 1024;
constexpr size_t WS_MOD = 1 * MiB;
constexpr size_t WS_SHWIN = WS_MOD + 2 * 3 * 6144 * 4;
constexpr size_t WS_SHW13 = WS_SHWIN + 2 * 3 * PWP * 4;
constexpr size_t WS_ROPE = WS_SHW13 + 2 * 3 * FF2 * 4;
constexpr size_t WS_LG = WS_ROPE + (128 + 64) * 24 * 2 * 4;
constexpr size_t WS_CT256 = WS_LG + 256;
constexpr size_t WS_SSQ = 2 * MiB;
constexpr size_t WS_XC = 4 * MiB;
constexpr size_t WS_W = 6 * MiB;
constexpr size_t W_WIN = 0, W_WOUT = (size_t)PWP * DM * 2, W_W13 = W_WOUT + (size_t)DM * DM * 2, W_W2 = W_W13 + (size_t)FF2 * DM * 2, W_LAYER = W_W2 + (size_t)DM * FF * 2;
static_assert(W_LAYER * 2 == 49 * MiB, "weight region");
constexpr size_t WS_TAB = 55 * MiB;
constexpr size_t T_WFT = 0, T_TWA = 2 * 256 * 256 * 2, T_TD2 = T_TWA + 256 * 256 * 2, T_TW8 = T_TD2 + 64 * 128 * 2;
constexpr size_t WS_XN = 56 * MiB;
constexpr size_t WS_CAT = 89 * MiB;
constexpr size_t WS_PROJ = 122 * MiB;
constexpr size_t WS_STATE = 217 * MiB;
constexpr size_t WS_END = WS_STATE + (size_t)16 * 66 * 9216 * 4;
static_assert(WS_END <= 256 * MiB && WS_PROJ + (size_t)MTOT * PW * 2 <= WS_STATE && WS_CAT + (size_t)MTOT * DM * 2 <= WS_PROJ && WS_XN + (size_t)MTOT * DM * 2 <= WS_CAT, "d_ws map");
static_assert(WS_CT256 + 2048 <= WS_SSQ && WS_SSQ + (size_t)MTOT * 64 <= WS_XC && WS_TAB + T_TW8 + 65536 <= WS_XN, "d_ws map (small)");
constexpr int CW_BAR = 1024;
constexpr int LDS_BYTES = 163840, MISC_OFF = LDS_BYTES - 256;

#define RLX_AGENT __ATOMIC_RELAXED, __HIP_MEMORY_SCOPE_AGENT
#define XB_TMO      128
#define XB_XCNT(j)  (256  + 64 * (j))
#define XB_XSUB(j)  (1280 + 64 * (j))
#define XB_XGEN(j)  (2304 + 64 * (j))
#define XB_TOP      3328
#define XB_TOPGEN   3392
#define XCD_BAR_WORDS 3456
#define XB_SPIN_CAP (1u << 18)
static_assert((CW_BAR + XCD_BAR_WORDS) * 4 <= (int)CTL_ZERO_BYTES, "barrier words inside the memset region");
__device__ __forceinline__ unsigned xb_ld(unsigned* p)              { return __hip_atomic_load(p, __ATOMIC_RELAXED, __HIP_MEMORY_SCOPE_AGENT); }
__device__ __forceinline__ unsigned xb_add(unsigned* p, unsigned v) { return __hip_atomic_fetch_add(p, v, __ATOMIC_RELAXED, __HIP_MEMORY_SCOPE_AGENT); }
__device__ __forceinline__ unsigned xb_xcc_id() { return (unsigned)__builtin_amdgcn_s_getreg((3 << 11) | 20) & 0xFu; }
#define XB_SPIN(cond, bar) do { unsigned _sp = 0; while (cond) { __builtin_amdgcn_s_sleep(1); \
    if ((++_sp & 255u) == 0u) { if (xb_ld(&(bar)[XB_TMO])) break; if (_sp > XB_SPIN_CAP) { atomicAdd(&(bar)[XB_TMO], 1u); break; } } } } while (0)
struct XcdBarrier { unsigned* bar; unsigned x; volatile LAS unsigned* st; };
__device__ __forceinline__ XcdBarrier xcd_barrier_post(unsigned* bar, volatile LAS unsigned* st) {
    XcdBarrier b; b.bar = bar; b.x = xb_xcc_id(); b.st = st;
    if (threadIdx.x == 0) (void)xb_add(&bar[XB_XCNT(b.x)], 1u);
    return b;
}
__device__ __forceinline__ void xcd_barrier_complete(unsigned* bar, unsigned x, unsigned& nloc, unsigned& nx) {
    const unsigned G = gridDim.x * gridDim.y * gridDim.z;
    unsigned sum, cnt, mine, sp = 0u;
    for (;;) {
        sum = 0u; cnt = 0u; mine = 0u;
#pragma unroll
        for (unsigned j = 0; j < 16; ++j) { const unsigned c = xb_ld(&bar[XB_XCNT(j)]); sum += c; cnt += (c > 0u) ? 1u : 0u; mine = (j == x) ? c : mine; }
        if (sum == G) break;
        __builtin_amdgcn_s_sleep(1);
        if ((++sp & 255u) == 0u) { if (xb_ld(&bar[XB_TMO])) break; if (sp > XB_SPIN_CAP) { atomicAdd(&bar[XB_TMO], 1u); break; } }
    }
    nloc = mine > 0u ? mine : 1u; nx = cnt > 0u ? cnt : 1u;
}
__device__ __forceinline__ void xcd_barrier(const XcdBarrier& b) {
    asm volatile("s_waitcnt vmcnt(0)" ::: "memory");
    __syncthreads();
    if (threadIdx.x == 0) {
        unsigned* bar = b.bar;
        __builtin_amdgcn_s_waitcnt(0);
        unsigned nloc = b.st[0], nx = b.st[1];
        if (nloc == 0u) { xcd_barrier_complete(bar, b.x, nloc, nx); b.st[0] = nloc; b.st[1] = nx; }
        const unsigned old = xb_add(&bar[XB_XSUB(b.x)], 1u);
        const unsigned gen = old / nloc;
        if (old + 1u == (gen + 1u) * nloc) {
            __builtin_amdgcn_fence(__ATOMIC_RELEASE, "agent");
            asm volatile("s_waitcnt vmcnt(0)" ::: "memory");
            const unsigned og = xb_add(&bar[XB_TOP], 1u);
            const unsigned tg = og / nx;
            if (og + 1u == (tg + 1u) * nx) xb_add(&bar[XB_TOPGEN], 1u);
            else XB_SPIN(xb_ld(&bar[XB_TOPGEN]) == tg, bar);
            __builtin_amdgcn_fence(__ATOMIC_ACQUIRE, "agent");
            xb_add(&bar[XB_XGEN(b.x)], 1u);
            asm volatile("s_waitcnt vmcnt(0)" ::: "memory");
        } else {
            XB_SPIN(xb_ld(&bar[XB_XGEN(b.x)]) == gen, bar);
            __builtin_amdgcn_fence(__ATOMIC_ACQUIRE, "agent");
            asm volatile("s_waitcnt vmcnt(0)" ::: "memory");
        }
    }
    __syncthreads();
}

struct Frame {
    LAS unsigned char* lds;
    int tid, lane, wave, G, vcu;
    __device__ __forceinline__ void fresh() { int t = threadIdx.x; asm volatile("" : "+v"(t)); tid = t; lane = t & 63; wave = __builtin_amdgcn_readfirstlane(t >> 6); }
    const float *x, *c, *ctx, *c_ctx, *w_ada, *b_ada, *g_mix, *w_in, *dlogit, *ret_g, *w_four, *rpb, *w_out, *g_ffn, *w1, *w3, *w2, *g_final;
    float* out; unsigned char* ws;
    float *MOD, *SHWIN, *SHW13, *ROPE, *LG, *CT256, *SSQ, *XC, *STATE, *ADAP; const float* TW8;
    bf16_t *XN, *CAT, *PROJ, *HID, *WFT, *TWA, *TD2; unsigned* Y;
    __device__ __forceinline__ bf16_t* W(int layer, size_t off) const { return (bf16_t*)(ws + WS_W + (size_t)layer * W_LAYER + off); }
};

__device__ __forceinline__ float wave_sum(float v) {
#pragma unroll
    for (int o = 1; o < 64; o <<= 1) v += __shfl_xor(v, o);
    return v;
}

__device__ __forceinline__ bf16x8 ld8(LAS const unsigned char* p) { return *(LAS const bf16x8*)p; }
__device__ __forceinline__ bf16x8 ld8(const unsigned char* p) { return *(const bf16x8*)p; }
template <int MT, int NT, class PA, class PB>
__device__ __forceinline__ void wave_mma(f32x4 (&acc)[MT][NT], PA A, int lda, PB B, int ldb, int ksteps, int fr, int fq) {
    PA a0 = A + fr * lda + fq * 16; PB b0 = B + fr * ldb + fq * 16;
    for (int s = 0; s < ksteps; ++s) {
        bf16x8 a[MT], b[NT];
#pragma unroll
        for (int m = 0; m < MT; ++m) a[m] = ld8(a0 + m * 16 * lda + s * 64);
#pragma unroll
        for (int n = 0; n < NT; ++n) b[n] = ld8(b0 + n * 16 * ldb + s * 64);
#pragma unroll
        for (int m = 0; m < MT; ++m)
#pragma unroll
            for (int n = 0; n < NT; ++n) acc[m][n] = __builtin_amdgcn_mfma_f32_16x16x32_bf16(a[m], b[n], acc[m][n], 0, 0, 0);
    }
}
template <int MT, int NT> __device__ __forceinline__ void zero_acc(f32x4 (&acc)[MT][NT]) {
#pragma unroll
    for (int m = 0; m < MT; ++m)
#pragma unroll
        for (int n = 0; n < NT; ++n) acc[m][n] = (f32x4){0.f, 0.f, 0.f, 0.f};
}

#define LDS_WAIT() asm volatile("s_waitcnt lgkmcnt(0)" ::: "memory")
__device__ __forceinline__ void p0_transpose_item(const float* W, int ldw, int K, int nblk, bf16_t* WT, int mapkind, int roff, LAS float* scr, int item, int lane) {
    const int kb = item / nblk, nb = item % nblk, k0 = 64 * kb, n0 = 32 * nb;
#pragma unroll 8
    for (int i = 0; i < 32; ++i) { const int kk = 2 * i + (lane >> 5); scr[kk * 33 + (lane & 31)] = W[(size_t)(k0 + kk) * ldw + n0 + (lane & 31)]; }
    LDS_WAIT(); asm volatile("" ::: "memory");
    const int c = lane & 7;
#pragma unroll
    for (int j = 0; j < 4; ++j) { const int n = (lane >> 3) + 8 * j; const LAS float* s = scr + (8 * c) * 33 + n;
        u32x4 o; o.x = pk2(s[0 * 33], s[1 * 33]); o.y = pk2(s[2 * 33], s[3 * 33]); o.z = pk2(s[4 * 33], s[5 * 33]); o.w = pk2(s[6 * 33], s[7 * 33]);
        const int nn = n0 + n; const int row = mapkind == 0 ? roff + nn : ((nn >> 7) * 256 + (nn & 127) + (mapkind == 2 ? 128 : 0));
        *(u32x4*)(WT + (size_t)row * K + k0 + 8 * c) = o; }
    LDS_WAIT(); asm volatile("" ::: "memory");
}

__device__ __forceinline__ void phase_p0a(Frame& F) {
    F.fresh();
    const int tid = F.tid, lane = F.lane, wave = F.wave;
    if (blockIdx.x < 32) {
        LAS float* wt = (LAS float*)F.lds; LAS float* T = (LAS float*)(F.lds + 64 * 257 * 4);
        for (int e = tid; e < 4096; e += NTHR) { const int c = e >> 6, p = e & 63; float sv, cv;
            if (p <= 32) { sincospif((float)((p * c) & 63) * (1.0f / 32.0f), &sv, &cv); T[e] = cv; }
            else { sincospif((float)(((p - 32) * c) & 63) * (1.0f / 32.0f), &sv, &cv); T[e] = -sv; } }
        for (int it = blockIdx.x; it < 32; it += F.G) {
            const int l = it >> 4, k0 = (it & 15) * 64;
            __syncthreads();
            for (int e = tid; e < 64 * 256; e += NTHR) { const int kk = e >> 8, cc = e & 255; wt[kk * 257 + cc] = F.w_in[((size_t)l * DM + k0 + kk) * PW + cc]; }
            __syncthreads();
            const int k = tid & 63, cg0 = tid >> 6; bf16_t* WT = F.W(l, W_WIN);
            for (int i = 0; i < 32; ++i) { const int col = cg0 + 8 * i, g = col >> 6, p = col & 63; float a = 0.f;
#pragma unroll 8
                for (int c = 0; c < 64; ++c) a += wt[k * 257 + g * 64 + c] * T[c * 64 + p];
                WT[(size_t)col * DM + k0 + k] = (bf16_t)f2bf(a); }
        }
        __syncthreads();
    }
    LAS float* sc = (LAS float*)(F.lds + 131072);
    for (int e = tid; e < 3072; e += NTHR) { const int s = e >> 10, k = e & 1023; const float v = s < 2 ? F.c[s * DM + k] : F.c_ctx[k]; sc[e] = v / (1.0f + expf(-v)); }
    __syncthreads();
    const int gw = F.vcu * NWAVES + wave, NGW = F.G * NWAVES;
    for (int it = gw; it < 2 * 8 * 96; it += NGW) {
        const int l = it / 768, rem = it % 768, kc = rem / 96, cb = rem % 96, col = cb * 64 + lane;
        const float* wp = F.w_ada + ((size_t)l * DM + kc * 128) * 6144 + col; float a0 = 0.f, a1 = 0.f, a2 = 0.f;
#pragma unroll 8
        for (int k = 0; k < 128; ++k) { const float w = wp[(size_t)k * 6144]; const int kk = kc * 128 + k; a0 += sc[kk] * w; a1 += sc[1024 + kk] * w; a2 += sc[2048 + kk] * w; }
        float* o = F.ADAP + ((size_t)(l * 8 + kc) * 3) * 6144 + col; o[0] = a0; o[6144] = a1; o[2 * 6144] = a2;
    }
    LAS float* scr = (LAS float*)(F.lds + wave * 16384);
    constexpr int I0 = 16 * 84, I1 = 16 * 32, I2 = 16 * 88, I3 = I2, I4 = 44 * 32, I5 = 4 * 8, IL = I0 + I1 + I2 + I3 + I4 + I5;
    for (int it = gw; it < 2 * IL; it += NGW) {
        const int l = it / IL; int r = it % IL;
        if (r < I0) { p0_transpose_item(F.w_in + (size_t)l * DM * PW + 256, PW, DM, 84, F.W(l, W_WIN), 0, 256, scr, r, lane); continue; } r -= I0;
        if (r < I1) { p0_transpose_item(F.w_out + (size_t)l * DM * DM, DM, DM, 32, F.W(l, W_WOUT), 0, 0, scr, r, lane); continue; } r -= I1;
        if (r < I2) { p0_transpose_item(F.w1 + (size_t)l * DM * FF, FF, DM, 88, F.W(l, W_W13), 1, 0, scr, r, lane); continue; } r -= I2;
        if (r < I3) { p0_transpose_item(F.w3 + (size_t)l * DM * FF, FF, DM, 88, F.W(l, W_W13), 2, 0, scr, r, lane); continue; } r -= I3;
        if (r < I4) { p0_transpose_item(F.w2 + (size_t)l * FF * DM, DM, FF, 32, F.W(l, W_W2), 0, 0, scr, r, lane); continue; } r -= I4;
        p0_transpose_item(F.w_four + (size_t)l * 65536, 256, 256, 8, F.WFT + (size_t)l * 65536, 0, 0, scr, r, lane);
    }
    const int gt = F.vcu * NTHR + tid, GT = F.G * NTHR;
    for (int e = gt; e < 2 * 128 * 128; e += GT) { const int l = e >> 14, q = e & 16383; *(u32x4*)(F.W(l, W_WIN) + (size_t)PW * DM + (size_t)q * 8) = (u32x4){0u, 0u, 0u, 0u}; }
    for (int e = gt; e < 192 * 24; e += GT) { const int pos = e < 128 * 24 ? e / 24 : (e - 128 * 24) / 24, i = e % 24;
        const float inv = powf(10000.0f, -(float)i / 24.0f), ang = (float)pos * inv; F.ROPE[2 * e] = cosf(ang); F.ROPE[2 * e + 1] = sinf(ang); }
    for (int e = gt; e < 16; e += GT) { const float xv = F.dlogit[e]; F.LG[e] = -log1pf(expf(-xv)); }
    for (int e = gt; e < 256; e += GT) { float sv, cv; sincospif((float)e * (2.0f / 256.0f), &sv, &cv); F.CT256[2 * e] = cv; F.CT256[2 * e + 1] = sv; }
    for (int e = gt; e < 8192; e += GT) { float sv, cv; sincospif((float)e * (2.0f / 8192.0f), &sv, &cv); ((float*)F.TW8)[2 * e] = cv; ((float*)F.TW8)[2 * e + 1] = sv; }
    for (int e = gt; e < 65536; e += GT) { const int row = e >> 8, col = e & 255, k1 = row >> 1, ro = row & 1, l1 = col >> 1, ri = col & 1; float sv, cv;
        sincospif((float)((k1 * l1) & 127) * (2.0f / 128.0f), &sv, &cv); const float v = ro == 0 ? (ri == 0 ? cv : sv) : (ri == 0 ? -sv : cv); F.TWA[e] = (bf16_t)f2bf(v); }
    for (int e = gt; e < 8192; e += GT) { const int k2 = e >> 7, col = e & 127, l2 = col >> 1, ri = col & 1; float sv, cv;
        sincospif((float)((k2 * l2) & 63) * (2.0f / 64.0f), &sv, &cv); F.TD2[e] = (bf16_t)f2bf(ri == 0 ? cv : sv); }
}

__device__ __forceinline__ float ada_val(const Frame& F, int l, int s, int j) {
    const float* p = F.ADAP + ((size_t)(l * 8) * 3 + s) * 6144 + j; float a = 0.f;
#pragma unroll
    for (int kc = 0; kc < 8; ++kc) a += p[(size_t)kc * 3 * 6144];
    return a + F.b_ada[l * 6144 + j];
}
__device__ __forceinline__ void phase_p0b(Frame& F) {
    F.fresh();
    const int tid = F.tid, lane = F.lane, wave = F.wave;
    const int gt = F.vcu * NTHR + tid, GT = F.G * NTHR, gw = F.vcu * NWAVES + wave, NGW = F.G * NWAVES;
    for (int e = gt; e < 2 * 3 * 6144; e += GT) { const int l = e / 18432, s = (e / 6144) % 3, j = e % 6144; F.MOD[e] = ada_val(F, l, s, j); }
    LAS float* vec = (LAS float*)F.lds;
    for (int e = tid; e < 3072; e += NTHR) { const int s = e >> 10, k = e & 1023; vec[e] = F.g_mix[k] * (1.0f + ada_val(F, 0, s, 1024 + k)); }
    __syncthreads();
    for (int m = gw; m < MTOT; m += NGW) {
        const int set = m < SEQ ? 0 : (m < MLAT ? 1 : 2); const float* src = m < MLAT ? F.x + (size_t)m * DM : F.ctx + (size_t)(m - MLAT) * DM;
        f32x4 v[4]; float ss = 0.f;
#pragma unroll
        for (int j = 0; j < 4; ++j) { v[j] = *(const f32x4*)(src + 4 * lane + 256 * j); ss += (v[j][0] * v[j][0] + v[j][1] * v[j][1]) + (v[j][2] * v[j][2] + v[j][3] * v[j][3]); }
        ss = wave_sum(ss);
#pragma unroll
        for (int j = 0; j < 4; ++j) { const f32x4 g = *(LAS const f32x4*)(vec + set * 1024 + 4 * lane + 256 * j); const f32x4 o = v[j] * g;
            u32x2 w; w.x = pk2(o[0], o[1]); w.y = pk2(o[2], o[3]); *(u32x2*)(F.XN + (size_t)m * DM + 4 * lane + 256 * j) = w; }
        if (lane < 16) F.SSQ[(size_t)m * 16 + lane] = lane == 0 ? ss : 0.f;
    }
    for (int combo = 0; combo < 4; ++combo) {
        const int l = combo >> 1, which = combo & 1;
        __syncthreads();
        for (int e = tid; e < 3072; e += NTHR) { const int s = e >> 10, k = e & 1023; vec[e] = ada_val(F, l, s, (which ? 3072 : 0) + k); }
        __syncthreads();
        const int nrows = which ? FF2 : PWP; const bf16_t* Wt = F.W(l, which ? W_W13 : W_WIN); float* dstv = (which ? F.SHW13 : F.SHWIN) + (size_t)l * 3 * nrows;
        for (int r = gw; r < nrows; r += NGW) {
            float a0 = 0.f, a1 = 0.f, a2 = 0.f;
#pragma unroll
            for (int j = 0; j < 2; ++j) { const int k0 = lane * 8 + 512 * j; const u32x4 w = *(const u32x4*)(Wt + (size_t)r * DM + k0);
                const float wf[8] = {bflo(w.x), bfhi(w.x), bflo(w.y), bfhi(w.y), bflo(w.z), bfhi(w.z), bflo(w.w), bfhi(w.w)};
#pragma unroll
                for (int e = 0; e < 8; ++e) { a0 += wf[e] * vec[k0 + e]; a1 += wf[e] * vec[1024 + k0 + e]; a2 += wf[e] * vec[2048 + k0 + e]; } }
            a0 = wave_sum(a0); a1 = wave_sum(a1); a2 = wave_sum(a2);
            if (lane == 0) { dstv[r] = a0; dstv[nrows + r] = a1; dstv[2 * nrows + r] = a2; }
        }
    }
}
__device__ __forceinline__ void phase_final(Frame& F) {
    F.fresh();
    const int gw = F.vcu * NWAVES + F.wave, NGW = F.G * NWAVES, lane = F.lane;
    for (int m = gw; m < MLAT; m += NGW) {
        const float ri = pg8::row_rinv(F.SSQ, m); float* row = F.out + (size_t)m * DM;
#pragma unroll
        for (int j = 0; j < 4; ++j) { const int c = 4 * lane + 256 * j; const f32x4 v = *(const f32x4*)(row + c), g = *(const f32x4*)(F.g_final + c); *(f32x4*)(row + c) = v * g * ri; }
    }
}

typedef LAS const unsigned char* lptr;
typedef const unsigned char* gptr;
constexpr float LOG2E = 1.4426950408889634f;
template <class RowFn>
__device__ __forceinline__ void stage_T(LAS unsigned char* dst, int dstride, RowFn rowp, int nd, int nk, int wave, int lane) {
    const int ndb = nd / 16, total = ndb * (nk / 16), dl = lane & 7, kl = lane >> 3;
    for (int wi = wave; wi < total; wi += NWAVES) {
        const int dvb = wi % ndb, kpb = wi / ndb, dvp = dvb * 8 + dl, kp = kpb * 8 + kl;
        const unsigned a = *(const unsigned*)(rowp(2 * kp) + 2 * dvp), b = *(const unsigned*)(rowp(2 * kp + 1) + 2 * dvp);
        *(LAS unsigned*)(dst + (2 * dvp) * dstride + kp * 4) = (a & 0xffffu) | (b << 16);
        *(LAS unsigned*)(dst + (2 * dvp + 1) * dstride + kp * 4) = (a >> 16) | (b & 0xffff0000u);
    }
}
__device__ __forceinline__ bf16x8 pack8(const f32x4& a, const f32x4& b) { u32x4 w; w.x = pk2(a[0], a[1]); w.y = pk2(a[2], a[3]); w.z = pk2(b[0], b[1]); w.w = pk2(b[2], b[3]); return __builtin_bit_cast(bf16x8, w); }

constexpr int NA_KL = 0, NA_KC = 73728, NA_Q = 110592, NA_RPB = 119808, NA_VL = 0, NA_VC = 66560, NA_COMB = 122880, NA_VLS = 1040, NA_VCS = 528;
static_assert(NA_COMB + 8 * 4224 <= MISC_OFF, "NA LDS map");
__device__ __forceinline__ void na_unit(Frame& F, int layer, int b, int h, int r, bool ctxq) {
    F.fresh();
    const int tid = F.tid, lane = F.lane, wave = F.wave, fr = lane & 15, fq = lane >> 4;
    LAS unsigned char* lds = F.lds; const bf16_t* P = F.PROJ;
    const int rs = ctxq ? 0 : min(max(r - 4, 0), 120);
    const int tokq0 = ctxq ? MLAT + b * CTXL + r * 64 : b * SEQ + r * 64;
    __syncthreads();
    if (!ctxq) {
#pragma unroll
        for (int i = 0; i < 8; ++i) { const int e = tid + NTHR * i, key = e >> 3, ch = e & 7; const size_t tok = (size_t)b * SEQ + (rs + (key >> 6)) * 64 + (key & 63);
            *(LAS u32x4*)(lds + NA_KL + key * 144 + ch * 16) = *(const u32x4*)(P + tok * PW + C_NK + h * 64 + ch * 8); }
    }
#pragma unroll
    for (int i = 0; i < 4; ++i) { const int e = tid + NTHR * i, key = e >> 3, ch = e & 7; const size_t tok = (size_t)MLAT + b * CTXL + key;
        *(LAS u32x4*)(lds + NA_KC + key * 144 + ch * 16) = *(const u32x4*)(P + tok * PW + C_NK + h * 64 + ch * 8); }
    { const int q = tid >> 3, ch = tid & 7; *(LAS u32x4*)(lds + NA_Q + q * 144 + ch * 16) = *(const u32x4*)(P + (size_t)(tokq0 + q) * PW + C_NQ + h * 64 + ch * 8); }
    if (tid < 465) ((LAS float*)(lds + NA_RPB))[tid] = F.rpb[((size_t)layer * 6 + h) * 465 + tid];
    __syncthreads();
    const int jb = wave & 3, half = wave >> 2; const bool active = !(ctxq && half == 0);
    const int cstart = min(max(16 * jb - 8, 0), 32);
    bf16x8 pa[8]; float mx = -3.0e38f, lsum = 0.f;
    if (active) {
        f32x4 st[16];
        const bf16x8 qf0 = ld8((lptr)(lds + NA_Q + (jb * 16 + fr) * 144 + fq * 16)), qf1 = ld8((lptr)(lds + NA_Q + (jb * 16 + fr) * 144 + 64 + fq * 16));
#pragma unroll
        for (int t = 0; t < 16; ++t) {
            const int kidx = half == 0 ? (t >> 1) * 64 + cstart + 16 * (t & 1) + fr : 16 * t + fr;
            lptr kp = (lptr)(lds + (half == 0 ? NA_KL : NA_KC) + kidx * 144 + fq * 16);
            f32x4 z = {0.f, 0.f, 0.f, 0.f};
            z = __builtin_amdgcn_mfma_f32_16x16x32_bf16(ld8(kp), qf0, z, 0, 0, 0);
            st[t] = __builtin_amdgcn_mfma_f32_16x16x32_bf16(ld8(kp + 64), qf1, z, 0, 0, 0);
        }
        if (half == 0) {
            const int qc = jb * 16 + fr, wsx = min(max(qc - 8, 0), 48); LAS const float* rp = (LAS const float*)(lds + NA_RPB);
#pragma unroll
            for (int t = 0; t < 16; ++t) { const int dr = rs + (t >> 1) - r + 7;
#pragma unroll
                for (int reg = 0; reg < 4; ++reg) { const int kc = cstart + 16 * (t & 1) + 4 * fq + reg; const bool ok = kc >= wsx && kc < wsx + 16;
                    const int dc = min(max(kc - qc + 15, 0), 30); const float bias = rp[dr * 31 + dc];
                    st[t][reg] = ok ? (st[t][reg] * 0.125f + bias) * LOG2E : -1.0e30f; } }
        } else {
#pragma unroll
            for (int t = 0; t < 16; ++t) st[t] = st[t] * (0.125f * LOG2E);
        }
#pragma unroll
        for (int t = 0; t < 16; ++t) mx = fmaxf(mx, fmaxf(fmaxf(st[t][0], st[t][1]), fmaxf(st[t][2], st[t][3])));
        mx = fmaxf(mx, __shfl_xor(mx, 16)); mx = fmaxf(mx, __shfl_xor(mx, 32));
#pragma unroll
        for (int t = 0; t < 16; ++t)
#pragma unroll
            for (int reg = 0; reg < 4; ++reg) { const float p = __builtin_amdgcn_exp2f(st[t][reg] - mx); st[t][reg] = p; lsum += p; }
        lsum += __shfl_xor(lsum, 16); lsum += __shfl_xor(lsum, 32);
#pragma unroll
        for (int s = 0; s < 8; ++s) pa[s] = pack8(st[2 * s], st[2 * s + 1]);
    } else {
#pragma unroll
        for (int s = 0; s < 8; ++s) pa[s] = (bf16x8){0, 0, 0, 0, 0, 0, 0, 0};
    }
    __syncthreads();
    if (!ctxq) stage_T(lds + NA_VL, NA_VLS, [&](int k) { return P + ((size_t)b * SEQ + (rs + (k >> 6)) * 64 + (k & 63)) * PW + C_NV + h * 64; }, 64, 512, wave, lane);
    stage_T(lds + NA_VC, NA_VCS, [&](int k) { return P + ((size_t)MLAT + b * CTXL + k) * PW + C_NV + h * 64; }, 64, 256, wave, lane);
    __syncthreads();
    f32x4 o[4];
#pragma unroll
    for (int n = 0; n < 4; ++n) o[n] = (f32x4){0.f, 0.f, 0.f, 0.f};
    if (active) {
        lptr vb = (lptr)(lds + (half == 0 ? NA_VL : NA_VC)); const int vs = half == 0 ? NA_VLS : NA_VCS;
#pragma unroll
        for (int s = 0; s < 8; ++s) { const int k0 = half == 0 ? s * 64 + cstart : 32 * s;
#pragma unroll
            for (int n = 0; n < 4; ++n) { lptr rowb = vb + (n * 16 + fr) * vs + (k0 + 4 * fq) * 2;
                const bf16x4 lo = *(LAS const bf16x4*)rowb, hi = *(LAS const bf16x4*)(rowb + 32);
                const bf16x8 bv = {lo[0], lo[1], lo[2], lo[3], hi[0], hi[1], hi[2], hi[3]};
                o[n] = __builtin_amdgcn_mfma_f32_16x16x32_bf16(pa[s], bv, o[n], 0, 0, 0); } }
    }
    LAS float* cb = (LAS float*)(lds + NA_COMB + wave * 4224);
#pragma unroll
    for (int n = 0; n < 4; ++n)
#pragma unroll
        for (int reg = 0; reg < 4; ++reg) cb[(4 * fq + reg) * 64 + n * 16 + fr] = o[n][reg];
    if (fq == 0) { cb[1024 + 2 * fr] = mx; cb[1025 + 2 * fr] = lsum; }
    __syncthreads();
    if (wave < 4) {
        LAS const float* c2 = (LAS const float*)(lds + NA_COMB + (wave + 4) * 4224);
#pragma unroll
        for (int reg = 0; reg < 4; ++reg) { const int q = 4 * fq + reg;
            const float m1 = cb[1024 + 2 * q], l1 = cb[1025 + 2 * q], m2 = c2[1024 + 2 * q], l2 = c2[1025 + 2 * q], M = fmaxf(m1, m2);
            const float w1 = __builtin_amdgcn_exp2f(m1 - M), w2 = __builtin_amdgcn_exp2f(m2 - M), inv = 1.0f / (w1 * l1 + w2 * l2);
            bf16_t* orow = F.CAT + (size_t)(tokq0 + jb * 16 + q) * DM + 640 + h * 64;
#pragma unroll
            for (int n = 0; n < 4; ++n) orow[n * 16 + fr] = (bf16_t)f2bf((w1 * o[n][reg] + w2 * c2[q * 64 + n * 16 + fr]) * inv); }
    }
}

__device__ __forceinline__ int ret_row0(int b, int t) { return t >= 2 ? b * SEQ + (t - 2) * 128 : MLAT + b * CTXL + t * 128; }
constexpr int R1_VT = 0, R1_KF = 26112, R1_KB = 52224;
__device__ __forceinline__ void r1_unit(Frame& F, int layer, int b, int h, int t) {
    F.fresh();
    const int lane = F.lane, wave = F.wave, fr = lane & 15, fq = lane >> 4;
    LAS unsigned char* lds = F.lds; const bf16_t* P = F.PROJ;
    const bool lat = t >= 2; const int row0 = ret_row0(b, t);
    const float lgf = F.LG[layer * 8 + h], lgb = F.LG[layer * 8 + 4 + h], ks = 0.10206207261596575f;
    __syncthreads();
    stage_T(lds + R1_VT, 272, [&](int k) { return P + (size_t)(row0 + k) * PW + C_RV + h * 96; }, 96, 128, wave, lane);
    const int il = lane & 7, jl = lane >> 3;
    for (int wi = wave; wi < 24; wi += NWAVES) {
        const int i = (wi % 3) * 8 + il, jp = (wi / 3) * 8 + jl; float kv[2][4];
#pragma unroll
        for (int tk = 0; tk < 2; ++tk) { const int j = 2 * jp + tk; const bf16_t* kr = P + (size_t)(row0 + j) * PW + C_RK + h * 96;
            const float x1 = bf2f(kr[i]), x2 = bf2f(kr[i + 24]), y1 = bf2f(kr[48 + i]), y2 = bf2f(kr[72 + i]);
            if (lat) { const int pos = (t - 2) * 128 + j, prow = pos >> 6, pcol = pos & 63;
                const float cr = F.ROPE[(prow * 24 + i) * 2], sr = F.ROPE[(prow * 24 + i) * 2 + 1], cc = F.ROPE[(3072 + pcol * 24 + i) * 2], sc = F.ROPE[(3072 + pcol * 24 + i) * 2 + 1];
                kv[tk][0] = x1 * cr - x2 * sr; kv[tk][1] = x1 * sr + x2 * cr; kv[tk][2] = y1 * cc - y2 * sc; kv[tk][3] = y1 * sc + y2 * cc;
            } else { kv[tk][0] = x1; kv[tk][1] = x2; kv[tk][2] = y1; kv[tk][3] = y2; } }
        const float wf0 = expf(lgf * (float)(127 - 2 * jp)) * ks, wf1 = expf(lgf * (float)(126 - 2 * jp)) * ks, wb0 = expf(lgb * (float)(2 * jp)) * ks, wb1 = expf(lgb * (float)(2 * jp + 1)) * ks;
#pragma unroll
        for (int q = 0; q < 4; ++q) { const int d = q * 24 + i;
            *(LAS unsigned*)(lds + R1_KF + d * 272 + jp * 4) = pk2(kv[0][q] * wf0, kv[1][q] * wf1);
            *(LAS unsigned*)(lds + R1_KB + d * 272 + jp * 4) = pk2(kv[0][q] * wb0, kv[1][q] * wb1); }
    }
    __syncthreads();
    const int dir = wave >> 2, q = wave & 3, mb = q >> 1, nb = q & 1; f32x4 acc[3][3]; zero_acc(acc);
    wave_mma<3, 3>(acc, (lptr)(lds + R1_VT + mb * 48 * 272), 272, (lptr)(lds + (dir ? R1_KB : R1_KF) + nb * 48 * 272), 272, 4, fr, fq);
    const int u = dir == 0 ? t : (t < 2 ? 1 - t : 67 - t);
    float* ST = F.STATE + (size_t)(((b * 4 + h) * 2 + dir) * 66 + u) * 9216;
#pragma unroll
    for (int m = 0; m < 3; ++m)
#pragma unroll
        for (int n = 0; n < 3; ++n)
#pragma unroll
            for (int reg = 0; reg < 4; ++reg) ST[(mb * 48 + m * 16 + 4 * fq + reg) * 96 + nb * 48 + n * 16 + fr] = acc[m][n][reg];
}
__device__ __forceinline__ void r2_scan(Frame& F, int layer) {
    F.fresh();
    const int gt = F.vcu * NTHR + F.tid, GT = F.G * NTHR;
    for (int e = gt; e < 16 * 9216; e += GT) { const int combo = e / 9216, idx = e % 9216, h = (combo >> 1) & 3, dir = combo & 1;
        const float dcy = expf(128.0f * F.LG[layer * 8 + dir * 4 + h]); float* p = F.STATE + (size_t)combo * 66 * 9216 + idx; float s = 0.f;
        for (int u0 = 0; u0 < 66; u0 += 6) { float kv[6];
#pragma unroll
            for (int q = 0; q < 6; ++q) kv[q] = p[(size_t)(u0 + q) * 9216];
#pragma unroll
            for (int q = 0; q < 6; ++q) { p[(size_t)(u0 + q) * 9216] = s; s = dcy * s + kv[q]; } } }
}
constexpr int R3_Q = 0, R3_K = 26624, R3_VT = 53248, R3_P = 79360, R3_SF = 114176, R3_SB = 134144;
static_assert(R3_SB + 96 * 208 <= MISC_OFF, "R3 LDS map");
__device__ __forceinline__ void r3_unit(Frame& F, int layer, int b, int h, int t) {
    F.fresh();
    const int tid = F.tid, lane = F.lane, wave = F.wave, fr = lane & 15, fq = lane >> 4;
    LAS unsigned char* lds = F.lds; const bf16_t* P = F.PROJ;
    const bool lat = t >= 2; const int row0 = ret_row0(b, t);
    const float lf2 = F.LG[layer * 8 + h] * LOG2E, lb2 = F.LG[layer * 8 + 4 + h] * LOG2E, ks = 0.10206207261596575f;
    __syncthreads();
    for (int e = tid; e < 1536; e += NTHR) { const int ip = e % 12, j = e / 12, i = 2 * ip;
        f32x4 cr = {1.f, 0.f, 1.f, 0.f}, cc = {1.f, 0.f, 1.f, 0.f};
        if (lat) { const int pos = (t - 2) * 128 + j, prow = pos >> 6, pcol = pos & 63; cr = *(const f32x4*)(F.ROPE + (prow * 24 + i) * 2); cc = *(const f32x4*)(F.ROPE + (3072 + pcol * 24 + i) * 2); }
#pragma unroll
        for (int X = 0; X < 2; ++X) { const bf16_t* xr = P + (size_t)(row0 + j) * PW + (X ? C_RK : C_RQ) + h * 96; const float scl = X ? ks : 1.0f;
            const unsigned u0 = *(const unsigned*)(xr + i), u1 = *(const unsigned*)(xr + i + 24), u2 = *(const unsigned*)(xr + 48 + i), u3 = *(const unsigned*)(xr + 72 + i);
            const float x1a = bflo(u0), x1b = bfhi(u0), x2a = bflo(u1), x2b = bfhi(u1), y1a = bflo(u2), y1b = bfhi(u2), y2a = bflo(u3), y2b = bfhi(u3);
            LAS unsigned char* dst = lds + (X ? R3_K : R3_Q) + j * 208 + i * 2;
            *(LAS unsigned*)(dst) = pk2((x1a * cr[0] - x2a * cr[1]) * scl, (x1b * cr[2] - x2b * cr[3]) * scl);
            *(LAS unsigned*)(dst + 48) = pk2((x1a * cr[1] + x2a * cr[0]) * scl, (x1b * cr[3] + x2b * cr[2]) * scl);
            *(LAS unsigned*)(dst + 96) = pk2((y1a * cc[0] - y2a * cc[1]) * scl, (y1b * cc[2] - y2b * cc[3]) * scl);
            *(LAS unsigned*)(dst + 144) = pk2((y1a * cc[1] + y2a * cc[0]) * scl, (y1b * cc[3] + y2b * cc[2]) * scl); }
    }
    stage_T(lds + R3_VT, 272, [&](int k) { return P + (size_t)(row0 + k) * PW + C_RV + h * 96; }, 96, 128, wave, lane);
    const int ub = t < 2 ? 1 - t : 67 - t;
#pragma unroll
    for (int dir = 0; dir < 2; ++dir) { const float* S = F.STATE + (size_t)(((b * 4 + h) * 2 + dir) * 66 + (dir ? ub : t)) * 9216;
        for (int e = tid; e < 2304; e += NTHR) { const int dv = e / 24, d4 = e % 24; const f32x4 v = *(const f32x4*)(S + dv * 96 + d4 * 4);
            u32x2 w; w.x = pk2(v[0], v[1]); w.y = pk2(v[2], v[3]); *(LAS u32x2*)(lds + (dir ? R3_SB : R3_SF) + dv * 208 + d4 * 8) = w; } }
    __syncthreads();
    {
        bf16x8 qf[3];
#pragma unroll
        for (int s = 0; s < 3; ++s) qf[s] = ld8((lptr)(lds + R3_Q + (wave * 16 + fr) * 208 + s * 64 + fq * 16));
        const int i = wave * 16 + fr;
#pragma unroll
        for (int m = 0; m < 8; ++m) { f32x4 a = {0.f, 0.f, 0.f, 0.f};
#pragma unroll
            for (int s = 0; s < 3; ++s) a = __builtin_amdgcn_mfma_f32_16x16x32_bf16(ld8((lptr)(lds + R3_K + (m * 16 + fr) * 208 + s * 64 + fq * 16)), qf[s], a, 0, 0, 0);
            float pv[4];
#pragma unroll
            for (int reg = 0; reg < 4; ++reg) { const int diff = i - (m * 16 + 4 * fq + reg);
                const float dec = diff > 0 ? __builtin_amdgcn_exp2f(lf2 * (float)diff) : (diff < 0 ? __builtin_amdgcn_exp2f(lb2 * (float)(-diff)) : 2.0f); pv[reg] = a[reg] * dec; }
            u32x2 w; w.x = pk2(pv[0], pv[1]); w.y = pk2(pv[2], pv[3]); *(LAS u32x2*)(lds + R3_P + i * 272 + (m * 16 + 4 * fq) * 2) = w; }
    }
    asm volatile("s_waitcnt lgkmcnt(0)" ::: "memory");
    f32x4 ao[1][6], af[1][6], ab[1][6]; zero_acc(ao); zero_acc(af); zero_acc(ab);
    wave_mma<1, 6>(ao, (lptr)(lds + R3_P + wave * 16 * 272), 272, (lptr)(lds + R3_VT), 272, 4, fr, fq);
    wave_mma<1, 6>(af, (lptr)(lds + R3_Q + wave * 16 * 208), 208, (lptr)(lds + R3_SF), 208, 3, fr, fq);
    wave_mma<1, 6>(ab, (lptr)(lds + R3_Q + wave * 16 * 208), 208, (lptr)(lds + R3_SB), 208, 3, fr, fq);
    const float* gain = F.ret_g + layer * 384 + h * 96;
#pragma unroll
    for (int reg = 0; reg < 4; ++reg) { const int il = wave * 16 + 4 * fq + reg;
        const float qdf = __builtin_amdgcn_exp2f(lf2 * (float)(il + 1)), qdb = __builtin_amdgcn_exp2f(lb2 * (float)(128 - il)); float ov[6], ss = 0.f;
#pragma unroll
        for (int n = 0; n < 6; ++n) { ov[n] = ao[0][n][reg] + qdf * af[0][n][reg] + qdb * ab[0][n][reg]; ss += ov[n] * ov[n]; }
        ss += __shfl_xor(ss, 1); ss += __shfl_xor(ss, 2); ss += __shfl_xor(ss, 4); ss += __shfl_xor(ss, 8);
        const float rn = rsqrtf(ss * (1.0f / 96.0f) + NORM_EPS); const size_t row = (size_t)(row0 + il);
#pragma unroll
        for (int n = 0; n < 6; ++n) { const int col = n * 16 + fr; const float gt = bf2f(P[row * PW + C_RG + h * 96 + col]);
            F.CAT[row * DM + 256 + h * 96 + col] = (bf16_t)f2bf(ov[n] * rn * gain[col] * silu_f(gt)); } }
}

__device__ __forceinline__ void d1_unit(Frame& F, int b, int l2, int g) {
    F.fresh();
    const int lane = F.lane, wave = F.wave, fr = lane & 15, fq = lane >> 4;
    LAS unsigned char* lds = F.lds; const bf16_t* P = F.PROJ;
    __syncthreads();
    const int ml = lane & 7, ll = lane >> 3;
    for (int wi = wave; wi < 128; wi += NWAVES) { const int m = (wi & 7) * 8 + ml, l1 = (wi >> 3) * 8 + ll;
        const bf16_t* base = P + ((size_t)b * SEQ + l1 * 64 + l2) * PW + g * 64;
        const unsigned hr = base[m <= 32 ? m : 64 - m]; unsigned hi;
        if (m == 0 || m == 32) hi = 0u; else if (m < 32) hi = base[32 + m]; else hi = (unsigned)base[96 - m] ^ 0x8000u;
        *(LAS unsigned*)(lds + m * 528 + l1 * 4) = hr | (hi << 16); }
    __syncthreads();
    f32x4 acc[2][4]; zero_acc(acc);
    wave_mma<2, 4>(acc, (gptr)F.TWA + (size_t)(wave * 32) * 512, 512, (lptr)lds, 528, 8, fr, fq);
#pragma unroll
    for (int mt = 0; mt < 2; ++mt)
#pragma unroll
        for (int nt = 0; nt < 4; ++nt)
#pragma unroll
            for (int pr = 0; pr < 2; ++pr) { const int k1 = wave * 16 + mt * 8 + 2 * fq + pr, m = nt * 16 + fr; const float yr = acc[mt][nt][2 * pr], yi = acc[mt][nt][2 * pr + 1];
                const f32x2 cs = *(const f32x2*)(F.TW8 + 2 * (k1 * l2));
                F.Y[((((size_t)b * 128 + k1) * 4 + g) * 64 + m) * 64 + l2] = pk2(yr * cs[0] + yi * cs[1], yi * cs[0] - yr * cs[1]); }
}
constexpr int D2_Y = 0, D2_A = 69632, D2_F = 87040;
__device__ __forceinline__ void d2_unit(Frame& F, int layer, int b, int k1) {
    F.fresh();
    const int tid = F.tid, lane = F.lane, wave = F.wave, fr = lane & 15, fq = lane >> 4;
    LAS unsigned char* lds = F.lds;
    __syncthreads();
    const unsigned* ysrc = F.Y + (size_t)(b * 128 + k1) * 4 * 64 * 64;
    for (int e = tid; e < 4096; e += NTHR) { const int row = e >> 4, ch = e & 15; *(LAS u32x4*)(lds + D2_Y + row * 272 + ch * 16) = *(const u32x4*)(ysrc + row * 64 + ch * 4); }
    for (int e = tid; e < 1024; e += NTHR) { const int row = e >> 4, ch = e & 15; *(LAS u32x4*)(lds + D2_A + row * 272 + ch * 16) = *(const u32x4*)(F.TD2 + row * 128 + ch * 8); }
    __syncthreads();
    f32x4 acc[4][2]; zero_acc(acc);
    wave_mma<4, 2>(acc, (lptr)(lds + D2_A), 272, (lptr)(lds + D2_Y + wave * 32 * 272), 272, 4, fr, fq);
    const float scale = 0.0013810679320049757f;
#pragma unroll
    for (int mt = 0; mt < 4; ++mt)
#pragma unroll
        for (int nt = 0; nt < 2; ++nt)
#pragma unroll
            for (int reg = 0; reg < 4; ++reg) *(LAS bf16_t*)(lds + D2_F + (mt * 16 + 4 * fq + reg) * 528 + (wave * 32 + nt * 16 + fr) * 2) = (bf16_t)f2bf(acc[mt][nt][reg] * scale);
    __syncthreads();
    zero_acc(acc);
    wave_mma<4, 2>(acc, (lptr)(lds + D2_F), 528, (gptr)(F.WFT + (size_t)layer * 65536) + (size_t)(wave * 32) * 512, 512, 8, fr, fq);
#pragma unroll
    for (int mt = 0; mt < 4; ++mt)
#pragma unroll
        for (int nt = 0; nt < 2; ++nt)
#pragma unroll
            for (int reg = 0; reg < 4; ++reg) { const int k2 = mt * 16 + 4 * fq + reg, oc = wave * 32 + nt * 16 + fr;
                F.CAT[((size_t)b * SEQ + k1 + 128 * k2) * DM + oc] = (bf16_t)f2bf(acc[mt][nt][reg]); }
}
__device__ __forceinline__ void dctx_item(Frame& F, int layer, int ip) {
    F.fresh();
    const int tid = F.tid; LAS float* ct = (LAS float*)F.lds; LAS float* fv = ct + 512; const bf16_t* P = F.PROJ;
    __syncthreads();
    ct[tid] = F.CT256[tid];
    __syncthreads();
    const int tk = ip * 2 + (tid >> 8), b = tk >> 8, k = tk & 255, ch = tid & 255, g = ch >> 6, m = ch & 63;
    const int pr = m <= 32 ? m : 64 - m, pi = (m == 0 || m == 32) ? -1 : (m < 32 ? 32 + m : 96 - m); const float sgn = m > 32 ? -1.0f : 1.0f;
    float a = 0.f;
    for (int l = 0; l < 256; ++l) { const bf16_t* base = P + ((size_t)MLAT + b * CTXL + l) * PW + g * 64;
        const float hr = bf2f(base[pr]), hi = pi >= 0 ? sgn * bf2f(base[pi]) : 0.f; const int j = (k * l) & 255; a += ct[2 * j] * hr + ct[2 * j + 1] * hi; }
    fv[tid] = a * (1.0f / 128.0f);
    __syncthreads();
    const float* wf = F.w_four + (size_t)layer * 65536 + ch; LAS const float* fr_ = fv + (tid >> 8) * 256; float o = 0.f;
#pragma unroll 8
    for (int c = 0; c < 256; ++c) o += fr_[c] * wf[(size_t)c * 256];
    F.CAT[((size_t)MLAT + b * CTXL + k) * DM + ch] = (bf16_t)f2bf(o);
}

__device__ __forceinline__ void phase_m1(Frame& F, int layer) {
    const int nNA = 1536, nCQ = layer == 0 ? 48 : 0, nR1 = 528, nD1 = 512, total = nNA + nCQ + nR1 + nD1;
    for (int it = blockIdx.x; it < total; it += F.G) {
        if (it < nNA) { na_unit(F, layer, it / 768, (it % 768) / 128, it % 128, false); continue; }
        int q = it - nNA;
        if (q < nCQ) { na_unit(F, layer, q / 24, (q % 24) / 4, q & 3, true); continue; } q -= nCQ;
        if (q < nR1) { r1_unit(F, layer, q / 264, (q % 264) / 66, q % 66); continue; } q -= nR1;
        d1_unit(F, q >> 8, (q >> 2) & 63, q & 3);
    }
}
__device__ __forceinline__ void phase_m2(Frame& F, int layer) {
    r2_scan(F, layer);
    const int nD2 = 256, nDC = layer == 0 ? 256 : 0;
    for (int it = blockIdx.x; it < nD2 + nDC; it += F.G) { if (it < nD2) d2_unit(F, layer, it >> 7, it & 127); else dctx_item(F, layer, it - nD2); }
}
__device__ __forceinline__ void phase_m3(Frame& F, int layer) {
    const int nt = layer == 0 ? 66 : 64, t0 = layer == 0 ? 0 : 2, total = 8 * nt;
    for (int it = blockIdx.x; it < total; it += F.G) r3_unit(F, layer, it / (4 * nt), (it / nt) & 3, t0 + it % nt);
}

#ifndef MK_N_LAUNCHES
#define MK_N_LAUNCHES 1
#endif
constexpr int N_PHASES = 17;
struct Args { const float* in[18]; float* out; unsigned char* ws; int ph_lo, ph_hi; };
__global__ void __launch_bounds__(NTHR, 2) hymba_fwd(Args args) {
    extern __shared__ __attribute__((aligned(16))) unsigned char lds_raw[];
    Frame F;
    F.lds = (LAS unsigned char*)lds_raw;
    F.tid = threadIdx.x; F.lane = F.tid & 63; F.wave = __builtin_amdgcn_readfirstlane(F.tid >> 6);
    F.G = gridDim.x; { const int bx = blockIdx.x; F.vcu = (F.G % 8 == 0) ? (bx % 8) * (F.G / 8) + bx / 8 : bx; }
    F.x = args.in[0]; F.c = args.in[1]; F.ctx = args.in[2]; F.c_ctx = args.in[3]; F.w_ada = args.in[4]; F.b_ada = args.in[5]; F.g_mix = args.in[6]; F.w_in = args.in[7];
    F.dlogit = args.in[8]; F.ret_g = args.in[9]; F.w_four = args.in[10]; F.rpb = args.in[11]; F.w_out = args.in[12]; F.g_ffn = args.in[13]; F.w1 = args.in[14]; F.w3 = args.in[15];
    F.w2 = args.in[16]; F.g_final = args.in[17]; F.out = args.out; F.ws = args.ws;
    unsigned char* ws = args.ws;
    F.MOD = (float*)(ws + WS_MOD); F.SHWIN = (float*)(ws + WS_SHWIN); F.SHW13 = (float*)(ws + WS_SHW13); F.ROPE = (float*)(ws + WS_ROPE); F.LG = (float*)(ws + WS_LG); F.CT256 = (float*)(ws + WS_CT256);
    F.SSQ = (float*)(ws + WS_SSQ); F.XC = (float*)(ws + WS_XC); F.STATE = (float*)(ws + WS_STATE); F.ADAP = (float*)(ws + WS_PROJ); F.TW8 = (const float*)(ws + WS_TAB + T_TW8);
    F.XN = (bf16_t*)(ws + WS_XN); F.CAT = (bf16_t*)(ws + WS_CAT); F.PROJ = (bf16_t*)(ws + WS_PROJ); F.HID = (bf16_t*)(ws + WS_PROJ);
    F.WFT = (bf16_t*)(ws + WS_TAB + T_WFT); F.TWA = (bf16_t*)(ws + WS_TAB + T_TWA); F.TD2 = (bf16_t*)(ws + WS_TAB + T_TD2); F.Y = (unsigned*)(ws + WS_XN);
    volatile LAS unsigned* MISC = (volatile LAS unsigned*)(F.lds + MISC_OFF);
    if (F.tid < 64) MISC[F.tid] = 0u;
    __syncthreads();
    const int lo = args.ph_lo, hi = args.ph_hi;
#if MK_N_LAUNCHES == 1
    XcdBarrier bar = xcd_barrier_post((unsigned*)(ws + WS_CTL) + CW_BAR, MISC + 8);
    cg::grid_group grid = cg::this_grid();
#define SEAM(k) do { if ((k) == 0) grid.sync(); else xcd_barrier(bar); } while (0)
#else
#define SEAM(k) do { } while (0)
#endif
#define IN(k) (lo <= (k) && (k) < hi)
    if (IN(0)) { phase_p0a(F); if (IN(1)) SEAM(0); }
    if (IN(1)) { phase_p0b(F); if (IN(2)) SEAM(1); }
#pragma unroll 1
    for (int layer = 0; layer < 2; ++layer) {
        const int pb = 2 + 7 * layer; const bool last = layer == 1;
        const float* mod = F.MOD + (size_t)layer * 3 * 6144;
        if (IN(pb + 0)) {
            pg8::Gemm g{F.XN, F.W(layer, W_WIN), MTOT, PWP, DM}; pg8::StaticOrder S; S.init(MTOT, PWP, F.G, (int)blockIdx.x);
            pg8::EpiProj E{F.PROJ, F.SSQ, F.SHWIN + (size_t)layer * 3 * PWP};
            pg8::gemm_phase<pg8::EpiProj, pg8::StaticOrder, true, true>(F.lds, g, S, E);
            if (IN(pb + 1)) SEAM(pb);
        }
        if (IN(pb + 1)) { phase_m1(F, layer); if (IN(pb + 2)) SEAM(pb + 1); }
        if (IN(pb + 2)) { phase_m2(F, layer); if (IN(pb + 3)) SEAM(pb + 2); }
        if (IN(pb + 3)) { phase_m3(F, layer); if (IN(pb + 4)) SEAM(pb + 3); }
        const int Mrows = last ? MLAT : MTOT;
        if (IN(pb + 4)) {
            pg8::Gemm g{F.CAT, F.W(layer, W_WOUT), Mrows, DM, DM}; pg8::StaticOrder S; S.init(Mrows, DM, F.G, (int)blockIdx.x);
            pg8::EpiRes E{last ? F.out : F.x, last ? F.XC : F.ctx, F.out, F.XC, F.XN, F.SSQ, mod + 2048, mod + 4096, F.g_ffn + layer * DM};
            pg8::gemm_phase<pg8::EpiRes, pg8::StaticOrder, true, true>(F.lds, g, S, E);
            if (IN(pb + 5)) SEAM(pb + 4);
        }
        if (IN(pb + 5)) {
            pg8::Gemm g{F.XN, F.W(layer, W_W13), Mrows, FF2, DM}; pg8::StaticOrder S; S.init(Mrows, FF2, F.G, (int)blockIdx.x);
            pg8::EpiSwiGLU E{F.HID, F.SSQ, F.SHW13 + (size_t)layer * 3 * FF2};
            pg8::gemm_phase<pg8::EpiSwiGLU, pg8::StaticOrder, true, true>(F.lds, g, S, E);
            if (IN(pb + 6)) SEAM(pb + 5);
        }
        if (IN(pb + 6)) {
            pg8::Gemm g{F.HID, F.W(layer, W_W2), Mrows, DM, FF}; pg8::StaticOrder S; S.init(Mrows, DM, F.G, (int)blockIdx.x);
            pg8::EpiRes E{F.out, F.XC, F.out, F.XC, last ? nullptr : F.XN, F.SSQ, mod + 5120, F.MOD + 3 * 6144 + 1024, F.g_mix + DM};
            pg8::gemm_phase<pg8::EpiRes, pg8::StaticOrder, true, true>(F.lds, g, S, E);
            if (IN(pb + 7)) SEAM(pb + 6);
        }
    }
    if (IN(16)) phase_final(F);
#undef IN
#undef SEAM
}

extern "C" void kernel_launch(void* const* d_in, const int* in_sizes, int n_in, void* d_out, int out_size, void* d_ws, size_t ws_size, hipStream_t stream) {
    static int grid = 0;
    if (grid == 0) {
        if (n_in != 18 || in_sizes[0] != MLAT * DM || out_size != MLAT * DM || ws_size < WS_END) {
            fprintf(stderr, "kernel_launch: built for 18 inputs, x/out of %d floats, >= %zu bytes of workspace; got n_in %d, in0 %d, out %d, ws %zu\n", MLAT * DM, (size_t)WS_END, n_in, n_in > 0 ? in_sizes[0] : -1, out_size, ws_size); grid = -1; return; }
        int dev = 0, cus = 0, per_cu = 0;
        if (hipGetDevice(&dev) != hipSuccess || hipDeviceGetAttribute(&cus, hipDeviceAttributeMultiprocessorCount, dev) != hipSuccess) { fprintf(stderr, "kernel_launch: device query failed\n"); grid = -1; return; }
        if (hipFuncSetAttribute((const void*)hymba_fwd, hipFuncAttributeMaxDynamicSharedMemorySize, LDS_BYTES) != hipSuccess) { fprintf(stderr, "kernel_launch: hipFuncSetAttribute failed\n"); grid = -1; return; }
        if (hipOccupancyMaxActiveBlocksPerMultiprocessor(&per_cu, (const void*)hymba_fwd, NTHR, LDS_BYTES) != hipSuccess || per_cu < 1) { fprintf(stderr, "kernel_launch: occupancy query says %d blocks per CU\n", per_cu); (void)hipGetLastError(); grid = -1; return; }
        grid = cus;
        fprintf(stderr, "kernel_launch: grid %d (cus %d, occupancy %d/CU), ws %zu\n", grid, cus, per_cu, ws_size);
    }
    if (grid < 0) return;
    if (hipMemsetAsync((char*)d_ws + WS_CTL, 0, CTL_ZERO_BYTES, stream) != hipSuccess) { fprintf(stderr, "kernel_launch: memset failed\n"); return; }
    Args a{};
    for (int i = 0; i < 18; ++i) a.in[i] = (const float*)d_in[i];
    a.out = (float*)d_out; a.ws = (unsigned char*)d_ws;
#if MK_N_LAUNCHES == 1
    a.ph_lo = 0; a.ph_hi = N_PHASES;
    void* kargs[] = {&a};
    const hipError_t le = hipLaunchCooperativeKernel((const void*)hymba_fwd, dim3(grid), dim3(NTHR), kargs, LDS_BYTES, stream);
    if (le != hipSuccess) fprintf(stderr, "kernel_launch: cooperative launch failed: %s (grid %d)\n", hipGetErrorString(le), grid);
#else
    for (int p = 0; p < N_PHASES; ++p) { a.ph_lo = p; a.ph_hi = p + 1; hipLaunchKernelGGL(hymba_fwd, dim3(grid), dim3(NTHR), LDS_BYTES, stream, a); }
#endif
}
```

```cpp
#include <hip/hip_runtime.h>
#include <hip/hip_cooperative_groups.h>
#include <cstdio>
#include <cstdint>
namespace cg = cooperative_groups;

#define LAS __attribute__((address_space(3)))
#define GAS __attribute__((address_space(1)))
typedef unsigned short bf16_t;
typedef short bf16x8 __attribute__((ext_vector_type(8)));
typedef short bf16x4 __attribute__((ext_vector_type(4)));
typedef float f32x4 __attribute__((ext_vector_type(4)));
typedef float f32x2 __attribute__((ext_vector_type(2)));
typedef unsigned u32x4 __attribute__((ext_vector_type(4)));
typedef unsigned u32x2 __attribute__((ext_vector_type(2)));

__device__ __forceinline__ unsigned f2bf(float f) { unsigned u = __builtin_bit_cast(unsigned, f); return (u + 0x7fffu + ((u >> 16) & 1u)) >> 16; }
__device__ __forceinline__ unsigned pk2(float lo, float hi) { return f2bf(lo) | (f2bf(hi) << 16); }
__device__ __forceinline__ float bf2f(unsigned h) { return __builtin_bit_cast(float, h << 16); }
__device__ __forceinline__ float bflo(unsigned w) { return __builtin_bit_cast(float, w << 16); }
__device__ __forceinline__ float bfhi(unsigned w) { return __builtin_bit_cast(float, w & 0xffff0000u); }
__device__ __forceinline__ float silu_f(float a) { return a * __builtin_amdgcn_rcpf(1.0f + __expf(-a)); }

constexpr int NB = 2, SEQ = 8192, DM = 1024, CTXL = 256, MLAT = NB * SEQ, MCTX = NB * CTXL, MTOT = MLAT + MCTX;
constexpr int PW = 2944, PWP = 3072, FF = 2816, FF2 = 5632;
constexpr int C_RQ = 256, C_RK = 640, C_RV = 1024, C_RG = 1408, C_NQ = 1792, C_NK = 2176, C_NV = 2560;
constexpr float NORM_EPS = 1e-6f;

namespace pg8 {
#define PG8_LAS __attribute__((address_space(3)))
constexpr int BM = 256, BK = 64, HALF = 128, HTB = HALF * BK * 2, STAGE_BYTES = 8 * HTB, NXCD = 8, WGM = 8;
__host__ __device__ __forceinline__ int lds_byte(int r, int c) { const int st = (r >> 4) * 2 + (c >> 5), rr = r & 15, cc = c & 31, ob = rr * 64 + cc * 2; return st * 1024 + (ob ^ (((ob >> 9) & 1) << 5)); }
__host__ __device__ __forceinline__ void stage_rc(int b, int& R, int& C) { const int st = b / 1024, sb = b % 1024, swz = sb ^ (((sb >> 9) & 1) << 5); R = (st >> 1) * 16 + swz / 64; C = (st & 1) * 32 + (swz % 64) / 2; }
__host__ __device__ __forceinline__ int perm32(int rho) { const int n = rho >> 4, i = rho & 15; return 8 * (i >> 2) + 4 * n + (i & 3); }
struct Unit { int pm, pn; };
struct Gemm { const bf16_t* A; const bf16_t* Bt; int M, N, K; };
struct StaticOrder {
    int nM, nN, nwg, G, c;
    __host__ __device__ void init(int M, int N, int G_, int c_) { nM = M / BM; nN = N / BM; nwg = nM * nN; G = G_; c = c_; }
    __host__ __device__ bool next(int i, Unit& u) const {
        const long L = (long)i * G + c; if (L >= nwg) return false;
        int wgid = (int)L; { const int q = nwg / NXCD, r = nwg % NXCD, xcd = wgid % NXCD, off = wgid / NXCD; wgid = (xcd < r ? xcd * (q + 1) : r * (q + 1) + (xcd - r) * q) + off; }
        const int nig = WGM * nN, gid = wgid / nig, fm = gid * WGM, gsz = (nM - fm) < WGM ? (nM - fm) : WGM;
        u.pm = fm + ((wgid % nig) % gsz); u.pn = (wgid % nig) / gsz; return true;
    }
    __device__ __forceinline__ void a_ready(const Unit&) const {}
    __device__ __forceinline__ void done(const Unit&) const {}
};
__device__ __forceinline__ unsigned cvt_pk_bf16(float lo, float hi) { unsigned r; asm volatile("v_cvt_pk_bf16_f32 %0, %1, %2" : "=v"(r) : "v"(lo), "v"(hi)); return r; }

__device__ __forceinline__ float row_rinv(const float* ssq, int row) {
    const f32x4* p = (const f32x4*)(ssq + (size_t)row * 16);
    const f32x4 a = p[0], b = p[1], c = p[2], d = p[3];
    const float s = (((a[0] + a[1]) + (a[2] + a[3])) + ((b[0] + b[1]) + (b[2] + b[3]))) + (((c[0] + c[1]) + (c[2] + c[3])) + ((d[0] + d[1]) + (d[2] + d[3])));
    return rsqrtf(s * (1.0f / 1024.0f) + NORM_EPS);
}
__device__ __forceinline__ int row_set(int pm) { return pm < 32 ? 0 : (pm < 64 ? 1 : 2); }

struct EpiProj {
    static constexpr bool PERM = true, AFTER_DRAIN = false;
    bf16_t* O; const float* ssq; const float* shw;
    __device__ __forceinline__ void operator()(const f32x4 (&acc)[2][2][4][2], const Unit& u, int wr, int wc, int fr, int fq) const {
        const int row0 = u.pm * BM + wr * 64 + fr, col0 = u.pn * BM + wc * 32 + 8 * fq; const int set = row_set(u.pm);
        f32x4 bv[2][2];
#pragma unroll
        for (int bj = 0; bj < 2; ++bj)
#pragma unroll
            for (int n = 0; n < 2; ++n) bv[bj][n] = *(const f32x4*)(shw + set * PWP + col0 + bj * HALF + 4 * n);
#pragma unroll
        for (int ai = 0; ai < 2; ++ai)
#pragma unroll
            for (int m = 0; m < 4; ++m) { const int r = row0 + ai * HALF + m * 16; const float ri = row_rinv(ssq, r); bf16_t* rowp = O + (size_t)r * PW + col0;
#pragma unroll
                for (int bj = 0; bj < 2; ++bj) { if (col0 + bj * HALF < PW) { const f32x4 v0 = acc[ai][bj][m][0] * ri + bv[bj][0], v1 = acc[ai][bj][m][1] * ri + bv[bj][1];
                    u32x4 w; w.x = cvt_pk_bf16(v0[0], v0[1]); w.y = cvt_pk_bf16(v0[2], v0[3]); w.z = cvt_pk_bf16(v1[0], v1[1]); w.w = cvt_pk_bf16(v1[2], v1[3]);
                    *(u32x4*)(rowp + bj * HALF) = w; } } }
    }
};
struct EpiSwiGLU {
    static constexpr bool PERM = true, AFTER_DRAIN = false;
    bf16_t* O; const float* ssq; const float* shw;
    __device__ __forceinline__ void operator()(const f32x4 (&acc)[2][2][4][2], const Unit& u, int wr, int wc, int fr, int fq) const {
        const int row0 = u.pm * BM + wr * 64 + fr, col0 = u.pn * BM + wc * 32 + 8 * fq, ocol = u.pn * HALF + wc * 32 + 8 * fq; const int set = row_set(u.pm);
        f32x4 ba[2], bb[2];
#pragma unroll
        for (int n = 0; n < 2; ++n) { ba[n] = *(const f32x4*)(shw + set * FF2 + col0 + 4 * n); bb[n] = *(const f32x4*)(shw + set * FF2 + col0 + HALF + 4 * n); }
#pragma unroll
        for (int ai = 0; ai < 2; ++ai)
#pragma unroll
            for (int m = 0; m < 4; ++m) { const int r = row0 + ai * HALF + m * 16; const float ri = row_rinv(ssq, r);
                float hv[8];
#pragma unroll
                for (int n = 0; n < 2; ++n) { const f32x4 a = acc[ai][0][m][n] * ri + ba[n], b = acc[ai][1][m][n] * ri + bb[n];
#pragma unroll
                    for (int e = 0; e < 4; ++e) hv[4 * n + e] = silu_f(a[e]) * b[e]; }
                u32x4 w; w.x = cvt_pk_bf16(hv[0], hv[1]); w.y = cvt_pk_bf16(hv[2], hv[3]); w.z = cvt_pk_bf16(hv[4], hv[5]); w.w = cvt_pk_bf16(hv[6], hv[7]);
                *(u32x4*)(O + (size_t)r * FF + ocol) = w; }
    }
};
struct EpiRes {
    static constexpr bool PERM = false, AFTER_DRAIN = false;
    const float* src_lat; const float* src_ctx; float* dst_lat; float* dst_ctx; bf16_t* XN; float* ssq; const float* gate; const float* sc; const float* g; float gmul;
    __device__ __forceinline__ void operator()(const f32x4 (&acc)[2][2][4][2], const Unit& u, int wr, int wc, int fr, int fq) const {
        const bool lat = u.pm < 64; const int set = row_set(u.pm);
        const int rg0 = u.pm * BM + wr * 64 + fr, rl0 = (lat ? u.pm : u.pm - 64) * BM + wr * 64 + fr;
        const float* src = lat ? src_lat : src_ctx; float* dst = lat ? dst_lat : dst_ctx;
        const int col0 = u.pn * BM + wc * 32 + 4 * fq;
        float ss[2][4];
#pragma unroll
        for (int ai = 0; ai < 2; ++ai)
#pragma unroll
            for (int m = 0; m < 4; ++m) ss[ai][m] = 0.f;
#pragma unroll
        for (int bj = 0; bj < 2; ++bj)
#pragma unroll
            for (int n = 0; n < 2; ++n) { const int c = col0 + bj * HALF + n * 16;
                const f32x4 ga = *(const f32x4*)(gate + set * 6144 + c) * gmul; f32x4 gs = {0.f, 0.f, 0.f, 0.f};
                if (XN) { const f32x4 s4 = *(const f32x4*)(sc + set * 6144 + c), g4 = *(const f32x4*)(g + c); gs = g4 * (s4 + 1.0f); }
#pragma unroll
                for (int ai = 0; ai < 2; ++ai)
#pragma unroll
                    for (int m = 0; m < 4; ++m) { const size_t ol = (size_t)(rl0 + ai * HALF + m * 16) * DM + c, og = (size_t)(rg0 + ai * HALF + m * 16) * DM + c;
                        const f32x4 x1 = *(const f32x4*)(src + ol) + ga * acc[ai][bj][m][n];
                        *(f32x4*)(dst + ol) = x1; ss[ai][m] += (x1[0] * x1[0] + x1[1] * x1[1]) + (x1[2] * x1[2] + x1[3] * x1[3]);
                        if (XN) { const f32x4 xn = x1 * gs; u32x2 w; w.x = cvt_pk_bf16(xn[0], xn[1]); w.y = cvt_pk_bf16(xn[2], xn[3]); *(u32x2*)(XN + og) = w; } } }
#pragma unroll
        for (int ai = 0; ai < 2; ++ai)
#pragma unroll
            for (int m = 0; m < 4; ++m) { float s = ss[ai][m]; s += __shfl_xor(s, 16); s += __shfl_xor(s, 32);
                if (fq == 0) ssq[(size_t)(rg0 + ai * HALF + m * 16) * 16 + u.pn * 4 + wc] = s; }
    }
};
template <class Epi, class Sched, bool ALIGN_EPI = false, bool SP2 = false>
__device__ __forceinline__ void gemm_phase(PG8_LAS unsigned char* lds, const Gemm g, const Sched& S, const Epi& E) {
    int tid_ = threadIdx.x; asm volatile("" : "+v"(tid_));
    const int tid = tid_, wid = __builtin_amdgcn_readfirstlane(tid >> 6), lane = tid & 63, wr = wid >> 2, wc = wid & 3, fr = lane & 15, fq = lane >> 4;
    const int K = g.K, nt = K / BK;
    unsigned voffA[2], voffB[2];
#pragma unroll
    for (int i = 0; i < 2; ++i) { int R, C; stage_rc(tid * 16 + i * 8192, R, C); const int Rb = Epi::PERM ? ((R & ~31) + perm32(R & 31)) : R;
        voffA[i] = (unsigned)(R * K + C) * 2u; voffB[i] = (unsigned)(Rb * K + C) * 2u; }
    const size_t kstep = (size_t)(BK * 2);
    const size_t hstep = (size_t)HALF * K * 2;
    const size_t tstep = 2 * hstep;
    const unsigned ldsw = (unsigned)wid * 1024u;
    const int aoff = lds_byte(wr * 64 + fr, fq * 8), boff = lds_byte(wc * 32 + fr, fq * 8);
#define PG8_SA(b, h) (((b) * 2 + (h)) * HTB)
#define PG8_SB(b, h) ((4 + (b) * 2 + (h)) * HTB)
#define PG8_STAGE(bufoff, gbase, voff) do { _Pragma("unroll") for (int _i = 0; _i < 2; ++_i) \
        __builtin_amdgcn_global_load_lds((const unsigned*)((const char*)(gbase) + (voff)[_i]), (PG8_LAS unsigned*)(lds + (bufoff) + ldsw + _i * 8192), 16, 0, 0); } while (0)
#define PG8_LDA(dst, b, h) do { _Pragma("unroll") for (int m = 0; m < 4; ++m) _Pragma("unroll") for (int k = 0; k < 2; ++k) dst[m][k] = *(const PG8_LAS bf16x8*)(lds + PG8_SA(b, h) + aoff + m * 2048 + k * 1024); } while (0)
#define PG8_LDB(dst, b, h) do { _Pragma("unroll") for (int n = 0; n < 2; ++n) _Pragma("unroll") for (int k = 0; k < 2; ++k) dst[n][k] = *(const PG8_LAS bf16x8*)(lds + PG8_SB(b, h) + boff + n * 2048 + k * 1024); } while (0)
#define PG8_MMA(ai, bj, At, Bt) do { __builtin_amdgcn_s_setprio(1); _Pragma("unroll") for (int m = 0; m < 4; ++m) _Pragma("unroll") for (int n = 0; n < 2; ++n) _Pragma("unroll") for (int k = 0; k < 2; ++k) \
        acc[ai][bj][m][n] = __builtin_amdgcn_mfma_f32_16x16x32_bf16(Bt[n][k], At[m][k], acc[ai][bj][m][n], 0, 0, 0); __builtin_amdgcn_s_setprio(0); } while (0)
#define PG8_WAIT_V(n) asm volatile("s_waitcnt vmcnt(" #n ")" ::: "memory")
#define PG8_WAIT_L(n) asm volatile("s_waitcnt lgkmcnt(" #n ")" ::: "memory")
#define PG8_BAR __builtin_amdgcn_s_barrier()
#define PG8_SCHED __builtin_amdgcn_sched_barrier(0)
    Unit cur, nxt; int ui = 0;
    if (!S.next(0, cur)) return;
    f32x4 acc[2][2][4][2];
#pragma unroll
    for (int a = 0; a < 2; ++a)
#pragma unroll
        for (int b = 0; b < 2; ++b)
#pragma unroll
            for (int m = 0; m < 4; ++m)
#pragma unroll
                for (int n = 0; n < 2; ++n) acc[a][b][m][n] = (f32x4){0.f, 0.f, 0.f, 0.f};
    bf16x8 At[4][2], B0[2][2], B1[2][2];
    const char* cA = (const char*)g.A + (size_t)cur.pm * tstep; const char* cB = (const char*)g.Bt + (size_t)cur.pn * tstep;
    S.a_ready(cur);
    if constexpr (SP2) {
        PG8_STAGE(PG8_SB(0, 0), cB, voffB); PG8_STAGE(PG8_SB(0, 1), cB + hstep, voffB); PG8_STAGE(PG8_SA(0, 0), cA, voffA); PG8_STAGE(PG8_SA(0, 1), cA + hstep, voffA);
        if (wr == 1) PG8_BAR;
        PG8_WAIT_V(2); PG8_BAR;
        PG8_STAGE(PG8_SB(1, 0), cB + kstep, voffB); PG8_STAGE(PG8_SA(1, 0), cA + kstep, voffA); PG8_STAGE(PG8_SB(1, 1), cB + hstep + kstep, voffB);
        PG8_WAIT_V(6); PG8_BAR;
    } else {
        PG8_STAGE(PG8_SB(0, 0), cB, voffB); PG8_STAGE(PG8_SA(0, 0), cA, voffA); PG8_STAGE(PG8_SB(0, 1), cB + hstep, voffB); PG8_STAGE(PG8_SA(0, 1), cA + hstep, voffA);
        if (wr == 1) PG8_BAR;
        PG8_WAIT_V(4); PG8_BAR;
        PG8_STAGE(PG8_SB(1, 0), cB + kstep, voffB); PG8_STAGE(PG8_SA(1, 0), cA + kstep, voffA); PG8_STAGE(PG8_SB(1, 1), cB + hstep + kstep, voffB);
        PG8_WAIT_V(6); PG8_BAR;
    }
    for (;;) {
        const bool has_next = S.next(ui + 1, nxt);
        const char* nA = has_next ? (const char*)g.A + (size_t)nxt.pm * tstep : cA; const char* nB = has_next ? (const char*)g.Bt + (size_t)nxt.pn * tstep : cB;
        for (int t = 0; t < nt; t += 2) {
            const bool last = (t == nt - 2);
            const char* a1 = cA + (size_t)(t + 1) * kstep;
            const char* a2 = last ? nA : cA + (size_t)(t + 2) * kstep; const char* b2 = last ? nB : cB + (size_t)(t + 2) * kstep;
            const char* a3 = a2 + kstep; const char* b3 = b2 + kstep;
            if (last && has_next) S.a_ready(nxt);
            if constexpr (SP2) {
            PG8_LDB(B0, 0, 0); PG8_LDB(B1, 0, 1); PG8_SCHED; PG8_LDA(At, 0, 0); PG8_STAGE(PG8_SA(1, 1), a1 + hstep, voffA);
            PG8_WAIT_V(8); PG8_WAIT_L(0); PG8_BAR; PG8_MMA(0, 0, At, B0); PG8_MMA(0, 1, At, B1); PG8_BAR; PG8_SCHED;
            PG8_LDA(At, 0, 1); PG8_STAGE(PG8_SB(0, 0), b2, voffB); PG8_STAGE(PG8_SB(0, 1), b2 + hstep, voffB); PG8_STAGE(PG8_SA(0, 0), a2, voffA);
            PG8_WAIT_V(8); PG8_WAIT_L(0); PG8_BAR; PG8_MMA(1, 0, At, B0); PG8_MMA(1, 1, At, B1); PG8_BAR; PG8_SCHED;
            PG8_LDB(B0, 1, 0); PG8_LDB(B1, 1, 1); PG8_SCHED; PG8_LDA(At, 1, 0); PG8_STAGE(PG8_SA(0, 1), a2 + hstep, voffA);
            PG8_WAIT_V(8); PG8_WAIT_L(0); PG8_BAR; PG8_MMA(0, 0, At, B0); PG8_MMA(0, 1, At, B1); PG8_BAR; PG8_SCHED;
            PG8_LDA(At, 1, 1); PG8_STAGE(PG8_SB(1, 0), b3, voffB); PG8_STAGE(PG8_SB(1, 1), b3 + hstep, voffB); PG8_STAGE(PG8_SA(1, 0), a3, voffA);
            PG8_WAIT_V(8); PG8_WAIT_L(0); PG8_BAR; PG8_MMA(1, 0, At, B0); PG8_MMA(1, 1, At, B1); PG8_BAR; PG8_SCHED;
            } else {
            PG8_LDB(B0, 0, 0); PG8_SCHED; PG8_LDA(At, 0, 0); PG8_STAGE(PG8_SA(1, 1), a1 + hstep, voffA);
            PG8_WAIT_L(8); PG8_BAR; PG8_WAIT_L(0); PG8_MMA(0, 0, At, B0); PG8_BAR; PG8_SCHED;
            PG8_LDB(B1, 0, 1); PG8_STAGE(PG8_SB(0, 0), b2, voffB);
            PG8_BAR; PG8_WAIT_L(0); PG8_MMA(0, 1, At, B1); PG8_BAR;
            PG8_LDA(At, 0, 1); PG8_STAGE(PG8_SA(0, 0), a2, voffA);
            PG8_BAR; PG8_WAIT_L(0); PG8_MMA(1, 0, At, B0); PG8_BAR; PG8_SCHED;
            PG8_STAGE(PG8_SB(0, 1), b2 + hstep, voffB);
            PG8_WAIT_V(6); PG8_BAR; PG8_MMA(1, 1, At, B1); PG8_BAR;
            PG8_LDB(B0, 1, 0); PG8_SCHED; PG8_LDA(At, 1, 0); PG8_STAGE(PG8_SA(0, 1), a2 + hstep, voffA);
            PG8_WAIT_L(8); PG8_BAR; PG8_WAIT_L(0); PG8_MMA(0, 0, At, B0); PG8_BAR; PG8_SCHED;
            PG8_LDB(B1, 1, 1); PG8_STAGE(PG8_SB(1, 0), b3, voffB);
            PG8_BAR; PG8_WAIT_L(0); PG8_MMA(0, 1, At, B1); PG8_BAR;
            PG8_LDA(At, 1, 1); PG8_STAGE(PG8_SA(1, 0), a3, voffA);
            PG8_BAR; PG8_WAIT_L(0); PG8_MMA(1, 0, At, B0); PG8_BAR; PG8_SCHED;
            PG8_STAGE(PG8_SB(1, 1), b3 + hstep, voffB);
            PG8_WAIT_V(6); PG8_BAR; PG8_MMA(1, 1, At, B1); PG8_BAR;
            }
        }
        if constexpr (ALIGN_EPI) { if (wr == 0) PG8_BAR; }
        if constexpr (!Epi::AFTER_DRAIN) { E(acc, cur, wr, wc, fr, fq); S.done(cur); }
        if (!has_next) break;
#pragma unroll
        for (int a = 0; a < 2; ++a)
#pragma unroll
            for (int b = 0; b < 2; ++b)
#pragma unroll
                for (int m = 0; m < 4; ++m)
#pragma unroll
                    for (int n = 0; n < 2; ++n) acc[a][b][m][n] = (f32x4){0.f, 0.f, 0.f, 0.f};
        cur = nxt; cA = nA; cB = nB; ++ui;
        if constexpr (ALIGN_EPI) { if (wr == 1) PG8_BAR; }
    }
    PG8_WAIT_V(0);
    if constexpr (!ALIGN_EPI) { if (wr == 0) PG8_BAR; }
    PG8_BAR;
    if constexpr (Epi::AFTER_DRAIN) { E.fused(acc, cur, wr, wc, fr, fq, lds, wid, lane); S.done(cur); }
#undef PG8_SA
#undef PG8_SB
#undef PG8_STAGE
#undef PG8_LDA
#undef PG8_LDB
#undef PG8_MMA
#undef PG8_WAIT_V
#undef PG8_WAIT_L
#undef PG8_BAR
#undef PG8_SCHED
}
}

constexpr int NWAVES = 8, NTHR = 512;
constexpr size_t MiB = 1u << 20;
constexpr size_t WS_CTL = 0, CTL_ZERO_BYTES = 64 * 1024;
constexpr size_t WS_MOD = 1 * MiB;
constexpr size_t WS_SHWIN = WS_MOD + 2 * 3 * 6144 * 4;
constexpr size_t WS_SHW13 = WS_SHWIN + 2 * 3 * PWP * 4;
constexpr size_t WS_ROPE = WS_SHW13 + 2 * 3 * FF2 * 4;
constexpr size_t WS_LG = WS_ROPE + (128 + 64) * 24 * 2 * 4;
constexpr size_t WS_CT256 = WS_LG + 256;
constexpr size_t WS_SSQ = 2 * MiB;
constexpr size_t WS_XC = 4 * MiB;
constexpr size_t WS_W = 6 * MiB;
constexpr size_t W_WIN = 0, W_WOUT = (size_t)PWP * DM * 2, W_W13 = W_WOUT + (size_t)DM * DM * 2, W_W2 = W_W13 + (size_t)FF2 * DM * 2, W_LAYER = W_W2 + (size_t)DM * FF * 2;
static_assert(W_LAYER * 2 == 49 * MiB, "weight region");
constexpr size_t WS_TAB = 55 * MiB;
constexpr size_t T_WFT = 0, T_TWA = 2 * 256 * 256 * 2, T_TD2 = T_TWA + 256 * 256 * 2, T_TW8 = T_TD2 + 64 * 128 * 2, T_TC = T_TW8 + 65536;
constexpr size_t WS_XN = 56 * MiB;
constexpr size_t WS_CAT = 89 * MiB;
constexpr size_t WS_PROJ = 122 * MiB;
constexpr size_t WS_STATE = 217 * MiB;
constexpr size_t WS_END = WS_STATE + (size_t)16 * 66 * 9216 * 4;
static_assert(WS_END <= 256 * MiB && WS_PROJ + (size_t)MTOT * PW * 2 <= WS_STATE && WS_CAT + (size_t)MTOT * DM * 2 <= WS_PROJ && WS_XN + (size_t)MTOT * DM * 2 <= WS_CAT, "d_ws map");
static_assert(WS_CT256 + 2048 <= WS_SSQ && WS_SSQ + (size_t)MTOT * 64 <= WS_XC && WS_TAB + T_TC + 262144 <= WS_XN, "d_ws map (small)");
constexpr int CW_BAR = 1024;
constexpr int LDS_BYTES = 163840, MISC_OFF = LDS_BYTES - 256;

#define RLX_AGENT __ATOMIC_RELAXED, __HIP_MEMORY_SCOPE_AGENT
#define XB_TMO      128
#define XB_XCNT(j)  (256  + 64 * (j))
#define XB_XSUB(j)  (1280 + 64 * (j))
#define XB_XGEN(j)  (2304 + 64 * (j))
#define XB_TOP      3328
#define XB_TOPGEN   3392
#define XCD_BAR_WORDS 3456
#define XB_SPIN_CAP (1u << 18)
static_assert((CW_BAR + XCD_BAR_WORDS) * 4 <= (int)CTL_ZERO_BYTES, "barrier words inside the memset region");
__device__ __forceinline__ unsigned xb_ld(unsigned* p)              { return __hip_atomic_load(p, __ATOMIC_RELAXED, __HIP_MEMORY_SCOPE_AGENT); }
__device__ __forceinline__ unsigned xb_add(unsigned* p, unsigned v) { return __hip_atomic_fetch_add(p, v, __ATOMIC_RELAXED, __HIP_MEMORY_SCOPE_AGENT); }
__device__ __forceinline__ unsigned xb_xcc_id() { return (unsigned)__builtin_amdgcn_s_getreg((3 << 11) | 20) & 0xFu; }
#define XB_SPIN(cond, bar) do { unsigned _sp = 0; while (cond) { __builtin_amdgcn_s_sleep(1); \
    if ((++_sp & 255u) == 0u) { if (xb_ld(&(bar)[XB_TMO])) break; if (_sp > XB_SPIN_CAP) { atomicAdd(&(bar)[XB_TMO], 1u); break; } } } } while (0)
struct XcdBarrier { unsigned* bar; unsigned x; volatile LAS unsigned* st; };
__device__ __forceinline__ XcdBarrier xcd_barrier_post(unsigned* bar, volatile LAS unsigned* st) {
    XcdBarrier b; b.bar = bar; b.x = xb_xcc_id(); b.st = st;
    if (threadIdx.x == 0) (void)xb_add(&bar[XB_XCNT(b.x)], 1u);
    return b;
}
__device__ __forceinline__ void xcd_barrier_complete(unsigned* bar, unsigned x, unsigned& nloc, unsigned& nx) {
    const unsigned G = gridDim.x * gridDim.y * gridDim.z;
    unsigned sum, cnt, mine, sp = 0u;
    for (;;) {
        sum = 0u; cnt = 0u; mine = 0u;
#pragma unroll
        for (unsigned j = 0; j < 16; ++j) { const unsigned c = xb_ld(&bar[XB_XCNT(j)]); sum += c; cnt += (c > 0u) ? 1u : 0u; mine = (j == x) ? c : mine; }
        if (sum == G) break;
        __builtin_amdgcn_s_sleep(1);
        if ((++sp & 255u) == 0u) { if (xb_ld(&bar[XB_TMO])) break; if (sp > XB_SPIN_CAP) { atomicAdd(&bar[XB_TMO], 1u); break; } }
    }
    nloc = mine > 0u ? mine : 1u; nx = cnt > 0u ? cnt : 1u;
}
__device__ __forceinline__ void xcd_barrier(const XcdBarrier& b) {
    asm volatile("s_waitcnt vmcnt(0)" ::: "memory");
    __syncthreads();
    if (threadIdx.x == 0) {
        unsigned* bar = b.bar;
        __builtin_amdgcn_s_waitcnt(0);
        unsigned nloc = b.st[0], nx = b.st[1];
        if (nloc == 0u) { xcd_barrier_complete(bar, b.x, nloc, nx); b.st[0] = nloc; b.st[1] = nx; }
        const unsigned old = xb_add(&bar[XB_XSUB(b.x)], 1u);
        const unsigned gen = old / nloc;
        if (old + 1u == (gen + 1u) * nloc) {
            __builtin_amdgcn_fence(__ATOMIC_RELEASE, "agent");
            asm volatile("s_waitcnt vmcnt(0)" ::: "memory");
            const unsigned og = xb_add(&bar[XB_TOP], 1u);
            const unsigned tg = og / nx;
            if (og + 1u == (tg + 1u) * nx) xb_add(&bar[XB_TOPGEN], 1u);
            else XB_SPIN(xb_ld(&bar[XB_TOPGEN]) == tg, bar);
            __builtin_amdgcn_fence(__ATOMIC_ACQUIRE, "agent");
            xb_add(&bar[XB_XGEN(b.x)], 1u);
            asm volatile("s_waitcnt vmcnt(0)" ::: "memory");
        } else {
            XB_SPIN(xb_ld(&bar[XB_XGEN(b.x)]) == gen, bar);
            __builtin_amdgcn_fence(__ATOMIC_ACQUIRE, "agent");
            asm volatile("s_waitcnt vmcnt(0)" ::: "memory");
        }
    }
    __syncthreads();
}

struct Frame {
    LAS unsigned char* lds;
    int tid, lane, wave, G, vcu;
    __device__ __forceinline__ void fresh() { int t = threadIdx.x; asm volatile("" : "+v"(t)); tid = t; lane = t & 63; wave = __builtin_amdgcn_readfirstlane(t >> 6); }
    const float *x, *c, *ctx, *c_ctx, *w_ada, *b_ada, *g_mix, *w_in, *dlogit, *ret_g, *w_four, *rpb, *w_out, *g_ffn, *w1, *w3, *w2, *g_final;
    float* out; unsigned char* ws;
    float *MOD, *SHWIN, *SHW13, *ROPE, *LG, *CT256, *SSQ, *XC, *STATE, *ADAP; const float* TW8;
    bf16_t *XN, *CAT, *PROJ, *HID, *WFT, *TWA, *TD2, *TC256; unsigned* Y;
    __device__ __forceinline__ bf16_t* W(int layer, size_t off) const { return (bf16_t*)(ws + WS_W + (size_t)layer * W_LAYER + off); }
};

__device__ __forceinline__ float wave_sum(float v) {
#pragma unroll
    for (int o = 1; o < 64; o <<= 1) v += __shfl_xor(v, o);
    return v;
}

__device__ __forceinline__ bf16x8 ld8(LAS const unsigned char* p) { return *(LAS const bf16x8*)p; }
__device__ __forceinline__ bf16x8 ld8(const unsigned char* p) { return *(const bf16x8*)p; }
template <int MT, int NT, class PA, class PB>
__device__ __forceinline__ void wave_mma(f32x4 (&acc)[MT][NT], PA A, int lda, PB B, int ldb, int ksteps, int fr, int fq) {
    PA a0 = A + fr * lda + fq * 16; PB b0 = B + fr * ldb + fq * 16;
    for (int s = 0; s < ksteps; ++s) {
        bf16x8 a[MT], b[NT];
#pragma unroll
        for (int m = 0; m < MT; ++m) a[m] = ld8(a0 + m * 16 * lda + s * 64);
#pragma unroll
        for (int n = 0; n < NT; ++n) b[n] = ld8(b0 + n * 16 * ldb + s * 64);
#pragma unroll
        for (int m = 0; m < MT; ++m)
#pragma unroll
            for (int n = 0; n < NT; ++n) acc[m][n] = __builtin_amdgcn_mfma_f32_16x16x32_bf16(a[m], b[n], acc[m][n], 0, 0, 0);
    }
}
template <int MT, int NT> __device__ __forceinline__ void zero_acc(f32x4 (&acc)[MT][NT]) {
#pragma unroll
    for (int m = 0; m < MT; ++m)
#pragma unroll
        for (int n = 0; n < NT; ++n) acc[m][n] = (f32x4){0.f, 0.f, 0.f, 0.f};
}

#define LDS_WAIT() asm volatile("s_waitcnt lgkmcnt(0)" ::: "memory")
__device__ __forceinline__ void p0_transpose_item(const float* W, int ldw, int K, int nblk, bf16_t* WT, int mapkind, int roff, LAS float* scr, int item, int lane) {
    const int kb = item / nblk, nb = item % nblk, k0 = 64 * kb, n0 = 32 * nb;
#pragma unroll 8
    for (int i = 0; i < 32; ++i) { const int kk = 2 * i + (lane >> 5); scr[kk * 33 + (lane & 31)] = W[(size_t)(k0 + kk) * ldw + n0 + (lane & 31)]; }
    LDS_WAIT(); asm volatile("" ::: "memory");
    const int c = lane & 7;
#pragma unroll
    for (int j = 0; j < 4; ++j) { const int n = (lane >> 3) + 8 * j; const LAS float* s = scr + (8 * c) * 33 + n;
        u32x4 o; o.x = pk2(s[0 * 33], s[1 * 33]); o.y = pk2(s[2 * 33], s[3 * 33]); o.z = pk2(s[4 * 33], s[5 * 33]); o.w = pk2(s[6 * 33], s[7 * 33]);
        const int nn = n0 + n; const int row = mapkind == 0 ? roff + nn : ((nn >> 7) * 256 + (nn & 127) + (mapkind == 2 ? 128 : 0));
        *(u32x4*)(WT + (size_t)row * K + k0 + 8 * c) = o; }
    LDS_WAIT(); asm volatile("" ::: "memory");
}

__device__ __forceinline__ void phase_p0a(Frame& F) {
    F.fresh();
    const int tid = F.tid, lane = F.lane, wave = F.wave;
    if (blockIdx.x < 32) {
        LAS float* wt = (LAS float*)F.lds; LAS float* T = (LAS float*)(F.lds + 64 * 257 * 4);
        for (int e = tid; e < 4096; e += NTHR) { const int c = e >> 6, p = e & 63; float sv, cv;
            if (p <= 32) { sincospif((float)((p * c) & 63) * (1.0f / 32.0f), &sv, &cv); T[e] = cv; }
            else { sincospif((float)(((p - 32) * c) & 63) * (1.0f / 32.0f), &sv, &cv); T[e] = -sv; } }
        for (int it = blockIdx.x; it < 32; it += F.G) {
            const int l = it >> 4, k0 = (it & 15) * 64;
            __syncthreads();
            for (int e = tid; e < 64 * 256; e += NTHR) { const int kk = e >> 8, cc = e & 255; wt[kk * 257 + cc] = F.w_in[((size_t)l * DM + k0 + kk) * PW + cc]; }
            __syncthreads();
            const int k = tid & 63, cg0 = tid >> 6; bf16_t* WT = F.W(l, W_WIN);
            for (int i = 0; i < 32; ++i) { const int col = cg0 + 8 * i, g = col >> 6, p = col & 63; float a = 0.f;
#pragma unroll 8
                for (int c = 0; c < 64; ++c) a += wt[k * 257 + g * 64 + c] * T[c * 64 + p];
                WT[(size_t)col * DM + k0 + k] = (bf16_t)f2bf(a); }
        }
        __syncthreads();
    }
    LAS float* sc = (LAS float*)(F.lds + 131072);
    for (int e = tid; e < 3072; e += NTHR) { const int s = e >> 10, k = e & 1023; const float v = s < 2 ? F.c[s * DM + k] : F.c_ctx[k]; sc[e] = v / (1.0f + expf(-v)); }
    __syncthreads();
    const int gw = F.vcu * NWAVES + wave, NGW = F.G * NWAVES;
    for (int it = gw; it < 2 * 8 * 96; it += NGW) {
        const int l = it / 768, rem = it % 768, kc = rem / 96, cb = rem % 96, col = cb * 64 + lane;
        const float* wp = F.w_ada + ((size_t)l * DM + kc * 128) * 6144 + col; float a0 = 0.f, a1 = 0.f, a2 = 0.f;
#pragma unroll 8
        for (int k = 0; k < 128; ++k) { const float w = wp[(size_t)k * 6144]; const int kk = kc * 128 + k; a0 += sc[kk] * w; a1 += sc[1024 + kk] * w; a2 += sc[2048 + kk] * w; }
        float* o = F.ADAP + ((size_t)(l * 8 + kc) * 3) * 6144 + col; o[0] = a0; o[6144] = a1; o[2 * 6144] = a2;
    }
    LAS float* scr = (LAS float*)(F.lds + wave * 16384);
    constexpr int I0 = 16 * 84, I1 = 16 * 32, I2 = 16 * 88, I3 = I2, I4 = 44 * 32, I5 = 4 * 8, IL = I0 + I1 + I2 + I3 + I4 + I5;
    for (int it = gw; it < 2 * IL; it += NGW) {
        const int l = it / IL; int r = it % IL;
        if (r < I0) { p0_transpose_item(F.w_in + (size_t)l * DM * PW + 256, PW, DM, 84, F.W(l, W_WIN), 0, 256, scr, r, lane); continue; } r -= I0;
        if (r < I1) { p0_transpose_item(F.w_out + (size_t)l * DM * DM, DM, DM, 32, F.W(l, W_WOUT), 0, 0, scr, r, lane); continue; } r -= I1;
        if (r < I2) { p0_transpose_item(F.w1 + (size_t)l * DM * FF, FF, DM, 88, F.W(l, W_W13), 1, 0, scr, r, lane); continue; } r -= I2;
        if (r < I3) { p0_transpose_item(F.w3 + (size_t)l * DM * FF, FF, DM, 88, F.W(l, W_W13), 2, 0, scr, r, lane); continue; } r -= I3;
        if (r < I4) { p0_transpose_item(F.w2 + (size_t)l * FF * DM, DM, FF, 32, F.W(l, W_W2), 0, 0, scr, r, lane); continue; } r -= I4;
        p0_transpose_item(F.w_four + (size_t)l * 65536, 256, 256, 8, F.WFT + (size_t)l * 65536, 0, 0, scr, r, lane);
    }
    const int gt = F.vcu * NTHR + tid, GT = F.G * NTHR;
    for (int e = gt; e < 2 * 128 * 128; e += GT) { const int l = e >> 14, q = e & 16383; *(u32x4*)(F.W(l, W_WIN) + (size_t)PW * DM + (size_t)q * 8) = (u32x4){0u, 0u, 0u, 0u}; }
    for (int e = gt; e < 192 * 24; e += GT) { const int pos = e < 128 * 24 ? e / 24 : (e - 128 * 24) / 24, i = e % 24;
        const float inv = powf(10000.0f, -(float)i / 24.0f), ang = (float)pos * inv; F.ROPE[2 * e] = cosf(ang); F.ROPE[2 * e + 1] = sinf(ang); }
    for (int e = gt; e < 16; e += GT) { const float xv = F.dlogit[e]; F.LG[e] = -log1pf(expf(-xv)); }
    for (int e = gt; e < 256; e += GT) { float sv, cv; sincospif((float)e * (2.0f / 256.0f), &sv, &cv); F.CT256[2 * e] = cv; F.CT256[2 * e + 1] = sv; }
    for (int e = gt; e < 8192; e += GT) { float sv, cv; sincospif((float)e * (2.0f / 8192.0f), &sv, &cv); ((float*)F.TW8)[2 * e] = cv; ((float*)F.TW8)[2 * e + 1] = sv; }
    for (int e = gt; e < 32768; e += GT) { const int row = e >> 7, l1 = e & 127, cs = row >> 7, k1 = row & 127; float sv, cv;
        sincospif((float)((k1 * l1) & 127) * (2.0f / 128.0f), &sv, &cv); F.TWA[e] = (bf16_t)f2bf(cs == 0 ? cv : sv); }
    for (int e = gt; e < 131072; e += GT) { const int cs = e >> 16, k = (e >> 8) & 255, l = e & 255; float sv, cv;
        sincospif((float)((k * l) & 255) * (2.0f / 256.0f), &sv, &cv); F.TC256[e] = (bf16_t)f2bf(cs == 0 ? cv : sv); }
    for (int e = gt; e < 8192; e += GT) { const int k2 = e >> 7, col = e & 127, l2 = col >> 1, ri = col & 1; float sv, cv;
        sincospif((float)((k2 * l2) & 63) * (2.0f / 64.0f), &sv, &cv); F.TD2[e] = (bf16_t)f2bf(ri == 0 ? cv : sv); }
}

__device__ __forceinline__ float ada_val(const Frame& F, int l, int s, int j) {
    const float* p = F.ADAP + ((size_t)(l * 8) * 3 + s) * 6144 + j; float a = 0.f;
#pragma unroll
    for (int kc = 0; kc < 8; ++kc) a += p[(size_t)kc * 3 * 6144];
    return a + F.b_ada[l * 6144 + j];
}
__device__ __forceinline__ void phase_p0b(Frame& F) {
    F.fresh();
    const int tid = F.tid, lane = F.lane, wave = F.wave;
    const int gt = F.vcu * NTHR + tid, GT = F.G * NTHR, gw = F.vcu * NWAVES + wave, NGW = F.G * NWAVES;
    for (int e = gt; e < 2 * 3 * 6144; e += GT) { const int l = e / 18432, s = (e / 6144) % 3, j = e % 6144; F.MOD[e] = ada_val(F, l, s, j); }
    LAS float* vec = (LAS float*)F.lds;
    for (int e = tid; e < 3072; e += NTHR) { const int s = e >> 10, k = e & 1023; vec[e] = F.g_mix[k] * (1.0f + ada_val(F, 0, s, 1024 + k)); }
    __syncthreads();
    for (int m = gw; m < MTOT; m += NGW) {
        const int set = m < SEQ ? 0 : (m < MLAT ? 1 : 2); const float* src = m < MLAT ? F.x + (size_t)m * DM : F.ctx + (size_t)(m - MLAT) * DM;
        f32x4 v[4]; float ss = 0.f;
#pragma unroll
        for (int j = 0; j < 4; ++j) { v[j] = *(const f32x4*)(src + 4 * lane + 256 * j); ss += (v[j][0] * v[j][0] + v[j][1] * v[j][1]) + (v[j][2] * v[j][2] + v[j][3] * v[j][3]); }
        ss = wave_sum(ss);
#pragma unroll
        for (int j = 0; j < 4; ++j) { const f32x4 g = *(LAS const f32x4*)(vec + set * 1024 + 4 * lane + 256 * j); const f32x4 o = v[j] * g;
            u32x2 w; w.x = pk2(o[0], o[1]); w.y = pk2(o[2], o[3]); *(u32x2*)(F.XN + (size_t)m * DM + 4 * lane + 256 * j) = w; }
        if (lane < 16) F.SSQ[(size_t)m * 16 + lane] = lane == 0 ? ss : 0.f;
    }
    for (int combo = 0; combo < 4; ++combo) {
        const int l = combo >> 1, which = combo & 1;
        __syncthreads();
        for (int e = tid; e < 3072; e += NTHR) { const int s = e >> 10, k = e & 1023; vec[e] = ada_val(F, l, s, (which ? 3072 : 0) + k); }
        __syncthreads();
        const int nrows = which ? FF2 : PWP; const bf16_t* Wt = F.W(l, which ? W_W13 : W_WIN); float* dstv = (which ? F.SHW13 : F.SHWIN) + (size_t)l * 3 * nrows;
        for (int r = gw; r < nrows; r += NGW) {
            float a0 = 0.f, a1 = 0.f, a2 = 0.f;
#pragma unroll
            for (int j = 0; j < 2; ++j) { const int k0 = lane * 8 + 512 * j; const u32x4 w = *(const u32x4*)(Wt + (size_t)r * DM + k0);
                const float wf[8] = {bflo(w.x), bfhi(w.x), bflo(w.y), bfhi(w.y), bflo(w.z), bfhi(w.z), bflo(w.w), bfhi(w.w)};
#pragma unroll
                for (int e = 0; e < 8; ++e) { a0 += wf[e] * vec[k0 + e]; a1 += wf[e] * vec[1024 + k0 + e]; a2 += wf[e] * vec[2048 + k0 + e]; } }
            a0 = wave_sum(a0); a1 = wave_sum(a1); a2 = wave_sum(a2);
            if (lane == 0) { dstv[r] = a0; dstv[nrows + r] = a1; dstv[2 * nrows + r] = a2; }
        }
    }
}
__device__ __forceinline__ void phase_final(Frame& F, bool dry = false, float delta = 0.f) {
    F.fresh();
    const int gw = F.vcu * NWAVES + F.wave, NGW = F.G * NWAVES, lane = F.lane;
    for (int m = gw; m < MLAT; m += NGW) {
        const float ri = pg8::row_rinv(F.SSQ, m); float* row = F.out + (size_t)m * DM;
#pragma unroll
        for (int j = 0; j < 4; ++j) { const int c = 4 * lane + 256 * j; const f32x4 v = *(const f32x4*)(row + c), g = *(const f32x4*)(F.g_final + c); *(f32x4*)(row + c) = dry ? v : v * g * ri + delta; }
    }
}

typedef LAS const unsigned char* lptr;
typedef const unsigned char* gptr;
constexpr float LOG2E = 1.4426950408889634f;
template <int NPW, class RowFn>
__device__ __forceinline__ void stage_T(LAS unsigned char* dst, int dstride, RowFn rowp, int nd, int wave, int lane) {
    const int ndb = nd / 16, dl = lane & 7, kl = lane >> 3; unsigned a[NPW], b[NPW];
#pragma unroll
    for (int it = 0; it < NPW; ++it) { const int wi = wave + NWAVES * it, dvp = (wi % ndb) * 8 + dl, kp = (wi / ndb) * 8 + kl;
        a[it] = *(const unsigned*)(rowp(2 * kp) + 2 * dvp); b[it] = *(const unsigned*)(rowp(2 * kp + 1) + 2 * dvp); }
#pragma unroll
    for (int it = 0; it < NPW; ++it) { const int wi = wave + NWAVES * it, dvp = (wi % ndb) * 8 + dl, kp = (wi / ndb) * 8 + kl;
        *(LAS unsigned*)(dst + (2 * dvp) * dstride + kp * 4) = (a[it] & 0xffffu) | (b[it] << 16);
        *(LAS unsigned*)(dst + (2 * dvp + 1) * dstride + kp * 4) = (a[it] >> 16) | (b[it] & 0xffff0000u); }
}
__device__ __forceinline__ bf16x4 vtr(LAS const unsigned char* p) { return __builtin_amdgcn_ds_read_tr16_b64_v4i16((LAS bf16x4*)p); }
__device__ __forceinline__ bf16x8 pack8(const f32x4& a, const f32x4& b) { u32x4 w; w.x = pk2(a[0], a[1]); w.y = pk2(a[2], a[3]); w.z = pk2(b[0], b[1]); w.w = pk2(b[2], b[3]); return __builtin_bit_cast(bf16x8, w); }

constexpr int NA_KC = 65536, NA_Q = 98304, NA_RPB = 106496, NA_COMB = 108544;
static_assert(NA_COMB + 8 * 4224 <= MISC_OFF, "NA LDS map");
__device__ __forceinline__ void na_unit(Frame& F, int layer, int b, int h, int r, bool ctxq) {
    F.fresh();
    const int tid = F.tid, lane = F.lane, wave = F.wave, fr = lane & 15, fq = lane >> 4;
    LAS unsigned char* lds = F.lds; const bf16_t* P = F.PROJ;
    const int rs = ctxq ? 0 : min(max(r - 4, 0), 120);
    const int tokq0 = ctxq ? MLAT + b * CTXL + r * 64 : b * SEQ + r * 64;
    const int sch = tid & 7, skey = tid >> 3;
    const unsigned sdst = (unsigned)(skey * 128 + ((sch ^ (skey & 7)) << 4));
    u32x4 kv[12];
    __syncthreads();
    {
        if (!ctxq) {
#pragma unroll
            for (int i = 0; i < 8; ++i) { const size_t tok = (size_t)b * SEQ + (rs + i) * 64 + skey; kv[i] = *(const u32x4*)(P + tok * PW + C_NK + h * 64 + sch * 8); }
        }
#pragma unroll
        for (int i = 0; i < 4; ++i) { const size_t tok = (size_t)MLAT + b * CTXL + skey + 64 * i; kv[8 + i] = *(const u32x4*)(P + tok * PW + C_NK + h * 64 + sch * 8); }
        const u32x4 qv = *(const u32x4*)(P + (size_t)(tokq0 + skey) * PW + C_NQ + h * 64 + sch * 8);
        if (tid < 465) ((LAS float*)(lds + NA_RPB))[tid] = F.rpb[((size_t)layer * 6 + h) * 465 + tid];
        if (!ctxq) {
#pragma unroll
            for (int i = 0; i < 8; ++i) *(LAS u32x4*)(lds + sdst + i * 8192) = kv[i];
        }
#pragma unroll
        for (int i = 0; i < 4; ++i) *(LAS u32x4*)(lds + NA_KC + sdst + i * 8192) = kv[8 + i];
        *(LAS u32x4*)(lds + NA_Q + sdst) = qv;
    }
    __syncthreads();
    const int jb = wave & 3, half = wave >> 2; const bool active = !(ctxq && half == 0);
    const int cstart = min(max(16 * jb - 8, 0), 32);
    bf16x8 pa[8]; float mx = -3.0e38f, lsum = 0.f; f32x4 st[16];
    if (active) {
        const int sw0 = (fq ^ (fr & 7)) << 4, sw1 = ((4 + fq) ^ (fr & 7)) << 4;
        lptr qb = (lptr)(lds + NA_Q + (jb * 16 + fr) * 128);
        const bf16x8 qf0 = ld8(qb + sw0), qf1 = ld8(qb + sw1);
#pragma unroll
        for (int t = 0; t < 16; ++t) {
            const int kidx = half == 0 ? (t >> 1) * 64 + cstart + 16 * (t & 1) + fr : 16 * t + fr;
            lptr kp = (lptr)(lds + (half == 0 ? 0 : NA_KC) + kidx * 128);
            f32x4 z = {0.f, 0.f, 0.f, 0.f};
            z = __builtin_amdgcn_mfma_f32_16x16x32_bf16(ld8(kp + sw0), qf0, z, 0, 0, 0);
            st[t] = __builtin_amdgcn_mfma_f32_16x16x32_bf16(ld8(kp + sw1), qf1, z, 0, 0, 0);
        }
    }
    if (!ctxq) {
#pragma unroll
        for (int i = 0; i < 8; ++i) { const size_t tok = (size_t)b * SEQ + (rs + i) * 64 + skey; kv[i] = *(const u32x4*)(P + tok * PW + C_NV + h * 64 + sch * 8); }
    }
#pragma unroll
    for (int i = 0; i < 4; ++i) { const size_t tok = (size_t)MLAT + b * CTXL + skey + 64 * i; kv[8 + i] = *(const u32x4*)(P + tok * PW + C_NV + h * 64 + sch * 8); }
    if (active) {
        if (half == 0) {
            const int qc = jb * 16 + fr, wsx = min(max(qc - 8, 0), 48); LAS const float* rp = (LAS const float*)(lds + NA_RPB);
#pragma unroll
            for (int t = 0; t < 16; ++t) { const int dr = rs + (t >> 1) - r + 7;
#pragma unroll
                for (int reg = 0; reg < 4; ++reg) { const int kc = cstart + 16 * (t & 1) + 4 * fq + reg; const bool ok = kc >= wsx && kc < wsx + 16;
                    const int dc = min(max(kc - qc + 15, 0), 30); const float bias = rp[dr * 31 + dc];
                    st[t][reg] = ok ? (st[t][reg] * 0.125f + bias) * LOG2E : -1.0e30f; } }
        } else {
#pragma unroll
            for (int t = 0; t < 16; ++t) st[t] = st[t] * (0.125f * LOG2E);
        }
#pragma unroll
        for (int t = 0; t < 16; ++t) mx = fmaxf(mx, fmaxf(fmaxf(st[t][0], st[t][1]), fmaxf(st[t][2], st[t][3])));
        mx = fmaxf(mx, __shfl_xor(mx, 16)); mx = fmaxf(mx, __shfl_xor(mx, 32));
#pragma unroll
        for (int t = 0; t < 16; ++t)
#pragma unroll
            for (int reg = 0; reg < 4; ++reg) { const float p = __builtin_amdgcn_exp2f(st[t][reg] - mx); st[t][reg] = p; lsum += p; }
        lsum += __shfl_xor(lsum, 16); lsum += __shfl_xor(lsum, 32);
#pragma unroll
        for (int s = 0; s < 8; ++s) pa[s] = pack8(st[2 * s], st[2 * s + 1]);
    } else {
#pragma unroll
        for (int s = 0; s < 8; ++s) pa[s] = (bf16x8){0, 0, 0, 0, 0, 0, 0, 0};
    }
    __syncthreads();
    if (!ctxq) {
#pragma unroll
        for (int i = 0; i < 8; ++i) *(LAS u32x4*)(lds + sdst + i * 8192) = kv[i];
    }
#pragma unroll
    for (int i = 0; i < 4; ++i) *(LAS u32x4*)(lds + NA_KC + sdst + i * 8192) = kv[8 + i];
    __syncthreads();
    f32x4 o[4];
#pragma unroll
    for (int n = 0; n < 4; ++n) o[n] = (f32x4){0.f, 0.f, 0.f, 0.f};
    if (active) {
        const int q4 = (lane & 15) >> 2, p4 = lane & 3, c7 = 4 * (fq & 1) + q4;
        lptr vb = (lptr)(lds + (half == 0 ? 0 : NA_KC) + (4 * fq + q4) * 128 + 8 * (p4 & 1));
        int xo[4];
#pragma unroll
        for (int n = 0; n < 4; ++n) xo[n] = ((2 * n + (p4 >> 1)) ^ c7) << 4;
#pragma unroll
        for (int s = 0; s < 8; ++s) { const int k0 = half == 0 ? s * 64 + cstart : 32 * s;
#pragma unroll
            for (int n = 0; n < 4; ++n) { lptr rb = vb + k0 * 128 + xo[n];
                const bf16x4 lo = vtr(rb), hi = vtr(rb + 16 * 128);
                const bf16x8 bv = {lo[0], lo[1], lo[2], lo[3], hi[0], hi[1], hi[2], hi[3]};
                o[n] = __builtin_amdgcn_mfma_f32_16x16x32_bf16(pa[s], bv, o[n], 0, 0, 0); } }
    }
    LAS float* cb = (LAS float*)(lds + NA_COMB + wave * 4224);
#pragma unroll
    for (int n = 0; n < 4; ++n)
#pragma unroll
        for (int reg = 0; reg < 4; ++reg) cb[(4 * fq + reg) * 64 + n * 16 + fr] = o[n][reg];
    if (fq == 0) { cb[1024 + 2 * fr] = mx; cb[1025 + 2 * fr] = lsum; }
    __syncthreads();
    if (wave < 4) {
        LAS const float* c2 = (LAS const float*)(lds + NA_COMB + (wave + 4) * 4224);
#pragma unroll
        for (int reg = 0; reg < 4; ++reg) { const int q = 4 * fq + reg;
            const float m1 = cb[1024 + 2 * q], l1 = cb[1025 + 2 * q], m2 = c2[1024 + 2 * q], l2 = c2[1025 + 2 * q], M = fmaxf(m1, m2);
            const float w1 = __builtin_amdgcn_exp2f(m1 - M), w2 = __builtin_amdgcn_exp2f(m2 - M), inv = 1.0f / (w1 * l1 + w2 * l2);
            bf16_t* orow = F.CAT + (size_t)(tokq0 + jb * 16 + q) * DM + 640 + h * 64;
#pragma unroll
            for (int n = 0; n < 4; ++n) orow[n * 16 + fr] = (bf16_t)f2bf((w1 * o[n][reg] + w2 * c2[q * 64 + n * 16 + fr]) * inv); }
    }
}

__device__ __forceinline__ int ret_row0(int b, int t) { return t >= 2 ? b * SEQ + (t - 2) * 128 : MLAT + b * CTXL + t * 128; }
constexpr int R1_VT = 0, R1_KF = 26112, R1_KB = 52224;
__device__ __forceinline__ void r1_unit(Frame& F, int layer, int b, int h, int t) {
    F.fresh();
    const int lane = F.lane, wave = F.wave, fr = lane & 15, fq = lane >> 4;
    LAS unsigned char* lds = F.lds; const bf16_t* P = F.PROJ;
    const bool lat = t >= 2; const int row0 = ret_row0(b, t);
    const float lgf = F.LG[layer * 8 + h], lgb = F.LG[layer * 8 + 4 + h], ks = 0.10206207261596575f;
    __syncthreads();
    stage_T<6>(lds + R1_VT, 272, [&](int k) { return P + (size_t)(row0 + k) * PW + C_RV + h * 96; }, 96, wave, lane);
    const int il = lane & 7, jl = lane >> 3;
#pragma unroll
    for (int it = 0; it < 3; ++it) { const int wi = wave + NWAVES * it;
        const int i = (wi % 3) * 8 + il, jp = (wi / 3) * 8 + jl; float kv[2][4];
#pragma unroll
        for (int tk = 0; tk < 2; ++tk) { const int j = 2 * jp + tk; const bf16_t* kr = P + (size_t)(row0 + j) * PW + C_RK + h * 96;
            const float x1 = bf2f(kr[i]), x2 = bf2f(kr[i + 24]), y1 = bf2f(kr[48 + i]), y2 = bf2f(kr[72 + i]);
            if (lat) { const int pos = (t - 2) * 128 + j, prow = pos >> 6, pcol = pos & 63;
                const float cr = F.ROPE[(prow * 24 + i) * 2], sr = F.ROPE[(prow * 24 + i) * 2 + 1], cc = F.ROPE[(3072 + pcol * 24 + i) * 2], sc = F.ROPE[(3072 + pcol * 24 + i) * 2 + 1];
                kv[tk][0] = x1 * cr - x2 * sr; kv[tk][1] = x1 * sr + x2 * cr; kv[tk][2] = y1 * cc - y2 * sc; kv[tk][3] = y1 * sc + y2 * cc;
            } else { kv[tk][0] = x1; kv[tk][1] = x2; kv[tk][2] = y1; kv[tk][3] = y2; } }
        const float wf0 = expf(lgf * (float)(127 - 2 * jp)) * ks, wf1 = expf(lgf * (float)(126 - 2 * jp)) * ks, wb0 = expf(lgb * (float)(2 * jp)) * ks, wb1 = expf(lgb * (float)(2 * jp + 1)) * ks;
#pragma unroll
        for (int q = 0; q < 4; ++q) { const int d = q * 24 + i;
            *(LAS unsigned*)(lds + R1_KF + d * 272 + jp * 4) = pk2(kv[0][q] * wf0, kv[1][q] * wf1);
            *(LAS unsigned*)(lds + R1_KB + d * 272 + jp * 4) = pk2(kv[0][q] * wb0, kv[1][q] * wb1); }
    }
    __syncthreads();
    const int dir = wave >> 2, q = wave & 3, mb = q >> 1, nb = q & 1; f32x4 acc[3][3]; zero_acc(acc);
    wave_mma<3, 3>(acc, (lptr)(lds + R1_VT + mb * 48 * 272), 272, (lptr)(lds + (dir ? R1_KB : R1_KF) + nb * 48 * 272), 272, 4, fr, fq);
    const int u = dir == 0 ? t : (t < 2 ? 1 - t : 67 - t);
    float* ST = F.STATE + (size_t)(((b * 4 + h) * 2 + dir) * 66 + u) * 9216;
#pragma unroll
    for (int m = 0; m < 3; ++m)
#pragma unroll
        for (int n = 0; n < 3; ++n)
#pragma unroll
            for (int reg = 0; reg < 4; ++reg) ST[(mb * 48 + m * 16 + 4 * fq + reg) * 96 + nb * 48 + n * 16 + fr] = acc[m][n][reg];
}
__device__ __forceinline__ void r2_scan(Frame& F, int layer) {
    F.fresh();
    const int gt = F.vcu * NTHR + F.tid, GT = F.G * NTHR;
    for (int e = gt; e < 16 * 4608; e += GT) { const int combo = e / 4608, idx = (e % 4608) * 2, h = (combo >> 1) & 3, dir = combo & 1;
        const float dcy = expf(128.0f * F.LG[layer * 8 + dir * 4 + h]); float* p = F.STATE + (size_t)combo * 66 * 9216 + idx; f32x2 s = {0.f, 0.f};
#pragma unroll 1
        for (int u0 = 0; u0 < 66; u0 += 33) { f32x2 kv[33];
#pragma unroll
            for (int q = 0; q < 33; ++q) kv[q] = *(const f32x2*)(p + (size_t)(u0 + q) * 9216);
#pragma unroll
            for (int q = 0; q < 33; ++q) { *(f32x2*)(p + (size_t)(u0 + q) * 9216) = s; s = s * dcy + kv[q]; } } }
}
constexpr int R3_Q = 0, R3_K = 26624, R3_VT = 53248, R3_P = 79360, R3_SF = 114176, R3_SB = 134144;
static_assert(R3_SB + 96 * 208 <= MISC_OFF, "R3 LDS map");
__device__ __forceinline__ void r3_unit(Frame& F, int layer, int b, int h, int t) {
    F.fresh();
    const int tid = F.tid, lane = F.lane, wave = F.wave, fr = lane & 15, fq = lane >> 4;
    LAS unsigned char* lds = F.lds; const bf16_t* P = F.PROJ;
    const bool lat = t >= 2; const int row0 = ret_row0(b, t);
    const float lf2 = F.LG[layer * 8 + h] * LOG2E, lb2 = F.LG[layer * 8 + 4 + h] * LOG2E, ks = 0.10206207261596575f;
    __syncthreads();
#pragma unroll
    for (int it = 0; it < 3; ++it) { const int e = tid + NTHR * it; const int ip = e % 12, j = e / 12, i = 2 * ip;
        f32x4 cr = {1.f, 0.f, 1.f, 0.f}, cc = {1.f, 0.f, 1.f, 0.f};
        if (lat) { const int pos = (t - 2) * 128 + j, prow = pos >> 6, pcol = pos & 63; cr = *(const f32x4*)(F.ROPE + (prow * 24 + i) * 2); cc = *(const f32x4*)(F.ROPE + (3072 + pcol * 24 + i) * 2); }
#pragma unroll
        for (int X = 0; X < 2; ++X) { const bf16_t* xr = P + (size_t)(row0 + j) * PW + (X ? C_RK : C_RQ) + h * 96; const float scl = X ? ks : 1.0f;
            const unsigned u0 = *(const unsigned*)(xr + i), u1 = *(const unsigned*)(xr + i + 24), u2 = *(const unsigned*)(xr + 48 + i), u3 = *(const unsigned*)(xr + 72 + i);
            const float x1a = bflo(u0), x1b = bfhi(u0), x2a = bflo(u1), x2b = bfhi(u1), y1a = bflo(u2), y1b = bfhi(u2), y2a = bflo(u3), y2b = bfhi(u3);
            LAS unsigned char* dst = lds + (X ? R3_K : R3_Q) + j * 208 + i * 2;
            *(LAS unsigned*)(dst) = pk2((x1a * cr[0] - x2a * cr[1]) * scl, (x1b * cr[2] - x2b * cr[3]) * scl);
            *(LAS unsigned*)(dst + 48) = pk2((x1a * cr[1] + x2a * cr[0]) * scl, (x1b * cr[3] + x2b * cr[2]) * scl);
            *(LAS unsigned*)(dst + 96) = pk2((y1a * cc[0] - y2a * cc[1]) * scl, (y1b * cc[2] - y2b * cc[3]) * scl);
            *(LAS unsigned*)(dst + 144) = pk2((y1a * cc[1] + y2a * cc[0]) * scl, (y1b * cc[3] + y2b * cc[2]) * scl); }
    }
    stage_T<6>(lds + R3_VT, 272, [&](int k) { return P + (size_t)(row0 + k) * PW + C_RV + h * 96; }, 96, wave, lane);
    const int ub = t < 2 ? 1 - t : 67 - t;
#pragma unroll
    for (int dir = 0; dir < 2; ++dir) { const float* S = F.STATE + (size_t)(((b * 4 + h) * 2 + dir) * 66 + (dir ? ub : t)) * 9216; f32x4 v[5];
#pragma unroll
        for (int it = 0; it < 5; ++it) { const int e = tid + NTHR * it; if (e < 2304) v[it] = *(const f32x4*)(S + (e / 24) * 96 + (e % 24) * 4); }
#pragma unroll
        for (int it = 0; it < 5; ++it) { const int e = tid + NTHR * it; if (e < 2304) { u32x2 w; w.x = pk2(v[it][0], v[it][1]); w.y = pk2(v[it][2], v[it][3]);
            *(LAS u32x2*)(lds + (dir ? R3_SB : R3_SF) + (e / 24) * 208 + (e % 24) * 8) = w; } } }
    __syncthreads();
    {
        bf16x8 qf[3];
#pragma unroll
        for (int s = 0; s < 3; ++s) qf[s] = ld8((lptr)(lds + R3_Q + (wave * 16 + fr) * 208 + s * 64 + fq * 16));
        const int i = wave * 16 + fr;
#pragma unroll
        for (int m = 0; m < 8; ++m) { f32x4 a = {0.f, 0.f, 0.f, 0.f};
#pragma unroll
            for (int s = 0; s < 3; ++s) a = __builtin_amdgcn_mfma_f32_16x16x32_bf16(ld8((lptr)(lds + R3_K + (m * 16 + fr) * 208 + s * 64 + fq * 16)), qf[s], a, 0, 0, 0);
            float pv[4];
#pragma unroll
            for (int reg = 0; reg < 4; ++reg) { const int diff = i - (m * 16 + 4 * fq + reg);
                const float dec = diff > 0 ? __builtin_amdgcn_exp2f(lf2 * (float)diff) : (diff < 0 ? __builtin_amdgcn_exp2f(lb2 * (float)(-diff)) : 2.0f); pv[reg] = a[reg] * dec; }
            u32x2 w; w.x = pk2(pv[0], pv[1]); w.y = pk2(pv[2], pv[3]); *(LAS u32x2*)(lds + R3_P + i * 272 + (m * 16 + 4 * fq) * 2) = w; }
    }
    asm volatile("s_waitcnt lgkmcnt(0)" ::: "memory");
    f32x4 ao[1][6], af[1][6], ab[1][6]; zero_acc(ao); zero_acc(af); zero_acc(ab);
    wave_mma<1, 6>(ao, (lptr)(lds + R3_P + wave * 16 * 272), 272, (lptr)(lds + R3_VT), 272, 4, fr, fq);
    wave_mma<1, 6>(af, (lptr)(lds + R3_Q + wave * 16 * 208), 208, (lptr)(lds + R3_SF), 208, 3, fr, fq);
    wave_mma<1, 6>(ab, (lptr)(lds + R3_Q + wave * 16 * 208), 208, (lptr)(lds + R3_SB), 208, 3, fr, fq);
    const float* gain = F.ret_g + layer * 384 + h * 96;
#pragma unroll
    for (int reg = 0; reg < 4; ++reg) { const int il = wave * 16 + 4 * fq + reg;
        const float qdf = __builtin_amdgcn_exp2f(lf2 * (float)(il + 1)), qdb = __builtin_amdgcn_exp2f(lb2 * (float)(128 - il)); float ov[6], ss = 0.f;
#pragma unroll
        for (int n = 0; n < 6; ++n) { ov[n] = ao[0][n][reg] + qdf * af[0][n][reg] + qdb * ab[0][n][reg]; ss += ov[n] * ov[n]; }
        ss += __shfl_xor(ss, 1); ss += __shfl_xor(ss, 2); ss += __shfl_xor(ss, 4); ss += __shfl_xor(ss, 8);
        const float rn = rsqrtf(ss * (1.0f / 96.0f) + NORM_EPS); const size_t row = (size_t)(row0 + il);
#pragma unroll
        for (int n = 0; n < 6; ++n) { const int col = n * 16 + fr; const float gt = bf2f(P[row * PW + C_RG + h * 96 + col]);
            F.CAT[row * DM + 256 + h * 96 + col] = (bf16_t)f2bf(ov[n] * rn * gain[col] * silu_f(gt)); } }
}

__device__ __forceinline__ void d1_unit(Frame& F, int b, int l2, int g) {
    F.fresh();
    const int tid = F.tid, lane = F.lane, wave = F.wave, fr = lane & 15, fq = lane >> 4;
    LAS unsigned char* lds = F.lds; const bf16_t* P = F.PROJ;
    __syncthreads();
    {
        u32x4 v[2];
#pragma unroll
        for (int i = 0; i < 2; ++i) { const int row = (tid >> 3) + 64 * i, ch = tid & 7; v[i] = *(const u32x4*)(P + ((size_t)b * SEQ + row * 64 + l2) * PW + g * 64 + ch * 8); }
#pragma unroll
        for (int i = 0; i < 2; ++i) { const int row = (tid >> 3) + 64 * i, ch = tid & 7; *(LAS u32x4*)(lds + row * 128 + ((ch ^ (row & 7)) << 4)) = v[i]; }
    }
    bf16x8 bfr[2][4];
#pragma unroll
    for (int cs = 0; cs < 2; ++cs)
#pragma unroll
        for (int s = 0; s < 4; ++s) bfr[cs][s] = *(const bf16x8*)(F.TWA + (size_t)(cs * 128 + 16 * wave + fr) * 128 + 32 * s + 8 * fq);
    __syncthreads();
    f32x4 acc[4][2]; zero_acc(acc);
    const int q4 = (lane & 15) >> 2, p4 = lane & 3;
#pragma unroll
    for (int s = 0; s < 4; ++s)
#pragma unroll
        for (int mt = 0; mt < 4; ++mt) {
            lptr rb = (lptr)(lds + (32 * s + 8 * fq + q4) * 128 + 8 * (p4 & 1));
            const bf16x4 lo = vtr(rb + (((2 * mt + (p4 >> 1)) ^ q4) << 4)), hi = vtr(rb + 4 * 128 + (((2 * mt + (p4 >> 1)) ^ (4 + q4)) << 4));
            const bf16x8 av = {lo[0], lo[1], lo[2], lo[3], hi[0], hi[1], hi[2], hi[3]};
            acc[mt][0] = __builtin_amdgcn_mfma_f32_16x16x32_bf16(av, bfr[0][s], acc[mt][0], 0, 0, 0);
            acc[mt][1] = __builtin_amdgcn_mfma_f32_16x16x32_bf16(av, bfr[1][s], acc[mt][1], 0, 0, 0);
        }
    const int k1 = 16 * wave + fr; const f32x2 cs2 = *(const f32x2*)(F.TW8 + 2 * (k1 * l2));
    unsigned* yb = F.Y + ((((size_t)b * 128 + k1) * 4 + g) * 64) * 64 + l2;
#pragma unroll
    for (int mt = 0; mt < 2; ++mt)
#pragma unroll
        for (int reg = 0; reg < 4; ++reg) { const int p = 16 * mt + 4 * fq + reg;
            const float cp = acc[mt][0][reg], sp = acc[mt][1][reg], cq = acc[mt + 2][0][reg], sq = acc[mt + 2][1][reg];
            float yr0, yi0, yr1, yi1; int m0, m1;
            if (p == 0) { m0 = 0; yr0 = cp; yi0 = -sp; m1 = 32; yr1 = cq; yi1 = -sq; }
            else { m0 = p; yr0 = cp + sq; yi0 = cq - sp; m1 = 64 - p; yr1 = cp - sq; yi1 = -cq - sp; }
            yb[(size_t)m0 * 64] = pk2(yr0 * cs2[0] + yi0 * cs2[1], yi0 * cs2[0] - yr0 * cs2[1]);
            yb[(size_t)m1 * 64] = pk2(yr1 * cs2[0] + yi1 * cs2[1], yi1 * cs2[0] - yr1 * cs2[1]); }
}
constexpr int D2_Y = 0, D2_A = 69632, D2_F = 87040;
__device__ __forceinline__ void d2_unit(Frame& F, int layer, int b, int k1) {
    F.fresh();
    const int tid = F.tid, lane = F.lane, wave = F.wave, fr = lane & 15, fq = lane >> 4;
    LAS unsigned char* lds = F.lds;
    __syncthreads();
    const unsigned* ysrc = F.Y + (size_t)(b * 128 + k1) * 4 * 64 * 64;
    for (int e = tid; e < 4096; e += NTHR) { const int row = e >> 4, ch = e & 15; *(LAS u32x4*)(lds + D2_Y + row * 272 + ch * 16) = *(const u32x4*)(ysrc + row * 64 + ch * 4); }
    for (int e = tid; e < 1024; e += NTHR) { const int row = e >> 4, ch = e & 15; *(LAS u32x4*)(lds + D2_A + row * 272 + ch * 16) = *(const u32x4*)(F.TD2 + row * 128 + ch * 8); }
    __syncthreads();
    f32x4 acc[4][2]; zero_acc(acc);
    wave_mma<4, 2>(acc, (lptr)(lds + D2_A), 272, (lptr)(lds + D2_Y + wave * 32 * 272), 272, 4, fr, fq);
    const float scale = 0.0013810679320049757f;
#pragma unroll
    for (int mt = 0; mt < 4; ++mt)
#pragma unroll
        for (int nt = 0; nt < 2; ++nt)
#pragma unroll
            for (int reg = 0; reg < 4; ++reg) *(LAS bf16_t*)(lds + D2_F + (mt * 16 + 4 * fq + reg) * 528 + (wave * 32 + nt * 16 + fr) * 2) = (bf16_t)f2bf(acc[mt][nt][reg] * scale);
    __syncthreads();
    zero_acc(acc);
    wave_mma<4, 2>(acc, (lptr)(lds + D2_F), 528, (gptr)(F.WFT + (size_t)layer * 65536) + (size_t)(wave * 32) * 512, 512, 8, fr, fq);
#pragma unroll
    for (int mt = 0; mt < 4; ++mt)
#pragma unroll
        for (int nt = 0; nt < 2; ++nt)
#pragma unroll
            for (int reg = 0; reg < 4; ++reg) { const int k2 = mt * 16 + 4 * fq + reg, oc = wave * 32 + nt * 16 + fr;
                F.CAT[((size_t)b * SEQ + k1 + 128 * k2) * DM + oc] = (bf16_t)f2bf(acc[mt][nt][reg]); }
}
constexpr int DC_H = 0, DC_F = 131072;
__device__ __forceinline__ void dctx_item(Frame& F, int layer, int it) {
    F.fresh();
    const int tid = F.tid, lane = F.lane, wave = F.wave, fr = lane & 15, fq = lane >> 4; LAS unsigned char* lds = F.lds; const bf16_t* P = F.PROJ;
    const int b = it >> 5, k0 = (it & 31) * 8;
    __syncthreads();
    { u32x4 v[16];
#pragma unroll
      for (int i = 0; i < 16; ++i) { const int e = tid + NTHR * i, row = e >> 5, ch = e & 31; v[i] = *(const u32x4*)(P + ((size_t)MLAT + b * CTXL + row) * PW + ch * 8); }
#pragma unroll
      for (int i = 0; i < 16; ++i) { const int e = tid + NTHR * i, row = e >> 5, ch = e & 31; *(LAS u32x4*)(lds + DC_H + row * 512 + ((ch ^ (row & 15)) << 4)) = v[i]; } }
    for (int e = tid; e < 16 * 132; e += NTHR) ((LAS unsigned*)(lds + DC_F))[e] = 0u;
    bf16x8 bfr[8];
    { const bf16_t* tb = F.TC256 + ((size_t)((fr >> 3) * 256 + k0 + (fr & 7))) * 256 + 8 * fq;
#pragma unroll
      for (int s = 0; s < 8; ++s) bfr[s] = *(const bf16x8*)(tb + 32 * s); }
    __syncthreads();
    const int g = wave >> 1, jj = wave & 1, q4 = (lane & 15) >> 2, p4 = lane & 3;
    f32x4 acc[2]; acc[0] = (f32x4){0.f, 0.f, 0.f, 0.f}; acc[1] = acc[0];
#pragma unroll
    for (int s = 0; s < 8; ++s)
#pragma unroll
        for (int mt = 0; mt < 2; ++mt) { const int chunk = 2 * (g * 4 + jj + 2 * mt) + (p4 >> 1); const int r0 = 32 * s + 8 * fq + q4;
            const bf16x4 lo = vtr((lptr)(lds + DC_H + r0 * 512 + ((chunk ^ (r0 & 15)) << 4) + 8 * (p4 & 1)));
            const bf16x4 hi = vtr((lptr)(lds + DC_H + (r0 + 4) * 512 + ((chunk ^ ((r0 + 4) & 15)) << 4) + 8 * (p4 & 1)));
            const bf16x8 av = {lo[0], lo[1], lo[2], lo[3], hi[0], hi[1], hi[2], hi[3]};
            acc[mt] = __builtin_amdgcn_mfma_f32_16x16x32_bf16(av, bfr[s], acc[mt], 0, 0, 0); }
    const int kk = fr & 7; const bool hiLane = fr >= 8;
#pragma unroll
    for (int reg = 0; reg < 4; ++reg) { const int pp = jj * 16 + 4 * fq + reg;
        const float vp = acc[0][reg], vq = acc[1][reg], op = __shfl_xor(vp, 8), oq = __shfl_xor(vq, 8);
        const float c_p = hiLane ? op : vp, c_q = hiLane ? oq : vq, s_q = hiLane ? vq : oq;
        float x; int m;
        if (pp == 0) { m = hiLane ? 32 : 0; x = hiLane ? c_q : c_p; } else { m = hiLane ? 64 - pp : pp; x = hiLane ? c_p - s_q : c_p + s_q; }
        *(LAS bf16_t*)(lds + DC_F + kk * 528 + (g * 64 + m) * 2) = (bf16_t)f2bf(x * (1.0f / 128.0f)); }
    __syncthreads();
    f32x4 o2[1][2]; zero_acc(o2);
    wave_mma<1, 2>(o2, (lptr)(lds + DC_F), 528, (gptr)(F.WFT + (size_t)layer * 65536) + (size_t)(wave * 32) * 512, 512, 8, fr, fq);
    if (fq < 2) {
#pragma unroll
        for (int nt = 0; nt < 2; ++nt)
#pragma unroll
            for (int reg = 0; reg < 4; ++reg) F.CAT[((size_t)MLAT + b * CTXL + k0 + 4 * fq + reg) * DM + wave * 32 + nt * 16 + fr] = (bf16_t)f2bf(o2[0][nt][reg]);
    }
}

#ifndef DUP_PHASE
#define DUP_PHASE 0
#endif
__device__ __forceinline__ void phase_m1(Frame& F, int layer) {
    const int nNA = 1536, nCQ = layer == 0 ? 48 : 0, nR1 = 528, nD1 = 512;
#pragma unroll 1
    for (int rep = 0; rep < (DUP_PHASE == 6 ? 2 : 1); ++rep)
        for (int it = blockIdx.x; it < nNA; it += F.G) na_unit(F, layer, it / 768, (it % 768) / 128, it % 128, false);
#pragma unroll 1
    for (int rep = 0; rep < (DUP_PHASE == 11 ? 2 : 1); ++rep)
        for (int q = blockIdx.x; q < nCQ; q += F.G) na_unit(F, layer, q / 24, (q % 24) / 4, q & 3, true);
#pragma unroll 1
    for (int rep = 0; rep < (DUP_PHASE == 7 ? 2 : 1); ++rep)
        for (int q = blockIdx.x; q < nR1; q += F.G) r1_unit(F, layer, q / 264, (q % 264) / 66, q % 66);
#pragma unroll 1
    for (int rep = 0; rep < (DUP_PHASE == 8 ? 2 : 1); ++rep)
        for (int q = blockIdx.x; q < nD1; q += F.G) d1_unit(F, q >> 8, (q >> 2) & 63, q & 3);
}
__device__ __forceinline__ void phase_m2(Frame& F, int layer) {
    r2_scan(F, layer);
    const int nD2 = 256, nDC = layer == 0 ? 64 : 0;
#pragma unroll 1
    for (int rep = 0; rep < (DUP_PHASE == 9 ? 2 : 1); ++rep)
        for (int it = blockIdx.x; it < nD2; it += F.G) d2_unit(F, layer, it >> 7, it & 127);
#pragma unroll 1
    for (int rep = 0; rep < (DUP_PHASE == 22 ? 2 : 1); ++rep)
        for (int it = blockIdx.x; it < nDC; it += F.G) dctx_item(F, layer, it);
}
__device__ __forceinline__ void phase_m3(Frame& F, int layer) {
    const int nt = layer == 0 ? 66 : 64, t0 = layer == 0 ? 0 : 2, total = 8 * nt;
    for (int it = blockIdx.x; it < total; it += F.G) r3_unit(F, layer, it / (4 * nt), (it / nt) & 3, t0 + it % nt);
}

struct SgParams {
    const bf16_t* A; int lda; const bf16_t* Bt; int K;
    int mode;
    const float* ssq; const float* shw;
    bf16_t* O;
    const float* src; float* dst; bf16_t* XN; float* ssq_out; const float* gate; const float* sc; const float* g; float gmul;
};
constexpr int SG_A = 0, SG_B = 16384, SG_STAGE = 16384 + 65536;
__device__ __forceinline__ void sg_unit(Frame& F, const SgParams& p, int mblk, int ntile) {
    F.fresh();
    const int tid = F.tid, lane = F.lane, wave = F.wave, fr = lane & 15, fq = lane >> 4, wr = wave & 1, wc = wave >> 1;
    LAS unsigned char* lds = F.lds;
    const int srow = tid >> 3, sch = tid & 7; const unsigned sdst = (unsigned)(srow * 128 + ((sch ^ (srow & 7)) << 4));
    const bf16_t* ap = p.A + (size_t)(mblk * 64 + srow) * p.lda + sch * 8;
    const bf16_t* bp = p.Bt + (size_t)(ntile * 256 + srow) * p.K + sch * 8;
    int boff[4];
#pragma unroll
    for (int n = 0; n < 4; ++n) boff[n] = p.mode == 2 ? ((n >> 1) * 128 + wc * 32 + (n & 1) * 16) : (wc * 64 + n * 16);
    const int sw0 = (fq ^ (fr & 7)) << 4, sw1 = ((4 + fq) ^ (fr & 7)) << 4;
    f32x4 acc[2][4]; zero_acc(acc);
    const int nk = p.K / 64;
    u32x4 ra, rb[4];
    __syncthreads();
    ra = *(const u32x4*)ap;
#pragma unroll
    for (int i = 0; i < 4; ++i) rb[i] = *(const u32x4*)(bp + (size_t)(64 * i) * p.K);
    *(LAS u32x4*)(lds + SG_A + sdst) = ra;
#pragma unroll
    for (int i = 0; i < 4; ++i) *(LAS u32x4*)(lds + SG_B + sdst + i * 8192) = rb[i];
    __syncthreads();
    for (int kt = 0; kt < nk; ++kt) {
        const int cur = kt & 1; const bool more = kt + 1 < nk;
        if (more) { ra = *(const u32x4*)(ap + (kt + 1) * 64);
#pragma unroll
            for (int i = 0; i < 4; ++i) rb[i] = *(const u32x4*)(bp + (size_t)(64 * i) * p.K + (kt + 1) * 64); }
        lptr Ab = (lptr)(lds + SG_A + cur * 8192 + (wr * 32 + fr) * 128), Bb = (lptr)(lds + SG_B + cur * 32768 + fr * 128);
#pragma unroll
        for (int s = 0; s < 2; ++s) { const int sw = s ? sw1 : sw0; bf16x8 a[2], b[4];
#pragma unroll
            for (int m = 0; m < 2; ++m) a[m] = ld8(Ab + m * 16 * 128 + sw);
#pragma unroll
            for (int n = 0; n < 4; ++n) b[n] = ld8(Bb + boff[n] * 128 + sw);
#pragma unroll
            for (int m = 0; m < 2; ++m)
#pragma unroll
                for (int n = 0; n < 4; ++n) acc[m][n] = __builtin_amdgcn_mfma_f32_16x16x32_bf16(b[n], a[m], acc[m][n], 0, 0, 0); }
        if (more) { *(LAS u32x4*)(lds + SG_A + (cur ^ 1) * 8192 + sdst) = ra;
#pragma unroll
            for (int i = 0; i < 4; ++i) *(LAS u32x4*)(lds + SG_B + (cur ^ 1) * 32768 + sdst + i * 8192) = rb[i]; }
        __syncthreads();
    }
#pragma unroll
    for (int m = 0; m < 2; ++m) { const int rl = mblk * 64 + wr * 32 + m * 16 + fr; const size_t rg = (size_t)MLAT + rl;
        if (p.mode == 0) { const float ri = pg8::row_rinv(p.ssq, (int)rg);
#pragma unroll
            for (int n = 0; n < 4; ++n) { const int col = ntile * 256 + boff[n] + 4 * fq; if (col < PW) { const f32x4 v = acc[m][n] * ri + *(const f32x4*)(p.shw + col);
                u32x2 w; w.x = pk2(v[0], v[1]); w.y = pk2(v[2], v[3]); *(u32x2*)(p.O + rg * PW + col) = w; } }
        } else if (p.mode == 2) { const float ri = pg8::row_rinv(p.ssq, (int)rg);
#pragma unroll
            for (int n = 0; n < 2; ++n) { const int wcol = ntile * 256 + boff[n] + 4 * fq, hcol = ntile * 128 + wc * 32 + n * 16 + 4 * fq;
                const f32x4 a = acc[m][n] * ri + *(const f32x4*)(p.shw + wcol), b = acc[m][n + 2] * ri + *(const f32x4*)(p.shw + wcol + 128);
                u32x2 w; w.x = pk2(silu_f(a[0]) * b[0], silu_f(a[1]) * b[1]); w.y = pk2(silu_f(a[2]) * b[2], silu_f(a[3]) * b[3]); *(u32x2*)(p.O + rg * FF + hcol) = w; }
        } else { float ss = 0.f;
#pragma unroll
            for (int n = 0; n < 4; ++n) { const int col = ntile * 256 + boff[n] + 4 * fq; const size_t ol = (size_t)rl * DM + col;
                const f32x4 x1 = *(const f32x4*)(p.src + ol) + *(const f32x4*)(p.gate + col) * p.gmul * acc[m][n];
                *(f32x4*)(p.dst + ol) = x1; ss += (x1[0] * x1[0] + x1[1] * x1[1]) + (x1[2] * x1[2] + x1[3] * x1[3]);
                if (p.XN) { const f32x4 xn = x1 * (*(const f32x4*)(p.g + col) * (*(const f32x4*)(p.sc + col) + 1.0f)); u32x2 w; w.x = pk2(xn[0], xn[1]); w.y = pk2(xn[2], xn[3]); *(u32x2*)(p.XN + rg * DM + col) = w; } }
            ss += __shfl_xor(ss, 16); ss += __shfl_xor(ss, 32);
            if (fq == 0) p.ssq_out[rg * 16 + ntile * 4 + wc] = ss; }
    }
}
__device__ __forceinline__ void sg_phase(Frame& F, const SgParams& p, int ntiles, int big_units) {
    const int first_free = big_units % F.G, nfree = F.G - first_free, c = (int)blockIdx.x;
    if (c < first_free) return;
    for (int u = c - first_free; u < 8 * ntiles; u += nfree) sg_unit(F, p, u % 8, u / 8);
}

#ifndef MK_N_LAUNCHES
#define MK_N_LAUNCHES 1
#endif
constexpr int N_PHASES = 17;
struct Args { const float* in[18]; float* out; unsigned char* ws; int ph_lo, ph_hi; };
__global__ void __launch_bounds__(NTHR, 2) hymba_fwd(Args args) {
    extern __shared__ __attribute__((aligned(16))) unsigned char lds_raw[];
    Frame F;
    F.lds = (LAS unsigned char*)lds_raw;
    F.tid = threadIdx.x; F.lane = F.tid & 63; F.wave = __builtin_amdgcn_readfirstlane(F.tid >> 6);
    F.G = gridDim.x; { const int bx = blockIdx.x; F.vcu = (F.G % 8 == 0) ? (bx % 8) * (F.G / 8) + bx / 8 : bx; }
    F.x = args.in[0]; F.c = args.in[1]; F.ctx = args.in[2]; F.c_ctx = args.in[3]; F.w_ada = args.in[4]; F.b_ada = args.in[5]; F.g_mix = args.in[6]; F.w_in = args.in[7];
    F.dlogit = args.in[8]; F.ret_g = args.in[9]; F.w_four = args.in[10]; F.rpb = args.in[11]; F.w_out = args.in[12]; F.g_ffn = args.in[13]; F.w1 = args.in[14]; F.w3 = args.in[15];
    F.w2 = args.in[16]; F.g_final = args.in[17]; F.out = args.out; F.ws = args.ws;
    unsigned char* ws = args.ws;
    F.MOD = (float*)(ws + WS_MOD); F.SHWIN = (float*)(ws + WS_SHWIN); F.SHW13 = (float*)(ws + WS_SHW13); F.ROPE = (float*)(ws + WS_ROPE); F.LG = (float*)(ws + WS_LG); F.CT256 = (float*)(ws + WS_CT256);
    F.SSQ = (float*)(ws + WS_SSQ); F.XC = (float*)(ws + WS_XC); F.STATE = (float*)(ws + WS_STATE); F.ADAP = (float*)(ws + WS_PROJ); F.TW8 = (const float*)(ws + WS_TAB + T_TW8);
    F.XN = (bf16_t*)(ws + WS_XN); F.CAT = (bf16_t*)(ws + WS_CAT); F.PROJ = (bf16_t*)(ws + WS_PROJ); F.HID = (bf16_t*)(ws + WS_PROJ);
    F.WFT = (bf16_t*)(ws + WS_TAB + T_WFT); F.TWA = (bf16_t*)(ws + WS_TAB + T_TWA); F.TD2 = (bf16_t*)(ws + WS_TAB + T_TD2); F.TC256 = (bf16_t*)(ws + WS_TAB + T_TC); F.Y = (unsigned*)(ws + WS_XN);
    volatile LAS unsigned* MISC = (volatile LAS unsigned*)(F.lds + MISC_OFF);
    if (F.tid < 64) MISC[F.tid] = 0u;
    __syncthreads();
    const int lo = args.ph_lo, hi = args.ph_hi;
#if MK_N_LAUNCHES == 1
    XcdBarrier bar = xcd_barrier_post((unsigned*)(ws + WS_CTL) + CW_BAR, MISC + 8);
    cg::grid_group grid = cg::this_grid();
#define SEAM(k) do { if ((k) == 0) grid.sync(); else { _Pragma("unroll 1") for (int rep_ = 0; rep_ < (DUP_PHASE == 19 ? 5 : 1); ++rep_) xcd_barrier(bar); } } while (0)
#else
#define SEAM(k) do { } while (0)
#endif
#define IN(k) (lo <= (k) && (k) < hi)
#ifndef STAMP_SEL
#define STAMP_SEL -1
#endif
    unsigned long long* stamps = (unsigned long long*)(ws + WS_CTL + 61440);
#define STAMP(k) do { if (STAMP_SEL >= 0 && blockIdx.x == 0 && threadIdx.x == 0) stamps[k] = __builtin_amdgcn_s_memrealtime(); } while (0)
    STAMP(0);
    if (IN(0)) { _Pragma("unroll 1") for (int rep = 0; rep < (DUP_PHASE == 5 ? 2 : 1); ++rep) { __syncthreads(); phase_p0a(F); } if (IN(1)) SEAM(0); } STAMP(1);
    if (IN(1)) { _Pragma("unroll 1") for (int rep = 0; rep < (DUP_PHASE == 21 ? 2 : 1); ++rep) { __syncthreads(); phase_p0b(F); } if (IN(2)) SEAM(1); } STAMP(2);
#pragma unroll 1
    for (int layer = 0; layer < 2; ++layer) {
        const int pb = 2 + 7 * layer; const bool last = layer == 1;
        const float* mod = F.MOD + (size_t)layer * 3 * 6144;
        if (IN(pb + 0)) {
            pg8::Gemm g{F.XN, F.W(layer, W_WIN), MLAT, PWP, DM}; pg8::StaticOrder S; S.init(MLAT, PWP, F.G, (int)blockIdx.x);
            pg8::EpiProj E{F.PROJ, F.SSQ, F.SHWIN + (size_t)layer * 3 * PWP};
            _Pragma("unroll 1") for (int rep = 0; rep < (DUP_PHASE == 1 ? 2 : 1); ++rep) { __syncthreads(); pg8::gemm_phase<pg8::EpiProj, pg8::StaticOrder, true, true>(F.lds, g, S, E); }
            { SgParams sp{}; sp.A = F.XN + (size_t)MLAT * DM; sp.lda = DM; sp.Bt = F.W(layer, W_WIN); sp.K = DM; sp.mode = 0; sp.ssq = F.SSQ; sp.shw = F.SHWIN + (size_t)(layer * 3 + 2) * PWP; sp.O = F.PROJ;
              _Pragma("unroll 1") for (int rep = 0; rep < (DUP_PHASE == 12 ? 3 : 1); ++rep) sg_phase(F, sp, 12, 768); }
            if (IN(pb + 1)) SEAM(pb);
        }
        STAMP(pb + 1);
        if (IN(pb + 1)) { _Pragma("unroll 1") for (int rep = 0; rep < (DUP_PHASE == 2 ? 2 : 1); ++rep) phase_m1(F, layer); if (IN(pb + 2)) SEAM(pb + 1); } STAMP(pb + 2);
        if (IN(pb + 2)) { phase_m2(F, layer); if (IN(pb + 3)) SEAM(pb + 2); } STAMP(pb + 3);
        if (IN(pb + 3)) { _Pragma("unroll 1") for (int rep = 0; rep < (DUP_PHASE == 3 ? 2 : 1); ++rep) phase_m3(F, layer); if (IN(pb + 4)) SEAM(pb + 3); } STAMP(pb + 4);
        const int Mrows = MLAT;
        if (IN(pb + 4)) {
            pg8::Gemm g{F.CAT, F.W(layer, W_WOUT), Mrows, DM, DM}; pg8::StaticOrder S; S.init(Mrows, DM, F.G, (int)blockIdx.x);
            pg8::EpiRes E{last ? F.out : F.x, last ? F.XC : F.ctx, F.out, F.XC, F.XN, F.SSQ, mod + 2048, mod + 4096, F.g_ffn + layer * DM, 1.0f};
            _Pragma("unroll 1") for (int rep = 0; rep < (DUP_PHASE == 16 ? 2 : 1); ++rep) { E.gmul = (DUP_PHASE == 16 && rep == 0) ? 0.0f : 1.0f; if (DUP_PHASE == 16 && rep == 0) { E.src_lat = F.out; } else { E.src_lat = last ? F.out : F.x; } __syncthreads(); pg8::gemm_phase<pg8::EpiRes, pg8::StaticOrder, true, true>(F.lds, g, S, E); }
            if (!last) { SgParams sp{}; sp.A = F.CAT + (size_t)MLAT * DM; sp.lda = DM; sp.Bt = F.W(layer, W_WOUT); sp.K = DM; sp.mode = 1; sp.src = F.ctx; sp.dst = F.XC; sp.XN = F.XN; sp.ssq_out = F.SSQ;
              sp.gate = mod + 2048 + 2 * 6144; sp.sc = mod + 4096 + 2 * 6144; sp.g = F.g_ffn + layer * DM; sp.gmul = 1.0f; _Pragma("unroll 1") for (int rep = 0; rep < (DUP_PHASE == 13 ? 3 : 1); ++rep) sg_phase(F, sp, 4, 256); }
            if (IN(pb + 5)) SEAM(pb + 4);
        }
        STAMP(pb + 5);
        if (IN(pb + 5)) {
            pg8::Gemm g{F.XN, F.W(layer, W_W13), Mrows, FF2, DM}; pg8::StaticOrder S; S.init(Mrows, FF2, F.G, (int)blockIdx.x);
            pg8::EpiSwiGLU E{F.HID, F.SSQ, F.SHW13 + (size_t)layer * 3 * FF2};
            _Pragma("unroll 1") for (int rep = 0; rep < (DUP_PHASE == 4 ? 2 : 1); ++rep) { __syncthreads(); pg8::gemm_phase<pg8::EpiSwiGLU, pg8::StaticOrder, true, true>(F.lds, g, S, E); }
            if (!last) { SgParams sp{}; sp.A = F.XN + (size_t)MLAT * DM; sp.lda = DM; sp.Bt = F.W(layer, W_W13); sp.K = DM; sp.mode = 2; sp.ssq = F.SSQ; sp.shw = F.SHW13 + (size_t)(layer * 3 + 2) * FF2; sp.O = F.HID;
              _Pragma("unroll 1") for (int rep = 0; rep < (DUP_PHASE == 14 ? 3 : 1); ++rep) sg_phase(F, sp, 22, 1408); }
            if (IN(pb + 6)) SEAM(pb + 5);
        }
        STAMP(pb + 6);
        if (IN(pb + 6)) {
            pg8::Gemm g{F.HID, F.W(layer, W_W2), Mrows, DM, FF}; pg8::StaticOrder S; S.init(Mrows, DM, F.G, (int)blockIdx.x);
            pg8::EpiRes E{F.out, F.XC, F.out, F.XC, last ? nullptr : F.XN, F.SSQ, mod + 5120, F.MOD + 3 * 6144 + 1024, F.g_mix + DM, 1.0f};
            _Pragma("unroll 1") for (int rep = 0; rep < (DUP_PHASE == 17 ? 2 : 1); ++rep) { E.gmul = (DUP_PHASE == 17 && rep == 0) ? 0.0f : 1.0f; __syncthreads(); pg8::gemm_phase<pg8::EpiRes, pg8::StaticOrder, true, true>(F.lds, g, S, E); }
            if (!last) { SgParams sp{}; sp.A = F.HID + (size_t)MLAT * FF; sp.lda = FF; sp.Bt = F.W(layer, W_W2); sp.K = FF; sp.mode = 1; sp.src = F.XC; sp.dst = F.XC; sp.XN = F.XN; sp.ssq_out = F.SSQ;
              sp.gate = mod + 5120 + 2 * 6144; sp.sc = F.MOD + 3 * 6144 + 1024 + 2 * 6144; sp.g = F.g_mix + DM; _Pragma("unroll 1") for (int rep = 0; rep < (DUP_PHASE == 15 ? 3 : 1); ++rep) { sp.gmul = (DUP_PHASE == 15 && rep < 2) ? 0.0f : 1.0f; sg_phase(F, sp, 4, 256); } }
            if (IN(pb + 7)) SEAM(pb + 6);
        }
        STAMP(pb + 7);
    }
    float delta = 0.f;
    if (STAMP_SEL >= 0) { const unsigned long long t0 = stamps[STAMP_SEL], t1 = stamps[STAMP_SEL + 1]; delta = sqrtf(1e-7f * 0.01f * (float)(t1 - t0)); }
    if (IN(16)) { if (DUP_PHASE == 23) phase_final(F, true); phase_final(F, false, delta); }
#undef IN
#undef SEAM
}

extern "C" void kernel_launch(void* const* d_in, const int* in_sizes, int n_in, void* d_out, int out_size, void* d_ws, size_t ws_size, hipStream_t stream) {
    static int grid = 0;
    if (grid == 0) {
        if (n_in != 18 || in_sizes[0] != MLAT * DM || out_size != MLAT * DM || ws_size < WS_END) {
            fprintf(stderr, "kernel_launch: built for 18 inputs, x/out of %d floats, >= %zu bytes of workspace; got n_in %d, in0 %d, out %d, ws %zu\n", MLAT * DM, (size_t)WS_END, n_in, n_in > 0 ? in_sizes[0] : -1, out_size, ws_size); grid = -1; return; }
        int dev = 0, cus = 0, per_cu = 0;
        if (hipGetDevice(&dev) != hipSuccess || hipDeviceGetAttribute(&cus, hipDeviceAttributeMultiprocessorCount, dev) != hipSuccess) { fprintf(stderr, "kernel_launch: device query failed\n"); grid = -1; return; }
        if (hipFuncSetAttribute((const void*)hymba_fwd, hipFuncAttributeMaxDynamicSharedMemorySize, LDS_BYTES) != hipSuccess) { fprintf(stderr, "kernel_launch: hipFuncSetAttribute failed\n"); grid = -1; return; }
        if (hipOccupancyMaxActiveBlocksPerMultiprocessor(&per_cu, (const void*)hymba_fwd, NTHR, LDS_BYTES) != hipSuccess || per_cu < 1) { fprintf(stderr, "kernel_launch: occupancy query says %d blocks per CU\n", per_cu); (void)hipGetLastError(); grid = -1; return; }
        grid = cus;
        fprintf(stderr, "kernel_launch: grid %d (cus %d, occupancy %d/CU), ws %zu\n", grid, cus, per_cu, ws_size);
    }
    if (grid < 0) return;
    if (hipMemsetAsync((char*)d_ws + WS_CTL, 0, CTL_ZERO_BYTES, stream) != hipSuccess) { fprintf(stderr, "kernel_launch: memset failed\n"); return; }
    Args a{};
    for (int i = 0; i < 18; ++i) a.in[i] = (const float*)d_in[i];
    a.out = (float*)d_out; a.ws = (unsigned char*)d_ws;
#if MK_N_LAUNCHES == 1
    a.ph_lo = 0; a.ph_hi = N_PHASES;
    void* kargs[] = {&a};
    if (DUP_PHASE == 30) { (void)hipLaunchCooperativeKernel((const void*)hymba_fwd, dim3(grid), dim3(NTHR), kargs, LDS_BYTES, stream); (void)hipMemsetAsync((char*)d_ws + WS_CTL, 0, CTL_ZERO_BYTES, stream); }
    const hipError_t le = hipLaunchCooperativeKernel((const void*)hymba_fwd, dim3(grid), dim3(NTHR), kargs, LDS_BYTES, stream);
    if (le != hipSuccess) fprintf(stderr, "kernel_launch: cooperative launch failed: %s (grid %d)\n", hipGetErrorString(le), grid);
#else
    for (int p = 0; p < N_PHASES; ++p) { a.ph_lo = p; a.ph_hi = p + 1; hipLaunchKernelGGL(hymba_fwd, dim3(grid), dim3(NTHR), LDS_BYTES, stream, a); }
#endif
}
```

```cpp
#include <hip/hip_runtime.h>
#include <hip/hip_cooperative_groups.h>
#include <cstdio>
#include <cstdint>
namespace cg = cooperative_groups;

#define LAS __attribute__((address_space(3)))
#define GAS __attribute__((address_space(1)))
typedef unsigned short bf16_t;
typedef short bf16x8 __attribute__((ext_vector_type(8)));
typedef short bf16x4 __attribute__((ext_vector_type(4)));
typedef float f32x4 __attribute__((ext_vector_type(4)));
typedef float f32x2 __attribute__((ext_vector_type(2)));
typedef unsigned u32x4 __attribute__((ext_vector_type(4)));
typedef unsigned u32x2 __attribute__((ext_vector_type(2)));

typedef __bf16 hwbf16x2 __attribute__((ext_vector_type(2)));
__device__ __forceinline__ unsigned pk2(float lo, float hi) { const f32x2 v = {lo, hi}; return __builtin_bit_cast(unsigned, __builtin_convertvector(v, hwbf16x2)); }
__device__ __forceinline__ unsigned f2bf(float f) { return pk2(f, f) & 0xffffu; }
__device__ __forceinline__ float bf2f(unsigned h) { return __builtin_bit_cast(float, h << 16); }
__device__ __forceinline__ float bflo(unsigned w) { return __builtin_bit_cast(float, w << 16); }
__device__ __forceinline__ float bfhi(unsigned w) { return __builtin_bit_cast(float, w & 0xffff0000u); }
__device__ __forceinline__ float silu_f(float a) { return a * __builtin_amdgcn_rcpf(1.0f + __expf(-a)); }

constexpr int NB = 2, SEQ = 8192, DM = 1024, CTXL = 256, MLAT = NB * SEQ, MCTX = NB * CTXL, MTOT = MLAT + MCTX;
constexpr int PW = 2944, PWP = 3072, FF = 2816, FF2 = 5632;
constexpr int C_RQ = 256, C_RK = 640, C_RV = 1024, C_RG = 1408, C_NQ = 1792, C_NK = 2176, C_NV = 2560;
constexpr float NORM_EPS = 1e-6f;

namespace pg8 {
#define PG8_LAS __attribute__((address_space(3)))
constexpr int BM = 256, BK = 64, HALF = 128, HTB = HALF * BK * 2, STAGE_BYTES = 8 * HTB, NXCD = 8, WGM = 8;
__host__ __device__ __forceinline__ int lds_byte(int r, int c) { const int st = (r >> 4) * 2 + (c >> 5), rr = r & 15, cc = c & 31, ob = rr * 64 + cc * 2; return st * 1024 + (ob ^ (((ob >> 9) & 1) << 5)); }
__host__ __device__ __forceinline__ void stage_rc(int b, int& R, int& C) { const int st = b / 1024, sb = b % 1024, swz = sb ^ (((sb >> 9) & 1) << 5); R = (st >> 1) * 16 + swz / 64; C = (st & 1) * 32 + (swz % 64) / 2; }
__host__ __device__ __forceinline__ int perm32(int rho) { const int n = rho >> 4, i = rho & 15; return 8 * (i >> 2) + 4 * n + (i & 3); }
struct Unit { int pm, pn; };
struct Gemm { const bf16_t* A; const bf16_t* Bt; int M, N, K; };
struct StaticOrder {
    int nM, nN, nwg, G, c;
    __host__ __device__ void init(int M, int N, int G_, int c_) { nM = M / BM; nN = N / BM; nwg = nM * nN; G = G_; c = c_; }
    __host__ __device__ bool next(int i, Unit& u) const {
        const long L = (long)i * G + c; if (L >= nwg) return false;
        int wgid = (int)L; { const int q = nwg / NXCD, r = nwg % NXCD, xcd = wgid % NXCD, off = wgid / NXCD; wgid = (xcd < r ? xcd * (q + 1) : r * (q + 1) + (xcd - r) * q) + off; }
        const int nig = WGM * nN, gid = wgid / nig, fm = gid * WGM, gsz = (nM - fm) < WGM ? (nM - fm) : WGM;
        u.pm = fm + ((wgid % nig) % gsz); u.pn = (wgid % nig) / gsz; return true;
    }
    __device__ __forceinline__ void a_ready(const Unit&) const {}
    __device__ __forceinline__ void done(const Unit&) const {}
};
__device__ __forceinline__ unsigned cvt_pk_bf16(float lo, float hi) { unsigned r; asm volatile("v_cvt_pk_bf16_f32 %0, %1, %2" : "=v"(r) : "v"(lo), "v"(hi)); return r; }

__device__ __forceinline__ float row_rinv(const float* ssq, int row) {
    const f32x4* p = (const f32x4*)(ssq + (size_t)row * 16);
    const f32x4 a = p[0], b = p[1], c = p[2], d = p[3];
    const float s = (((a[0] + a[1]) + (a[2] + a[3])) + ((b[0] + b[1]) + (b[2] + b[3]))) + (((c[0] + c[1]) + (c[2] + c[3])) + ((d[0] + d[1]) + (d[2] + d[3])));
    return rsqrtf(s * (1.0f / 1024.0f) + NORM_EPS);
}
__device__ __forceinline__ int row_set(int pm) { return pm < 32 ? 0 : (pm < 64 ? 1 : 2); }

struct EpiProj {
    static constexpr bool PERM = true, AFTER_DRAIN = false;
    bf16_t* O; const float* ssq; const float* shw;
    __device__ __forceinline__ void operator()(const f32x4 (&acc)[2][2][4][2], const Unit& u, int wr, int wc, int fr, int fq) const {
        const int row0 = u.pm * BM + wr * 64 + fr, col0 = u.pn * BM + wc * 32 + 8 * fq; const int set = row_set(u.pm);
        f32x4 bv[2][2];
#pragma unroll
        for (int bj = 0; bj < 2; ++bj)
#pragma unroll
            for (int n = 0; n < 2; ++n) bv[bj][n] = *(const f32x4*)(shw + set * PWP + col0 + bj * HALF + 4 * n);
#pragma unroll
        for (int ai = 0; ai < 2; ++ai)
#pragma unroll
            for (int m = 0; m < 4; ++m) { const int r = row0 + ai * HALF + m * 16; const float ri = row_rinv(ssq, r); bf16_t* rowp = O + (size_t)r * PW + col0;
#pragma unroll
                for (int bj = 0; bj < 2; ++bj) { if (col0 + bj * HALF < PW) { const f32x4 v0 = acc[ai][bj][m][0] * ri + bv[bj][0], v1 = acc[ai][bj][m][1] * ri + bv[bj][1];
                    u32x4 w; w.x = cvt_pk_bf16(v0[0], v0[1]); w.y = cvt_pk_bf16(v0[2], v0[3]); w.z = cvt_pk_bf16(v1[0], v1[1]); w.w = cvt_pk_bf16(v1[2], v1[3]);
                    *(u32x4*)(rowp + bj * HALF) = w; } } }
    }
};
struct EpiSwiGLU {
    static constexpr bool PERM = true, AFTER_DRAIN = false;
    bf16_t* O; const float* ssq; const float* shw;
    __device__ __forceinline__ void operator()(const f32x4 (&acc)[2][2][4][2], const Unit& u, int wr, int wc, int fr, int fq) const {
        const int row0 = u.pm * BM + wr * 64 + fr, col0 = u.pn * BM + wc * 32 + 8 * fq, ocol = u.pn * HALF + wc * 32 + 8 * fq; const int set = row_set(u.pm);
        f32x4 ba[2], bb[2];
#pragma unroll
        for (int n = 0; n < 2; ++n) { ba[n] = *(const f32x4*)(shw + set * FF2 + col0 + 4 * n); bb[n] = *(const f32x4*)(shw + set * FF2 + col0 + HALF + 4 * n); }
#pragma unroll
        for (int ai = 0; ai < 2; ++ai)
#pragma unroll
            for (int m = 0; m < 4; ++m) { const int r = row0 + ai * HALF + m * 16; const float ri = row_rinv(ssq, r);
                float hv[8];
#pragma unroll
                for (int n = 0; n < 2; ++n) { const f32x4 a = acc[ai][0][m][n] * ri + ba[n], b = acc[ai][1][m][n] * ri + bb[n];
#pragma unroll
                    for (int e = 0; e < 4; ++e) hv[4 * n + e] = silu_f(a[e]) * b[e]; }
                u32x4 w; w.x = cvt_pk_bf16(hv[0], hv[1]); w.y = cvt_pk_bf16(hv[2], hv[3]); w.z = cvt_pk_bf16(hv[4], hv[5]); w.w = cvt_pk_bf16(hv[6], hv[7]);
                *(u32x4*)(O + (size_t)r * FF + ocol) = w; }
    }
};
struct EpiRes {
    static constexpr bool PERM = false, AFTER_DRAIN = false;
    const float* src_lat; const float* src_ctx; float* dst_lat; float* dst_ctx; bf16_t* XN; float* ssq; const float* gate; const float* sc; const float* g; float gmul;
    __device__ __forceinline__ void operator()(const f32x4 (&acc)[2][2][4][2], const Unit& u, int wr, int wc, int fr, int fq) const {
        const bool lat = u.pm < 64; const int set = row_set(u.pm);
        const int rg0 = u.pm * BM + wr * 64 + fr, rl0 = (lat ? u.pm : u.pm - 64) * BM + wr * 64 + fr;
        const float* src = lat ? src_lat : src_ctx; float* dst = lat ? dst_lat : dst_ctx;
        const int col0 = u.pn * BM + wc * 32 + 4 * fq;
        float ss[2][4];
#pragma unroll
        for (int ai = 0; ai < 2; ++ai)
#pragma unroll
            for (int m = 0; m < 4; ++m) ss[ai][m] = 0.f;
#pragma unroll
        for (int bj = 0; bj < 2; ++bj)
#pragma unroll
            for (int n = 0; n < 2; ++n) { const int c = col0 + bj * HALF + n * 16;
                const f32x4 ga = *(const f32x4*)(gate + set * 6144 + c) * gmul; f32x4 gs = {0.f, 0.f, 0.f, 0.f};
                if (XN) { const f32x4 s4 = *(const f32x4*)(sc + set * 6144 + c), g4 = *(const f32x4*)(g + c); gs = g4 * (s4 + 1.0f); }
#pragma unroll
                for (int ai = 0; ai < 2; ++ai)
#pragma unroll
                    for (int m = 0; m < 4; ++m) { const size_t ol = (size_t)(rl0 + ai * HALF + m * 16) * DM + c, og = (size_t)(rg0 + ai * HALF + m * 16) * DM + c;
                        const f32x4 x1 = *(const f32x4*)(src + ol) + ga * acc[ai][bj][m][n];
                        *(f32x4*)(dst + ol) = x1; ss[ai][m] += (x1[0] * x1[0] + x1[1] * x1[1]) + (x1[2] * x1[2] + x1[3] * x1[3]);
                        if (XN) { const f32x4 xn = x1 * gs; u32x2 w; w.x = cvt_pk_bf16(xn[0], xn[1]); w.y = cvt_pk_bf16(xn[2], xn[3]); *(u32x2*)(XN + og) = w; } } }
#pragma unroll
        for (int ai = 0; ai < 2; ++ai)
#pragma unroll
            for (int m = 0; m < 4; ++m) { float s = ss[ai][m]; s += __shfl_xor(s, 16); s += __shfl_xor(s, 32);
                if (fq == 0) ssq[(size_t)(rg0 + ai * HALF + m * 16) * 16 + u.pn * 4 + wc] = s; }
    }
};
template <class Epi, class Sched, bool ALIGN_EPI = false, bool SP2 = false>
__device__ __forceinline__ void gemm_phase(PG8_LAS unsigned char* lds, const Gemm g, const Sched& S, const Epi& E) {
    int tid_ = threadIdx.x; asm volatile("" : "+v"(tid_));
    const int tid = tid_, wid = __builtin_amdgcn_readfirstlane(tid >> 6), lane = tid & 63, wr = wid >> 2, wc = wid & 3, fr = lane & 15, fq = lane >> 4;
    const int K = g.K, nt = K / BK;
    unsigned voffA[2], voffB[2];
#pragma unroll
    for (int i = 0; i < 2; ++i) { int R, C; stage_rc(tid * 16 + i * 8192, R, C); const int Rb = Epi::PERM ? ((R & ~31) + perm32(R & 31)) : R;
        voffA[i] = (unsigned)(R * K + C) * 2u; voffB[i] = (unsigned)(Rb * K + C) * 2u; }
    const size_t kstep = (size_t)(BK * 2);
    const size_t hstep = (size_t)HALF * K * 2;
    const size_t tstep = 2 * hstep;
    const unsigned ldsw = (unsigned)wid * 1024u;
    const int aoff = lds_byte(wr * 64 + fr, fq * 8), boff = lds_byte(wc * 32 + fr, fq * 8);
#define PG8_SA(b, h) (((b) * 2 + (h)) * HTB)
#define PG8_SB(b, h) ((4 + (b) * 2 + (h)) * HTB)
#define PG8_STAGE(bufoff, gbase, voff) do { _Pragma("unroll") for (int _i = 0; _i < 2; ++_i) \
        __builtin_amdgcn_global_load_lds((const unsigned*)((const char*)(gbase) + (voff)[_i]), (PG8_LAS unsigned*)(lds + (bufoff) + ldsw + _i * 8192), 16, 0, 0); } while (0)
#define PG8_LDA(dst, b, h) do { _Pragma("unroll") for (int m = 0; m < 4; ++m) _Pragma("unroll") for (int k = 0; k < 2; ++k) dst[m][k] = *(const PG8_LAS bf16x8*)(lds + PG8_SA(b, h) + aoff + m * 2048 + k * 1024); } while (0)
#define PG8_LDB(dst, b, h) do { _Pragma("unroll") for (int n = 0; n < 2; ++n) _Pragma("unroll") for (int k = 0; k < 2; ++k) dst[n][k] = *(const PG8_LAS bf16x8*)(lds + PG8_SB(b, h) + boff + n * 2048 + k * 1024); } while (0)
#define PG8_MMA(ai, bj, At, Bt) do { __builtin_amdgcn_s_setprio(1); _Pragma("unroll") for (int m = 0; m < 4; ++m) _Pragma("unroll") for (int n = 0; n < 2; ++n) _Pragma("unroll") for (int k = 0; k < 2; ++k) \
        acc[ai][bj][m][n] = __builtin_amdgcn_mfma_f32_16x16x32_bf16(Bt[n][k], At[m][k], acc[ai][bj][m][n], 0, 0, 0); __builtin_amdgcn_s_setprio(0); } while (0)
#define PG8_WAIT_V(n) asm volatile("s_waitcnt vmcnt(" #n ")" ::: "memory")
#define PG8_WAIT_L(n) asm volatile("s_waitcnt lgkmcnt(" #n ")" ::: "memory")
#define PG8_BAR __builtin_amdgcn_s_barrier()
#define PG8_SCHED __builtin_amdgcn_sched_barrier(0)
    Unit cur, nxt; int ui = 0;
    if (!S.next(0, cur)) return;
    f32x4 acc[2][2][4][2];
#pragma unroll
    for (int a = 0; a < 2; ++a)
#pragma unroll
        for (int b = 0; b < 2; ++b)
#pragma unroll
            for (int m = 0; m < 4; ++m)
#pragma unroll
                for (int n = 0; n < 2; ++n) acc[a][b][m][n] = (f32x4){0.f, 0.f, 0.f, 0.f};
    bf16x8 At[4][2], B0[2][2], B1[2][2];
    const char* cA = (const char*)g.A + (size_t)cur.pm * tstep; const char* cB = (const char*)g.Bt + (size_t)cur.pn * tstep;
    S.a_ready(cur);
    if constexpr (SP2) {
        PG8_STAGE(PG8_SB(0, 0), cB, voffB); PG8_STAGE(PG8_SB(0, 1), cB + hstep, voffB); PG8_STAGE(PG8_SA(0, 0), cA, voffA); PG8_STAGE(PG8_SA(0, 1), cA + hstep, voffA);
        if (wr == 1) PG8_BAR;
        PG8_WAIT_V(2); PG8_BAR;
        PG8_STAGE(PG8_SB(1, 0), cB + kstep, voffB); PG8_STAGE(PG8_SA(1, 0), cA + kstep, voffA); PG8_STAGE(PG8_SB(1, 1), cB + hstep + kstep, voffB);
        PG8_WAIT_V(6); PG8_BAR;
    } else {
        PG8_STAGE(PG8_SB(0, 0), cB, voffB); PG8_STAGE(PG8_SA(0, 0), cA, voffA); PG8_STAGE(PG8_SB(0, 1), cB + hstep, voffB); PG8_STAGE(PG8_SA(0, 1), cA + hstep, voffA);
        if (wr == 1) PG8_BAR;
        PG8_WAIT_V(4); PG8_BAR;
        PG8_STAGE(PG8_SB(1, 0), cB + kstep, voffB); PG8_STAGE(PG8_SA(1, 0), cA + kstep, voffA); PG8_STAGE(PG8_SB(1, 1), cB + hstep + kstep, voffB);
        PG8_WAIT_V(6); PG8_BAR;
    }
    for (;;) {
        const bool has_next = S.next(ui + 1, nxt);
        const char* nA = has_next ? (const char*)g.A + (size_t)nxt.pm * tstep : cA; const char* nB = has_next ? (const char*)g.Bt + (size_t)nxt.pn * tstep : cB;
        for (int t = 0; t < nt; t += 2) {
            const bool last = (t == nt - 2);
            const char* a1 = cA + (size_t)(t + 1) * kstep;
            const char* a2 = last ? nA : cA + (size_t)(t + 2) * kstep; const char* b2 = last ? nB : cB + (size_t)(t + 2) * kstep;
            const char* a3 = a2 + kstep; const char* b3 = b2 + kstep;
            if (last && has_next) S.a_ready(nxt);
            if constexpr (SP2) {
            PG8_LDB(B0, 0, 0); PG8_LDB(B1, 0, 1); PG8_SCHED; PG8_LDA(At, 0, 0); PG8_STAGE(PG8_SA(1, 1), a1 + hstep, voffA);
            PG8_WAIT_V(8); PG8_WAIT_L(0); PG8_BAR; PG8_MMA(0, 0, At, B0); PG8_MMA(0, 1, At, B1); PG8_BAR; PG8_SCHED;
            PG8_LDA(At, 0, 1); PG8_STAGE(PG8_SB(0, 0), b2, voffB); PG8_STAGE(PG8_SB(0, 1), b2 + hstep, voffB); PG8_STAGE(PG8_SA(0, 0), a2, voffA);
            PG8_WAIT_V(8); PG8_WAIT_L(0); PG8_BAR; PG8_MMA(1, 0, At, B0); PG8_MMA(1, 1, At, B1); PG8_BAR; PG8_SCHED;
            PG8_LDB(B0, 1, 0); PG8_LDB(B1, 1, 1); PG8_SCHED; PG8_LDA(At, 1, 0); PG8_STAGE(PG8_SA(0, 1), a2 + hstep, voffA);
            PG8_WAIT_V(8); PG8_WAIT_L(0); PG8_BAR; PG8_MMA(0, 0, At, B0); PG8_MMA(0, 1, At, B1); PG8_BAR; PG8_SCHED;
            PG8_LDA(At, 1, 1); PG8_STAGE(PG8_SB(1, 0), b3, voffB); PG8_STAGE(PG8_SB(1, 1), b3 + hstep, voffB); PG8_STAGE(PG8_SA(1, 0), a3, voffA);
            PG8_WAIT_V(8); PG8_WAIT_L(0); PG8_BAR; PG8_MMA(1, 0, At, B0); PG8_MMA(1, 1, At, B1); PG8_BAR; PG8_SCHED;
            } else {
            PG8_LDB(B0, 0, 0); PG8_SCHED; PG8_LDA(At, 0, 0); PG8_STAGE(PG8_SA(1, 1), a1 + hstep, voffA);
            PG8_WAIT_L(8); PG8_BAR; PG8_WAIT_L(0); PG8_MMA(0, 0, At, B0); PG8_BAR; PG8_SCHED;
            PG8_LDB(B1, 0, 1); PG8_STAGE(PG8_SB(0, 0), b2, voffB);
            PG8_BAR; PG8_WAIT_L(0); PG8_MMA(0, 1, At, B1); PG8_BAR;
            PG8_LDA(At, 0, 1); PG8_STAGE(PG8_SA(0, 0), a2, voffA);
            PG8_BAR; PG8_WAIT_L(0); PG8_MMA(1, 0, At, B0); PG8_BAR; PG8_SCHED;
            PG8_STAGE(PG8_SB(0, 1), b2 + hstep, voffB);
            PG8_WAIT_V(6); PG8_BAR; PG8_MMA(1, 1, At, B1); PG8_BAR;
            PG8_LDB(B0, 1, 0); PG8_SCHED; PG8_LDA(At, 1, 0); PG8_STAGE(PG8_SA(0, 1), a2 + hstep, voffA);
            PG8_WAIT_L(8); PG8_BAR; PG8_WAIT_L(0); PG8_MMA(0, 0, At, B0); PG8_BAR; PG8_SCHED;
            PG8_LDB(B1, 1, 1); PG8_STAGE(PG8_SB(1, 0), b3, voffB);
            PG8_BAR; PG8_WAIT_L(0); PG8_MMA(0, 1, At, B1); PG8_BAR;
            PG8_LDA(At, 1, 1); PG8_STAGE(PG8_SA(1, 0), a3, voffA);
            PG8_BAR; PG8_WAIT_L(0); PG8_MMA(1, 0, At, B0); PG8_BAR; PG8_SCHED;
            PG8_STAGE(PG8_SB(1, 1), b3 + hstep, voffB);
            PG8_WAIT_V(6); PG8_BAR; PG8_MMA(1, 1, At, B1); PG8_BAR;
            }
        }
        if constexpr (ALIGN_EPI) { if (wr == 0) PG8_BAR; }
        if constexpr (!Epi::AFTER_DRAIN) { E(acc, cur, wr, wc, fr, fq); S.done(cur); }
        if (!has_next) break;
#pragma unroll
        for (int a = 0; a < 2; ++a)
#pragma unroll
            for (int b = 0; b < 2; ++b)
#pragma unroll
                for (int m = 0; m < 4; ++m)
#pragma unroll
                    for (int n = 0; n < 2; ++n) acc[a][b][m][n] = (f32x4){0.f, 0.f, 0.f, 0.f};
        cur = nxt; cA = nA; cB = nB; ++ui;
        if constexpr (ALIGN_EPI) { if (wr == 1) PG8_BAR; }
    }
    PG8_WAIT_V(0);
    if constexpr (!ALIGN_EPI) { if (wr == 0) PG8_BAR; }
    PG8_BAR;
    if constexpr (Epi::AFTER_DRAIN) { E.fused(acc, cur, wr, wc, fr, fq, lds, wid, lane); S.done(cur); }
#undef PG8_SA
#undef PG8_SB
#undef PG8_STAGE
#undef PG8_LDA
#undef PG8_LDB
#undef PG8_MMA
#undef PG8_WAIT_V
#undef PG8_WAIT_L
#undef PG8_BAR
#undef PG8_SCHED
}
}

constexpr int NWAVES = 8, NTHR = 512;
constexpr size_t MiB = 1u << 20;
constexpr size_t WS_CTL = 0, CTL_ZERO_BYTES = 64 * 1024;
constexpr size_t WS_MOD = 1 * MiB;
constexpr size_t WS_SHWIN = WS_MOD + 2 * 3 * 6144 * 4;
constexpr size_t WS_SHW13 = WS_SHWIN + 2 * 3 * PWP * 4;
constexpr size_t WS_ROPE = WS_SHW13 + 2 * 3 * FF2 * 4;
constexpr size_t WS_LG = WS_ROPE + (128 + 64) * 24 * 2 * 4;
constexpr size_t WS_CT256 = WS_LG + 256;
constexpr size_t WS_SSQ = 2 * MiB;
constexpr size_t WS_XC = 4 * MiB;
constexpr size_t WS_W = 6 * MiB;
constexpr size_t W_WIN = 0, W_WOUT = (size_t)PWP * DM * 2, W_W13 = W_WOUT + (size_t)DM * DM * 2, W_W2 = W_W13 + (size_t)FF2 * DM * 2, W_LAYER = W_W2 + (size_t)DM * FF * 2;
static_assert(W_LAYER * 2 == 49 * MiB, "weight region");
constexpr size_t WS_TAB = 55 * MiB;
constexpr size_t T_WFT = 0, T_TWA = 2 * 256 * 256 * 2, T_TD2 = T_TWA + 256 * 256 * 2, T_TW8 = T_TD2 + 64 * 128 * 2, T_TC = T_TW8 + 65536;
constexpr size_t WS_XN = 56 * MiB;
constexpr size_t WS_CAT = 89 * MiB;
constexpr size_t WS_PROJ = 122 * MiB;
constexpr size_t WS_STATE = 217 * MiB;
constexpr size_t WS_END = WS_STATE + (size_t)16 * 66 * 9216 * 2;
static_assert(WS_END <= 256 * MiB && WS_PROJ + (size_t)MTOT * PW * 2 <= WS_STATE && WS_CAT + (size_t)MTOT * DM * 2 <= WS_PROJ && WS_XN + (size_t)MTOT * DM * 2 <= WS_CAT, "d_ws map");
static_assert(WS_CT256 + 2048 <= WS_SSQ && WS_SSQ + (size_t)MTOT * 64 <= WS_XC && WS_TAB + T_TC + 262144 <= WS_XN, "d_ws map (small)");
constexpr int CW_BAR = 1024;
constexpr int LDS_BYTES = 163840, MISC_OFF = LDS_BYTES - 256;

#define RLX_AGENT __ATOMIC_RELAXED, __HIP_MEMORY_SCOPE_AGENT
#define XB_TMO      128
#define XB_XCNT(j)  (256  + 64 * (j))
#define XB_XSUB(j)  (1280 + 64 * (j))
#define XB_XGEN(j)  (2304 + 64 * (j))
#define XB_TOP      3328
#define XB_TOPGEN   3392
#define XCD_BAR_WORDS 3456
#define XB_SPIN_CAP (1u << 18)
static_assert((CW_BAR + XCD_BAR_WORDS) * 4 <= (int)CTL_ZERO_BYTES, "barrier words inside the memset region");
__device__ __forceinline__ unsigned xb_ld(unsigned* p)              { return __hip_atomic_load(p, __ATOMIC_RELAXED, __HIP_MEMORY_SCOPE_AGENT); }
__device__ __forceinline__ unsigned xb_add(unsigned* p, unsigned v) { return __hip_atomic_fetch_add(p, v, __ATOMIC_RELAXED, __HIP_MEMORY_SCOPE_AGENT); }
__device__ __forceinline__ unsigned xb_xcc_id() { return (unsigned)__builtin_amdgcn_s_getreg((3 << 11) | 20) & 0xFu; }
#define XB_SPIN(cond, bar) do { unsigned _sp = 0; while (cond) { __builtin_amdgcn_s_sleep(1); \
    if ((++_sp & 255u) == 0u) { if (xb_ld(&(bar)[XB_TMO])) break; if (_sp > XB_SPIN_CAP) { atomicAdd(&(bar)[XB_TMO], 1u); break; } } } } while (0)
struct XcdBarrier { unsigned* bar; unsigned x; volatile LAS unsigned* st; };
__device__ __forceinline__ XcdBarrier xcd_barrier_post(unsigned* bar, volatile LAS unsigned* st) {
    XcdBarrier b; b.bar = bar; b.x = xb_xcc_id(); b.st = st;
    if (threadIdx.x == 0) (void)xb_add(&bar[XB_XCNT(b.x)], 1u);
    return b;
}
__device__ __forceinline__ void xcd_barrier_complete(unsigned* bar, unsigned x, unsigned& nloc, unsigned& nx) {
    const unsigned G = gridDim.x * gridDim.y * gridDim.z;
    unsigned sum, cnt, mine, sp = 0u;
    for (;;) {
        sum = 0u; cnt = 0u; mine = 0u;
#pragma unroll
        for (unsigned j = 0; j < 16; ++j) { const unsigned c = xb_ld(&bar[XB_XCNT(j)]); sum += c; cnt += (c > 0u) ? 1u : 0u; mine = (j == x) ? c : mine; }
        if (sum == G) break;
        __builtin_amdgcn_s_sleep(1);
        if ((++sp & 255u) == 0u) { if (xb_ld(&bar[XB_TMO])) break; if (sp > XB_SPIN_CAP) { atomicAdd(&bar[XB_TMO], 1u); break; } }
    }
    nloc = mine > 0u ? mine : 1u; nx = cnt > 0u ? cnt : 1u;
}
__device__ __forceinline__ void xcd_barrier(const XcdBarrier& b) {
    asm volatile("s_waitcnt vmcnt(0)" ::: "memory");
    __syncthreads();
    if (threadIdx.x == 0) {
        unsigned* bar = b.bar;
        __builtin_amdgcn_s_waitcnt(0);
        unsigned nloc = b.st[0], nx = b.st[1];
        if (nloc == 0u) { xcd_barrier_complete(bar, b.x, nloc, nx); b.st[0] = nloc; b.st[1] = nx; }
        const unsigned old = xb_add(&bar[XB_XSUB(b.x)], 1u);
        const unsigned gen = old / nloc;
        if (old + 1u == (gen + 1u) * nloc) {
            __builtin_amdgcn_fence(__ATOMIC_RELEASE, "agent");
            asm volatile("s_waitcnt vmcnt(0)" ::: "memory");
            const unsigned og = xb_add(&bar[XB_TOP], 1u);
            const unsigned tg = og / nx;
            if (og + 1u == (tg + 1u) * nx) xb_add(&bar[XB_TOPGEN], 1u);
            else XB_SPIN(xb_ld(&bar[XB_TOPGEN]) == tg, bar);
            __builtin_amdgcn_fence(__ATOMIC_ACQUIRE, "agent");
            xb_add(&bar[XB_XGEN(b.x)], 1u);
            asm volatile("s_waitcnt vmcnt(0)" ::: "memory");
        } else {
            XB_SPIN(xb_ld(&bar[XB_XGEN(b.x)]) == gen, bar);
            __builtin_amdgcn_fence(__ATOMIC_ACQUIRE, "agent");
            asm volatile("s_waitcnt vmcnt(0)" ::: "memory");
        }
    }
    __syncthreads();
}

#ifndef PROF_A
#define PROF_A -1
#endif
#ifndef PROF_B
#define PROF_B -1
#endif
#define USTAMP(k) do { if ((PROF_A >= 0 || PROF_B >= 0) && F.prof && blockIdx.x == 0 && F.tid == 0) ((unsigned long long*)(F.ws + WS_CTL + 61440 + 512))[k] = __builtin_amdgcn_s_memrealtime(); } while (0)
struct Frame {
    LAS unsigned char* lds;
    int tid, lane, wave, G, vcu; bool prof;
    __device__ __forceinline__ void fresh() { int t = threadIdx.x; asm volatile("" : "+v"(t)); tid = t; lane = t & 63; wave = __builtin_amdgcn_readfirstlane(t >> 6); }
    const float *x, *c, *ctx, *c_ctx, *w_ada, *b_ada, *g_mix, *w_in, *dlogit, *ret_g, *w_four, *rpb, *w_out, *g_ffn, *w1, *w3, *w2, *g_final;
    float* out; unsigned char* ws;
    float *MOD, *SHWIN, *SHW13, *ROPE, *LG, *CT256, *SSQ, *XC, *ADAP; const float* TW8; bf16_t* STATE;
    bf16_t *XN, *CAT, *PROJ, *HID, *WFT, *TWA, *TD2, *TC256; unsigned* Y;
    __device__ __forceinline__ bf16_t* W(int layer, size_t off) const { return (bf16_t*)(ws + WS_W + (size_t)layer * W_LAYER + off); }
};

__device__ __forceinline__ float wave_sum(float v) {
#pragma unroll
    for (int o = 1; o < 64; o <<= 1) v += __shfl_xor(v, o);
    return v;
}

__device__ __forceinline__ bf16x8 ld8(LAS const unsigned char* p) { return *(LAS const bf16x8*)p; }
__device__ __forceinline__ bf16x8 ld8(const unsigned char* p) { return *(const bf16x8*)p; }
template <int MT, int NT, class PA, class PB>
__device__ __forceinline__ void wave_mma(f32x4 (&acc)[MT][NT], PA A, int lda, PB B, int ldb, int ksteps, int fr, int fq) {
    PA a0 = A + fr * lda + fq * 16; PB b0 = B + fr * ldb + fq * 16;
    for (int s = 0; s < ksteps; ++s) {
        bf16x8 a[MT], b[NT];
#pragma unroll
        for (int m = 0; m < MT; ++m) a[m] = ld8(a0 + m * 16 * lda + s * 64);
#pragma unroll
        for (int n = 0; n < NT; ++n) b[n] = ld8(b0 + n * 16 * ldb + s * 64);
#pragma unroll
        for (int m = 0; m < MT; ++m)
#pragma unroll
            for (int n = 0; n < NT; ++n) acc[m][n] = __builtin_amdgcn_mfma_f32_16x16x32_bf16(a[m], b[n], acc[m][n], 0, 0, 0);
    }
}
template <int MT, int NT> __device__ __forceinline__ void zero_acc(f32x4 (&acc)[MT][NT]) {
#pragma unroll
    for (int m = 0; m < MT; ++m)
#pragma unroll
        for (int n = 0; n < NT; ++n) acc[m][n] = (f32x4){0.f, 0.f, 0.f, 0.f};
}

#define LDS_WAIT() asm volatile("s_waitcnt lgkmcnt(0)" ::: "memory")
__device__ __forceinline__ void p0_transpose_item(const float* W, int ldw, int K, int nblk, bf16_t* WT, int mapkind, int roff, LAS float* scr, int item, int lane) {
    const int kb = item / nblk, nb = item % nblk, k0 = 64 * kb, n0 = 32 * nb;
#pragma unroll 8
    for (int i = 0; i < 32; ++i) { const int kk = 2 * i + (lane >> 5); scr[kk * 33 + (lane & 31)] = W[(size_t)(k0 + kk) * ldw + n0 + (lane & 31)]; }
    LDS_WAIT(); asm volatile("" ::: "memory");
    const int c = lane & 7;
#pragma unroll
    for (int j = 0; j < 4; ++j) { const int n = (lane >> 3) + 8 * j; const LAS float* s = scr + (8 * c) * 33 + n;
        u32x4 o; o.x = pk2(s[0 * 33], s[1 * 33]); o.y = pk2(s[2 * 33], s[3 * 33]); o.z = pk2(s[4 * 33], s[5 * 33]); o.w = pk2(s[6 * 33], s[7 * 33]);
        const int nn = n0 + n; const int row = mapkind == 0 ? roff + nn : ((nn >> 7) * 256 + (nn & 127) + (mapkind == 2 ? 128 : 0));
        *(u32x4*)(WT + (size_t)row * K + k0 + 8 * c) = o; }
    LDS_WAIT(); asm volatile("" ::: "memory");
}

__device__ __forceinline__ void phase_p0a(Frame& F) {
    F.fresh();
    const int tid = F.tid, lane = F.lane, wave = F.wave;
    if (blockIdx.x < 32) {
        LAS float* wt = (LAS float*)F.lds; LAS float* T = (LAS float*)(F.lds + 64 * 257 * 4);
        for (int e = tid; e < 4096; e += NTHR) { const int c = e >> 6, p = e & 63; float sv, cv;
            if (p <= 32) { sincospif((float)((p * c) & 63) * (1.0f / 32.0f), &sv, &cv); T[e] = cv; }
            else { sincospif((float)(((p - 32) * c) & 63) * (1.0f / 32.0f), &sv, &cv); T[e] = -sv; } }
        for (int it = blockIdx.x; it < 32; it += F.G) {
            const int l = it >> 4, k0 = (it & 15) * 64;
            __syncthreads();
            for (int e = tid; e < 64 * 256; e += NTHR) { const int kk = e >> 8, cc = e & 255; wt[kk * 257 + cc] = F.w_in[((size_t)l * DM + k0 + kk) * PW + cc]; }
            __syncthreads();
            const int k = tid & 63, cg0 = tid >> 6; bf16_t* WT = F.W(l, W_WIN);
            for (int i = 0; i < 32; ++i) { const int col = cg0 + 8 * i, g = col >> 6, p = col & 63; float a = 0.f;
#pragma unroll 8
                for (int c = 0; c < 64; ++c) a += wt[k * 257 + g * 64 + c] * T[c * 64 + p];
                WT[(size_t)col * DM + k0 + k] = (bf16_t)f2bf(a); }
        }
        __syncthreads();
    }
    LAS float* sc = (LAS float*)(F.lds + 131072);
    for (int e = tid; e < 3072; e += NTHR) { const int s = e >> 10, k = e & 1023; const float v = s < 2 ? F.c[s * DM + k] : F.c_ctx[k]; sc[e] = v / (1.0f + expf(-v)); }
    __syncthreads();
    const int gw = F.vcu * NWAVES + wave, NGW = F.G * NWAVES;
    for (int it = gw; it < 2 * 8 * 96; it += NGW) {
        const int l = it / 768, rem = it % 768, kc = rem / 96, cb = rem % 96, col = cb * 64 + lane;
        const float* wp = F.w_ada + ((size_t)l * DM + kc * 128) * 6144 + col; float a0 = 0.f, a1 = 0.f, a2 = 0.f;
#pragma unroll 8
        for (int k = 0; k < 128; ++k) { const float w = wp[(size_t)k * 6144]; const int kk = kc * 128 + k; a0 += sc[kk] * w; a1 += sc[1024 + kk] * w; a2 += sc[2048 + kk] * w; }
        float* o = F.ADAP + ((size_t)(l * 8 + kc) * 3) * 6144 + col; o[0] = a0; o[6144] = a1; o[2 * 6144] = a2;
    }
    LAS float* scr = (LAS float*)(F.lds + wave * 16384);
    constexpr int I0 = 16 * 84, I1 = 16 * 32, I2 = 16 * 88, I3 = I2, I4 = 44 * 32, I5 = 4 * 8, IL = I0 + I1 + I2 + I3 + I4 + I5;
    for (int it = gw; it < 2 * IL; it += NGW) {
        const int l = it / IL; int r = it % IL;
        if (r < I0) { p0_transpose_item(F.w_in + (size_t)l * DM * PW + 256, PW, DM, 84, F.W(l, W_WIN), 0, 256, scr, r, lane); continue; } r -= I0;
        if (r < I1) { p0_transpose_item(F.w_out + (size_t)l * DM * DM, DM, DM, 32, F.W(l, W_WOUT), 0, 0, scr, r, lane); continue; } r -= I1;
        if (r < I2) { p0_transpose_item(F.w1 + (size_t)l * DM * FF, FF, DM, 88, F.W(l, W_W13), 1, 0, scr, r, lane); continue; } r -= I2;
        if (r < I3) { p0_transpose_item(F.w3 + (size_t)l * DM * FF, FF, DM, 88, F.W(l, W_W13), 2, 0, scr, r, lane); continue; } r -= I3;
        if (r < I4) { p0_transpose_item(F.w2 + (size_t)l * FF * DM, DM, FF, 32, F.W(l, W_W2), 0, 0, scr, r, lane); continue; } r -= I4;
        p0_transpose_item(F.w_four + (size_t)l * 65536, 256, 256, 8, F.WFT + (size_t)l * 65536, 0, 0, scr, r, lane);
    }
    const int gt = F.vcu * NTHR + tid, GT = F.G * NTHR;
    for (int e = gt; e < 2 * 128 * 128; e += GT) { const int l = e >> 14, q = e & 16383; *(u32x4*)(F.W(l, W_WIN) + (size_t)PW * DM + (size_t)q * 8) = (u32x4){0u, 0u, 0u, 0u}; }
    for (int e = gt; e < 192 * 24; e += GT) { const int pos = e < 128 * 24 ? e / 24 : (e - 128 * 24) / 24, i = e % 24;
        const float inv = powf(10000.0f, -(float)i / 24.0f), ang = (float)pos * inv; F.ROPE[2 * e] = cosf(ang); F.ROPE[2 * e + 1] = sinf(ang); }
    for (int e = gt; e < 16; e += GT) { const float xv = F.dlogit[e]; F.LG[e] = -log1pf(expf(-xv)); }
    for (int e = gt; e < 256; e += GT) { float sv, cv; sincospif((float)e * (2.0f / 256.0f), &sv, &cv); F.CT256[2 * e] = cv; F.CT256[2 * e + 1] = sv; }
    for (int e = gt; e < 8192; e += GT) { float sv, cv; sincospif((float)e * (2.0f / 8192.0f), &sv, &cv); ((float*)F.TW8)[2 * e] = cv; ((float*)F.TW8)[2 * e + 1] = sv; }
    for (int e = gt; e < 32768; e += GT) { const int row = e >> 7, l1 = e & 127, cs = row >> 7, k1 = row & 127; float sv, cv;
        sincospif((float)((k1 * l1) & 127) * (2.0f / 128.0f), &sv, &cv); F.TWA[e] = (bf16_t)f2bf(cs == 0 ? cv : sv); }
    for (int e = gt; e < 131072; e += GT) { const int cs = e >> 16, k = (e >> 8) & 255, l = e & 255; float sv, cv;
        sincospif((float)((k * l) & 255) * (2.0f / 256.0f), &sv, &cv); F.TC256[e] = (bf16_t)f2bf(cs == 0 ? cv : sv); }
    for (int e = gt; e < 8192; e += GT) { const int k2 = e >> 7, col = e & 127, l2 = col >> 1, ri = col & 1; float sv, cv;
        sincospif((float)((k2 * l2) & 63) * (2.0f / 64.0f), &sv, &cv); F.TD2[e] = (bf16_t)f2bf(ri == 0 ? cv : sv); }
}

__device__ __forceinline__ float ada_val(const Frame& F, int l, int s, int j) {
    const float* p = F.ADAP + ((size_t)(l * 8) * 3 + s) * 6144 + j; float a = 0.f;
#pragma unroll
    for (int kc = 0; kc < 8; ++kc) a += p[(size_t)kc * 3 * 6144];
    return a + F.b_ada[l * 6144 + j];
}
__device__ __forceinline__ void phase_p0b(Frame& F) {
    F.fresh();
    const int tid = F.tid, lane = F.lane, wave = F.wave;
    const int gt = F.vcu * NTHR + tid, GT = F.G * NTHR, gw = F.vcu * NWAVES + wave, NGW = F.G * NWAVES;
    for (int e = gt; e < 2 * 3 * 6144; e += GT) { const int l = e / 18432, s = (e / 6144) % 3, j = e % 6144; F.MOD[e] = ada_val(F, l, s, j); }
    LAS float* vec = (LAS float*)F.lds;
    for (int e = tid; e < 3072; e += NTHR) { const int s = e >> 10, k = e & 1023; vec[e] = F.g_mix[k] * (1.0f + ada_val(F, 0, s, 1024 + k)); }
    __syncthreads();
    for (int m = gw; m < MTOT; m += NGW) {
        const int set = m < SEQ ? 0 : (m < MLAT ? 1 : 2); const float* src = m < MLAT ? F.x + (size_t)m * DM : F.ctx + (size_t)(m - MLAT) * DM;
        f32x4 v[4]; float ss = 0.f;
#pragma unroll
        for (int j = 0; j < 4; ++j) { v[j] = *(const f32x4*)(src + 4 * lane + 256 * j); ss += (v[j][0] * v[j][0] + v[j][1] * v[j][1]) + (v[j][2] * v[j][2] + v[j][3] * v[j][3]); }
        ss = wave_sum(ss);
#pragma unroll
        for (int j = 0; j < 4; ++j) { const f32x4 g = *(LAS const f32x4*)(vec + set * 1024 + 4 * lane + 256 * j); const f32x4 o = v[j] * g;
            u32x2 w; w.x = pk2(o[0], o[1]); w.y = pk2(o[2], o[3]); *(u32x2*)(F.XN + (size_t)m * DM + 4 * lane + 256 * j) = w; }
        if (lane < 16) F.SSQ[(size_t)m * 16 + lane] = lane == 0 ? ss : 0.f;
    }
    for (int combo = 0; combo < 4; ++combo) {
        const int l = combo >> 1, which = combo & 1;
        __syncthreads();
        for (int e = tid; e < 3072; e += NTHR) { const int s = e >> 10, k = e & 1023; vec[e] = ada_val(F, l, s, (which ? 3072 : 0) + k); }
        __syncthreads();
        const int nrows = which ? FF2 : PWP; const bf16_t* Wt = F.W(l, which ? W_W13 : W_WIN); float* dstv = (which ? F.SHW13 : F.SHWIN) + (size_t)l * 3 * nrows;
        for (int r = gw; r < nrows; r += NGW) {
            float a0 = 0.f, a1 = 0.f, a2 = 0.f;
#pragma unroll
            for (int j = 0; j < 2; ++j) { const int k0 = lane * 8 + 512 * j; const u32x4 w = *(const u32x4*)(Wt + (size_t)r * DM + k0);
                const float wf[8] = {bflo(w.x), bfhi(w.x), bflo(w.y), bfhi(w.y), bflo(w.z), bfhi(w.z), bflo(w.w), bfhi(w.w)};
#pragma unroll
                for (int e = 0; e < 8; ++e) { a0 += wf[e] * vec[k0 + e]; a1 += wf[e] * vec[1024 + k0 + e]; a2 += wf[e] * vec[2048 + k0 + e]; } }
            a0 = wave_sum(a0); a1 = wave_sum(a1); a2 = wave_sum(a2);
            if (lane == 0) { dstv[r] = a0; dstv[nrows + r] = a1; dstv[2 * nrows + r] = a2; }
        }
    }
}
__device__ __forceinline__ void phase_final(Frame& F, bool dry = false, float delta = 0.f) {
    F.fresh();
    const int gw = F.vcu * NWAVES + F.wave, NGW = F.G * NWAVES, lane = F.lane;
    for (int m = gw; m < MLAT; m += NGW) {
        const float ri = pg8::row_rinv(F.SSQ, m); float* row = F.out + (size_t)m * DM;
#pragma unroll
        for (int j = 0; j < 4; ++j) { const int c = 4 * lane + 256 * j; const f32x4 v = *(const f32x4*)(row + c), g = *(const f32x4*)(F.g_final + c); *(f32x4*)(row + c) = dry ? v : v * g * ri + delta; }
    }
}

typedef LAS const unsigned char* lptr;
typedef const unsigned char* gptr;
constexpr float LOG2E = 1.4426950408889634f;
template <int NPW, class RowFn>
__device__ __forceinline__ void stage_T_load(unsigned (&a)[NPW], unsigned (&b)[NPW], RowFn rowp, int nd, int wave, int lane) {
    const int ndb = nd / 16, dl = lane & 7, kl = lane >> 3;
#pragma unroll
    for (int it = 0; it < NPW; ++it) { const int wi = wave + NWAVES * it, dvp = (wi % ndb) * 8 + dl, kp = (wi / ndb) * 8 + kl;
        a[it] = *(const unsigned*)(rowp(2 * kp) + 2 * dvp); b[it] = *(const unsigned*)(rowp(2 * kp + 1) + 2 * dvp); }
}
template <int NPW>
__device__ __forceinline__ void stage_T_store(const unsigned (&a)[NPW], const unsigned (&b)[NPW], LAS unsigned char* dst, int dstride, int nd, int wave, int lane) {
    const int ndb = nd / 16, dl = lane & 7, kl = lane >> 3;
#pragma unroll
    for (int it = 0; it < NPW; ++it) { const int wi = wave + NWAVES * it, dvp = (wi % ndb) * 8 + dl, kp = (wi / ndb) * 8 + kl;
        *(LAS unsigned*)(dst + (2 * dvp) * dstride + kp * 4) = (a[it] & 0xffffu) | (b[it] << 16);
        *(LAS unsigned*)(dst + (2 * dvp + 1) * dstride + kp * 4) = (a[it] >> 16) | (b[it] & 0xffff0000u); }
}
template <int NPW, class RowFn>
__device__ __forceinline__ void stage_T(LAS unsigned char* dst, int dstride, RowFn rowp, int nd, int wave, int lane) {
    unsigned a[NPW], b[NPW]; stage_T_load<NPW>(a, b, rowp, nd, wave, lane); stage_T_store<NPW>(a, b, dst, dstride, nd, wave, lane);
}
__device__ __forceinline__ bf16x4 vtr(LAS const unsigned char* p) { return __builtin_amdgcn_ds_read_tr16_b64_v4i16((LAS bf16x4*)p); }
__device__ __forceinline__ bf16x8 pack8(const f32x4& a, const f32x4& b) { u32x4 w; w.x = pk2(a[0], a[1]); w.y = pk2(a[2], a[3]); w.z = pk2(b[0], b[1]); w.w = pk2(b[2], b[3]); return __builtin_bit_cast(bf16x8, w); }

constexpr int NA_KC = 65536, NA_Q = 98304, NA_RPB = 106496, NA_COMB = 108544;
static_assert(NA_COMB + 8 * 4224 <= MISC_OFF, "NA LDS map");
__device__ __forceinline__ void na_units(Frame& F, int layer, bool ctxq, int total) {
    F.fresh();
    const int tid = F.tid, lane = F.lane, wave = F.wave, fr = lane & 15, fq = lane >> 4;
    LAS unsigned char* lds = F.lds; const bf16_t* P = F.PROJ;
    const int sch = tid & 7, skey = tid >> 3;
    const unsigned sdst = (unsigned)(skey * 128 + ((sch ^ (skey & 7)) << 4));
    const int jb = wave & 3, half = wave >> 2; const bool active = !(ctxq && half == 0);
    const int cstart = min(max(16 * jb - 8, 0), 32);
    u32x4 kv[12], qv; float rpv = 0.f;
    int it = blockIdx.x;
    if (it >= total) return;
#define NA_DECODE(itx, b_, h_, r_) do { if (ctxq) { b_ = (itx) / 24; h_ = ((itx) % 24) / 4; r_ = (itx) & 3; } else { b_ = (itx) / 768; h_ = ((itx) % 768) / 128; r_ = (itx) % 128; } } while (0)
#define NA_LOADK(b_, h_, r_) do { const int rs_ = ctxq ? 0 : min(max((r_) - 4, 0), 120); const int tq_ = ctxq ? MLAT + (b_) * CTXL + (r_) * 64 : (b_) * SEQ + (r_) * 64; \
        if (!ctxq) { _Pragma("unroll") for (int i = 0; i < 8; ++i) { const size_t tok = (size_t)(b_) * SEQ + (rs_ + i) * 64 + skey; kv[i] = *(const u32x4*)(P + tok * PW + C_NK + (h_) * 64 + sch * 8); } } \
        _Pragma("unroll") for (int i = 0; i < 4; ++i) { const size_t tok = (size_t)MLAT + (b_) * CTXL + skey + 64 * i; kv[8 + i] = *(const u32x4*)(P + tok * PW + C_NK + (h_) * 64 + sch * 8); } \
        qv = *(const u32x4*)(P + (size_t)(tq_ + skey) * PW + C_NQ + (h_) * 64 + sch * 8); \
        if (tid < 465) rpv = F.rpb[((size_t)layer * 6 + (h_)) * 465 + tid] * LOG2E; } while (0)
    int b, h, r; NA_DECODE(it, b, h, r); NA_LOADK(b, h, r);
    for (; it < total; it += F.G) {
        NA_DECODE(it, b, h, r);
        const int rs = ctxq ? 0 : min(max(r - 4, 0), 120);
        const int tokq0 = ctxq ? MLAT + b * CTXL + r * 64 : b * SEQ + r * 64;
        __syncthreads();
        USTAMP(0);
        if (!ctxq) {
#pragma unroll
            for (int i = 0; i < 8; ++i) *(LAS u32x4*)(lds + sdst + i * 8192) = kv[i];
        }
#pragma unroll
        for (int i = 0; i < 4; ++i) *(LAS u32x4*)(lds + NA_KC + sdst + i * 8192) = kv[8 + i];
        *(LAS u32x4*)(lds + NA_Q + sdst) = qv;
        if (tid < 465) ((LAS float*)(lds + NA_RPB))[tid] = rpv;
        __syncthreads();
        USTAMP(1);
        bf16x8 pa[8]; float mx = -3.0e38f, lsum = 0.f; f32x4 st[16];
        if (active) {
            const int sw0 = (fq ^ (fr & 7)) << 4, sw1 = ((4 + fq) ^ (fr & 7)) << 4;
            lptr qb = (lptr)(lds + NA_Q + (jb * 16 + fr) * 128);
            const bf16x8 qf0 = ld8(qb + sw0), qf1 = ld8(qb + sw1);
#pragma unroll
            for (int t = 0; t < 16; ++t) {
                const int kidx = half == 0 ? (t >> 1) * 64 + cstart + 16 * (t & 1) + fr : 16 * t + fr;
                lptr kp = (lptr)(lds + (half == 0 ? 0 : NA_KC) + kidx * 128);
                f32x4 z = {0.f, 0.f, 0.f, 0.f};
                z = __builtin_amdgcn_mfma_f32_16x16x32_bf16(ld8(kp + sw0), qf0, z, 0, 0, 0);
                st[t] = __builtin_amdgcn_mfma_f32_16x16x32_bf16(ld8(kp + sw1), qf1, z, 0, 0, 0);
            }
        }
        USTAMP(2);
        if (!ctxq) {
#pragma unroll
            for (int i = 0; i < 8; ++i) { const size_t tok = (size_t)b * SEQ + (rs + i) * 64 + skey; kv[i] = *(const u32x4*)(P + tok * PW + C_NV + h * 64 + sch * 8); }
        }
#pragma unroll
        for (int i = 0; i < 4; ++i) { const size_t tok = (size_t)MLAT + b * CTXL + skey + 64 * i; kv[8 + i] = *(const u32x4*)(P + tok * PW + C_NV + h * 64 + sch * 8); }
        if (active) {
            constexpr float SC = 0.125f * LOG2E;
            if (half == 0) {
                const int qc = jb * 16 + fr, wsx = min(max(qc - 8, 0), 48); LAS const float* rp = (LAS const float*)(lds + NA_RPB) + (rs - r + 7) * 31 + (cstart + 4 * fq - qc + 15);
                bool ok[2][4];
#pragma unroll
                for (int hf = 0; hf < 2; ++hf)
#pragma unroll
                    for (int reg = 0; reg < 4; ++reg) { const int kc = cstart + 16 * hf + 4 * fq + reg; ok[hf][reg] = kc >= wsx && kc < wsx + 16; }
#pragma unroll
                for (int t = 0; t < 16; ++t) { LAS const float* bp = rp + (t >> 1) * 31 + 16 * (t & 1);
#pragma unroll
                    for (int reg = 0; reg < 4; ++reg) { const float x = __builtin_fmaf(st[t][reg], SC, bp[reg]); st[t][reg] = ok[t & 1][reg] ? x : -1.0e30f; } }
            } else {
#pragma unroll
                for (int t = 0; t < 16; ++t) st[t] = st[t] * SC;
            }
#pragma unroll
            for (int t = 0; t < 16; ++t) mx = fmaxf(mx, fmaxf(fmaxf(st[t][0], st[t][1]), fmaxf(st[t][2], st[t][3])));
            mx = fmaxf(mx, __shfl_xor(mx, 16)); mx = fmaxf(mx, __shfl_xor(mx, 32));
#pragma unroll
            for (int t = 0; t < 16; ++t)
#pragma unroll
                for (int reg = 0; reg < 4; ++reg) { const float p = __builtin_amdgcn_exp2f(st[t][reg] - mx); st[t][reg] = p; lsum += p; }
            lsum += __shfl_xor(lsum, 16); lsum += __shfl_xor(lsum, 32);
#pragma unroll
            for (int s = 0; s < 8; ++s) pa[s] = pack8(st[2 * s], st[2 * s + 1]);
        } else {
#pragma unroll
            for (int s = 0; s < 8; ++s) pa[s] = (bf16x8){0, 0, 0, 0, 0, 0, 0, 0};
        }
        USTAMP(3);
        __syncthreads();
        if (!ctxq) {
#pragma unroll
            for (int i = 0; i < 8; ++i) *(LAS u32x4*)(lds + sdst + i * 8192) = kv[i];
        }
#pragma unroll
        for (int i = 0; i < 4; ++i) *(LAS u32x4*)(lds + NA_KC + sdst + i * 8192) = kv[8 + i];
        __syncthreads();
        USTAMP(4);
        if (it + F.G < total) { int b2, h2, r2; NA_DECODE(it + F.G, b2, h2, r2); NA_LOADK(b2, h2, r2); }
        f32x4 o[4];
#pragma unroll
        for (int n = 0; n < 4; ++n) o[n] = (f32x4){0.f, 0.f, 0.f, 0.f};
        if (active) {
            const int q4 = (lane & 15) >> 2, p4 = lane & 3, c7 = 4 * (fq & 1) + q4;
            lptr vb = (lptr)(lds + (half == 0 ? 0 : NA_KC) + (4 * fq + q4) * 128 + 8 * (p4 & 1));
            int xo[4];
#pragma unroll
            for (int n = 0; n < 4; ++n) xo[n] = ((2 * n + (p4 >> 1)) ^ c7) << 4;
#pragma unroll
            for (int s = 0; s < 8; ++s) { const int k0 = half == 0 ? s * 64 + cstart : 32 * s;
#pragma unroll
                for (int n = 0; n < 4; ++n) { lptr rb = vb + k0 * 128 + xo[n];
                    const bf16x4 lo = vtr(rb), hi = vtr(rb + 16 * 128);
                    const bf16x8 bv = {lo[0], lo[1], lo[2], lo[3], hi[0], hi[1], hi[2], hi[3]};
                    o[n] = __builtin_amdgcn_mfma_f32_16x16x32_bf16(pa[s], bv, o[n], 0, 0, 0); } }
        }
        USTAMP(5);
        LAS float* cb = (LAS float*)(lds + NA_COMB + wave * 4224);
#pragma unroll
        for (int n = 0; n < 4; ++n)
#pragma unroll
            for (int reg = 0; reg < 4; ++reg) cb[(4 * fq + reg) * 64 + n * 16 + fr] = o[n][reg];
        if (fq == 0) { cb[1024 + 2 * fr] = mx; cb[1025 + 2 * fr] = lsum; }
        __syncthreads();
        if (wave < 4) {
            LAS const float* c2 = (LAS const float*)(lds + NA_COMB + (wave + 4) * 4224);
#pragma unroll
            for (int reg = 0; reg < 4; ++reg) { const int q = 4 * fq + reg;
                const float m1 = cb[1024 + 2 * q], l1 = cb[1025 + 2 * q], m2 = c2[1024 + 2 * q], l2 = c2[1025 + 2 * q], M = fmaxf(m1, m2);
                const float w1 = __builtin_amdgcn_exp2f(m1 - M), w2 = __builtin_amdgcn_exp2f(m2 - M), inv = 1.0f / (w1 * l1 + w2 * l2);
                bf16_t* orow = F.CAT + (size_t)(tokq0 + jb * 16 + q) * DM + 640 + h * 64;
#pragma unroll
                for (int n = 0; n < 4; ++n) orow[n * 16 + fr] = (bf16_t)f2bf((w1 * o[n][reg] + w2 * c2[q * 64 + n * 16 + fr]) * inv); }
        }
        USTAMP(6);
    }
#undef NA_DECODE
#undef NA_LOADK
}

__device__ __forceinline__ int ret_row0(int b, int t) { return t >= 2 ? b * SEQ + (t - 2) * 128 : MLAT + b * CTXL + t * 128; }
constexpr int R1_K = 0, R1_VF = 32768, R1_VB = 65536;
__device__ __forceinline__ unsigned r1_swz(int row, int ch) { return (unsigned)(row * 256 + ((ch ^ (row & 15)) << 4)); }
__device__ __forceinline__ u32x4 scale8(const u32x4& v, float w) { u32x4 o; o.x = pk2(bflo(v.x) * w, bfhi(v.x) * w); o.y = pk2(bflo(v.y) * w, bfhi(v.y) * w); o.z = pk2(bflo(v.z) * w, bfhi(v.z) * w); o.w = pk2(bflo(v.w) * w, bfhi(v.w) * w); return o; }
__device__ __forceinline__ void r1_unit(Frame& F, int layer, int b, int h, int t) {
    F.fresh();
    const int tid = F.tid, lane = F.lane, wave = F.wave, fr = lane & 15, fq = lane >> 4;
    LAS unsigned char* lds = F.lds; bf16_t* P = F.PROJ;
    const bool lat = t >= 2; const int row0 = ret_row0(b, t);
    const float lgf = F.LG[layer * 8 + h], lgb = F.LG[layer * 8 + 4 + h], ks = 0.10206207261596575f;
    __syncthreads();
    u32x4 xa[3], xb[3], vv[3]; f32x4 tb[3][4];
#pragma unroll
    for (int it = 0; it < 3; ++it) { const int e = tid + NTHR * it, X = e / 768, rem = e % 768, j = rem / 6, cp = rem % 6, c0 = cp < 3 ? cp : cp + 3;
        const bf16_t* xr = P + (size_t)(row0 + j) * PW + (X ? C_RQ : C_RK) + h * 96;
        xa[it] = *(const u32x4*)(xr + c0 * 8); xb[it] = *(const u32x4*)(xr + (c0 + 3) * 8);
        if (lat) { const int pos = (t - 2) * 128 + j, prow = pos >> 6, pcol = pos & 63; const float* tp = F.ROPE + ((cp < 3 ? prow * 24 : 3072 + pcol * 24) + 8 * (cp % 3)) * 2;
#pragma unroll
            for (int q = 0; q < 4; ++q) tb[it][q] = *(const f32x4*)(tp + 4 * q); } }
#pragma unroll
    for (int it = 0; it < 3; ++it) { const int e = tid + NTHR * it, j = e / 12, ch = e % 12; vv[it] = *(const u32x4*)(P + (size_t)(row0 + j) * PW + C_RV + h * 96 + ch * 8); }
#pragma unroll
    for (int it = 0; it < 3; ++it) { const int e = tid + NTHR * it, X = e / 768, rem = e % 768, j = rem / 6, cp = rem % 6, c0 = cp < 3 ? cp : cp + 3;
        const float scl = X ? 1.0f : ks; u32x4 oa, ob;
        if (lat) { float ra[8], rb[8]; const unsigned ua[4] = {xa[it].x, xa[it].y, xa[it].z, xa[it].w}, ub[4] = {xb[it].x, xb[it].y, xb[it].z, xb[it].w};
#pragma unroll
            for (int q = 0; q < 4; ++q) { const float a0 = bflo(ua[q]), a1 = bfhi(ua[q]), b0 = bflo(ub[q]), b1 = bfhi(ub[q]); const f32x4 cs = tb[it][q];
                ra[2 * q] = (a0 * cs[0] - b0 * cs[1]) * scl; rb[2 * q] = (a0 * cs[1] + b0 * cs[0]) * scl; ra[2 * q + 1] = (a1 * cs[2] - b1 * cs[3]) * scl; rb[2 * q + 1] = (a1 * cs[3] + b1 * cs[2]) * scl; }
            oa.x = pk2(ra[0], ra[1]); oa.y = pk2(ra[2], ra[3]); oa.z = pk2(ra[4], ra[5]); oa.w = pk2(ra[6], ra[7]);
            ob.x = pk2(rb[0], rb[1]); ob.y = pk2(rb[2], rb[3]); ob.z = pk2(rb[4], rb[5]); ob.w = pk2(rb[6], rb[7]);
        } else { oa = X ? xa[it] : scale8(xa[it], ks); ob = X ? xb[it] : scale8(xb[it], ks); }
        if (lat || X == 0) { bf16_t* xr = P + (size_t)(row0 + j) * PW + (X ? C_RQ : C_RK) + h * 96; *(u32x4*)(xr + c0 * 8) = oa; *(u32x4*)(xr + (c0 + 3) * 8) = ob; }
        if (X == 0) { *(LAS u32x4*)(lds + R1_K + r1_swz(j, c0)) = oa; *(LAS u32x4*)(lds + R1_K + r1_swz(j, c0 + 3)) = ob; } }
#pragma unroll
    for (int it = 0; it < 3; ++it) { const int e = tid + NTHR * it, j = e / 12, ch = e % 12;
        *(LAS u32x4*)(lds + R1_VF + r1_swz(j, ch)) = scale8(vv[it], expf(lgf * (float)(127 - j))); *(LAS u32x4*)(lds + R1_VB + r1_swz(j, ch)) = scale8(vv[it], expf(lgb * (float)j)); }
    __syncthreads();
    const int dir = wave >> 2, q = wave & 3, mb = q >> 1, nb = q & 1, q4 = (lane & 15) >> 2, p4 = lane & 3; f32x4 acc[3][3]; zero_acc(acc);
    lptr vbase = (lptr)(lds + (dir ? R1_VB : R1_VF)), kbase = (lptr)(lds + R1_K);
#pragma unroll
    for (int s = 0; s < 4; ++s) { bf16x8 a[3], bb[3]; const int r0 = 32 * s + 8 * fq + q4, r1 = r0 + 4;
#pragma unroll
        for (int m = 0; m < 3; ++m) { const int ch = 2 * (mb * 3 + m) + (p4 >> 1); const bf16x4 lo = vtr(vbase + r1_swz(r0, ch) + 8 * (p4 & 1)), hi = vtr(vbase + r1_swz(r1, ch) + 8 * (p4 & 1));
            a[m] = (bf16x8){lo[0], lo[1], lo[2], lo[3], hi[0], hi[1], hi[2], hi[3]}; }
#pragma unroll
        for (int n = 0; n < 3; ++n) { const int ch = 2 * (nb * 3 + n) + (p4 >> 1); const bf16x4 lo = vtr(kbase + r1_swz(r0, ch) + 8 * (p4 & 1)), hi = vtr(kbase + r1_swz(r1, ch) + 8 * (p4 & 1));
            bb[n] = (bf16x8){lo[0], lo[1], lo[2], lo[3], hi[0], hi[1], hi[2], hi[3]}; }
#pragma unroll
        for (int m = 0; m < 3; ++m)
#pragma unroll
            for (int n = 0; n < 3; ++n) acc[m][n] = __builtin_amdgcn_mfma_f32_16x16x32_bf16(a[m], bb[n], acc[m][n], 0, 0, 0); }
    const int u = dir == 0 ? t : (t < 2 ? 1 - t : 67 - t);
    bf16_t* ST = F.STATE + (size_t)(((b * 4 + h) * 2 + dir) * 66 + u) * 9216;
#pragma unroll
    for (int m = 0; m < 3; ++m)
#pragma unroll
        for (int n = 0; n < 3; ++n)
#pragma unroll
            for (int reg = 0; reg < 4; ++reg) ST[(mb * 48 + m * 16 + 4 * fq + reg) * 96 + nb * 48 + n * 16 + fr] = (bf16_t)f2bf(acc[m][n][reg]);
}
__device__ __forceinline__ void r2_scan(Frame& F, int layer) {
    F.fresh();
    const int gt = F.vcu * NTHR + F.tid, GT = F.G * NTHR;
    for (int e = gt; e < 16 * 4608; e += GT) { const int combo = e / 4608, idx = (e % 4608) * 2, h = (combo >> 1) & 3, dir = combo & 1;
        const float dcy = expf(128.0f * F.LG[layer * 8 + dir * 4 + h]); unsigned* p = (unsigned*)(F.STATE + (size_t)combo * 66 * 9216 + idx); float s0 = 0.f, s1 = 0.f;
#pragma unroll 1
        for (int u0 = 0; u0 < 66; u0 += 33) { unsigned kv[33];
#pragma unroll
            for (int q = 0; q < 33; ++q) kv[q] = p[(size_t)(u0 + q) * 4608];
#pragma unroll
            for (int q = 0; q < 33; ++q) { p[(size_t)(u0 + q) * 4608] = pk2(s0, s1); s0 = s0 * dcy + bflo(kv[q]); s1 = s1 * dcy + bfhi(kv[q]); } } }
}
constexpr int R3_Q = 0, R3_K = 26624, R3_V = 53248, R3_P = 86016, R3_SF = 120832, R3_SB = 140800;
static_assert(R3_SB + 96 * 208 <= MISC_OFF, "R3 LDS map");
__device__ __forceinline__ void r3_units(Frame& F, int layer) {
    F.fresh();
    const int tid = F.tid, lane = F.lane, wave = F.wave, fr = lane & 15, fq = lane >> 4, q4 = (lane & 15) >> 2, p4 = lane & 3;
    LAS unsigned char* lds = F.lds; const bf16_t* P = F.PROJ;
    const int nt = layer == 0 ? 66 : 64, t0 = layer == 0 ? 0 : 2, total = 8 * nt;
    int it = blockIdx.x; if (it >= total) return;
    u32x4 rq[3], rk[3], rv[3], sv[5];
#define R3_DECODE(itx, b_, h_, t_) do { b_ = (itx) / (4 * nt); h_ = ((itx) / nt) & 3; t_ = t0 + (itx) % nt; } while (0)
#define R3_LOAD(b_, h_, t_) do { const int r0_ = ret_row0(b_, t_); \
        _Pragma("unroll") for (int i_ = 0; i_ < 3; ++i_) { const int e_ = tid + NTHR * i_, j_ = e_ / 12, c_ = e_ % 12; const bf16_t* rp_ = P + (size_t)(r0_ + j_) * PW + (h_) * 96 + c_ * 8; \
            rq[i_] = *(const u32x4*)(rp_ + C_RQ); rk[i_] = *(const u32x4*)(rp_ + C_RK); rv[i_] = *(const u32x4*)(rp_ + C_RV); } \
        const int ub_ = (t_) < 2 ? 1 - (t_) : 67 - (t_); \
        _Pragma("unroll") for (int i_ = 0; i_ < 5; ++i_) { const int e_ = tid + NTHR * i_; if (e_ < 2304) { const int d_ = e_ >= 1152, c_ = d_ ? e_ - 1152 : e_; \
            sv[i_] = *(const u32x4*)(F.STATE + (size_t)((((b_) * 4 + (h_)) * 2 + d_) * 66 + (d_ ? ub_ : (t_))) * 9216 + c_ * 8); } } } while (0)
    int b, h, t; R3_DECODE(it, b, h, t); R3_LOAD(b, h, t);
    for (; it < total; it += F.G) {
        R3_DECODE(it, b, h, t);
        const int row0 = ret_row0(b, t);
        const float lf2 = F.LG[layer * 8 + h] * LOG2E, lb2 = F.LG[layer * 8 + 4 + h] * LOG2E;
        __syncthreads();
        USTAMP(10);
#pragma unroll
        for (int i = 0; i < 3; ++i) { const int e = tid + NTHR * i, j = e / 12, c = e % 12;
            *(LAS u32x4*)(lds + R3_Q + j * 208 + c * 16) = rq[i]; *(LAS u32x4*)(lds + R3_K + j * 208 + c * 16) = rk[i]; *(LAS u32x4*)(lds + R3_V + r1_swz(j, c)) = rv[i]; }
#pragma unroll
        for (int i = 0; i < 5; ++i) { const int e = tid + NTHR * i; if (e < 2304) { const int d = e >= 1152, c = d ? e - 1152 : e;
            *(LAS u32x4*)(lds + (d ? R3_SB : R3_SF) + (c / 12) * 208 + (c % 12) * 16) = sv[i]; } }
        __syncthreads();
        USTAMP(11);
        unsigned short gtv[4][6]; float gnv[6];
#pragma unroll
        for (int reg = 0; reg < 4; ++reg)
#pragma unroll
            for (int n = 0; n < 6; ++n) gtv[reg][n] = P[(size_t)(row0 + wave * 16 + 4 * fq + reg) * PW + C_RG + h * 96 + n * 16 + fr];
#pragma unroll
        for (int n = 0; n < 6; ++n) gnv[n] = F.ret_g[layer * 384 + h * 96 + n * 16 + fr];
        if (it + F.G < total) { int b2, h2, t2; R3_DECODE(it + F.G, b2, h2, t2); R3_LOAD(b2, h2, t2); }
        f32x4 ao[1][6];
        {
            f32x4 af[1][6], ab[1][6]; zero_acc(af); zero_acc(ab);
            wave_mma<1, 6>(af, (lptr)(lds + R3_Q + wave * 16 * 208), 208, (lptr)(lds + R3_SF), 208, 3, fr, fq);
            wave_mma<1, 6>(ab, (lptr)(lds + R3_Q + wave * 16 * 208), 208, (lptr)(lds + R3_SB), 208, 3, fr, fq);
#pragma unroll
            for (int reg = 0; reg < 4; ++reg) { const int il = wave * 16 + 4 * fq + reg; const float qdf = __builtin_amdgcn_exp2f(lf2 * (float)(il + 1)), qdb = __builtin_amdgcn_exp2f(lb2 * (float)(128 - il));
#pragma unroll
                for (int n = 0; n < 6; ++n) ao[0][n][reg] = qdf * af[0][n][reg] + qdb * ab[0][n][reg]; }
        }
        {
            bf16x8 qf[3];
#pragma unroll
            for (int s = 0; s < 3; ++s) qf[s] = ld8((lptr)(lds + R3_Q + (wave * 16 + fr) * 208 + s * 64 + fq * 16));
            const int i = wave * 16 + fr;
#pragma unroll 2
            for (int m = 0; m < 8; ++m) { f32x4 a = {0.f, 0.f, 0.f, 0.f};
#pragma unroll
                for (int s = 0; s < 3; ++s) a = __builtin_amdgcn_mfma_f32_16x16x32_bf16(ld8((lptr)(lds + R3_K + (m * 16 + fr) * 208 + s * 64 + fq * 16)), qf[s], a, 0, 0, 0);
                float pv[4];
#pragma unroll
                for (int reg = 0; reg < 4; ++reg) { const int diff = i - (m * 16 + 4 * fq + reg);
                    const float ex = __builtin_amdgcn_exp2f((diff > 0 ? lf2 : lb2) * (float)(diff > 0 ? diff : -diff)); const float dec = diff == 0 ? 2.0f : ex; pv[reg] = a[reg] * dec; }
                u32x2 w; w.x = pk2(pv[0], pv[1]); w.y = pk2(pv[2], pv[3]); *(LAS u32x2*)(lds + R3_P + i * 272 + (m * 16 + 4 * fq) * 2) = w; }
        }
        asm volatile("s_waitcnt lgkmcnt(0)" ::: "memory");
        USTAMP(12);
#pragma unroll 1
        for (int s = 0; s < 4; ++s) { const bf16x8 a = ld8((lptr)(lds + R3_P + (wave * 16 + fr) * 272 + s * 64 + fq * 16)); const int r0 = 32 * s + 8 * fq + q4;
#pragma unroll
            for (int n = 0; n < 6; ++n) { const int ch = 2 * n + (p4 >> 1); const bf16x4 lo = vtr((lptr)(lds + R3_V + r1_swz(r0, ch) + 8 * (p4 & 1))), hi = vtr((lptr)(lds + R3_V + r1_swz(r0 + 4, ch) + 8 * (p4 & 1)));
                const bf16x8 bv = {lo[0], lo[1], lo[2], lo[3], hi[0], hi[1], hi[2], hi[3]};
                ao[0][n] = __builtin_amdgcn_mfma_f32_16x16x32_bf16(a, bv, ao[0][n], 0, 0, 0); } }
        USTAMP(13);
#pragma unroll
        for (int reg = 0; reg < 4; ++reg) { const int il = wave * 16 + 4 * fq + reg;
            float ov[6], ss = 0.f;
#pragma unroll
            for (int n = 0; n < 6; ++n) { ov[n] = ao[0][n][reg]; ss += ov[n] * ov[n]; }
            ss += __shfl_xor(ss, 1); ss += __shfl_xor(ss, 2); ss += __shfl_xor(ss, 4); ss += __shfl_xor(ss, 8);
            const float rn = rsqrtf(ss * (1.0f / 96.0f) + NORM_EPS); const size_t row = (size_t)(row0 + il);
#pragma unroll
            for (int n = 0; n < 6; ++n) { const int col = n * 16 + fr; const float gt = bf2f(gtv[reg][n]);
                F.CAT[row * DM + 256 + h * 96 + col] = (bf16_t)f2bf(ov[n] * rn * gnv[n] * silu_f(gt)); } }
        USTAMP(14);
    }
#undef R3_DECODE
#undef R3_LOAD
}

__device__ __forceinline__ void d1_unit(Frame& F, int b, int l2, int g) {
    F.fresh();
    const int tid = F.tid, lane = F.lane, wave = F.wave, fr = lane & 15, fq = lane >> 4;
    LAS unsigned char* lds = F.lds; const bf16_t* P = F.PROJ;
    __syncthreads();
    {
        u32x4 v[2];
#pragma unroll
        for (int i = 0; i < 2; ++i) { const int row = (tid >> 3) + 64 * i, ch = tid & 7; v[i] = *(const u32x4*)(P + ((size_t)b * SEQ + row * 64 + l2) * PW + g * 64 + ch * 8); }
#pragma unroll
        for (int i = 0; i < 2; ++i) { const int row = (tid >> 3) + 64 * i, ch = tid & 7; *(LAS u32x4*)(lds + row * 128 + ((ch ^ (row & 7)) << 4)) = v[i]; }
    }
    bf16x8 bfr[2][4];
#pragma unroll
    for (int cs = 0; cs < 2; ++cs)
#pragma unroll
        for (int s = 0; s < 4; ++s) bfr[cs][s] = *(const bf16x8*)(F.TWA + (size_t)(cs * 128 + 16 * wave + fr) * 128 + 32 * s + 8 * fq);
    __syncthreads();
    f32x4 acc[4][2]; zero_acc(acc);
    const int q4 = (lane & 15) >> 2, p4 = lane & 3;
#pragma unroll
    for (int s = 0; s < 4; ++s)
#pragma unroll
        for (int mt = 0; mt < 4; ++mt) {
            lptr rb = (lptr)(lds + (32 * s + 8 * fq + q4) * 128 + 8 * (p4 & 1));
            const bf16x4 lo = vtr(rb + (((2 * mt + (p4 >> 1)) ^ q4) << 4)), hi = vtr(rb + 4 * 128 + (((2 * mt + (p4 >> 1)) ^ (4 + q4)) << 4));
            const bf16x8 av = {lo[0], lo[1], lo[2], lo[3], hi[0], hi[1], hi[2], hi[3]};
            acc[mt][0] = __builtin_amdgcn_mfma_f32_16x16x32_bf16(av, bfr[0][s], acc[mt][0], 0, 0, 0);
            acc[mt][1] = __builtin_amdgcn_mfma_f32_16x16x32_bf16(av, bfr[1][s], acc[mt][1], 0, 0, 0);
        }
    const int k1 = 16 * wave + fr; const f32x2 cs2 = *(const f32x2*)(F.TW8 + 2 * (k1 * l2));
    unsigned* yb = F.Y + ((((size_t)b * 128 + k1) * 4 + g) * 64) * 64 + l2;
#pragma unroll
    for (int mt = 0; mt < 2; ++mt)
#pragma unroll
        for (int reg = 0; reg < 4; ++reg) { const int p = 16 * mt + 4 * fq + reg;
            const float cp = acc[mt][0][reg], sp = acc[mt][1][reg], cq = acc[mt + 2][0][reg], sq = acc[mt + 2][1][reg];
            float yr0, yi0, yr1, yi1; int m0, m1;
            if (p == 0) { m0 = 0; yr0 = cp; yi0 = -sp; m1 = 32; yr1 = cq; yi1 = -sq; }
            else { m0 = p; yr0 = cp + sq; yi0 = cq - sp; m1 = 64 - p; yr1 = cp - sq; yi1 = -cq - sp; }
            yb[(size_t)m0 * 64] = pk2(yr0 * cs2[0] + yi0 * cs2[1], yi0 * cs2[0] - yr0 * cs2[1]);
            yb[(size_t)m1 * 64] = pk2(yr1 * cs2[0] + yi1 * cs2[1], yi1 * cs2[0] - yr1 * cs2[1]); }
}
constexpr int D2_Y = 0, D2_A = 69632, D2_F = 87040;
__device__ __forceinline__ void d2_unit(Frame& F, int layer, int b, int k1) {
    F.fresh();
    const int tid = F.tid, lane = F.lane, wave = F.wave, fr = lane & 15, fq = lane >> 4;
    LAS unsigned char* lds = F.lds;
    __syncthreads();
    const unsigned* ysrc = F.Y + (size_t)(b * 128 + k1) * 4 * 64 * 64;
    for (int e = tid; e < 4096; e += NTHR) { const int row = e >> 4, ch = e & 15; *(LAS u32x4*)(lds + D2_Y + row * 272 + ch * 16) = *(const u32x4*)(ysrc + row * 64 + ch * 4); }
    for (int e = tid; e < 1024; e += NTHR) { const int row = e >> 4, ch = e & 15; *(LAS u32x4*)(lds + D2_A + row * 272 + ch * 16) = *(const u32x4*)(F.TD2 + row * 128 + ch * 8); }
    __syncthreads();
    f32x4 acc[4][2]; zero_acc(acc);
    wave_mma<4, 2>(acc, (lptr)(lds + D2_A), 272, (lptr)(lds + D2_Y + wave * 32 * 272), 272, 4, fr, fq);
    const float scale = 0.0013810679320049757f;
#pragma unroll
    for (int mt = 0; mt < 4; ++mt)
#pragma unroll
        for (int nt = 0; nt < 2; ++nt)
#pragma unroll
            for (int reg = 0; reg < 4; ++reg) *(LAS bf16_t*)(lds + D2_F + (mt * 16 + 4 * fq + reg) * 528 + (wave * 32 + nt * 16 + fr) * 2) = (bf16_t)f2bf(acc[mt][nt][reg] * scale);
    __syncthreads();
    zero_acc(acc);
    wave_mma<4, 2>(acc, (lptr)(lds + D2_F), 528, (gptr)(F.WFT + (size_t)layer * 65536) + (size_t)(wave * 32) * 512, 512, 8, fr, fq);
#pragma unroll
    for (int mt = 0; mt < 4; ++mt)
#pragma unroll
        for (int nt = 0; nt < 2; ++nt)
#pragma unroll
            for (int reg = 0; reg < 4; ++reg) { const int k2 = mt * 16 + 4 * fq + reg, oc = wave * 32 + nt * 16 + fr;
                F.CAT[((size_t)b * SEQ + k1 + 128 * k2) * DM + oc] = (bf16_t)f2bf(acc[mt][nt][reg]); }
}
constexpr int DC_H = 0, DC_F = 131072;
__device__ __forceinline__ void dctx_item(Frame& F, int layer, int it) {
    F.fresh();
    const int tid = F.tid, lane = F.lane, wave = F.wave, fr = lane & 15, fq = lane >> 4; LAS unsigned char* lds = F.lds; const bf16_t* P = F.PROJ;
    const int b = it >> 5, k0 = (it & 31) * 8;
    __syncthreads();
    { u32x4 v[16];
#pragma unroll
      for (int i = 0; i < 16; ++i) { const int e = tid + NTHR * i, row = e >> 5, ch = e & 31; v[i] = *(const u32x4*)(P + ((size_t)MLAT + b * CTXL + row) * PW + ch * 8); }
#pragma unroll
      for (int i = 0; i < 16; ++i) { const int e = tid + NTHR * i, row = e >> 5, ch = e & 31; *(LAS u32x4*)(lds + DC_H + row * 512 + ((ch ^ (row & 15)) << 4)) = v[i]; } }
    for (int e = tid; e < 16 * 132; e += NTHR) ((LAS unsigned*)(lds + DC_F))[e] = 0u;
    bf16x8 bfr[8];
    { const bf16_t* tb = F.TC256 + ((size_t)((fr >> 3) * 256 + k0 + (fr & 7))) * 256 + 8 * fq;
#pragma unroll
      for (int s = 0; s < 8; ++s) bfr[s] = *(const bf16x8*)(tb + 32 * s); }
    __syncthreads();
    const int g = wave >> 1, jj = wave & 1, q4 = (lane & 15) >> 2, p4 = lane & 3;
    f32x4 acc[2]; acc[0] = (f32x4){0.f, 0.f, 0.f, 0.f}; acc[1] = acc[0];
#pragma unroll
    for (int s = 0; s < 8; ++s)
#pragma unroll
        for (int mt = 0; mt < 2; ++mt) { const int chunk = 2 * (g * 4 + jj + 2 * mt) + (p4 >> 1); const int r0 = 32 * s + 8 * fq + q4;
            const bf16x4 lo = vtr((lptr)(lds + DC_H + r0 * 512 + ((chunk ^ (r0 & 15)) << 4) + 8 * (p4 & 1)));
            const bf16x4 hi = vtr((lptr)(lds + DC_H + (r0 + 4) * 512 + ((chunk ^ ((r0 + 4) & 15)) << 4) + 8 * (p4 & 1)));
            const bf16x8 av = {lo[0], lo[1], lo[2], lo[3], hi[0], hi[1], hi[2], hi[3]};
            acc[mt] = __builtin_amdgcn_mfma_f32_16x16x32_bf16(av, bfr[s], acc[mt], 0, 0, 0); }
    const int kk = fr & 7; const bool hiLane = fr >= 8;
#pragma unroll
    for (int reg = 0; reg < 4; ++reg) { const int pp = jj * 16 + 4 * fq + reg;
        const float vp = acc[0][reg], vq = acc[1][reg], op = __shfl_xor(vp, 8), oq = __shfl_xor(vq, 8);
        const float c_p = hiLane ? op : vp, c_q = hiLane ? oq : vq, s_q = hiLane ? vq : oq;
        float x; int m;
        if (pp == 0) { m = hiLane ? 32 : 0; x = hiLane ? c_q : c_p; } else { m = hiLane ? 64 - pp : pp; x = hiLane ? c_p - s_q : c_p + s_q; }
        *(LAS bf16_t*)(lds + DC_F + kk * 528 + (g * 64 + m) * 2) = (bf16_t)f2bf(x * (1.0f / 128.0f)); }
    __syncthreads();
    f32x4 o2[1][2]; zero_acc(o2);
    wave_mma<1, 2>(o2, (lptr)(lds + DC_F), 528, (gptr)(F.WFT + (size_t)layer * 65536) + (size_t)(wave * 32) * 512, 512, 8, fr, fq);
    if (fq < 2) {
#pragma unroll
        for (int nt = 0; nt < 2; ++nt)
#pragma unroll
            for (int reg = 0; reg < 4; ++reg) F.CAT[((size_t)MLAT + b * CTXL + k0 + 4 * fq + reg) * DM + wave * 32 + nt * 16 + fr] = (bf16_t)f2bf(o2[0][nt][reg]);
    }
}

#ifndef DUP_PHASE
#define DUP_PHASE 0
#endif
__device__ __forceinline__ void phase_m1(Frame& F, int layer) {
    const int nNA = 1536, nCQ = layer == 0 ? 48 : 0, nR1 = 528, nD1 = 512;
#pragma unroll 1
    for (int rep = 0; rep < (DUP_PHASE == 6 ? 2 : 1); ++rep)
        { F.prof = (layer == 1); na_units(F, layer, false, nNA); F.prof = false; }
#pragma unroll 1
    for (int rep = 0; rep < (DUP_PHASE == 11 ? 2 : 1); ++rep)
        na_units(F, layer, true, nCQ);
#pragma unroll 1
    for (int rep = 0; rep < (DUP_PHASE == 7 ? 2 : 1); ++rep)
        for (int q = blockIdx.x; q < nR1; q += F.G) r1_unit(F, layer, q / 264, (q % 264) / 66, q % 66);
#pragma unroll 1
    for (int rep = 0; rep < (DUP_PHASE == 8 ? 2 : 1); ++rep)
        for (int q = blockIdx.x; q < nD1; q += F.G) d1_unit(F, q >> 8, (q >> 2) & 63, q & 3);
}
__device__ __forceinline__ void phase_m2(Frame& F, int layer) {
    r2_scan(F, layer);
    const int nD2 = 256, nDC = layer == 0 ? 64 : 0;
#pragma unroll 1
    for (int rep = 0; rep < (DUP_PHASE == 9 ? 2 : 1); ++rep)
        for (int it = blockIdx.x; it < nD2; it += F.G) d2_unit(F, layer, it >> 7, it & 127);
#pragma unroll 1
    for (int rep = 0; rep < (DUP_PHASE == 22 ? 2 : 1); ++rep)
        for (int it = blockIdx.x; it < nDC; it += F.G) dctx_item(F, layer, it);
}
__device__ __forceinline__ void phase_m3(Frame& F, int layer) {
    const int nt = layer == 0 ? 66 : 64, t0 = layer == 0 ? 0 : 2, total = 8 * nt;
    (void)nt; (void)t0; (void)total; F.prof = (layer == 1); r3_units(F, layer); F.prof = false;
}

struct SgParams {
    const bf16_t* A; int lda; const bf16_t* Bt; int K;
    int mode;
    const float* ssq; const float* shw;
    bf16_t* O;
    const float* src; float* dst; bf16_t* XN; float* ssq_out; const float* gate; const float* sc; const float* g; float gmul;
};
constexpr int SG_A = 0, SG_B = 16384;
template <int NTW>
__device__ __forceinline__ void sg_unit(Frame& F, const SgParams& p, int mblk, int ntile) {
    F.fresh();
    constexpr int NB = NTW, BSTAGE = NTW * 8192, UW = 64 * NTW;
    const int tid = F.tid, lane = F.lane, wave = F.wave, fr = lane & 15, fq = lane >> 4, wr = wave & 1, wc = wave >> 1;
    LAS unsigned char* lds = F.lds;
    const int srow = tid >> 3, sch = tid & 7; const unsigned sdst = (unsigned)(srow * 128 + ((sch ^ (srow & 7)) << 4));
    const bf16_t* ap = p.A + (size_t)(mblk * 64 + srow) * p.lda + sch * 8;
    const bf16_t* bp = p.Bt + (size_t)(ntile * UW + srow) * p.K + sch * 8;
    int boff[NTW];
#pragma unroll
    for (int n = 0; n < NTW; ++n) boff[n] = NTW == 1 ? wc * 16 : (p.mode == 2 ? ((n >> 1) * 128 + wc * 32 + (n & 1) * 16) : (wc * 64 + n * 16));
    const int sw0 = (fq ^ (fr & 7)) << 4, sw1 = ((4 + fq) ^ (fr & 7)) << 4;
    f32x4 acc[2][NTW]; zero_acc(acc);
    const int nk = p.K / 64;
    u32x4 ra0, ra1, rb0[NB], rb1[NB];
#define SG_LOAD(RA, RB, kt) do { RA = *(const u32x4*)(ap + (kt) * 64); _Pragma("unroll") for (int i_ = 0; i_ < NB; ++i_) RB[i_] = *(const u32x4*)(bp + (size_t)(64 * i_) * p.K + (kt) * 64); } while (0)
#define SG_WRITE(RA, RB, buf) do { *(LAS u32x4*)(lds + SG_A + (buf) * 8192 + sdst) = RA; _Pragma("unroll") for (int i_ = 0; i_ < NB; ++i_) *(LAS u32x4*)(lds + SG_B + (buf) * BSTAGE + sdst + i_ * 8192) = RB[i_]; } while (0)
#define SG_MMA(buf) do { lptr Ab_ = (lptr)(lds + SG_A + (buf) * 8192 + (wr * 32 + fr) * 128), Bb_ = (lptr)(lds + SG_B + (buf) * BSTAGE + fr * 128); \
        _Pragma("unroll") for (int s_ = 0; s_ < 2; ++s_) { const int sw_ = s_ ? sw1 : sw0; bf16x8 a_[2], b_[NTW]; \
            _Pragma("unroll") for (int m_ = 0; m_ < 2; ++m_) a_[m_] = ld8(Ab_ + m_ * 16 * 128 + sw_); \
            _Pragma("unroll") for (int n_ = 0; n_ < NTW; ++n_) b_[n_] = ld8(Bb_ + boff[n_] * 128 + sw_); \
            _Pragma("unroll") for (int m_ = 0; m_ < 2; ++m_) _Pragma("unroll") for (int n_ = 0; n_ < NTW; ++n_) acc[m_][n_] = __builtin_amdgcn_mfma_f32_16x16x32_bf16(b_[n_], a_[m_], acc[m_][n_], 0, 0, 0); } } while (0)
    __syncthreads();
    SG_LOAD(ra0, rb0, 0); SG_LOAD(ra1, rb1, 1);
    SG_WRITE(ra0, rb0, 0);
    __syncthreads();
    for (int kt = 0; kt < nk; kt += 2) {
        if (kt + 2 < nk) SG_LOAD(ra0, rb0, kt + 2);
        SG_MMA(0);
        SG_WRITE(ra1, rb1, 1);
        __syncthreads();
        if (kt + 3 < nk) SG_LOAD(ra1, rb1, kt + 3);
        SG_MMA(1);
        if (kt + 2 < nk) SG_WRITE(ra0, rb0, 0);
        __syncthreads();
    }
#undef SG_LOAD
#undef SG_WRITE
#undef SG_MMA
    LAS float* red = (LAS float*)(lds + 98304);
#pragma unroll
    for (int m = 0; m < 2; ++m) { const int rl = mblk * 64 + wr * 32 + m * 16 + fr; const size_t rg = (size_t)MLAT + rl;
        if (p.mode == 0) { const float ri = pg8::row_rinv(p.ssq, (int)rg);
#pragma unroll
            for (int n = 0; n < NTW; ++n) { const int col = ntile * UW + boff[n] + 4 * fq; if (col < PW) { const f32x4 v = acc[m][n] * ri + *(const f32x4*)(p.shw + col);
                u32x2 w; w.x = pk2(v[0], v[1]); w.y = pk2(v[2], v[3]); *(u32x2*)(p.O + rg * PW + col) = w; } }
        } else if (p.mode == 2) { if constexpr (NTW == 4) { const float ri = pg8::row_rinv(p.ssq, (int)rg);
#pragma unroll
            for (int n = 0; n < 2; ++n) { const int wcol = ntile * 256 + boff[n] + 4 * fq, hcol = ntile * 128 + wc * 32 + n * 16 + 4 * fq;
                const f32x4 a = acc[m][n] * ri + *(const f32x4*)(p.shw + wcol), b = acc[m][n + 2] * ri + *(const f32x4*)(p.shw + wcol + 128);
                u32x2 w; w.x = pk2(silu_f(a[0]) * b[0], silu_f(a[1]) * b[1]); w.y = pk2(silu_f(a[2]) * b[2], silu_f(a[3]) * b[3]); *(u32x2*)(p.O + rg * FF + hcol) = w; } }
        } else { float ss = 0.f;
#pragma unroll
            for (int n = 0; n < NTW; ++n) { const int col = ntile * UW + boff[n] + 4 * fq; const size_t ol = (size_t)rl * DM + col;
                const f32x4 x1 = *(const f32x4*)(p.src + ol) + *(const f32x4*)(p.gate + col) * p.gmul * acc[m][n];
                *(f32x4*)(p.dst + ol) = x1; ss += (x1[0] * x1[0] + x1[1] * x1[1]) + (x1[2] * x1[2] + x1[3] * x1[3]);
                if (p.XN) { const f32x4 xn = x1 * (*(const f32x4*)(p.g + col) * (*(const f32x4*)(p.sc + col) + 1.0f)); u32x2 w; w.x = pk2(xn[0], xn[1]); w.y = pk2(xn[2], xn[3]); *(u32x2*)(p.XN + rg * DM + col) = w; } }
            ss += __shfl_xor(ss, 16); ss += __shfl_xor(ss, 32);
            if (NTW == 4) { if (fq == 0) p.ssq_out[rg * 16 + ntile * 4 + wc] = ss; }
            else { if (fq == 0) red[wc * 64 + wr * 32 + m * 16 + fr] = ss; } }
    }
    if (NTW == 1 && p.mode == 1) { __syncthreads(); if (tid < 64) p.ssq_out[((size_t)MLAT + mblk * 64 + tid) * 16 + ntile] = (red[tid] + red[64 + tid]) + (red[128 + tid] + red[192 + tid]); }
}
template <int NTW>
__device__ __forceinline__ void sg_phase(Frame& F, const SgParams& p, int ntiles, int big_units) {
    const int first_free = big_units % F.G, nfree = F.G - first_free, c = (int)blockIdx.x;
    if (c < first_free) return;
    for (int u = c - first_free; u < 8 * ntiles; u += nfree) sg_unit<NTW>(F, p, u % 8, u / 8);
}

#ifndef USE_COOP
#define USE_COOP 1
#endif
#ifndef MK_N_LAUNCHES
#define MK_N_LAUNCHES 1
#endif
constexpr int N_PHASES = 17;
struct Args { const float* in[18]; float* out; unsigned char* ws; int ph_lo, ph_hi; };
__global__ void __launch_bounds__(NTHR, 2) hymba_fwd(Args args) {
    extern __shared__ __attribute__((aligned(16))) unsigned char lds_raw[];
    Frame F;
    F.lds = (LAS unsigned char*)lds_raw;
    F.tid = threadIdx.x; F.lane = F.tid & 63; F.wave = __builtin_amdgcn_readfirstlane(F.tid >> 6);
    F.prof = false; F.G = gridDim.x; { const int bx = blockIdx.x; F.vcu = (F.G % 8 == 0) ? (bx % 8) * (F.G / 8) + bx / 8 : bx; }
    F.x = args.in[0]; F.c = args.in[1]; F.ctx = args.in[2]; F.c_ctx = args.in[3]; F.w_ada = args.in[4]; F.b_ada = args.in[5]; F.g_mix = args.in[6]; F.w_in = args.in[7];
    F.dlogit = args.in[8]; F.ret_g = args.in[9]; F.w_four = args.in[10]; F.rpb = args.in[11]; F.w_out = args.in[12]; F.g_ffn = args.in[13]; F.w1 = args.in[14]; F.w3 = args.in[15];
    F.w2 = args.in[16]; F.g_final = args.in[17]; F.out = args.out; F.ws = args.ws;
    unsigned char* ws = args.ws;
    F.MOD = (float*)(ws + WS_MOD); F.SHWIN = (float*)(ws + WS_SHWIN); F.SHW13 = (float*)(ws + WS_SHW13); F.ROPE = (float*)(ws + WS_ROPE); F.LG = (float*)(ws + WS_LG); F.CT256 = (float*)(ws + WS_CT256);
    F.SSQ = (float*)(ws + WS_SSQ); F.XC = (float*)(ws + WS_XC); F.STATE = (bf16_t*)(ws + WS_STATE); F.ADAP = (float*)(ws + WS_PROJ); F.TW8 = (const float*)(ws + WS_TAB + T_TW8);
    F.XN = (bf16_t*)(ws + WS_XN); F.CAT = (bf16_t*)(ws + WS_CAT); F.PROJ = (bf16_t*)(ws + WS_PROJ); F.HID = (bf16_t*)(ws + WS_PROJ);
    F.WFT = (bf16_t*)(ws + WS_TAB + T_WFT); F.TWA = (bf16_t*)(ws + WS_TAB + T_TWA); F.TD2 = (bf16_t*)(ws + WS_TAB + T_TD2); F.TC256 = (bf16_t*)(ws + WS_TAB + T_TC); F.Y = (unsigned*)(ws + WS_XN);
    volatile LAS unsigned* MISC = (volatile LAS unsigned*)(F.lds + MISC_OFF);
    if (F.tid < 64) MISC[F.tid] = 0u;
    __syncthreads();
    const int lo = args.ph_lo, hi = args.ph_hi;
#if MK_N_LAUNCHES == 1
    XcdBarrier bar = xcd_barrier_post((unsigned*)(ws + WS_CTL) + CW_BAR, MISC + 8);
    cg::grid_group grid = cg::this_grid();
#define SEAM(k) do { if ((k) == 0 && USE_COOP) grid.sync(); else { _Pragma("unroll 1") for (int rep_ = 0; rep_ < (DUP_PHASE == 19 ? 5 : 1); ++rep_) xcd_barrier(bar); } } while (0)
#else
#define SEAM(k) do { } while (0)
#endif
#define IN(k) (lo <= (k) && (k) < hi)
#ifndef STAMP_SEL
#define STAMP_SEL -1
#endif
    unsigned long long* stamps = (unsigned long long*)(ws + WS_CTL + 61440);
#define STAMP(k) do { if (STAMP_SEL >= 0 && blockIdx.x == 0 && threadIdx.x == 0) stamps[k] = __builtin_amdgcn_s_memrealtime(); } while (0)
    STAMP(0);
    if (IN(0)) { _Pragma("unroll 1") for (int rep = 0; rep < (DUP_PHASE == 5 ? 2 : 1); ++rep) { __syncthreads(); phase_p0a(F); } if (IN(1)) SEAM(0); } STAMP(1);
    if (IN(1)) { _Pragma("unroll 1") for (int rep = 0; rep < (DUP_PHASE == 21 ? 2 : 1); ++rep) { __syncthreads(); phase_p0b(F); } if (IN(2)) SEAM(1); } STAMP(2);
#pragma unroll 1
    for (int layer = 0; layer < 2; ++layer) {
        const int pb = 2 + 7 * layer; const bool last = layer == 1;
        const float* mod = F.MOD + (size_t)layer * 3 * 6144;
        if (IN(pb + 0)) {
            pg8::Gemm g{F.XN, F.W(layer, W_WIN), MLAT, PWP, DM}; pg8::StaticOrder S; S.init(MLAT, PWP, F.G, (int)blockIdx.x);
            pg8::EpiProj E{F.PROJ, F.SSQ, F.SHWIN + (size_t)layer * 3 * PWP};
            _Pragma("unroll 1") for (int rep = 0; rep < (DUP_PHASE == 1 ? 2 : 1); ++rep) { __syncthreads(); pg8::gemm_phase<pg8::EpiProj, pg8::StaticOrder, true, true>(F.lds, g, S, E); }
            { SgParams sp{}; sp.A = F.XN + (size_t)MLAT * DM; sp.lda = DM; sp.Bt = F.W(layer, W_WIN); sp.K = DM; sp.mode = 0; sp.ssq = F.SSQ; sp.shw = F.SHWIN + (size_t)(layer * 3 + 2) * PWP; sp.O = F.PROJ;
              _Pragma("unroll 1") for (int rep = 0; rep < (DUP_PHASE == 12 ? 3 : 1); ++rep) sg_phase<1>(F, sp, 46, 768); }
            if (IN(pb + 1)) SEAM(pb);
        }
        STAMP(pb + 1);
        if (IN(pb + 1)) { _Pragma("unroll 1") for (int rep = 0; rep < (DUP_PHASE == 2 ? 2 : 1); ++rep) phase_m1(F, layer); if (IN(pb + 2)) SEAM(pb + 1); } STAMP(pb + 2);
        if (IN(pb + 2)) { phase_m2(F, layer); if (IN(pb + 3)) SEAM(pb + 2); } STAMP(pb + 3);
        if (IN(pb + 3)) { _Pragma("unroll 1") for (int rep = 0; rep < (DUP_PHASE == 3 ? 2 : 1); ++rep) phase_m3(F, layer); if (IN(pb + 4)) SEAM(pb + 3); } STAMP(pb + 4);
        const int Mrows = MLAT;
        if (IN(pb + 4)) {
            pg8::Gemm g{F.CAT, F.W(layer, W_WOUT), Mrows, DM, DM}; pg8::StaticOrder S; S.init(Mrows, DM, F.G, (int)blockIdx.x);
            pg8::EpiRes E{last ? F.out : F.x, last ? F.XC : F.ctx, F.out, F.XC, F.XN, F.SSQ, mod + 2048, mod + 4096, F.g_ffn + layer * DM, 1.0f};
            _Pragma("unroll 1") for (int rep = 0; rep < (DUP_PHASE == 16 ? 2 : 1); ++rep) { E.gmul = (DUP_PHASE == 16 && rep == 0) ? 0.0f : 1.0f; if (DUP_PHASE == 16 && rep == 0) { E.src_lat = F.out; } else { E.src_lat = last ? F.out : F.x; } __syncthreads(); pg8::gemm_phase<pg8::EpiRes, pg8::StaticOrder, true, true>(F.lds, g, S, E); }
            if (!last) { SgParams sp{}; sp.A = F.CAT + (size_t)MLAT * DM; sp.lda = DM; sp.Bt = F.W(layer, W_WOUT); sp.K = DM; sp.mode = 1; sp.src = F.ctx; sp.dst = F.XC; sp.XN = F.XN; sp.ssq_out = F.SSQ;
              sp.gate = mod + 2048 + 2 * 6144; sp.sc = mod + 4096 + 2 * 6144; sp.g = F.g_ffn + layer * DM; sp.gmul = 1.0f; _Pragma("unroll 1") for (int rep = 0; rep < (DUP_PHASE == 13 ? 3 : 1); ++rep) sg_phase<1>(F, sp, 16, 256); }
            if (IN(pb + 5)) SEAM(pb + 4);
        }
        STAMP(pb + 5);
        if (IN(pb + 5)) {
            pg8::Gemm g{F.XN, F.W(layer, W_W13), Mrows, FF2, DM}; pg8::StaticOrder S; S.init(Mrows, FF2, F.G, (int)blockIdx.x);
            pg8::EpiSwiGLU E{F.HID, F.SSQ, F.SHW13 + (size_t)layer * 3 * FF2};
            _Pragma("unroll 1") for (int rep = 0; rep < (DUP_PHASE == 4 ? 2 : 1); ++rep) { __syncthreads(); pg8::gemm_phase<pg8::EpiSwiGLU, pg8::StaticOrder, true, true>(F.lds, g, S, E); }
            if (!last) { SgParams sp{}; sp.A = F.XN + (size_t)MLAT * DM; sp.lda = DM; sp.Bt = F.W(layer, W_W13); sp.K = DM; sp.mode = 2; sp.ssq = F.SSQ; sp.shw = F.SHW13 + (size_t)(layer * 3 + 2) * FF2; sp.O = F.HID;
              _Pragma("unroll 1") for (int rep = 0; rep < (DUP_PHASE == 14 ? 3 : 1); ++rep) sg_phase<4>(F, sp, 22, 1408); }
            if (IN(pb + 6)) SEAM(pb + 5);
        }
        STAMP(pb + 6);
        if (IN(pb + 6)) {
            pg8::Gemm g{F.HID, F.W(layer, W_W2), Mrows, DM, FF}; pg8::StaticOrder S; S.init(Mrows, DM, F.G, (int)blockIdx.x);
            pg8::EpiRes E{F.out, F.XC, F.out, F.XC, last ? nullptr : F.XN, F.SSQ, mod + 5120, F.MOD + 3 * 6144 + 1024, F.g_mix + DM, 1.0f};
            _Pragma("unroll 1") for (int rep = 0; rep < (DUP_PHASE == 17 ? 2 : 1); ++rep) { E.gmul = (DUP_PHASE == 17 && rep == 0) ? 0.0f : 1.0f; __syncthreads(); pg8::gemm_phase<pg8::EpiRes, pg8::StaticOrder, true, true>(F.lds, g, S, E); }
            if (!last) { SgParams sp{}; sp.A = F.HID + (size_t)MLAT * FF; sp.lda = FF; sp.Bt = F.W(layer, W_W2); sp.K = FF; sp.mode = 1; sp.src = F.XC; sp.dst = F.XC; sp.XN = F.XN; sp.ssq_out = F.SSQ;
              sp.gate = mod + 5120 + 2 * 6144; sp.sc = F.MOD + 3 * 6144 + 1024 + 2 * 6144; sp.g = F.g_mix + DM; _Pragma("unroll 1") for (int rep = 0; rep < (DUP_PHASE == 15 ? 3 : 1); ++rep) { sp.gmul = (DUP_PHASE == 15 && rep < 2) ? 0.0f : 1.0f; sg_phase<1>(F, sp, 16, 256); } }
            if (IN(pb + 7)) SEAM(pb + 6);
        }
        STAMP(pb + 7);
    }
    float delta = 0.f;
    if (STAMP_SEL >= 0) { const unsigned long long t0 = stamps[STAMP_SEL], t1 = stamps[STAMP_SEL + 1]; delta = sqrtf(1e-7f * 0.01f * (float)(t1 - t0)); }
    if (PROF_A >= 0) { const unsigned long long* us = (const unsigned long long*)(ws + WS_CTL + 61440 + 512); delta = sqrtf(1e-6f * 0.01f * (float)(us[PROF_A + 1] - us[PROF_A])); }
    if (PROF_B >= 0 && blockIdx.x == 0 && threadIdx.x == 0) { const unsigned long long* us = (const unsigned long long*)(ws + WS_CTL + 61440 + 512); const unsigned long long d = (us[PROF_B + 1] - us[PROF_B]) * 20ull, t0 = __builtin_amdgcn_s_memrealtime(); while (__builtin_amdgcn_s_memrealtime() - t0 < d) __builtin_amdgcn_s_sleep(8); }
    if (IN(16)) { if (DUP_PHASE == 23) phase_final(F, true); phase_final(F, false, delta); }
#undef IN
#undef SEAM
}

extern "C" void kernel_launch(void* const* d_in, const int* in_sizes, int n_in, void* d_out, int out_size, void* d_ws, size_t ws_size, hipStream_t stream) {
    static int grid = 0;
    if (grid == 0) {
        if (n_in != 18 || in_sizes[0] != MLAT * DM || out_size != MLAT * DM || ws_size < WS_END) {
            fprintf(stderr, "kernel_launch: built for 18 inputs, x/out of %d floats, >= %zu bytes of workspace; got n_in %d, in0 %d, out %d, ws %zu\n", MLAT * DM, (size_t)WS_END, n_in, n_in > 0 ? in_sizes[0] : -1, out_size, ws_size); grid = -1; return; }
        int dev = 0, cus = 0, per_cu = 0;
        if (hipGetDevice(&dev) != hipSuccess || hipDeviceGetAttribute(&cus, hipDeviceAttributeMultiprocessorCount, dev) != hipSuccess) { fprintf(stderr, "kernel_launch: device query failed\n"); grid = -1; return; }
        if (hipFuncSetAttribute((const void*)hymba_fwd, hipFuncAttributeMaxDynamicSharedMemorySize, LDS_BYTES) != hipSuccess) { fprintf(stderr, "kernel_launch: hipFuncSetAttribute failed\n"); grid = -1; return; }
        if (hipOccupancyMaxActiveBlocksPerMultiprocessor(&per_cu, (const void*)hymba_fwd, NTHR, LDS_BYTES) != hipSuccess || per_cu < 1) { fprintf(stderr, "kernel_launch: occupancy query says %d blocks per CU\n", per_cu); (void)hipGetLastError(); grid = -1; return; }
        grid = cus;
        fprintf(stderr, "kernel_launch: grid %d (cus %d, occupancy %d/CU), ws %zu\n", grid, cus, per_cu, ws_size);
    }
    if (grid < 0) return;
    if (hipMemsetAsync((char*)d_ws + WS_CTL, 0, CTL_ZERO_BYTES, stream) != hipSuccess) { fprintf(stderr, "kernel_launch: memset failed\n"); return; }
    Args a{};
    for (int i = 0; i < 18; ++i) a.in[i] = (const float*)d_in[i];
    a.out = (float*)d_out; a.ws = (unsigned char*)d_ws;
#if MK_N_LAUNCHES == 1
    a.ph_lo = 0; a.ph_hi = N_PHASES;
    void* kargs[] = {&a};
    if (DUP_PHASE == 30) { (void)hipLaunchCooperativeKernel((const void*)hymba_fwd, dim3(grid), dim3(NTHR), kargs, LDS_BYTES, stream); (void)hipMemsetAsync((char*)d_ws + WS_CTL, 0, CTL_ZERO_BYTES, stream); }
    hipError_t le = hipSuccess;
    if (USE_COOP) le = hipLaunchCooperativeKernel((const void*)hymba_fwd, dim3(grid), dim3(NTHR), kargs, LDS_BYTES, stream);
    else { hipLaunchKernelGGL(hymba_fwd, dim3(grid), dim3(NTHR), LDS_BYTES, stream, a); le = hipPeekAtLastError(); }
    if (le != hipSuccess) fprintf(stderr, "kernel_launch: cooperative launch failed: %s (grid %d)\n", hipGetErrorString(le), grid);
#else
    for (int p = 0; p < N_PHASES; ++p) { a.ph_lo = p; a.ph_hi = p + 1; hipLaunchKernelGGL(hymba_fwd, dim3(grid), dim3(NTHR), LDS_BYTES, stream, a); }
#endif
}
```

```cpp
#include <hip/hip_runtime.h>
#include <hip/hip_cooperative_groups.h>
#include <cstdio>
#include <cstdint>
namespace cg = cooperative_groups;

#define LAS __attribute__((address_space(3)))
#define GAS __attribute__((address_space(1)))
typedef unsigned short bf16_t;
typedef short bf16x8 __attribute__((ext_vector_type(8)));
typedef short bf16x4 __attribute__((ext_vector_type(4)));
typedef float f32x4 __attribute__((ext_vector_type(4)));
typedef float f32x2 __attribute__((ext_vector_type(2)));
typedef unsigned u32x4 __attribute__((ext_vector_type(4)));
typedef unsigned u32x2 __attribute__((ext_vector_type(2)));

typedef __bf16 hwbf16x2 __attribute__((ext_vector_type(2)));
__device__ __forceinline__ unsigned pk2(float lo, float hi) { const f32x2 v = {lo, hi}; return __builtin_bit_cast(unsigned, __builtin_convertvector(v, hwbf16x2)); }
__device__ __forceinline__ unsigned f2bf(float f) { return pk2(f, f) & 0xffffu; }
__device__ __forceinline__ float bf2f(unsigned h) { return __builtin_bit_cast(float, h << 16); }
__device__ __forceinline__ float bflo(unsigned w) { return __builtin_bit_cast(float, w << 16); }
__device__ __forceinline__ float bfhi(unsigned w) { return __builtin_bit_cast(float, w & 0xffff0000u); }
__device__ __forceinline__ float silu_f(float a) { return a * __builtin_amdgcn_rcpf(1.0f + __expf(-a)); }

constexpr int NB = 2, SEQ = 8192, DM = 1024, CTXL = 256, MLAT = NB * SEQ, MCTX = NB * CTXL, MTOT = MLAT + MCTX;
constexpr int PW = 2944, PWP = 3072, FF = 2816, FF2 = 5632;
constexpr int C_RQ = 256, C_RK = 640, C_RV = 1024, C_RG = 1408, C_NQ = 1792, C_NK = 2176, C_NV = 2560;
constexpr float NORM_EPS = 1e-6f;

namespace pg8 {
#define PG8_LAS __attribute__((address_space(3)))
constexpr int BM = 256, BK = 64, HALF = 128, HTB = HALF * BK * 2, STAGE_BYTES = 8 * HTB, NXCD = 8, WGM = 8;
__host__ __device__ __forceinline__ int lds_byte(int r, int c) { const int st = (r >> 4) * 2 + (c >> 5), rr = r & 15, cc = c & 31, ob = rr * 64 + cc * 2; return st * 1024 + (ob ^ (((ob >> 9) & 1) << 5)); }
__host__ __device__ __forceinline__ void stage_rc(int b, int& R, int& C) { const int st = b / 1024, sb = b % 1024, swz = sb ^ (((sb >> 9) & 1) << 5); R = (st >> 1) * 16 + swz / 64; C = (st & 1) * 32 + (swz % 64) / 2; }
__host__ __device__ __forceinline__ int perm32(int rho) { const int n = rho >> 4, i = rho & 15; return 8 * (i >> 2) + 4 * n + (i & 3); }
struct Unit { int pm, pn; };
struct Gemm { const bf16_t* A; const bf16_t* Bt; int M, N, K; };
struct StaticOrder {
    int nM, nN, nwg, G, c;
    __host__ __device__ void init(int M, int N, int G_, int c_) { nM = M / BM; nN = N / BM; nwg = nM * nN; G = G_; c = c_; }
    __host__ __device__ bool next(int i, Unit& u) const {
        const long L = (long)i * G + c; if (L >= nwg) return false;
        int wgid = (int)L; { const int q = nwg / NXCD, r = nwg % NXCD, xcd = wgid % NXCD, off = wgid / NXCD; wgid = (xcd < r ? xcd * (q + 1) : r * (q + 1) + (xcd - r) * q) + off; }
        const int nig = WGM * nN, gid = wgid / nig, fm = gid * WGM, gsz = (nM - fm) < WGM ? (nM - fm) : WGM;
        u.pm = fm + ((wgid % nig) % gsz); u.pn = (wgid % nig) / gsz; return true;
    }
    __device__ __forceinline__ void a_ready(const Unit&) const {}
    __device__ __forceinline__ void done(const Unit&) const {}
};
__device__ __forceinline__ unsigned cvt_pk_bf16(float lo, float hi) { unsigned r; asm volatile("v_cvt_pk_bf16_f32 %0, %1, %2" : "=v"(r) : "v"(lo), "v"(hi)); return r; }

__device__ __forceinline__ float row_rinv(const float* ssq, int row) {
    const f32x4* p = (const f32x4*)(ssq + (size_t)row * 16);
    const f32x4 a = p[0], b = p[1], c = p[2], d = p[3];
    const float s = (((a[0] + a[1]) + (a[2] + a[3])) + ((b[0] + b[1]) + (b[2] + b[3]))) + (((c[0] + c[1]) + (c[2] + c[3])) + ((d[0] + d[1]) + (d[2] + d[3])));
    return rsqrtf(s * (1.0f / 1024.0f) + NORM_EPS);
}
__device__ __forceinline__ int row_set(int pm) { return pm < 32 ? 0 : (pm < 64 ? 1 : 2); }

struct EpiProj {
    static constexpr bool PERM = true, AFTER_DRAIN = false;
    bf16_t* O; const float* ssq; const float* shw;
    __device__ __forceinline__ void operator()(const f32x4 (&acc)[2][2][4][2], const Unit& u, int wr, int wc, int fr, int fq) const {
        const int row0 = u.pm * BM + wr * 64 + fr, col0 = u.pn * BM + wc * 32 + 8 * fq; const int set = row_set(u.pm);
        f32x4 bv[2][2];
#pragma unroll
        for (int bj = 0; bj < 2; ++bj)
#pragma unroll
            for (int n = 0; n < 2; ++n) bv[bj][n] = *(const f32x4*)(shw + set * PWP + col0 + bj * HALF + 4 * n);
#pragma unroll
        for (int ai = 0; ai < 2; ++ai)
#pragma unroll
            for (int m = 0; m < 4; ++m) { const int r = row0 + ai * HALF + m * 16; const float ri = row_rinv(ssq, r); bf16_t* rowp = O + (size_t)r * PW + col0;
#pragma unroll
                for (int bj = 0; bj < 2; ++bj) { if (col0 + bj * HALF < PW) { const f32x4 v0 = acc[ai][bj][m][0] * ri + bv[bj][0], v1 = acc[ai][bj][m][1] * ri + bv[bj][1];
                    u32x4 w; w.x = cvt_pk_bf16(v0[0], v0[1]); w.y = cvt_pk_bf16(v0[2], v0[3]); w.z = cvt_pk_bf16(v1[0], v1[1]); w.w = cvt_pk_bf16(v1[2], v1[3]);
                    *(u32x4*)(rowp + bj * HALF) = w; } } }
    }
};
struct EpiSwiGLU {
    static constexpr bool PERM = true, AFTER_DRAIN = false;
    bf16_t* O; const float* ssq; const float* shw;
    __device__ __forceinline__ void operator()(const f32x4 (&acc)[2][2][4][2], const Unit& u, int wr, int wc, int fr, int fq) const {
        const int row0 = u.pm * BM + wr * 64 + fr, col0 = u.pn * BM + wc * 32 + 8 * fq, ocol = u.pn * HALF + wc * 32 + 8 * fq; const int set = row_set(u.pm);
        f32x4 ba[2], bb[2];
#pragma unroll
        for (int n = 0; n < 2; ++n) { ba[n] = *(const f32x4*)(shw + set * FF2 + col0 + 4 * n); bb[n] = *(const f32x4*)(shw + set * FF2 + col0 + HALF + 4 * n); }
#pragma unroll
        for (int ai = 0; ai < 2; ++ai)
#pragma unroll
            for (int m = 0; m < 4; ++m) { const int r = row0 + ai * HALF + m * 16; const float ri = row_rinv(ssq, r);
                float hv[8];
#pragma unroll
                for (int n = 0; n < 2; ++n) { const f32x4 a = acc[ai][0][m][n] * ri + ba[n], b = acc[ai][1][m][n] * ri + bb[n];
#pragma unroll
                    for (int e = 0; e < 4; ++e) hv[4 * n + e] = silu_f(a[e]) * b[e]; }
                u32x4 w; w.x = cvt_pk_bf16(hv[0], hv[1]); w.y = cvt_pk_bf16(hv[2], hv[3]); w.z = cvt_pk_bf16(hv[4], hv[5]); w.w = cvt_pk_bf16(hv[6], hv[7]);
                *(u32x4*)(O + (size_t)r * FF + ocol) = w; }
    }
};
struct EpiRes {
    static constexpr bool PERM = false, AFTER_DRAIN = false;
    const float* src_lat; const float* src_ctx; float* dst_lat; float* dst_ctx; bf16_t* XN; float* ssq; const float* gate; const float* sc; const float* g; float gmul;
    __device__ __forceinline__ void operator()(const f32x4 (&acc)[2][2][4][2], const Unit& u, int wr, int wc, int fr, int fq) const {
        const bool lat = u.pm < 64; const int set = row_set(u.pm);
        const int rg0 = u.pm * BM + wr * 64 + fr, rl0 = (lat ? u.pm : u.pm - 64) * BM + wr * 64 + fr;
        const float* src = lat ? src_lat : src_ctx; float* dst = lat ? dst_lat : dst_ctx;
        const int col0 = u.pn * BM + wc * 32 + 4 * fq;
        float ss[2][4];
#pragma unroll
        for (int ai = 0; ai < 2; ++ai)
#pragma unroll
            for (int m = 0; m < 4; ++m) ss[ai][m] = 0.f;
#pragma unroll
        for (int bj = 0; bj < 2; ++bj)
#pragma unroll
            for (int n = 0; n < 2; ++n) { const int c = col0 + bj * HALF + n * 16;
                const f32x4 ga = *(const f32x4*)(gate + set * 6144 + c) * gmul; f32x4 gs = {0.f, 0.f, 0.f, 0.f};
                if (XN) { const f32x4 s4 = *(const f32x4*)(sc + set * 6144 + c), g4 = *(const f32x4*)(g + c); gs = g4 * (s4 + 1.0f); }
#pragma unroll
                for (int ai = 0; ai < 2; ++ai)
#pragma unroll
                    for (int m = 0; m < 4; ++m) { const size_t ol = (size_t)(rl0 + ai * HALF + m * 16) * DM + c, og = (size_t)(rg0 + ai * HALF + m * 16) * DM + c;
                        const f32x4 x1 = *(const f32x4*)(src + ol) + ga * acc[ai][bj][m][n];
                        *(f32x4*)(dst + ol) = x1; ss[ai][m] += (x1[0] * x1[0] + x1[1] * x1[1]) + (x1[2] * x1[2] + x1[3] * x1[3]);
                        if (XN) { const f32x4 xn = x1 * gs; u32x2 w; w.x = cvt_pk_bf16(xn[0], xn[1]); w.y = cvt_pk_bf16(xn[2], xn[3]); *(u32x2*)(XN + og) = w; } } }
#pragma unroll
        for (int ai = 0; ai < 2; ++ai)
#pragma unroll
            for (int m = 0; m < 4; ++m) { float s = ss[ai][m]; s += __shfl_xor(s, 16); s += __shfl_xor(s, 32);
                if (fq == 0) ssq[(size_t)(rg0 + ai * HALF + m * 16) * 16 + u.pn * 4 + wc] = s; }
    }
};
template <class Epi, class Sched, bool ALIGN_EPI = false, bool SP2 = false>
__device__ __forceinline__ void gemm_phase(PG8_LAS unsigned char* lds, const Gemm g, const Sched& S, const Epi& E) {
    int tid_ = threadIdx.x; asm volatile("" : "+v"(tid_));
    const int tid = tid_, wid = __builtin_amdgcn_readfirstlane(tid >> 6), lane = tid & 63, wr = wid >> 2, wc = wid & 3, fr = lane & 15, fq = lane >> 4;
    const int K = g.K, nt = K / BK;
    unsigned voffA[2], voffB[2];
#pragma unroll
    for (int i = 0; i < 2; ++i) { int R, C; stage_rc(tid * 16 + i * 8192, R, C); const int Rb = Epi::PERM ? ((R & ~31) + perm32(R & 31)) : R;
        voffA[i] = (unsigned)(R * K + C) * 2u; voffB[i] = (unsigned)(Rb * K + C) * 2u; }
    const size_t kstep = (size_t)(BK * 2);
    const size_t hstep = (size_t)HALF * K * 2;
    const size_t tstep = 2 * hstep;
    const unsigned ldsw = (unsigned)wid * 1024u;
    const int aoff = lds_byte(wr * 64 + fr, fq * 8), boff = lds_byte(wc * 32 + fr, fq * 8);
#define PG8_SA(b, h) (((b) * 2 + (h)) * HTB)
#define PG8_SB(b, h) ((4 + (b) * 2 + (h)) * HTB)
#define PG8_STAGE(bufoff, gbase, voff) do { _Pragma("unroll") for (int _i = 0; _i < 2; ++_i) \
        __builtin_amdgcn_global_load_lds((const unsigned*)((const char*)(gbase) + (voff)[_i]), (PG8_LAS unsigned*)(lds + (bufoff) + ldsw + _i * 8192), 16, 0, 0); } while (0)
#define PG8_LDA(dst, b, h) do { _Pragma("unroll") for (int m = 0; m < 4; ++m) _Pragma("unroll") for (int k = 0; k < 2; ++k) dst[m][k] = *(const PG8_LAS bf16x8*)(lds + PG8_SA(b, h) + aoff + m * 2048 + k * 1024); } while (0)
#define PG8_LDB(dst, b, h) do { _Pragma("unroll") for (int n = 0; n < 2; ++n) _Pragma("unroll") for (int k = 0; k < 2; ++k) dst[n][k] = *(const PG8_LAS bf16x8*)(lds + PG8_SB(b, h) + boff + n * 2048 + k * 1024); } while (0)
#define PG8_MMA(ai, bj, At, Bt) do { __builtin_amdgcn_s_setprio(1); _Pragma("unroll") for (int m = 0; m < 4; ++m) _Pragma("unroll") for (int n = 0; n < 2; ++n) _Pragma("unroll") for (int k = 0; k < 2; ++k) \
        acc[ai][bj][m][n] = __builtin_amdgcn_mfma_f32_16x16x32_bf16(Bt[n][k], At[m][k], acc[ai][bj][m][n], 0, 0, 0); __builtin_amdgcn_s_setprio(0); } while (0)
#define PG8_WAIT_V(n) asm volatile("s_waitcnt vmcnt(" #n ")" ::: "memory")
#define PG8_WAIT_L(n) asm volatile("s_waitcnt lgkmcnt(" #n ")" ::: "memory")
#define PG8_BAR __builtin_amdgcn_s_barrier()
#define PG8_SCHED __builtin_amdgcn_sched_barrier(0)
    Unit cur, nxt; int ui = 0;
    if (!S.next(0, cur)) return;
    f32x4 acc[2][2][4][2];
#pragma unroll
    for (int a = 0; a < 2; ++a)
#pragma unroll
        for (int b = 0; b < 2; ++b)
#pragma unroll
            for (int m = 0; m < 4; ++m)
#pragma unroll
                for (int n = 0; n < 2; ++n) acc[a][b][m][n] = (f32x4){0.f, 0.f, 0.f, 0.f};
    bf16x8 At[4][2], B0[2][2], B1[2][2];
    const char* cA = (const char*)g.A + (size_t)cur.pm * tstep; const char* cB = (const char*)g.Bt + (size_t)cur.pn * tstep;
    S.a_ready(cur);
    if constexpr (SP2) {
        PG8_STAGE(PG8_SB(0, 0), cB, voffB); PG8_STAGE(PG8_SB(0, 1), cB + hstep, voffB); PG8_STAGE(PG8_SA(0, 0), cA, voffA); PG8_STAGE(PG8_SA(0, 1), cA + hstep, voffA);
        if (wr == 1) PG8_BAR;
        PG8_WAIT_V(2); PG8_BAR;
        PG8_STAGE(PG8_SB(1, 0), cB + kstep, voffB); PG8_STAGE(PG8_SA(1, 0), cA + kstep, voffA); PG8_STAGE(PG8_SB(1, 1), cB + hstep + kstep, voffB);
        PG8_WAIT_V(6); PG8_BAR;
    } else {
        PG8_STAGE(PG8_SB(0, 0), cB, voffB); PG8_STAGE(PG8_SA(0, 0), cA, voffA); PG8_STAGE(PG8_SB(0, 1), cB + hstep, voffB); PG8_STAGE(PG8_SA(0, 1), cA + hstep, voffA);
        if (wr == 1) PG8_BAR;
        PG8_WAIT_V(4); PG8_BAR;
        PG8_STAGE(PG8_SB(1, 0), cB + kstep, voffB); PG8_STAGE(PG8_SA(1, 0), cA + kstep, voffA); PG8_STAGE(PG8_SB(1, 1), cB + hstep + kstep, voffB);
        PG8_WAIT_V(6); PG8_BAR;
    }
    for (;;) {
        const bool has_next = S.next(ui + 1, nxt);
        const char* nA = has_next ? (const char*)g.A + (size_t)nxt.pm * tstep : cA; const char* nB = has_next ? (const char*)g.Bt + (size_t)nxt.pn * tstep : cB;
        for (int t = 0; t < nt; t += 2) {
            const bool last = (t == nt - 2);
            const char* a1 = cA + (size_t)(t + 1) * kstep;
            const char* a2 = last ? nA : cA + (size_t)(t + 2) * kstep; const char* b2 = last ? nB : cB + (size_t)(t + 2) * kstep;
            const char* a3 = a2 + kstep; const char* b3 = b2 + kstep;
            if (last && has_next) S.a_ready(nxt);
            if constexpr (SP2) {
            PG8_LDB(B0, 0, 0); PG8_LDB(B1, 0, 1); PG8_SCHED; PG8_LDA(At, 0, 0); PG8_STAGE(PG8_SA(1, 1), a1 + hstep, voffA);
            PG8_WAIT_V(8); PG8_WAIT_L(0); PG8_BAR; PG8_MMA(0, 0, At, B0); PG8_MMA(0, 1, At, B1); PG8_BAR; PG8_SCHED;
            PG8_LDA(At, 0, 1); PG8_STAGE(PG8_SB(0, 0), b2, voffB); PG8_STAGE(PG8_SB(0, 1), b2 + hstep, voffB); PG8_STAGE(PG8_SA(0, 0), a2, voffA);
            PG8_WAIT_V(8); PG8_WAIT_L(0); PG8_BAR; PG8_MMA(1, 0, At, B0); PG8_MMA(1, 1, At, B1); PG8_BAR; PG8_SCHED;
            PG8_LDB(B0, 1, 0); PG8_LDB(B1, 1, 1); PG8_SCHED; PG8_LDA(At, 1, 0); PG8_STAGE(PG8_SA(0, 1), a2 + hstep, voffA);
            PG8_WAIT_V(8); PG8_WAIT_L(0); PG8_BAR; PG8_MMA(0, 0, At, B0); PG8_MMA(0, 1, At, B1); PG8_BAR; PG8_SCHED;
            PG8_LDA(At, 1, 1); PG8_STAGE(PG8_SB(1, 0), b3, voffB); PG8_STAGE(PG8_SB(1, 1), b3 + hstep, voffB); PG8_STAGE(PG8_SA(1, 0), a3, voffA);
            PG8_WAIT_V(8); PG8_WAIT_L(0); PG8_BAR; PG8_MMA(1, 0, At, B0); PG8_MMA(1, 1, At, B1); PG8_BAR; PG8_SCHED;
            } else {
            PG8_LDB(B0, 0, 0); PG8_SCHED; PG8_LDA(At, 0, 0); PG8_STAGE(PG8_SA(1, 1), a1 + hstep, voffA);
            PG8_WAIT_L(8); PG8_BAR; PG8_WAIT_L(0); PG8_MMA(0, 0, At, B0); PG8_BAR; PG8_SCHED;
            PG8_LDB(B1, 0, 1); PG8_STAGE(PG8_SB(0, 0), b2, voffB);
            PG8_BAR; PG8_WAIT_L(0); PG8_MMA(0, 1, At, B1); PG8_BAR;
            PG8_LDA(At, 0, 1); PG8_STAGE(PG8_SA(0, 0), a2, voffA);
            PG8_BAR; PG8_WAIT_L(0); PG8_MMA(1, 0, At, B0); PG8_BAR; PG8_SCHED;
            PG8_STAGE(PG8_SB(0, 1), b2 + hstep, voffB);
            PG8_WAIT_V(6); PG8_BAR; PG8_MMA(1, 1, At, B1); PG8_BAR;
            PG8_LDB(B0, 1, 0); PG8_SCHED; PG8_LDA(At, 1, 0); PG8_STAGE(PG8_SA(0, 1), a2 + hstep, voffA);
            PG8_WAIT_L(8); PG8_BAR; PG8_WAIT_L(0); PG8_MMA(0, 0, At, B0); PG8_BAR; PG8_SCHED;
            PG8_LDB(B1, 1, 1); PG8_STAGE(PG8_SB(1, 0), b3, voffB);
            PG8_BAR; PG8_WAIT_L(0); PG8_MMA(0, 1, At, B1); PG8_BAR;
            PG8_LDA(At, 1, 1); PG8_STAGE(PG8_SA(1, 0), a3, voffA);
            PG8_BAR; PG8_WAIT_L(0); PG8_MMA(1, 0, At, B0); PG8_BAR; PG8_SCHED;
            PG8_STAGE(PG8_SB(1, 1), b3 + hstep, voffB);
            PG8_WAIT_V(6); PG8_BAR; PG8_MMA(1, 1, At, B1); PG8_BAR;
            }
        }
        if constexpr (ALIGN_EPI) { if (wr == 0) PG8_BAR; }
        if constexpr (!Epi::AFTER_DRAIN) { E(acc, cur, wr, wc, fr, fq); S.done(cur); }
        if (!has_next) break;
#pragma unroll
        for (int a = 0; a < 2; ++a)
#pragma unroll
            for (int b = 0; b < 2; ++b)
#pragma unroll
                for (int m = 0; m < 4; ++m)
#pragma unroll
                    for (int n = 0; n < 2; ++n) acc[a][b][m][n] = (f32x4){0.f, 0.f, 0.f, 0.f};
        cur = nxt; cA = nA; cB = nB; ++ui;
        if constexpr (ALIGN_EPI) { if (wr == 1) PG8_BAR; }
    }
    PG8_WAIT_V(0);
    if constexpr (!ALIGN_EPI) { if (wr == 0) PG8_BAR; }
    PG8_BAR;
    if constexpr (Epi::AFTER_DRAIN) { E.fused(acc, cur, wr, wc, fr, fq, lds, wid, lane); S.done(cur); }
#undef PG8_SA
#undef PG8_SB
#undef PG8_STAGE
#undef PG8_LDA
#undef PG8_LDB
#undef PG8_MMA
#undef PG8_WAIT_V
#undef PG8_WAIT_L
#undef PG8_BAR
#undef PG8_SCHED
}
}

constexpr int NWAVES = 8, NTHR = 512;
constexpr size_t MiB = 1u << 20;
constexpr size_t WS_CTL = 0, CTL_ZERO_BYTES = 64 * 1024;
constexpr size_t WS_MOD = 1 * MiB;
constexpr size_t WS_SHWIN = WS_MOD + 2 * 3 * 6144 * 4;
constexpr size_t WS_SHW13 = WS_SHWIN + 2 * 3 * PWP * 4;
constexpr size_t WS_ROPE = WS_SHW13 + 2 * 3 * FF2 * 4;
constexpr size_t WS_LG = WS_ROPE + (128 + 64) * 24 * 2 * 4;
constexpr size_t WS_CT256 = WS_LG + 256;
constexpr size_t WS_SSQ = 2 * MiB;
constexpr size_t WS_XC = 4 * MiB;
constexpr size_t WS_W = 6 * MiB;
constexpr size_t W_WIN = 0, W_WOUT = (size_t)PWP * DM * 2, W_W13 = W_WOUT + (size_t)DM * DM * 2, W_W2 = W_W13 + (size_t)FF2 * DM * 2, W_LAYER = W_W2 + (size_t)DM * FF * 2;
static_assert(W_LAYER * 2 == 49 * MiB, "weight region");
constexpr size_t WS_TAB = 55 * MiB;
constexpr size_t T_WFT = 0, T_TWA = 2 * 256 * 256 * 2, T_TD2 = T_TWA + 256 * 256 * 2, T_TW8 = T_TD2 + 64 * 128 * 2, T_TC = T_TW8 + 65536;
constexpr size_t WS_XN = 56 * MiB;
constexpr size_t WS_CAT = 89 * MiB;
constexpr size_t WS_PROJ = 122 * MiB;
constexpr size_t WS_STATE = 217 * MiB;
constexpr size_t WS_END = WS_STATE + (size_t)16 * 66 * 9216 * 2;
static_assert(WS_END <= 256 * MiB && WS_PROJ + (size_t)MTOT * PW * 2 <= WS_STATE && WS_CAT + (size_t)MTOT * DM * 2 <= WS_PROJ && WS_XN + (size_t)MTOT * DM * 2 <= WS_CAT, "d_ws map");
static_assert(WS_CT256 + 2048 <= WS_SSQ && WS_SSQ + (size_t)MTOT * 64 <= WS_XC && WS_TAB + T_TC + 262144 <= WS_XN, "d_ws map (small)");
constexpr int CW_BAR = 1024;
constexpr int LDS_BYTES = 163840, MISC_OFF = LDS_BYTES - 256;

#define RLX_AGENT __ATOMIC_RELAXED, __HIP_MEMORY_SCOPE_AGENT
#define XB_TMO      128
#define XB_XCNT(j)  (256  + 64 * (j))
#define XB_XSUB(j)  (1280 + 64 * (j))
#define XB_XGEN(j)  (2304 + 64 * (j))
#define XB_TOP      3328
#define XB_TOPGEN   3392
#define XCD_BAR_WORDS 3456
#define XB_SPIN_CAP (1u << 18)
static_assert((CW_BAR + XCD_BAR_WORDS) * 4 <= (int)CTL_ZERO_BYTES, "barrier words inside the memset region");
__device__ __forceinline__ unsigned xb_ld(unsigned* p)              { return __hip_atomic_load(p, __ATOMIC_RELAXED, __HIP_MEMORY_SCOPE_AGENT); }
__device__ __forceinline__ unsigned xb_add(unsigned* p, unsigned v) { return __hip_atomic_fetch_add(p, v, __ATOMIC_RELAXED, __HIP_MEMORY_SCOPE_AGENT); }
__device__ __forceinline__ unsigned xb_xcc_id() { return (unsigned)__builtin_amdgcn_s_getreg((3 << 11) | 20) & 0xFu; }
#define XB_SPIN(cond, bar) do { unsigned _sp = 0; while (cond) { __builtin_amdgcn_s_sleep(1); \
    if ((++_sp & 255u) == 0u) { if (xb_ld(&(bar)[XB_TMO])) break; if (_sp > XB_SPIN_CAP) { atomicAdd(&(bar)[XB_TMO], 1u); break; } } } } while (0)
struct XcdBarrier { unsigned* bar; unsigned x; volatile LAS unsigned* st; };
__device__ __forceinline__ XcdBarrier xcd_barrier_post(unsigned* bar, volatile LAS unsigned* st) {
    XcdBarrier b; b.bar = bar; b.x = xb_xcc_id(); b.st = st;
    if (threadIdx.x == 0) (void)xb_add(&bar[XB_XCNT(b.x)], 1u);
    return b;
}
__device__ __forceinline__ void xcd_barrier_complete(unsigned* bar, unsigned x, unsigned& nloc, unsigned& nx) {
    const unsigned G = gridDim.x * gridDim.y * gridDim.z;
    unsigned sum, cnt, mine, sp = 0u;
    for (;;) {
        sum = 0u; cnt = 0u; mine = 0u;
#pragma unroll
        for (unsigned j = 0; j < 16; ++j) { const unsigned c = xb_ld(&bar[XB_XCNT(j)]); sum += c; cnt += (c > 0u) ? 1u : 0u; mine = (j == x) ? c : mine; }
        if (sum == G) break;
        __builtin_amdgcn_s_sleep(1);
        if ((++sp & 255u) == 0u) { if (xb_ld(&bar[XB_TMO])) break; if (sp > XB_SPIN_CAP) { atomicAdd(&bar[XB_TMO], 1u); break; } }
    }
    nloc = mine > 0u ? mine : 1u; nx = cnt > 0u ? cnt : 1u;
}
__device__ __forceinline__ void xcd_barrier(const XcdBarrier& b) {
    asm volatile("s_waitcnt vmcnt(0)" ::: "memory");
    __syncthreads();
    if (threadIdx.x == 0) {
        unsigned* bar = b.bar;
        __builtin_amdgcn_s_waitcnt(0);
        unsigned nloc = b.st[0], nx = b.st[1];
        if (nloc == 0u) { xcd_barrier_complete(bar, b.x, nloc, nx); b.st[0] = nloc; b.st[1] = nx; }
        const unsigned old = xb_add(&bar[XB_XSUB(b.x)], 1u);
        const unsigned gen = old / nloc;
        if (old + 1u == (gen + 1u) * nloc) {
            __builtin_amdgcn_fence(__ATOMIC_RELEASE, "agent");
            asm volatile("s_waitcnt vmcnt(0)" ::: "memory");
            const unsigned og = xb_add(&bar[XB_TOP], 1u);
            const unsigned tg = og / nx;
            if (og + 1u == (tg + 1u) * nx) xb_add(&bar[XB_TOPGEN], 1u);
            else XB_SPIN(xb_ld(&bar[XB_TOPGEN]) == tg, bar);
            __builtin_amdgcn_fence(__ATOMIC_ACQUIRE, "agent");
            xb_add(&bar[XB_XGEN(b.x)], 1u);
            asm volatile("s_waitcnt vmcnt(0)" ::: "memory");
        } else {
            XB_SPIN(xb_ld(&bar[XB_XGEN(b.x)]) == gen, bar);
            __builtin_amdgcn_fence(__ATOMIC_ACQUIRE, "agent");
            asm volatile("s_waitcnt vmcnt(0)" ::: "memory");
        }
    }
    __syncthreads();
}

#ifndef PROF_A
#define PROF_A -1
#endif
#ifndef PROF_B
#define PROF_B -1
#endif
#define USTAMP(k) do { if ((PROF_A >= 0 || PROF_B >= 0) && F.prof && blockIdx.x == 0 && F.tid == 0) ((unsigned long long*)(F.ws + WS_CTL + 61440 + 512))[k] = __builtin_amdgcn_s_memrealtime(); } while (0)
struct Frame {
    LAS unsigned char* lds;
    int tid, lane, wave, G, vcu; bool prof;
    __device__ __forceinline__ void fresh() { int t = threadIdx.x; asm volatile("" : "+v"(t)); tid = t; lane = t & 63; wave = __builtin_amdgcn_readfirstlane(t >> 6); }
    const float *x, *c, *ctx, *c_ctx, *w_ada, *b_ada, *g_mix, *w_in, *dlogit, *ret_g, *w_four, *rpb, *w_out, *g_ffn, *w1, *w3, *w2, *g_final;
    float* out; unsigned char* ws;
    float *MOD, *SHWIN, *SHW13, *ROPE, *LG, *CT256, *SSQ, *XC, *ADAP; const float* TW8; bf16_t* STATE;
    bf16_t *XN, *CAT, *PROJ, *HID, *WFT, *TWA, *TD2, *TC256; unsigned* Y;
    __device__ __forceinline__ bf16_t* W(int layer, size_t off) const { return (bf16_t*)(ws + WS_W + (size_t)layer * W_LAYER + off); }
};

__device__ __forceinline__ float wave_sum(float v) {
#pragma unroll
    for (int o = 1; o < 64; o <<= 1) v += __shfl_xor(v, o);
    return v;
}

__device__ __forceinline__ bf16x8 ld8(LAS const unsigned char* p) { return *(LAS const bf16x8*)p; }
__device__ __forceinline__ bf16x8 ld8(const unsigned char* p) { return *(const bf16x8*)p; }
template <int MT, int NT, class PA, class PB>
__device__ __forceinline__ void wave_mma(f32x4 (&acc)[MT][NT], PA A, int lda, PB B, int ldb, int ksteps, int fr, int fq) {
    PA a0 = A + fr * lda + fq * 16; PB b0 = B + fr * ldb + fq * 16;
    for (int s = 0; s < ksteps; ++s) {
        bf16x8 a[MT], b[NT];
#pragma unroll
        for (int m = 0; m < MT; ++m) a[m] = ld8(a0 + m * 16 * lda + s * 64);
#pragma unroll
        for (int n = 0; n < NT; ++n) b[n] = ld8(b0 + n * 16 * ldb + s * 64);
#pragma unroll
        for (int m = 0; m < MT; ++m)
#pragma unroll
            for (int n = 0; n < NT; ++n) acc[m][n] = __builtin_amdgcn_mfma_f32_16x16x32_bf16(a[m], b[n], acc[m][n], 0, 0, 0);
    }
}
template <int MT, int NT> __device__ __forceinline__ void zero_acc(f32x4 (&acc)[MT][NT]) {
#pragma unroll
    for (int m = 0; m < MT; ++m)
#pragma unroll
        for (int n = 0; n < NT; ++n) acc[m][n] = (f32x4){0.f, 0.f, 0.f, 0.f};
}

#define LDS_WAIT() asm volatile("s_waitcnt lgkmcnt(0)" ::: "memory")
__device__ __forceinline__ void p0_transpose_item(const float* W, int ldw, int K, int nblk, bf16_t* WT, int mapkind, int roff, LAS float* scr, int item, int lane) {
    const int kb = item / nblk, nb = item % nblk, k0 = 64 * kb, n0 = 32 * nb;
    { f32x4 v[8]; const int r = lane >> 3, c4 = lane & 7;
#pragma unroll
      for (int i = 0; i < 8; ++i) v[i] = *(const f32x4*)(W + (size_t)(k0 + 8 * i + r) * ldw + n0 + 4 * c4);
#pragma unroll
      for (int i = 0; i < 8; ++i) { LAS float* d = scr + (8 * i + r) * 33 + 4 * c4; d[0] = v[i][0]; d[1] = v[i][1]; d[2] = v[i][2]; d[3] = v[i][3]; } }
    LDS_WAIT(); asm volatile("" ::: "memory");
    const int c = lane & 7;
#pragma unroll
    for (int j = 0; j < 4; ++j) { const int n = (lane >> 3) + 8 * j; const LAS float* s = scr + (8 * c) * 33 + n;
        u32x4 o; o.x = pk2(s[0 * 33], s[1 * 33]); o.y = pk2(s[2 * 33], s[3 * 33]); o.z = pk2(s[4 * 33], s[5 * 33]); o.w = pk2(s[6 * 33], s[7 * 33]);
        const int nn = n0 + n; const int row = mapkind == 0 ? roff + nn : ((nn >> 7) * 256 + (nn & 127) + (mapkind == 2 ? 128 : 0));
        *(u32x4*)(WT + (size_t)row * K + k0 + 8 * c) = o; }
    LDS_WAIT(); asm volatile("" ::: "memory");
}

__device__ __forceinline__ void phase_p0a(Frame& F) {
    F.fresh();
    const int tid = F.tid, lane = F.lane, wave = F.wave;
    {
        LAS float* wt = (LAS float*)F.lds; LAS float* T = (LAS float*)(F.lds + 8 * 257 * 4);
        for (int e = tid; e < 4096; e += NTHR) { const int c = e >> 6, p = e & 63; float sv, cv;
            if (p <= 32) { sincospif((float)((p * c) & 63) * (1.0f / 32.0f), &sv, &cv); T[e] = cv; }
            else { sincospif((float)(((p - 32) * c) & 63) * (1.0f / 32.0f), &sv, &cv); T[e] = -sv; } }
        for (int it = blockIdx.x; it < 256; it += F.G) {
            const int l = it >> 7, k0 = (it & 127) * 8;
            __syncthreads();
            for (int e = tid; e < 8 * 64; e += NTHR) { const int kk = e >> 6, c4 = e & 63; const f32x4 v = *(const f32x4*)(F.w_in + ((size_t)l * DM + k0 + kk) * PW + 4 * c4);
                LAS float* d = wt + kk * 257 + 4 * c4; d[0] = v[0]; d[1] = v[1]; d[2] = v[2]; d[3] = v[3]; }
            __syncthreads();
            const int k = tid & 7, cb = tid >> 3; bf16_t* WT = F.W(l, W_WIN);
#pragma unroll
            for (int i = 0; i < 4; ++i) { const int col = cb + 64 * i, g = col >> 6, p = col & 63; float a = 0.f;
#pragma unroll 16
                for (int c = 0; c < 64; ++c) a += wt[k * 257 + g * 64 + c] * T[c * 64 + p];
                WT[(size_t)col * DM + k0 + k] = (bf16_t)f2bf(a); }
        }
        __syncthreads();
    }
    LAS float* sc = (LAS float*)(F.lds + 131072);
    for (int e = tid; e < 3072; e += NTHR) { const int s = e >> 10, k = e & 1023; const float v = s < 2 ? F.c[s * DM + k] : F.c_ctx[k]; sc[e] = v / (1.0f + expf(-v)); }
    __syncthreads();
    const int gw = F.vcu * NWAVES + wave, NGW = F.G * NWAVES;
    for (int it = gw; it < 2 * 8 * 24; it += NGW) {
        const int l = it / 192, rem = it % 192, kc = rem / 24, cb = rem % 24, col = cb * 256 + 4 * lane;
        const float* wp = F.w_ada + ((size_t)l * DM + kc * 128) * 6144 + col; f32x4 a0 = {0.f, 0.f, 0.f, 0.f}, a1 = a0, a2 = a0;
#pragma unroll 1
        for (int h2 = 0; h2 < 8; ++h2) { f32x4 w[16];
#pragma unroll
            for (int k = 0; k < 16; ++k) w[k] = *(const f32x4*)(wp + (size_t)(h2 * 16 + k) * 6144);
#pragma unroll
            for (int k = 0; k < 16; ++k) { const int kk = kc * 128 + h2 * 16 + k; a0 += w[k] * sc[kk]; a1 += w[k] * sc[1024 + kk]; a2 += w[k] * sc[2048 + kk]; } }
        float* o = F.ADAP + ((size_t)(l * 8 + kc) * 3) * 6144 + col; *(f32x4*)o = a0; *(f32x4*)(o + 6144) = a1; *(f32x4*)(o + 2 * 6144) = a2;
    }
    LAS float* scr = (LAS float*)(F.lds + wave * 16384);
    constexpr int I0 = 16 * 84, I1 = 16 * 32, I2 = 16 * 88, I3 = I2, I4 = 44 * 32, I5 = 4 * 8, IL = I0 + I1 + I2 + I3 + I4 + I5;
    for (int it = gw; it < 2 * IL; it += NGW) {
        const int l = it / IL; int r = it % IL;
        if (r < I0) { p0_transpose_item(F.w_in + (size_t)l * DM * PW + 256, PW, DM, 84, F.W(l, W_WIN), 0, 256, scr, r, lane); continue; } r -= I0;
        if (r < I1) { p0_transpose_item(F.w_out + (size_t)l * DM * DM, DM, DM, 32, F.W(l, W_WOUT), 0, 0, scr, r, lane); continue; } r -= I1;
        if (r < I2) { p0_transpose_item(F.w1 + (size_t)l * DM * FF, FF, DM, 88, F.W(l, W_W13), 1, 0, scr, r, lane); continue; } r -= I2;
        if (r < I3) { p0_transpose_item(F.w3 + (size_t)l * DM * FF, FF, DM, 88, F.W(l, W_W13), 2, 0, scr, r, lane); continue; } r -= I3;
        if (r < I4) { p0_transpose_item(F.w2 + (size_t)l * FF * DM, DM, FF, 32, F.W(l, W_W2), 0, 0, scr, r, lane); continue; } r -= I4;
        p0_transpose_item(F.w_four + (size_t)l * 65536, 256, 256, 8, F.WFT + (size_t)l * 65536, 0, 0, scr, r, lane);
    }
    const int gt = F.vcu * NTHR + tid, GT = F.G * NTHR;
    for (int e = gt; e < 2 * 128 * 128; e += GT) { const int l = e >> 14, q = e & 16383; *(u32x4*)(F.W(l, W_WIN) + (size_t)PW * DM + (size_t)q * 8) = (u32x4){0u, 0u, 0u, 0u}; }
    for (int e = gt; e < 192 * 24; e += GT) { const int pos = e < 128 * 24 ? e / 24 : (e - 128 * 24) / 24, i = e % 24;
        const float inv = powf(10000.0f, -(float)i / 24.0f), ang = (float)pos * inv; F.ROPE[2 * e] = cosf(ang); F.ROPE[2 * e + 1] = sinf(ang); }
    for (int e = gt; e < 16; e += GT) { const float xv = F.dlogit[e]; F.LG[e] = -log1pf(expf(-xv)); }
    for (int e = gt; e < 256; e += GT) { float sv, cv; sincospif((float)e * (2.0f / 256.0f), &sv, &cv); F.CT256[2 * e] = cv; F.CT256[2 * e + 1] = sv; }
    for (int e = gt; e < 8192; e += GT) { float sv, cv; sincospif((float)e * (2.0f / 8192.0f), &sv, &cv); ((float*)F.TW8)[2 * e] = cv; ((float*)F.TW8)[2 * e + 1] = sv; }
    for (int e = gt; e < 32768; e += GT) { const int row = e >> 7, l1 = e & 127, cs = row >> 7, k1 = row & 127; float sv, cv;
        sincospif((float)((k1 * l1) & 127) * (2.0f / 128.0f), &sv, &cv); F.TWA[e] = (bf16_t)f2bf(cs == 0 ? cv : sv); }
    for (int e = gt; e < 131072; e += GT) { const int cs = e >> 16, k = (e >> 8) & 255, l = e & 255; float sv, cv;
        sincospif((float)((k * l) & 255) * (2.0f / 256.0f), &sv, &cv); F.TC256[e] = (bf16_t)f2bf(cs == 0 ? cv : sv); }
    for (int e = gt; e < 8192; e += GT) { const int k2 = e >> 7, col = e & 127, l2 = col >> 1, ri = col & 1; float sv, cv;
        sincospif((float)((k2 * l2) & 63) * (2.0f / 64.0f), &sv, &cv); F.TD2[e] = (bf16_t)f2bf(ri == 0 ? cv : sv); }
}

__device__ __forceinline__ float ada_val(const Frame& F, int l, int s, int j) {
    const float* p = F.ADAP + ((size_t)(l * 8) * 3 + s) * 6144 + j; float a = 0.f;
#pragma unroll
    for (int kc = 0; kc < 8; ++kc) a += p[(size_t)kc * 3 * 6144];
    return a + F.b_ada[l * 6144 + j];
}
__device__ __forceinline__ void phase_p0b(Frame& F) {
    F.fresh();
    const int tid = F.tid, lane = F.lane, wave = F.wave;
    const int gt = F.vcu * NTHR + tid, GT = F.G * NTHR, gw = F.vcu * NWAVES + wave, NGW = F.G * NWAVES;
    for (int e = gt; e < 2 * 3 * 6144; e += GT) { const int l = e / 18432, s = (e / 6144) % 3, j = e % 6144; F.MOD[e] = ada_val(F, l, s, j); }
    LAS float* vec = (LAS float*)F.lds;
#pragma unroll
    for (int i = 0; i < 6; ++i) { const int e = tid + NTHR * i, s = e >> 10, k = e & 1023; vec[e] = F.g_mix[k] * (1.0f + ada_val(F, 0, s, 1024 + k)); }
    __syncthreads();
    for (int m0 = gw; m0 < MTOT; m0 += 2 * NGW) {
        f32x4 v[2][4]; float ss[2] = {0.f, 0.f}; const int m1 = m0 + NGW; const bool has1 = m1 < MTOT;
#pragma unroll
        for (int q = 0; q < 2; ++q) { const int m = q ? m1 : m0; if (q == 0 || has1) { const float* src = m < MLAT ? F.x + (size_t)m * DM : F.ctx + (size_t)(m - MLAT) * DM;
#pragma unroll
            for (int j = 0; j < 4; ++j) v[q][j] = *(const f32x4*)(src + 4 * lane + 256 * j); } }
#pragma unroll
        for (int q = 0; q < 2; ++q) { const int m = q ? m1 : m0; if (q == 0 || has1) { const int set = m < SEQ ? 0 : (m < MLAT ? 1 : 2);
#pragma unroll
            for (int j = 0; j < 4; ++j) ss[q] += (v[q][j][0] * v[q][j][0] + v[q][j][1] * v[q][j][1]) + (v[q][j][2] * v[q][j][2] + v[q][j][3] * v[q][j][3]);
            ss[q] = wave_sum(ss[q]);
#pragma unroll
            for (int j = 0; j < 4; ++j) { const f32x4 g = *(LAS const f32x4*)(vec + set * 1024 + 4 * lane + 256 * j); const f32x4 o = v[q][j] * g;
                u32x2 w; w.x = pk2(o[0], o[1]); w.y = pk2(o[2], o[3]); *(u32x2*)(F.XN + (size_t)m * DM + 4 * lane + 256 * j) = w; }
            if (lane < 16) F.SSQ[(size_t)m * 16 + lane] = lane == 0 ? ss[q] : 0.f; } }
    }
    for (int combo = 0; combo < 4; ++combo) {
        const int l = combo >> 1, which = combo & 1;
        __syncthreads();
#pragma unroll
        for (int i = 0; i < 6; ++i) { const int e = tid + NTHR * i, s = e >> 10, k = e & 1023; vec[e] = ada_val(F, l, s, (which ? 3072 : 0) + k); }
        __syncthreads();
        const int nrows = which ? FF2 : PWP; const bf16_t* Wt = F.W(l, which ? W_W13 : W_WIN); float* dstv = (which ? F.SHW13 : F.SHWIN) + (size_t)l * 3 * nrows;
        for (int r0 = gw; r0 < nrows; r0 += 2 * NGW) { const int r1 = r0 + NGW; const bool has1 = r1 < nrows;
            u32x4 w[2][2];
#pragma unroll
            for (int q = 0; q < 2; ++q) if (q == 0 || has1) {
#pragma unroll
                for (int j = 0; j < 2; ++j) w[q][j] = *(const u32x4*)(Wt + (size_t)(q ? r1 : r0) * DM + lane * 8 + 512 * j); }
#pragma unroll
            for (int q = 0; q < 2; ++q) if (q == 0 || has1) { float a0 = 0.f, a1 = 0.f, a2 = 0.f;
#pragma unroll
                for (int j = 0; j < 2; ++j) { const int k0 = lane * 8 + 512 * j; const u32x4 ww = w[q][j];
                    const float wf[8] = {bflo(ww.x), bfhi(ww.x), bflo(ww.y), bfhi(ww.y), bflo(ww.z), bfhi(ww.z), bflo(ww.w), bfhi(ww.w)};
#pragma unroll
                    for (int e = 0; e < 8; ++e) { a0 += wf[e] * vec[k0 + e]; a1 += wf[e] * vec[1024 + k0 + e]; a2 += wf[e] * vec[2048 + k0 + e]; } }
                a0 = wave_sum(a0); a1 = wave_sum(a1); a2 = wave_sum(a2); const int r = q ? r1 : r0;
                if (lane == 0) { dstv[r] = a0; dstv[nrows + r] = a1; dstv[2 * nrows + r] = a2; } }
        }
    }
}
__device__ __forceinline__ void phase_final(Frame& F, bool dry = false, float delta = 0.f) {
    F.fresh();
    const int gw = F.vcu * NWAVES + F.wave, NGW = F.G * NWAVES, lane = F.lane;
    for (int m = gw; m < MLAT; m += NGW) {
        const float ri = pg8::row_rinv(F.SSQ, m); float* row = F.out + (size_t)m * DM;
#pragma unroll
        for (int j = 0; j < 4; ++j) { const int c = 4 * lane + 256 * j; const f32x4 v = *(const f32x4*)(row + c), g = *(const f32x4*)(F.g_final + c); *(f32x4*)(row + c) = dry ? v : v * g * ri + delta; }
    }
}

typedef LAS const unsigned char* lptr;
typedef const unsigned char* gptr;
constexpr float LOG2E = 1.4426950408889634f;
template <int NPW, class RowFn>
__device__ __forceinline__ void stage_T_load(unsigned (&a)[NPW], unsigned (&b)[NPW], RowFn rowp, int nd, int wave, int lane) {
    const int ndb = nd / 16, dl = lane & 7, kl = lane >> 3;
#pragma unroll
    for (int it = 0; it < NPW; ++it) { const int wi = wave + NWAVES * it, dvp = (wi % ndb) * 8 + dl, kp = (wi / ndb) * 8 + kl;
        a[it] = *(const unsigned*)(rowp(2 * kp) + 2 * dvp); b[it] = *(const unsigned*)(rowp(2 * kp + 1) + 2 * dvp); }
}
template <int NPW>
__device__ __forceinline__ void stage_T_store(const unsigned (&a)[NPW], const unsigned (&b)[NPW], LAS unsigned char* dst, int dstride, int nd, int wave, int lane) {
    const int ndb = nd / 16, dl = lane & 7, kl = lane >> 3;
#pragma unroll
    for (int it = 0; it < NPW; ++it) { const int wi = wave + NWAVES * it, dvp = (wi % ndb) * 8 + dl, kp = (wi / ndb) * 8 + kl;
        *(LAS unsigned*)(dst + (2 * dvp) * dstride + kp * 4) = (a[it] & 0xffffu) | (b[it] << 16);
        *(LAS unsigned*)(dst + (2 * dvp + 1) * dstride + kp * 4) = (a[it] >> 16) | (b[it] & 0xffff0000u); }
}
template <int NPW, class RowFn>
__device__ __forceinline__ void stage_T(LAS unsigned char* dst, int dstride, RowFn rowp, int nd, int wave, int lane) {
    unsigned a[NPW], b[NPW]; stage_T_load<NPW>(a, b, rowp, nd, wave, lane); stage_T_store<NPW>(a, b, dst, dstride, nd, wave, lane);
}
__device__ __forceinline__ bf16x4 vtr(LAS const unsigned char* p) { return __builtin_amdgcn_ds_read_tr16_b64_v4i16((LAS bf16x4*)p); }
__device__ __forceinline__ bf16x8 pack8(const f32x4& a, const f32x4& b) { u32x4 w; w.x = pk2(a[0], a[1]); w.y = pk2(a[2], a[3]); w.z = pk2(b[0], b[1]); w.w = pk2(b[2], b[3]); return __builtin_bit_cast(bf16x8, w); }

constexpr int NA_KC = 65536, NA_Q = 98304, NA_RPB = 106496, NA_COMB = 108544;
static_assert(NA_COMB + 8 * 4224 <= MISC_OFF, "NA LDS map");
__device__ __forceinline__ void na_units(Frame& F, int layer, bool ctxq, int total, int k0 = 0, int k1 = 1 << 20) {
    F.fresh();
    const int tid = F.tid, lane = F.lane, wave = F.wave, fr = lane & 15, fq = lane >> 4;
    LAS unsigned char* lds = F.lds; const bf16_t* P = F.PROJ;
    const int sch = tid & 7, skey = tid >> 3;
    const unsigned sdst = (unsigned)(skey * 128 + ((sch ^ (skey & 7)) << 4));
    const int jb = wave & 3, half = wave >> 2; const bool active = !(ctxq && half == 0);
    const int cstart = min(max(16 * jb - 8, 0), 32);
    u32x4 kv[12], qv; float rpv = 0.f;
    int it = blockIdx.x + k0 * F.G; { const long lim = (long)blockIdx.x + (long)k1 * F.G; if (lim < total) total = (int)lim; }
    if (it >= total) return;
#define NA_DECODE(itx, b_, h_, r_) do { if (ctxq) { b_ = (itx) / 24; h_ = ((itx) % 24) / 4; r_ = (itx) & 3; } else { b_ = (itx) / 768; h_ = ((itx) % 768) / 128; r_ = (itx) % 128; } } while (0)
#define NA_LOADK(b_, h_, r_) do { const int rs_ = ctxq ? 0 : min(max((r_) - 4, 0), 120); const int tq_ = ctxq ? MLAT + (b_) * CTXL + (r_) * 64 : (b_) * SEQ + (r_) * 64; \
        if (!ctxq) { _Pragma("unroll") for (int i = 0; i < 8; ++i) { const size_t tok = (size_t)(b_) * SEQ + (rs_ + i) * 64 + skey; kv[i] = *(const u32x4*)(P + tok * PW + C_NK + (h_) * 64 + sch * 8); } } \
        _Pragma("unroll") for (int i = 0; i < 4; ++i) { const size_t tok = (size_t)MLAT + (b_) * CTXL + skey + 64 * i; kv[8 + i] = *(const u32x4*)(P + tok * PW + C_NK + (h_) * 64 + sch * 8); } \
        qv = *(const u32x4*)(P + (size_t)(tq_ + skey) * PW + C_NQ + (h_) * 64 + sch * 8); \
        if (tid < 465) rpv = F.rpb[((size_t)layer * 6 + (h_)) * 465 + tid] * 8.0f; } while (0)
    int b, h, r; NA_DECODE(it, b, h, r); NA_LOADK(b, h, r);
    for (; it < total; it += F.G) {
        NA_DECODE(it, b, h, r);
        const int rs = ctxq ? 0 : min(max(r - 4, 0), 120);
        const int tokq0 = ctxq ? MLAT + b * CTXL + r * 64 : b * SEQ + r * 64;
        __syncthreads();
        USTAMP(0);
        if (!ctxq) {
#pragma unroll
            for (int i = 0; i < 8; ++i) *(LAS u32x4*)(lds + sdst + i * 8192) = kv[i];
        }
#pragma unroll
        for (int i = 0; i < 4; ++i) *(LAS u32x4*)(lds + NA_KC + sdst + i * 8192) = kv[8 + i];
        *(LAS u32x4*)(lds + NA_Q + sdst) = qv;
        if (tid < 465) ((LAS float*)(lds + NA_RPB))[tid] = rpv;
        __syncthreads();
        USTAMP(1);
        bf16x8 pa[8]; float mx = -3.0e38f, lsum = 0.f; f32x4 st[16];
        if (active) {
            const int sw0 = (fq ^ (fr & 7)) << 4, sw1 = ((4 + fq) ^ (fr & 7)) << 4;
            lptr qb = (lptr)(lds + NA_Q + (jb * 16 + fr) * 128);
            const bf16x8 qf0 = ld8(qb + sw0), qf1 = ld8(qb + sw1);
            if (half == 0) {
                const int qc = jb * 16 + fr, wsx = min(max(qc - 8, 0), 48); LAS const float* rp = (LAS const float*)(lds + NA_RPB) + (rs - r + 7) * 31 + (cstart + 4 * fq - qc + 15);
                bool ok[2][4];
#pragma unroll
                for (int hf = 0; hf < 2; ++hf)
#pragma unroll
                    for (int reg = 0; reg < 4; ++reg) { const int kc = cstart + 16 * hf + 4 * fq + reg; ok[hf][reg] = kc >= wsx && kc < wsx + 16; }
#pragma unroll
                for (int t = 0; t < 16; ++t) { LAS const float* bp = rp + (t >> 1) * 31 + 16 * (t & 1);
#pragma unroll
                    for (int reg = 0; reg < 4; ++reg) { const float x = bp[reg]; st[t][reg] = ok[t & 1][reg] ? x : -1.0e30f; } }
            } else {
#pragma unroll
                for (int t = 0; t < 16; ++t) st[t] = (f32x4){0.f, 0.f, 0.f, 0.f};
            }
#pragma unroll
            for (int t = 0; t < 16; ++t) {
                const int kidx = half == 0 ? (t >> 1) * 64 + cstart + 16 * (t & 1) + fr : 16 * t + fr;
                lptr kp = (lptr)(lds + (half == 0 ? 0 : NA_KC) + kidx * 128);
                st[t] = __builtin_amdgcn_mfma_f32_16x16x32_bf16(ld8(kp + sw0), qf0, st[t], 0, 0, 0);
                st[t] = __builtin_amdgcn_mfma_f32_16x16x32_bf16(ld8(kp + sw1), qf1, st[t], 0, 0, 0);
            }
        }
        USTAMP(2);
        if (!ctxq) {
#pragma unroll
            for (int i = 0; i < 8; ++i) { const size_t tok = (size_t)b * SEQ + (rs + i) * 64 + skey; kv[i] = *(const u32x4*)(P + tok * PW + C_NV + h * 64 + sch * 8); }
        }
#pragma unroll
        for (int i = 0; i < 4; ++i) { const size_t tok = (size_t)MLAT + b * CTXL + skey + 64 * i; kv[8 + i] = *(const u32x4*)(P + tok * PW + C_NV + h * 64 + sch * 8); }
        if (active) {
            constexpr float SC = 0.125f * LOG2E;
#pragma unroll
            for (int t = 0; t < 16; ++t) st[t] = st[t] * SC;
#pragma unroll
            for (int t = 0; t < 16; ++t) mx = fmaxf(mx, fmaxf(fmaxf(st[t][0], st[t][1]), fmaxf(st[t][2], st[t][3])));
            mx = fmaxf(mx, __shfl_xor(mx, 16)); mx = fmaxf(mx, __shfl_xor(mx, 32));
#pragma unroll
            for (int t = 0; t < 16; ++t)
#pragma unroll
                for (int reg = 0; reg < 4; ++reg) { const float p = __builtin_amdgcn_exp2f(st[t][reg] - mx); st[t][reg] = p; lsum += p; }
            lsum += __shfl_xor(lsum, 16); lsum += __shfl_xor(lsum, 32);
#pragma unroll
            for (int s = 0; s < 8; ++s) pa[s] = pack8(st[2 * s], st[2 * s + 1]);
        } else {
#pragma unroll
            for (int s = 0; s < 8; ++s) pa[s] = (bf16x8){0, 0, 0, 0, 0, 0, 0, 0};
        }
        USTAMP(3);
        __syncthreads();
        if (!ctxq) {
#pragma unroll
            for (int i = 0; i < 8; ++i) *(LAS u32x4*)(lds + sdst + i * 8192) = kv[i];
        }
#pragma unroll
        for (int i = 0; i < 4; ++i) *(LAS u32x4*)(lds + NA_KC + sdst + i * 8192) = kv[8 + i];
        __syncthreads();
        USTAMP(4);
        if (it + F.G < total) { int b2, h2, r2; NA_DECODE(it + F.G, b2, h2, r2); NA_LOADK(b2, h2, r2); }
        f32x4 o[4];
#pragma unroll
        for (int n = 0; n < 4; ++n) o[n] = (f32x4){0.f, 0.f, 0.f, 0.f};
        if (active) {
            const int q4 = (lane & 15) >> 2, p4 = lane & 3, c7 = 4 * (fq & 1) + q4;
            lptr vb = (lptr)(lds + (half == 0 ? 0 : NA_KC) + (4 * fq + q4) * 128 + 8 * (p4 & 1));
            int xo[4];
#pragma unroll
            for (int n = 0; n < 4; ++n) xo[n] = ((2 * n + (p4 >> 1)) ^ c7) << 4;
#pragma unroll
            for (int s = 0; s < 8; ++s) { const int k0 = half == 0 ? s * 64 + cstart : 32 * s;
#pragma unroll
                for (int n = 0; n < 4; ++n) { lptr rb = vb + k0 * 128 + xo[n];
                    const bf16x4 lo = vtr(rb), hi = vtr(rb + 16 * 128);
                    const bf16x8 bv = {lo[0], lo[1], lo[2], lo[3], hi[0], hi[1], hi[2], hi[3]};
                    o[n] = __builtin_amdgcn_mfma_f32_16x16x32_bf16(pa[s], bv, o[n], 0, 0, 0); } }
        }
        USTAMP(5);
        LAS float* cb = (LAS float*)(lds + NA_COMB + wave * 4224);
#pragma unroll
        for (int n = 0; n < 4; ++n)
#pragma unroll
            for (int reg = 0; reg < 4; ++reg) cb[(4 * fq + reg) * 64 + n * 16 + fr] = o[n][reg];
        if (fq == 0) { cb[1024 + 2 * fr] = mx; cb[1025 + 2 * fr] = lsum; }
        __syncthreads();
        if (wave < 4) {
            LAS const float* c2 = (LAS const float*)(lds + NA_COMB + (wave + 4) * 4224);
#pragma unroll
            for (int reg = 0; reg < 4; ++reg) { const int q = 4 * fq + reg;
                const float m1 = cb[1024 + 2 * q], l1 = cb[1025 + 2 * q], m2 = c2[1024 + 2 * q], l2 = c2[1025 + 2 * q], M = fmaxf(m1, m2);
                const float w1 = __builtin_amdgcn_exp2f(m1 - M), w2 = __builtin_amdgcn_exp2f(m2 - M), inv = 1.0f / (w1 * l1 + w2 * l2);
                bf16_t* orow = F.CAT + (size_t)(tokq0 + jb * 16 + q) * DM + 640 + h * 64;
#pragma unroll
                for (int n = 0; n < 4; ++n) orow[n * 16 + fr] = (bf16_t)f2bf((w1 * o[n][reg] + w2 * c2[q * 64 + n * 16 + fr]) * inv); }
        }
        USTAMP(6);
    }
#undef NA_DECODE
#undef NA_LOADK
}

__device__ __forceinline__ int ret_row0(int b, int t) { return t >= 2 ? b * SEQ + (t - 2) * 128 : MLAT + b * CTXL + t * 128; }
constexpr int R1_K = 0, R1_VF = 32768, R1_VB = 65536;
__device__ __forceinline__ unsigned r1_swz(int row, int ch) { return (unsigned)(row * 256 + ((ch ^ (row & 15)) << 4)); }
__device__ __forceinline__ u32x4 scale8(const u32x4& v, float w) { u32x4 o; o.x = pk2(bflo(v.x) * w, bfhi(v.x) * w); o.y = pk2(bflo(v.y) * w, bfhi(v.y) * w); o.z = pk2(bflo(v.z) * w, bfhi(v.z) * w); o.w = pk2(bflo(v.w) * w, bfhi(v.w) * w); return o; }
__device__ __forceinline__ void r1_unit(Frame& F, int layer, int b, int h, int t) {
    F.fresh();
    const int tid = F.tid, lane = F.lane, wave = F.wave, fr = lane & 15, fq = lane >> 4;
    LAS unsigned char* lds = F.lds; bf16_t* P = F.PROJ;
    const bool lat = t >= 2; const int row0 = ret_row0(b, t);
    const float lgf = F.LG[layer * 8 + h], lgb = F.LG[layer * 8 + 4 + h], ks = 0.10206207261596575f;
    __syncthreads();
    u32x4 xa[3], xb[3], vv[3]; f32x4 tb[3][4];
#pragma unroll
    for (int it = 0; it < 3; ++it) { const int e = tid + NTHR * it, X = e / 768, rem = e % 768, j = rem / 6, cp = rem % 6, c0 = cp < 3 ? cp : cp + 3;
        const bf16_t* xr = P + (size_t)(row0 + j) * PW + (X ? C_RQ : C_RK) + h * 96;
        xa[it] = *(const u32x4*)(xr + c0 * 8); xb[it] = *(const u32x4*)(xr + (c0 + 3) * 8);
        if (lat) { const int pos = (t - 2) * 128 + j, prow = pos >> 6, pcol = pos & 63; const float* tp = F.ROPE + ((cp < 3 ? prow * 24 : 3072 + pcol * 24) + 8 * (cp % 3)) * 2;
#pragma unroll
            for (int q = 0; q < 4; ++q) tb[it][q] = *(const f32x4*)(tp + 4 * q); } }
#pragma unroll
    for (int it = 0; it < 3; ++it) { const int e = tid + NTHR * it, j = e / 12, ch = e % 12; vv[it] = *(const u32x4*)(P + (size_t)(row0 + j) * PW + C_RV + h * 96 + ch * 8); }
#pragma unroll
    for (int it = 0; it < 3; ++it) { const int e = tid + NTHR * it, X = e / 768, rem = e % 768, j = rem / 6, cp = rem % 6, c0 = cp < 3 ? cp : cp + 3;
        const float scl = X ? 1.0f : ks; u32x4 oa, ob;
        if (lat) { float ra[8], rb[8]; const unsigned ua[4] = {xa[it].x, xa[it].y, xa[it].z, xa[it].w}, ub[4] = {xb[it].x, xb[it].y, xb[it].z, xb[it].w};
#pragma unroll
            for (int q = 0; q < 4; ++q) { const float a0 = bflo(ua[q]), a1 = bfhi(ua[q]), b0 = bflo(ub[q]), b1 = bfhi(ub[q]); const f32x4 cs = tb[it][q];
                ra[2 * q] = (a0 * cs[0] - b0 * cs[1]) * scl; rb[2 * q] = (a0 * cs[1] + b0 * cs[0]) * scl; ra[2 * q + 1] = (a1 * cs[2] - b1 * cs[3]) * scl; rb[2 * q + 1] = (a1 * cs[3] + b1 * cs[2]) * scl; }
            oa.x = pk2(ra[0], ra[1]); oa.y = pk2(ra[2], ra[3]); oa.z = pk2(ra[4], ra[5]); oa.w = pk2(ra[6], ra[7]);
            ob.x = pk2(rb[0], rb[1]); ob.y = pk2(rb[2], rb[3]); ob.z = pk2(rb[4], rb[5]); ob.w = pk2(rb[6], rb[7]);
        } else { oa = X ? xa[it] : scale8(xa[it], ks); ob = X ? xb[it] : scale8(xb[it], ks); }
        if (lat || X == 0) { bf16_t* xr = P + (size_t)(row0 + j) * PW + (X ? C_RQ : C_RK) + h * 96; *(u32x4*)(xr + c0 * 8) = oa; *(u32x4*)(xr + (c0 + 3) * 8) = ob; }
        if (X == 0) { *(LAS u32x4*)(lds + R1_K + r1_swz(j, c0)) = oa; *(LAS u32x4*)(lds + R1_K + r1_swz(j, c0 + 3)) = ob; } }
#pragma unroll
    for (int it = 0; it < 3; ++it) { const int e = tid + NTHR * it, j = e / 12, ch = e % 12;
        *(LAS u32x4*)(lds + R1_VF + r1_swz(j, ch)) = scale8(vv[it], expf(lgf * (float)(127 - j))); *(LAS u32x4*)(lds + R1_VB + r1_swz(j, ch)) = scale8(vv[it], expf(lgb * (float)j)); }
    __syncthreads();
    const int dir = wave >> 2, q = wave & 3, mb = q >> 1, nb = q & 1, q4 = (lane & 15) >> 2, p4 = lane & 3; f32x4 acc[3][3]; zero_acc(acc);
    lptr vbase = (lptr)(lds + (dir ? R1_VB : R1_VF)), kbase = (lptr)(lds + R1_K);
#pragma unroll
    for (int s = 0; s < 4; ++s) { bf16x8 a[3], bb[3]; const int r0 = 32 * s + 8 * fq + q4, r1 = r0 + 4;
#pragma unroll
        for (int m = 0; m < 3; ++m) { const int ch = 2 * (mb * 3 + m) + (p4 >> 1); const bf16x4 lo = vtr(vbase + r1_swz(r0, ch) + 8 * (p4 & 1)), hi = vtr(vbase + r1_swz(r1, ch) + 8 * (p4 & 1));
            a[m] = (bf16x8){lo[0], lo[1], lo[2], lo[3], hi[0], hi[1], hi[2], hi[3]}; }
#pragma unroll
        for (int n = 0; n < 3; ++n) { const int ch = 2 * (nb * 3 + n) + (p4 >> 1); const bf16x4 lo = vtr(kbase + r1_swz(r0, ch) + 8 * (p4 & 1)), hi = vtr(kbase + r1_swz(r1, ch) + 8 * (p4 & 1));
            bb[n] = (bf16x8){lo[0], lo[1], lo[2], lo[3], hi[0], hi[1], hi[2], hi[3]}; }
#pragma unroll
        for (int m = 0; m < 3; ++m)
#pragma unroll
            for (int n = 0; n < 3; ++n) acc[m][n] = __builtin_amdgcn_mfma_f32_16x16x32_bf16(a[m], bb[n], acc[m][n], 0, 0, 0); }
    const int u = dir == 0 ? t : (t < 2 ? 1 - t : 67 - t);
    bf16_t* ST = F.STATE + (size_t)(((b * 4 + h) * 2 + dir) * 66 + u) * 9216;
#pragma unroll
    for (int m = 0; m < 3; ++m)
#pragma unroll
        for (int n = 0; n < 3; ++n)
#pragma unroll
            for (int reg = 0; reg < 4; ++reg) ST[(mb * 48 + m * 16 + 4 * fq + reg) * 96 + nb * 48 + n * 16 + fr] = (bf16_t)f2bf(acc[m][n][reg]);
}
__device__ __forceinline__ void r2_scan(Frame& F, int layer) {
    F.fresh();
    const int gt = F.vcu * NTHR + F.tid, GT = F.G * NTHR;
    for (int e = gt; e < 16 * 4608; e += GT) { const int combo = e / 4608, idx = (e % 4608) * 2, h = (combo >> 1) & 3, dir = combo & 1;
        const float dcy = expf(128.0f * F.LG[layer * 8 + dir * 4 + h]); unsigned* p = (unsigned*)(F.STATE + (size_t)combo * 66 * 9216 + idx); float s0 = 0.f, s1 = 0.f;
#pragma unroll 1
        for (int u0 = 0; u0 < 66; u0 += 33) { unsigned kv[33];
#pragma unroll
            for (int q = 0; q < 33; ++q) kv[q] = p[(size_t)(u0 + q) * 4608];
#pragma unroll
            for (int q = 0; q < 33; ++q) { p[(size_t)(u0 + q) * 4608] = pk2(s0, s1); s0 = s0 * dcy + bflo(kv[q]); s1 = s1 * dcy + bfhi(kv[q]); } } }
}
constexpr int R3_Q = 0, R3_K = 26624, R3_V = 53248, R3_P = 86016, R3_SF = 120832, R3_SB = 140800;
static_assert(R3_SB + 96 * 208 <= MISC_OFF, "R3 LDS map");
__device__ __forceinline__ void r3_units(Frame& F, int layer) {
    F.fresh();
    const int tid = F.tid, lane = F.lane, wave = F.wave, fr = lane & 15, fq = lane >> 4, q4 = (lane & 15) >> 2, p4 = lane & 3;
    LAS unsigned char* lds = F.lds; const bf16_t* P = F.PROJ;
    const int nt = layer == 0 ? 66 : 64, t0 = layer == 0 ? 0 : 2, total = 8 * nt;
    int it = blockIdx.x; if (it >= total) return;
    u32x4 rq[3], rk[3], rv[3], sv[5];
#define R3_DECODE(itx, b_, h_, t_) do { b_ = (itx) / (4 * nt); h_ = ((itx) / nt) & 3; t_ = t0 + (itx) % nt; } while (0)
#define R3_LOAD(b_, h_, t_) do { const int r0_ = ret_row0(b_, t_); \
        _Pragma("unroll") for (int i_ = 0; i_ < 3; ++i_) { const int e_ = tid + NTHR * i_, j_ = e_ / 12, c_ = e_ % 12; const bf16_t* rp_ = P + (size_t)(r0_ + j_) * PW + (h_) * 96 + c_ * 8; \
            rq[i_] = *(const u32x4*)(rp_ + C_RQ); rk[i_] = *(const u32x4*)(rp_ + C_RK); rv[i_] = *(const u32x4*)(rp_ + C_RV); } \
        const int ub_ = (t_) < 2 ? 1 - (t_) : 67 - (t_); \
        _Pragma("unroll") for (int i_ = 0; i_ < 5; ++i_) { const int e_ = tid + NTHR * i_; if (e_ < 2304) { const int d_ = e_ >= 1152, c_ = d_ ? e_ - 1152 : e_; \
            sv[i_] = *(const u32x4*)(F.STATE + (size_t)((((b_) * 4 + (h_)) * 2 + d_) * 66 + (d_ ? ub_ : (t_))) * 9216 + c_ * 8); } } } while (0)
    int b, h, t; R3_DECODE(it, b, h, t); R3_LOAD(b, h, t);
    for (; it < total; it += F.G) {
        R3_DECODE(it, b, h, t);
        const int row0 = ret_row0(b, t);
        const float lf2 = F.LG[layer * 8 + h] * LOG2E, lb2 = F.LG[layer * 8 + 4 + h] * LOG2E;
        __syncthreads();
        USTAMP(10);
#pragma unroll
        for (int i = 0; i < 3; ++i) { const int e = tid + NTHR * i, j = e / 12, c = e % 12;
            *(LAS u32x4*)(lds + R3_Q + j * 208 + c * 16) = rq[i]; *(LAS u32x4*)(lds + R3_K + j * 208 + c * 16) = rk[i]; *(LAS u32x4*)(lds + R3_V + r1_swz(j, c)) = rv[i]; }
#pragma unroll
        for (int i = 0; i < 5; ++i) { const int e = tid + NTHR * i; if (e < 2304) { const int d = e >= 1152, c = d ? e - 1152 : e;
            *(LAS u32x4*)(lds + (d ? R3_SB : R3_SF) + (c / 12) * 208 + (c % 12) * 16) = sv[i]; } }
        __syncthreads();
        USTAMP(11);
        unsigned short gtv[4][6]; float gnv[6];
#pragma unroll
        for (int reg = 0; reg < 4; ++reg)
#pragma unroll
            for (int n = 0; n < 6; ++n) gtv[reg][n] = P[(size_t)(row0 + wave * 16 + 4 * fq + reg) * PW + C_RG + h * 96 + n * 16 + fr];
#pragma unroll
        for (int n = 0; n < 6; ++n) gnv[n] = F.ret_g[layer * 384 + h * 96 + n * 16 + fr];
        if (it + F.G < total) { int b2, h2, t2; R3_DECODE(it + F.G, b2, h2, t2); R3_LOAD(b2, h2, t2); }
        f32x4 ao[1][6];
        {
            f32x4 af[1][6], ab[1][6]; zero_acc(af); zero_acc(ab);
            wave_mma<1, 6>(af, (lptr)(lds + R3_Q + wave * 16 * 208), 208, (lptr)(lds + R3_SF), 208, 3, fr, fq);
            wave_mma<1, 6>(ab, (lptr)(lds + R3_Q + wave * 16 * 208), 208, (lptr)(lds + R3_SB), 208, 3, fr, fq);
#pragma unroll
            for (int reg = 0; reg < 4; ++reg) { const int il = wave * 16 + 4 * fq + reg; const float qdf = __builtin_amdgcn_exp2f(lf2 * (float)(il + 1)), qdb = __builtin_amdgcn_exp2f(lb2 * (float)(128 - il));
#pragma unroll
                for (int n = 0; n < 6; ++n) ao[0][n][reg] = qdf * af[0][n][reg] + qdb * ab[0][n][reg]; }
        }
        {
            bf16x8 qf[3];
#pragma unroll
            for (int s = 0; s < 3; ++s) qf[s] = ld8((lptr)(lds + R3_Q + (wave * 16 + fr) * 208 + s * 64 + fq * 16));
            const int i = wave * 16 + fr;
#pragma unroll 1
            for (int m = 0; m < 8; ++m) { f32x4 a = {0.f, 0.f, 0.f, 0.f};
#pragma unroll
                for (int s = 0; s < 3; ++s) a = __builtin_amdgcn_mfma_f32_16x16x32_bf16(ld8((lptr)(lds + R3_K + (m * 16 + fr) * 208 + s * 64 + fq * 16)), qf[s], a, 0, 0, 0);
                float pv[4];
#pragma unroll
                for (int reg = 0; reg < 4; ++reg) { const int diff = i - (m * 16 + 4 * fq + reg);
                    const float ex = __builtin_amdgcn_exp2f((diff > 0 ? lf2 : lb2) * (float)(diff > 0 ? diff : -diff)); const float dec = diff == 0 ? 2.0f : ex; pv[reg] = a[reg] * dec; }
                u32x2 w; w.x = pk2(pv[0], pv[1]); w.y = pk2(pv[2], pv[3]); *(LAS u32x2*)(lds + R3_P + i * 272 + (m * 16 + 4 * fq) * 2) = w; }
        }
        asm volatile("s_waitcnt lgkmcnt(0)" ::: "memory");
        USTAMP(12);
#pragma unroll 1
        for (int s = 0; s < 4; ++s) { const bf16x8 a = ld8((lptr)(lds + R3_P + (wave * 16 + fr) * 272 + s * 64 + fq * 16)); const int r0 = 32 * s + 8 * fq + q4;
#pragma unroll
            for (int n = 0; n < 6; ++n) { const int ch = 2 * n + (p4 >> 1); const bf16x4 lo = vtr((lptr)(lds + R3_V + r1_swz(r0, ch) + 8 * (p4 & 1))), hi = vtr((lptr)(lds + R3_V + r1_swz(r0 + 4, ch) + 8 * (p4 & 1)));
                const bf16x8 bv = {lo[0], lo[1], lo[2], lo[3], hi[0], hi[1], hi[2], hi[3]};
                ao[0][n] = __builtin_amdgcn_mfma_f32_16x16x32_bf16(a, bv, ao[0][n], 0, 0, 0); } }
        USTAMP(13);
#pragma unroll
        for (int reg = 0; reg < 4; ++reg) { const int il = wave * 16 + 4 * fq + reg;
            float ov[6], ss = 0.f;
#pragma unroll
            for (int n = 0; n < 6; ++n) { ov[n] = ao[0][n][reg]; ss += ov[n] * ov[n]; }
            ss += __shfl_xor(ss, 1); ss += __shfl_xor(ss, 2); ss += __shfl_xor(ss, 4); ss += __shfl_xor(ss, 8);
            const float rn = rsqrtf(ss * (1.0f / 96.0f) + NORM_EPS); const size_t row = (size_t)(row0 + il);
#pragma unroll
            for (int n = 0; n < 6; ++n) { const int col = n * 16 + fr; const float gt = bf2f(gtv[reg][n]);
                F.CAT[row * DM + 256 + h * 96 + col] = (bf16_t)f2bf(ov[n] * rn * gnv[n] * silu_f(gt)); } }
        USTAMP(14);
    }
#undef R3_DECODE
#undef R3_LOAD
}

__device__ __forceinline__ void d1_unit(Frame& F, int b, int l2, int g) {
    F.fresh();
    const int tid = F.tid, lane = F.lane, wave = F.wave, fr = lane & 15, fq = lane >> 4;
    LAS unsigned char* lds = F.lds; const bf16_t* P = F.PROJ;
    __syncthreads();
    {
        u32x4 v[2];
#pragma unroll
        for (int i = 0; i < 2; ++i) { const int row = (tid >> 3) + 64 * i, ch = tid & 7; v[i] = *(const u32x4*)(P + ((size_t)b * SEQ + row * 64 + l2) * PW + g * 64 + ch * 8); }
#pragma unroll
        for (int i = 0; i < 2; ++i) { const int row = (tid >> 3) + 64 * i, ch = tid & 7; *(LAS u32x4*)(lds + row * 128 + ((ch ^ (row & 7)) << 4)) = v[i]; }
    }
    bf16x8 bfr[2][4];
#pragma unroll
    for (int cs = 0; cs < 2; ++cs)
#pragma unroll
        for (int s = 0; s < 4; ++s) bfr[cs][s] = *(const bf16x8*)(F.TWA + (size_t)(cs * 128 + 16 * wave + fr) * 128 + 32 * s + 8 * fq);
    __syncthreads();
    f32x4 acc[4][2]; zero_acc(acc);
    const int q4 = (lane & 15) >> 2, p4 = lane & 3;
#pragma unroll
    for (int s = 0; s < 4; ++s)
#pragma unroll
        for (int mt = 0; mt < 4; ++mt) {
            lptr rb = (lptr)(lds + (32 * s + 8 * fq + q4) * 128 + 8 * (p4 & 1));
            const bf16x4 lo = vtr(rb + (((2 * mt + (p4 >> 1)) ^ q4) << 4)), hi = vtr(rb + 4 * 128 + (((2 * mt + (p4 >> 1)) ^ (4 + q4)) << 4));
            const bf16x8 av = {lo[0], lo[1], lo[2], lo[3], hi[0], hi[1], hi[2], hi[3]};
            acc[mt][0] = __builtin_amdgcn_mfma_f32_16x16x32_bf16(av, bfr[0][s], acc[mt][0], 0, 0, 0);
            acc[mt][1] = __builtin_amdgcn_mfma_f32_16x16x32_bf16(av, bfr[1][s], acc[mt][1], 0, 0, 0);
        }
    const int k1 = 16 * wave + fr; const f32x2 cs2 = *(const f32x2*)(F.TW8 + 2 * (k1 * l2));
    unsigned* yb = F.Y + ((((size_t)b * 128 + k1) * 4 + g) * 64) * 64 + l2;
#pragma unroll
    for (int mt = 0; mt < 2; ++mt)
#pragma unroll
        for (int reg = 0; reg < 4; ++reg) { const int p = 16 * mt + 4 * fq + reg;
            const float cp = acc[mt][0][reg], sp = acc[mt][1][reg], cq = acc[mt + 2][0][reg], sq = acc[mt + 2][1][reg];
            float yr0, yi0, yr1, yi1; int m0, m1;
            if (p == 0) { m0 = 0; yr0 = cp; yi0 = -sp; m1 = 32; yr1 = cq; yi1 = -sq; }
            else { m0 = p; yr0 = cp + sq; yi0 = cq - sp; m1 = 64 - p; yr1 = cp - sq; yi1 = -cq - sp; }
            yb[(size_t)m0 * 64] = pk2(yr0 * cs2[0] + yi0 * cs2[1], yi0 * cs2[0] - yr0 * cs2[1]);
            yb[(size_t)m1 * 64] = pk2(yr1 * cs2[0] + yi1 * cs2[1], yi1 * cs2[0] - yr1 * cs2[1]); }
}
constexpr int D2_Y = 0, D2_A = 69632, D2_F = 87040;
__device__ __forceinline__ void d2_unit(Frame& F, int layer, int b, int k1) {
    F.fresh();
    const int tid = F.tid, lane = F.lane, wave = F.wave, fr = lane & 15, fq = lane >> 4;
    LAS unsigned char* lds = F.lds;
    __syncthreads();
    const unsigned* ysrc = F.Y + (size_t)(b * 128 + k1) * 4 * 64 * 64;
    for (int e = tid; e < 4096; e += NTHR) { const int row = e >> 4, ch = e & 15; *(LAS u32x4*)(lds + D2_Y + row * 272 + ch * 16) = *(const u32x4*)(ysrc + row * 64 + ch * 4); }
    for (int e = tid; e < 1024; e += NTHR) { const int row = e >> 4, ch = e & 15; *(LAS u32x4*)(lds + D2_A + row * 272 + ch * 16) = *(const u32x4*)(F.TD2 + row * 128 + ch * 8); }
    __syncthreads();
    f32x4 acc[4][2]; zero_acc(acc);
    wave_mma<4, 2>(acc, (lptr)(lds + D2_A), 272, (lptr)(lds + D2_Y + wave * 32 * 272), 272, 4, fr, fq);
    const float scale = 0.0013810679320049757f;
#pragma unroll
    for (int mt = 0; mt < 4; ++mt)
#pragma unroll
        for (int nt = 0; nt < 2; ++nt)
#pragma unroll
            for (int reg = 0; reg < 4; ++reg) *(LAS bf16_t*)(lds + D2_F + (mt * 16 + 4 * fq + reg) * 528 + (wave * 32 + nt * 16 + fr) * 2) = (bf16_t)f2bf(acc[mt][nt][reg] * scale);
    __syncthreads();
    zero_acc(acc);
    wave_mma<4, 2>(acc, (lptr)(lds + D2_F), 528, (gptr)(F.WFT + (size_t)layer * 65536) + (size_t)(wave * 32) * 512, 512, 8, fr, fq);
#pragma unroll
    for (int mt = 0; mt < 4; ++mt)
#pragma unroll
        for (int nt = 0; nt < 2; ++nt)
#pragma unroll
            for (int reg = 0; reg < 4; ++reg) { const int k2 = mt * 16 + 4 * fq + reg, oc = wave * 32 + nt * 16 + fr;
                F.CAT[((size_t)b * SEQ + k1 + 128 * k2) * DM + oc] = (bf16_t)f2bf(acc[mt][nt][reg]); }
}
constexpr int DC_H = 0, DC_F = 131072;
__device__ __forceinline__ void dctx_item(Frame& F, int layer, int it) {
    F.fresh();
    const int tid = F.tid, lane = F.lane, wave = F.wave, fr = lane & 15, fq = lane >> 4; LAS unsigned char* lds = F.lds; const bf16_t* P = F.PROJ;
    const int b = it >> 5, k0 = (it & 31) * 8;
    __syncthreads();
    { u32x4 v[16];
#pragma unroll
      for (int i = 0; i < 16; ++i) { const int e = tid + NTHR * i, row = e >> 5, ch = e & 31; v[i] = *(const u32x4*)(P + ((size_t)MLAT + b * CTXL + row) * PW + ch * 8); }
#pragma unroll
      for (int i = 0; i < 16; ++i) { const int e = tid + NTHR * i, row = e >> 5, ch = e & 31; *(LAS u32x4*)(lds + DC_H + row * 512 + ((ch ^ (row & 15)) << 4)) = v[i]; } }
    for (int e = tid; e < 16 * 132; e += NTHR) ((LAS unsigned*)(lds + DC_F))[e] = 0u;
    bf16x8 bfr[8];
    { const bf16_t* tb = F.TC256 + ((size_t)((fr >> 3) * 256 + k0 + (fr & 7))) * 256 + 8 * fq;
#pragma unroll
      for (int s = 0; s < 8; ++s) bfr[s] = *(const bf16x8*)(tb + 32 * s); }
    __syncthreads();
    const int g = wave >> 1, jj = wave & 1, q4 = (lane & 15) >> 2, p4 = lane & 3;
    f32x4 acc[2]; acc[0] = (f32x4){0.f, 0.f, 0.f, 0.f}; acc[1] = acc[0];
#pragma unroll
    for (int s = 0; s < 8; ++s)
#pragma unroll
        for (int mt = 0; mt < 2; ++mt) { const int chunk = 2 * (g * 4 + jj + 2 * mt) + (p4 >> 1); const int r0 = 32 * s + 8 * fq + q4;
            const bf16x4 lo = vtr((lptr)(lds + DC_H + r0 * 512 + ((chunk ^ (r0 & 15)) << 4) + 8 * (p4 & 1)));
            const bf16x4 hi = vtr((lptr)(lds + DC_H + (r0 + 4) * 512 + ((chunk ^ ((r0 + 4) & 15)) << 4) + 8 * (p4 & 1)));
            const bf16x8 av = {lo[0], lo[1], lo[2], lo[3], hi[0], hi[1], hi[2], hi[3]};
            acc[mt] = __builtin_amdgcn_mfma_f32_16x16x32_bf16(av, bfr[s], acc[mt], 0, 0, 0); }
    const int kk = fr & 7; const bool hiLane = fr >= 8;
#pragma unroll
    for (int reg = 0; reg < 4; ++reg) { const int pp = jj * 16 + 4 * fq + reg;
        const float vp = acc[0][reg], vq = acc[1][reg], op = __shfl_xor(vp, 8), oq = __shfl_xor(vq, 8);
        const float c_p = hiLane ? op : vp, c_q = hiLane ? oq : vq, s_q = hiLane ? vq : oq;
        float x; int m;
        if (pp == 0) { m = hiLane ? 32 : 0; x = hiLane ? c_q : c_p; } else { m = hiLane ? 64 - pp : pp; x = hiLane ? c_p - s_q : c_p + s_q; }
        *(LAS bf16_t*)(lds + DC_F + kk * 528 + (g * 64 + m) * 2) = (bf16_t)f2bf(x * (1.0f / 128.0f)); }
    __syncthreads();
    f32x4 o2[1][2]; zero_acc(o2);
    wave_mma<1, 2>(o2, (lptr)(lds + DC_F), 528, (gptr)(F.WFT + (size_t)layer * 65536) + (size_t)(wave * 32) * 512, 512, 8, fr, fq);
    if (fq < 2) {
#pragma unroll
        for (int nt = 0; nt < 2; ++nt)
#pragma unroll
            for (int reg = 0; reg < 4; ++reg) F.CAT[((size_t)MLAT + b * CTXL + k0 + 4 * fq + reg) * DM + wave * 32 + nt * 16 + fr] = (bf16_t)f2bf(o2[0][nt][reg]);
    }
}

#ifndef DUP_PHASE
#define DUP_PHASE 0
#endif
__device__ __forceinline__ void phase_m1(Frame& F, int layer) {
    const int nNA = 1536, nCQ = layer == 0 ? 48 : 0, nR1 = 528, nD1 = 512;
    for (int q = blockIdx.x; q < nR1; q += F.G) r1_unit(F, layer, q / 264, (q % 264) / 66, q % 66);
#pragma unroll 1
    for (int rep = 0; rep < (DUP_PHASE == 8 ? 2 : 1); ++rep)
        for (int q = blockIdx.x; q < nD1; q += F.G) d1_unit(F, q >> 8, (q >> 2) & 63, q & 3);
    na_units(F, layer, true, nCQ);
    na_units(F, layer, false, nNA, 0, 1);
}
__device__ __forceinline__ void phase_m2(Frame& F, int layer) {
    r2_scan(F, layer);
    const int nD2 = 256, nDC = layer == 0 ? 64 : 0;
    for (int it = blockIdx.x; it < nD2; it += F.G) d2_unit(F, layer, it >> 7, it & 127);
    for (int it = blockIdx.x; it < nDC; it += F.G) dctx_item(F, layer, it);
    F.prof = (layer == 1); na_units(F, layer, false, 1536, 1, 4); F.prof = false;
}
__device__ __forceinline__ void phase_m3(Frame& F, int layer) {
    F.prof = (layer == 1); r3_units(F, layer); F.prof = false;
    na_units(F, layer, false, 1536, 4, 6);
}

struct SgParams {
    const bf16_t* A; int lda; const bf16_t* Bt; int K;
    int mode;
    const float* ssq; const float* shw;
    bf16_t* O;
    const float* src; float* dst; bf16_t* XN; float* ssq_out; const float* gate; const float* sc; const float* g; float gmul;
};
constexpr int SG_A = 0, SG_B = 16384;
template <int NTW>
__device__ __forceinline__ void sg_unit(Frame& F, const SgParams& p, int mblk, int ntile) {
    F.fresh();
    constexpr int NB = NTW, BSTAGE = NTW * 8192, UW = 64 * NTW;
    const int tid = F.tid, lane = F.lane, wave = F.wave, fr = lane & 15, fq = lane >> 4, wr = wave & 1, wc = wave >> 1;
    LAS unsigned char* lds = F.lds;
    const int srow = tid >> 3, sch = tid & 7; const unsigned sdst = (unsigned)(srow * 128 + ((sch ^ (srow & 7)) << 4));
    const bf16_t* ap = p.A + (size_t)(mblk * 64 + srow) * p.lda + sch * 8;
    const bf16_t* bp = p.Bt + (size_t)(ntile * UW + srow) * p.K + sch * 8;
    int boff[NTW];
#pragma unroll
    for (int n = 0; n < NTW; ++n) boff[n] = NTW == 1 ? wc * 16 : (p.mode == 2 ? ((n >> 1) * 128 + wc * 32 + (n & 1) * 16) : (wc * 64 + n * 16));
    const int sw0 = (fq ^ (fr & 7)) << 4, sw1 = ((4 + fq) ^ (fr & 7)) << 4;
    f32x4 acc[2][NTW]; zero_acc(acc);
    const int nk = p.K / 64;
    u32x4 ra0, ra1, rb0[NB], rb1[NB];
#define SG_LOAD(RA, RB, kt) do { RA = *(const u32x4*)(ap + (kt) * 64); _Pragma("unroll") for (int i_ = 0; i_ < NB; ++i_) RB[i_] = *(const u32x4*)(bp + (size_t)(64 * i_) * p.K + (kt) * 64); } while (0)
#define SG_WRITE(RA, RB, buf) do { *(LAS u32x4*)(lds + SG_A + (buf) * 8192 + sdst) = RA; _Pragma("unroll") for (int i_ = 0; i_ < NB; ++i_) *(LAS u32x4*)(lds + SG_B + (buf) * BSTAGE + sdst + i_ * 8192) = RB[i_]; } while (0)
#define SG_MMA(buf) do { lptr Ab_ = (lptr)(lds + SG_A + (buf) * 8192 + (wr * 32 + fr) * 128), Bb_ = (lptr)(lds + SG_B + (buf) * BSTAGE + fr * 128); \
        _Pragma("unroll") for (int s_ = 0; s_ < 2; ++s_) { const int sw_ = s_ ? sw1 : sw0; bf16x8 a_[2], b_[NTW]; \
            _Pragma("unroll") for (int m_ = 0; m_ < 2; ++m_) a_[m_] = ld8(Ab_ + m_ * 16 * 128 + sw_); \
            _Pragma("unroll") for (int n_ = 0; n_ < NTW; ++n_) b_[n_] = ld8(Bb_ + boff[n_] * 128 + sw_); \
            _Pragma("unroll") for (int m_ = 0; m_ < 2; ++m_) _Pragma("unroll") for (int n_ = 0; n_ < NTW; ++n_) acc[m_][n_] = __builtin_amdgcn_mfma_f32_16x16x32_bf16(b_[n_], a_[m_], acc[m_][n_], 0, 0, 0); } } while (0)
    __syncthreads();
    SG_LOAD(ra0, rb0, 0); SG_LOAD(ra1, rb1, 1);
    SG_WRITE(ra0, rb0, 0);
    __syncthreads();
    for (int kt = 0; kt < nk; kt += 2) {
        if (kt + 2 < nk) SG_LOAD(ra0, rb0, kt + 2);
        SG_MMA(0);
        SG_WRITE(ra1, rb1, 1);
        __syncthreads();
        if (kt + 3 < nk) SG_LOAD(ra1, rb1, kt + 3);
        SG_MMA(1);
        if (kt + 2 < nk) SG_WRITE(ra0, rb0, 0);
        __syncthreads();
    }
#undef SG_LOAD
#undef SG_WRITE
#undef SG_MMA
    LAS float* red = (LAS float*)(lds + 98304);
#pragma unroll
    for (int m = 0; m < 2; ++m) { const int rl = mblk * 64 + wr * 32 + m * 16 + fr; const size_t rg = (size_t)MLAT + rl;
        if (p.mode == 0) { const float ri = pg8::row_rinv(p.ssq, (int)rg);
#pragma unroll
            for (int n = 0; n < NTW; ++n) { const int col = ntile * UW + boff[n] + 4 * fq; if (col < PW) { const f32x4 v = acc[m][n] * ri + *(const f32x4*)(p.shw + col);
                u32x2 w; w.x = pk2(v[0], v[1]); w.y = pk2(v[2], v[3]); *(u32x2*)(p.O + rg * PW + col) = w; } }
        } else if (p.mode == 2) { if constexpr (NTW == 4) { const float ri = pg8::row_rinv(p.ssq, (int)rg);
#pragma unroll
            for (int n = 0; n < 2; ++n) { const int wcol = ntile * 256 + boff[n] + 4 * fq, hcol = ntile * 128 + wc * 32 + n * 16 + 4 * fq;
                const f32x4 a = acc[m][n] * ri + *(const f32x4*)(p.shw + wcol), b = acc[m][n + 2] * ri + *(const f32x4*)(p.shw + wcol + 128);
                u32x2 w; w.x = pk2(silu_f(a[0]) * b[0], silu_f(a[1]) * b[1]); w.y = pk2(silu_f(a[2]) * b[2], silu_f(a[3]) * b[3]); *(u32x2*)(p.O + rg * FF + hcol) = w; } }
        } else { float ss = 0.f;
#pragma unroll
            for (int n = 0; n < NTW; ++n) { const int col = ntile * UW + boff[n] + 4 * fq; const size_t ol = (size_t)rl * DM + col;
                const f32x4 x1 = *(const f32x4*)(p.src + ol) + *(const f32x4*)(p.gate + col) * p.gmul * acc[m][n];
                *(f32x4*)(p.dst + ol) = x1; ss += (x1[0] * x1[0] + x1[1] * x1[1]) + (x1[2] * x1[2] + x1[3] * x1[3]);
                if (p.XN) { const f32x4 xn = x1 * (*(const f32x4*)(p.g + col) * (*(const f32x4*)(p.sc + col) + 1.0f)); u32x2 w; w.x = pk2(xn[0], xn[1]); w.y = pk2(xn[2], xn[3]); *(u32x2*)(p.XN + rg * DM + col) = w; } }
            ss += __shfl_xor(ss, 16); ss += __shfl_xor(ss, 32);
            if (NTW == 4) { if (fq == 0) p.ssq_out[rg * 16 + ntile * 4 + wc] = ss; }
            else { if (fq == 0) red[wc * 64 + wr * 32 + m * 16 + fr] = ss; } }
    }
    if (NTW == 1 && p.mode == 1) { __syncthreads(); if (tid < 64) p.ssq_out[((size_t)MLAT + mblk * 64 + tid) * 16 + ntile] = (red[tid] + red[64 + tid]) + (red[128 + tid] + red[192 + tid]); }
}
template <int NTW>
__device__ __forceinline__ void sg_phase(Frame& F, const SgParams& p, int ntiles, int big_units) {
    const int first_free = big_units % F.G, nfree = F.G - first_free, c = (int)blockIdx.x;
    if (c < first_free) return;
    for (int u = c - first_free; u < 8 * ntiles; u += nfree) sg_unit<NTW>(F, p, u % 8, u / 8);
}

#ifndef USE_COOP
#define USE_COOP 1
#endif
#ifndef MK_N_LAUNCHES
#define MK_N_LAUNCHES 1
#endif
constexpr int N_PHASES = 17;
struct Args { const float* in[18]; float* out; unsigned char* ws; int ph_lo, ph_hi; };
__global__ void __launch_bounds__(NTHR, 2) hymba_fwd(Args args) {
    extern __shared__ __attribute__((aligned(16))) unsigned char lds_raw[];
    Frame F;
    F.lds = (LAS unsigned char*)lds_raw;
    F.tid = threadIdx.x; F.lane = F.tid & 63; F.wave = __builtin_amdgcn_readfirstlane(F.tid >> 6);
    F.prof = false; F.G = gridDim.x; { const int bx = blockIdx.x; F.vcu = (F.G % 8 == 0) ? (bx % 8) * (F.G / 8) + bx / 8 : bx; }
    F.x = args.in[0]; F.c = args.in[1]; F.ctx = args.in[2]; F.c_ctx = args.in[3]; F.w_ada = args.in[4]; F.b_ada = args.in[5]; F.g_mix = args.in[6]; F.w_in = args.in[7];
    F.dlogit = args.in[8]; F.ret_g = args.in[9]; F.w_four = args.in[10]; F.rpb = args.in[11]; F.w_out = args.in[12]; F.g_ffn = args.in[13]; F.w1 = args.in[14]; F.w3 = args.in[15];
    F.w2 = args.in[16]; F.g_final = args.in[17]; F.out = args.out; F.ws = args.ws;
    unsigned char* ws = args.ws;
    F.MOD = (float*)(ws + WS_MOD); F.SHWIN = (float*)(ws + WS_SHWIN); F.SHW13 = (float*)(ws + WS_SHW13); F.ROPE = (float*)(ws + WS_ROPE); F.LG = (float*)(ws + WS_LG); F.CT256 = (float*)(ws + WS_CT256);
    F.SSQ = (float*)(ws + WS_SSQ); F.XC = (float*)(ws + WS_XC); F.STATE = (bf16_t*)(ws + WS_STATE); F.ADAP = (float*)(ws + WS_PROJ); F.TW8 = (const float*)(ws + WS_TAB + T_TW8);
    F.XN = (bf16_t*)(ws + WS_XN); F.CAT = (bf16_t*)(ws + WS_CAT); F.PROJ = (bf16_t*)(ws + WS_PROJ); F.HID = (bf16_t*)(ws + WS_PROJ);
    F.WFT = (bf16_t*)(ws + WS_TAB + T_WFT); F.TWA = (bf16_t*)(ws + WS_TAB + T_TWA); F.TD2 = (bf16_t*)(ws + WS_TAB + T_TD2); F.TC256 = (bf16_t*)(ws + WS_TAB + T_TC); F.Y = (unsigned*)(ws + WS_XN);
    volatile LAS unsigned* MISC = (volatile LAS unsigned*)(F.lds + MISC_OFF);
    if (F.tid < 64) MISC[F.tid] = 0u;
    __syncthreads();
    const int lo = args.ph_lo, hi = args.ph_hi;
#if MK_N_LAUNCHES == 1
    XcdBarrier bar = xcd_barrier_post((unsigned*)(ws + WS_CTL) + CW_BAR, MISC + 8);
    cg::grid_group grid = cg::this_grid();
#define SEAM(k) do { if (USE_COOP && args.ph_lo < 0) grid.sync();     \
    else { _Pragma("unroll 1") for (int rep_ = 0; rep_ < (DUP_PHASE == 19 ? 5 : 1); ++rep_) xcd_barrier(bar); } } while (0)
#else
#define SEAM(k) do { } while (0)
#endif
#define IN(k) (lo <= (k) && (k) < hi)
#ifndef STAMP_SEL
#define STAMP_SEL -1
#endif
    unsigned long long* stamps = (unsigned long long*)(ws + WS_CTL + 61440);
#define STAMP(k) do { if (STAMP_SEL >= 0 && blockIdx.x == 0 && threadIdx.x == 0) stamps[k] = __builtin_amdgcn_s_memrealtime(); } while (0)
    STAMP(0);
    if (IN(0)) { _Pragma("unroll 1") for (int rep = 0; rep < (DUP_PHASE == 5 ? 2 : 1); ++rep) { __syncthreads(); phase_p0a(F); } if (IN(1)) SEAM(0); } STAMP(1);
    if (IN(1)) { _Pragma("unroll 1") for (int rep = 0; rep < (DUP_PHASE == 21 ? 2 : 1); ++rep) { __syncthreads(); phase_p0b(F); } if (IN(2)) SEAM(1); } STAMP(2);
#pragma unroll 1
    for (int layer = 0; layer < 2; ++layer) {
        const int pb = 2 + 7 * layer; const bool last = layer == 1;
        const float* mod = F.MOD + (size_t)layer * 3 * 6144;
        if (IN(pb + 0)) {
            pg8::Gemm g{F.XN, F.W(layer, W_WIN), MLAT, PWP, DM}; pg8::StaticOrder S; S.init(MLAT, PWP, F.G, (int)blockIdx.x);
            pg8::EpiProj E{F.PROJ, F.SSQ, F.SHWIN + (size_t)layer * 3 * PWP};
            _Pragma("unroll 1") for (int rep = 0; rep < (DUP_PHASE == 1 ? 2 : 1); ++rep) { __syncthreads(); pg8::gemm_phase<pg8::EpiProj, pg8::StaticOrder, true, true>(F.lds, g, S, E); }
            { SgParams sp{}; sp.A = F.XN + (size_t)MLAT * DM; sp.lda = DM; sp.Bt = F.W(layer, W_WIN); sp.K = DM; sp.mode = 0; sp.ssq = F.SSQ; sp.shw = F.SHWIN + (size_t)(layer * 3 + 2) * PWP; sp.O = F.PROJ;
              _Pragma("unroll 1") for (int rep = 0; rep < (DUP_PHASE == 12 ? 3 : 1); ++rep) sg_phase<1>(F, sp, 46, 768); }
            if (IN(pb + 1)) SEAM(pb);
        }
        STAMP(pb + 1);
        if (IN(pb + 1)) { _Pragma("unroll 1") for (int rep = 0; rep < (DUP_PHASE == 2 ? 2 : 1); ++rep) phase_m1(F, layer); if (IN(pb + 2)) SEAM(pb + 1); } STAMP(pb + 2);
        if (IN(pb + 2)) { phase_m2(F, layer); if (IN(pb + 3)) SEAM(pb + 2); } STAMP(pb + 3);
        if (IN(pb + 3)) { _Pragma("unroll 1") for (int rep = 0; rep < (DUP_PHASE == 3 ? 2 : 1); ++rep) phase_m3(F, layer); if (IN(pb + 4)) SEAM(pb + 3); } STAMP(pb + 4);
        const int Mrows = MLAT;
        if (IN(pb + 4)) {
            pg8::Gemm g{F.CAT, F.W(layer, W_WOUT), Mrows, DM, DM}; pg8::StaticOrder S; S.init(Mrows, DM, F.G, (int)blockIdx.x);
            pg8::EpiRes E{last ? F.out : F.x, last ? F.XC : F.ctx, F.out, F.XC, F.XN, F.SSQ, mod + 2048, mod + 4096, F.g_ffn + layer * DM, 1.0f};
            _Pragma("unroll 1") for (int rep = 0; rep < (DUP_PHASE == 16 ? 2 : 1); ++rep) { E.gmul = (DUP_PHASE == 16 && rep == 0) ? 0.0f : 1.0f; if (DUP_PHASE == 16 && rep == 0) { E.src_lat = F.out; } else { E.src_lat = last ? F.out : F.x; } __syncthreads(); pg8::gemm_phase<pg8::EpiRes, pg8::StaticOrder, true, true>(F.lds, g, S, E); }
            if (!last) { SgParams sp{}; sp.A = F.CAT + (size_t)MLAT * DM; sp.lda = DM; sp.Bt = F.W(layer, W_WOUT); sp.K = DM; sp.mode = 1; sp.src = F.ctx; sp.dst = F.XC; sp.XN = F.XN; sp.ssq_out = F.SSQ;
              sp.gate = mod + 2048 + 2 * 6144; sp.sc = mod + 4096 + 2 * 6144; sp.g = F.g_ffn + layer * DM; sp.gmul = 1.0f; _Pragma("unroll 1") for (int rep = 0; rep < (DUP_PHASE == 13 ? 3 : 1); ++rep) sg_phase<1>(F, sp, 16, 256); }
            if (IN(pb + 5)) SEAM(pb + 4);
        }
        STAMP(pb + 5);
        if (IN(pb + 5)) {
            pg8::Gemm g{F.XN, F.W(layer, W_W13), Mrows, FF2, DM}; pg8::StaticOrder S; S.init(Mrows, FF2, F.G, (int)blockIdx.x);
            pg8::EpiSwiGLU E{F.HID, F.SSQ, F.SHW13 + (size_t)layer * 3 * FF2};
            _Pragma("unroll 1") for (int rep = 0; rep < (DUP_PHASE == 4 ? 2 : 1); ++rep) { __syncthreads(); pg8::gemm_phase<pg8::EpiSwiGLU, pg8::StaticOrder, true, true>(F.lds, g, S, E); }
            if (!last) { SgParams sp{}; sp.A = F.XN + (size_t)MLAT * DM; sp.lda = DM; sp.Bt = F.W(layer, W_W13); sp.K = DM; sp.mode = 2; sp.ssq = F.SSQ; sp.shw = F.SHW13 + (size_t)(layer * 3 + 2) * FF2; sp.O = F.HID;
              _Pragma("unroll 1") for (int rep = 0; rep < (DUP_PHASE == 14 ? 3 : 1); ++rep) sg_phase<4>(F, sp, 22, 1408); }
            if (IN(pb + 6)) SEAM(pb + 5);
        }
        STAMP(pb + 6);
        if (IN(pb + 6)) {
            pg8::Gemm g{F.HID, F.W(layer, W_W2), Mrows, DM, FF}; pg8::StaticOrder S; S.init(Mrows, DM, F.G, (int)blockIdx.x);
            pg8::EpiRes E{F.out, F.XC, F.out, F.XC, last ? nullptr : F.XN, F.SSQ, mod + 5120, F.MOD + 3 * 6144 + 1024, F.g_mix + DM, 1.0f};
            _Pragma("unroll 1") for (int rep = 0; rep < (DUP_PHASE == 17 ? 2 : 1); ++rep) { E.gmul = (DUP_PHASE == 17 && rep == 0) ? 0.0f : 1.0f; __syncthreads(); pg8::gemm_phase<pg8::EpiRes, pg8::StaticOrder, true, true>(F.lds, g, S, E); }
            if (!last) { SgParams sp{}; sp.A = F.HID + (size_t)MLAT * FF; sp.lda = FF; sp.Bt = F.W(layer, W_W2); sp.K = FF; sp.mode = 1; sp.src = F.XC; sp.dst = F.XC; sp.XN = F.XN; sp.ssq_out = F.SSQ;
              sp.gate = mod + 5120 + 2 * 6144; sp.sc = F.MOD + 3 * 6144 + 1024 + 2 * 6144; sp.g = F.g_mix + DM; _Pragma("unroll 1") for (int rep = 0; rep < (DUP_PHASE == 15 ? 3 : 1); ++rep) { sp.gmul = (DUP_PHASE == 15 && rep < 2) ? 0.0f : 1.0f; sg_phase<1>(F, sp, 16, 256); } }
            if (IN(pb + 7)) SEAM(pb + 6);
        }
        STAMP(pb + 7);
    }
    float delta = 0.f;
    if (STAMP_SEL >= 0) { const unsigned long long t0 = stamps[STAMP_SEL], t1 = stamps[STAMP_SEL + 1]; delta = sqrtf(1e-7f * 0.01f * (float)(t1 - t0)); }
    if (PROF_A >= 0) { const unsigned long long* us = (const unsigned long long*)(ws + WS_CTL + 61440 + 512); delta = sqrtf(1e-6f * 0.01f * (float)(us[PROF_A + 1] - us[PROF_A])); }
    if (PROF_B >= 0 && blockIdx.x == 0 && threadIdx.x == 0) { const unsigned long long* us = (const unsigned long long*)(ws + WS_CTL + 61440 + 512); const unsigned long long d = (us[PROF_B + 1] - us[PROF_B]) * 20ull, t0 = __builtin_amdgcn_s_memrealtime(); while (__builtin_amdgcn_s_memrealtime() - t0 < d) __builtin_amdgcn_s_sleep(8); }
    if (IN(16)) { if (DUP_PHASE == 23) phase_final(F, true); phase_final(F, false, delta); }
#undef IN
#undef SEAM
}

extern "C" void kernel_launch(void* const* d_in, const int* in_sizes, int n_in, void* d_out, int out_size, void* d_ws, size_t ws_size, hipStream_t stream) {
    static int grid = 0;
    if (grid == 0) {
        if (n_in != 18 || in_sizes[0] != MLAT * DM || out_size != MLAT * DM || ws_size < WS_END) {
            fprintf(stderr, "kernel_launch: built for 18 inputs, x/out of %d floats, >= %zu bytes of workspace; got n_in %d, in0 %d, out %d, ws %zu\n", MLAT * DM, (size_t)WS_END, n_in, n_in > 0 ? in_sizes[0] : -1, out_size, ws_size); grid = -1; return; }
        int dev = 0, cus = 0, per_cu = 0;
        if (hipGetDevice(&dev) != hipSuccess || hipDeviceGetAttribute(&cus, hipDeviceAttributeMultiprocessorCount, dev) != hipSuccess) { fprintf(stderr, "kernel_launch: device query failed\n"); grid = -1; return; }
        if (hipFuncSetAttribute((const void*)hymba_fwd, hipFuncAttributeMaxDynamicSharedMemorySize, LDS_BYTES) != hipSuccess) { fprintf(stderr, "kernel_launch: hipFuncSetAttribute failed\n"); grid = -1; return; }
        if (hipOccupancyMaxActiveBlocksPerMultiprocessor(&per_cu, (const void*)hymba_fwd, NTHR, LDS_BYTES) != hipSuccess || per_cu < 1) { fprintf(stderr, "kernel_launch: occupancy query says %d blocks per CU\n", per_cu); (void)hipGetLastError(); grid = -1; return; }
        grid = cus;
        fprintf(stderr, "kernel_launch: grid %d (cus %d, occupancy %d/CU), ws %zu\n", grid, cus, per_cu, ws_size);
    }
    if (grid < 0) return;
    if (hipMemsetAsync((char*)d_ws + WS_CTL, 0, CTL_ZERO_BYTES, stream) != hipSuccess) { fprintf(stderr, "kernel_launch: memset failed\n"); return; }
    Args a{};
    for (int i = 0; i < 18; ++i) a.in[i] = (const float*)d_in[i];
    a.out = (float*)d_out; a.ws = (unsigned char*)d_ws;
#if MK_N_LAUNCHES == 1
    a.ph_lo = 0; a.ph_hi = N_PHASES;
    void* kargs[] = {&a};
    if (DUP_PHASE == 30) { (void)hipLaunchCooperativeKernel((const void*)hymba_fwd, dim3(grid), dim3(NTHR), kargs, LDS_BYTES, stream); (void)hipMemsetAsync((char*)d_ws + WS_CTL, 0, CTL_ZERO_BYTES, stream); }
    hipError_t le = hipSuccess;
    if (USE_COOP) le = hipLaunchCooperativeKernel((const void*)hymba_fwd, dim3(grid), dim3(NTHR), kargs, LDS_BYTES, stream);
    else { hipLaunchKernelGGL(hymba_fwd, dim3(grid), dim3(NTHR), LDS_BYTES, stream, a); le = hipPeekAtLastError(); }
    if (le != hipSuccess) fprintf(stderr, "kernel_launch: cooperative launch failed: %s (grid %d)\n", hipGetErrorString(le), grid);
#else
    for (int p = 0; p < N_PHASES; ++p) { a.ph_lo = p; a.ph_hi = p + 1; hipLaunchKernelGGL(hymba_fwd, dim3(grid), dim3(NTHR), LDS_BYTES, stream, a); }
#endif
}
```

```cpp
#include <hip/hip_runtime.h>
#include <hip/hip_cooperative_groups.h>
#include <cstdio>
#include <cstdint>
namespace cg = cooperative_groups;

#define LAS __attribute__((address_space(3)))
#define GAS __attribute__((address_space(1)))
typedef unsigned short bf16_t;
typedef short bf16x8 __attribute__((ext_vector_type(8)));
typedef short bf16x4 __attribute__((ext_vector_type(4)));
typedef float f32x4 __attribute__((ext_vector_type(4)));
typedef float f32x2 __attribute__((ext_vector_type(2)));
typedef unsigned u32x4 __attribute__((ext_vector_type(4)));
typedef unsigned u32x2 __attribute__((ext_vector_type(2)));

typedef __bf16 hwbf16x2 __attribute__((ext_vector_type(2)));
__device__ __forceinline__ unsigned pk2(float lo, float hi) { const f32x2 v = {lo, hi}; return __builtin_bit_cast(unsigned, __builtin_convertvector(v, hwbf16x2)); }
__device__ __forceinline__ unsigned f2bf(float f) { return pk2(f, f) & 0xffffu; }
__device__ __forceinline__ float bf2f(unsigned h) { return __builtin_bit_cast(float, h << 16); }
__device__ __forceinline__ float bflo(unsigned w) { return __builtin_bit_cast(float, w << 16); }
__device__ __forceinline__ float bfhi(unsigned w) { return __builtin_bit_cast(float, w & 0xffff0000u); }
__device__ __forceinline__ float silu_f(float a) { return a * __builtin_amdgcn_rcpf(1.0f + __expf(-a)); }

constexpr int NB = 2, SEQ = 8192, DM = 1024, CTXL = 256, MLAT = NB * SEQ, MCTX = NB * CTXL, MTOT = MLAT + MCTX;
constexpr int PW = 2944, PWP = 3072, FF = 2816, FF2 = 5632;
constexpr int C_RQ = 256, C_RK = 640, C_RV = 1024, C_RG = 1408, C_NQ = 1792, C_NK = 2176, C_NV = 2560;
constexpr float NORM_EPS = 1e-6f;

namespace pg8 {
#define PG8_LAS __attribute__((address_space(3)))
constexpr int BM = 256, BK = 64, HALF = 128, HTB = HALF * BK * 2, STAGE_BYTES = 8 * HTB, NXCD = 8, WGM = 8;
__host__ __device__ __forceinline__ int lds_byte(int r, int c) { const int st = (r >> 4) * 2 + (c >> 5), rr = r & 15, cc = c & 31, ob = rr * 64 + cc * 2; return st * 1024 + (ob ^ (((ob >> 9) & 1) << 5)); }
__host__ __device__ __forceinline__ void stage_rc(int b, int& R, int& C) { const int st = b / 1024, sb = b % 1024, swz = sb ^ (((sb >> 9) & 1) << 5); R = (st >> 1) * 16 + swz / 64; C = (st & 1) * 32 + (swz % 64) / 2; }
__host__ __device__ __forceinline__ int perm32(int rho) { const int n = rho >> 4, i = rho & 15; return 8 * (i >> 2) + 4 * n + (i & 3); }
struct Unit { int pm, pn; };
struct Gemm { const bf16_t* A; const bf16_t* Bt; int M, N, K; };
struct StaticOrder {
    int nM, nN, nwg, G, c;
    __host__ __device__ void init(int M, int N, int G_, int c_) { nM = M / BM; nN = N / BM; nwg = nM * nN; G = G_; c = c_; }
    __host__ __device__ bool next(int i, Unit& u) const {
        const long L = (long)i * G + c; if (L >= nwg) return false;
        int wgid = (int)L; { const int q = nwg / NXCD, r = nwg % NXCD, xcd = wgid % NXCD, off = wgid / NXCD; wgid = (xcd < r ? xcd * (q + 1) : r * (q + 1) + (xcd - r) * q) + off; }
        const int nig = WGM * nN, gid = wgid / nig, fm = gid * WGM, gsz = (nM - fm) < WGM ? (nM - fm) : WGM;
        u.pm = fm + ((wgid % nig) % gsz); u.pn = (wgid % nig) / gsz; return true;
    }
    __device__ __forceinline__ void a_ready(const Unit&) const {}
    __device__ __forceinline__ void done(const Unit&) const {}
};
__device__ __forceinline__ unsigned cvt_pk_bf16(float lo, float hi) { unsigned r; asm volatile("v_cvt_pk_bf16_f32 %0, %1, %2" : "=v"(r) : "v"(lo), "v"(hi)); return r; }

__device__ __forceinline__ float row_rinv(const float* ssq, int row) {
    const f32x4* p = (const f32x4*)(ssq + (size_t)row * 16);
    const f32x4 a = p[0], b = p[1], c = p[2], d = p[3];
    const float s = (((a[0] + a[1]) + (a[2] + a[3])) + ((b[0] + b[1]) + (b[2] + b[3]))) + (((c[0] + c[1]) + (c[2] + c[3])) + ((d[0] + d[1]) + (d[2] + d[3])));
    return rsqrtf(s * (1.0f / 1024.0f) + NORM_EPS);
}
__device__ __forceinline__ int row_set(int pm) { return pm < 32 ? 0 : (pm < 64 ? 1 : 2); }

struct EpiProj {
    static constexpr bool PERM = true, AFTER_DRAIN = false;
    bf16_t* O; const float* ssq; const float* shw;
    __device__ __forceinline__ void operator()(const f32x4 (&acc)[2][2][4][2], const Unit& u, int wr, int wc, int fr, int fq) const {
        const int row0 = u.pm * BM + wr * 64 + fr, col0 = u.pn * BM + wc * 32 + 8 * fq; const int set = row_set(u.pm);
        f32x4 bv[2][2];
#pragma unroll
        for (int bj = 0; bj < 2; ++bj)
#pragma unroll
            for (int n = 0; n < 2; ++n) bv[bj][n] = *(const f32x4*)(shw + set * PWP + col0 + bj * HALF + 4 * n);
#pragma unroll
        for (int ai = 0; ai < 2; ++ai)
#pragma unroll
            for (int m = 0; m < 4; ++m) { const int r = row0 + ai * HALF + m * 16; const float ri = row_rinv(ssq, r); bf16_t* rowp = O + (size_t)r * PW + col0;
#pragma unroll
                for (int bj = 0; bj < 2; ++bj) { if (col0 + bj * HALF < PW) { const f32x4 v0 = acc[ai][bj][m][0] * ri + bv[bj][0], v1 = acc[ai][bj][m][1] * ri + bv[bj][1];
                    u32x4 w; w.x = cvt_pk_bf16(v0[0], v0[1]); w.y = cvt_pk_bf16(v0[2], v0[3]); w.z = cvt_pk_bf16(v1[0], v1[1]); w.w = cvt_pk_bf16(v1[2], v1[3]);
                    *(u32x4*)(rowp + bj * HALF) = w; } } }
    }
};
struct EpiSwiGLU {
    static constexpr bool PERM = true, AFTER_DRAIN = false;
    bf16_t* O; const float* ssq; const float* shw;
    __device__ __forceinline__ void operator()(const f32x4 (&acc)[2][2][4][2], const Unit& u, int wr, int wc, int fr, int fq) const {
        const int row0 = u.pm * BM + wr * 64 + fr, col0 = u.pn * BM + wc * 32 + 8 * fq, ocol = u.pn * HALF + wc * 32 + 8 * fq; const int set = row_set(u.pm);
        f32x4 ba[2], bb[2];
#pragma unroll
        for (int n = 0; n < 2; ++n) { ba[n] = *(const f32x4*)(shw + set * FF2 + col0 + 4 * n); bb[n] = *(const f32x4*)(shw + set * FF2 + col0 + HALF + 4 * n); }
#pragma unroll
        for (int ai = 0; ai < 2; ++ai)
#pragma unroll
            for (int m = 0; m < 4; ++m) { const int r = row0 + ai * HALF + m * 16; const float ri = row_rinv(ssq, r);
                float hv[8];
#pragma unroll
                for (int n = 0; n < 2; ++n) { const f32x4 a = acc[ai][0][m][n] * ri + ba[n], b = acc[ai][1][m][n] * ri + bb[n];
#pragma unroll
                    for (int e = 0; e < 4; ++e) hv[4 * n + e] = silu_f(a[e]) * b[e]; }
                u32x4 w; w.x = cvt_pk_bf16(hv[0], hv[1]); w.y = cvt_pk_bf16(hv[2], hv[3]); w.z = cvt_pk_bf16(hv[4], hv[5]); w.w = cvt_pk_bf16(hv[6], hv[7]);
                *(u32x4*)(O + (size_t)r * FF + ocol) = w; }
    }
};
struct EpiRes {
    static constexpr bool PERM = false, AFTER_DRAIN = false;
    const float* src_lat; const float* src_ctx; float* dst_lat; float* dst_ctx; bf16_t* XN; float* ssq; const float* gate; const float* sc; const float* g; float gmul;
    __device__ __forceinline__ void operator()(const f32x4 (&acc)[2][2][4][2], const Unit& u, int wr, int wc, int fr, int fq) const {
        const bool lat = u.pm < 64; const int set = row_set(u.pm);
        const int rg0 = u.pm * BM + wr * 64 + fr, rl0 = (lat ? u.pm : u.pm - 64) * BM + wr * 64 + fr;
        const float* src = lat ? src_lat : src_ctx; float* dst = lat ? dst_lat : dst_ctx;
        const int col0 = u.pn * BM + wc * 32 + 4 * fq;
        float ss[2][4];
#pragma unroll
        for (int ai = 0; ai < 2; ++ai)
#pragma unroll
            for (int m = 0; m < 4; ++m) ss[ai][m] = 0.f;
#pragma unroll
        for (int bj = 0; bj < 2; ++bj)
#pragma unroll
            for (int n = 0; n < 2; ++n) { const int c = col0 + bj * HALF + n * 16;
                const f32x4 ga = *(const f32x4*)(gate + set * 6144 + c) * gmul; f32x4 gs = {0.f, 0.f, 0.f, 0.f};
                if (XN) { const f32x4 s4 = *(const f32x4*)(sc + set * 6144 + c), g4 = *(const f32x4*)(g + c); gs = g4 * (s4 + 1.0f); }
#pragma unroll
                for (int ai = 0; ai < 2; ++ai)
#pragma unroll
                    for (int m = 0; m < 4; ++m) { const size_t ol = (size_t)(rl0 + ai * HALF + m * 16) * DM + c, og = (size_t)(rg0 + ai * HALF + m * 16) * DM + c;
                        const f32x4 x1 = *(const f32x4*)(src + ol) + ga * acc[ai][bj][m][n];
                        *(f32x4*)(dst + ol) = x1; ss[ai][m] += (x1[0] * x1[0] + x1[1] * x1[1]) + (x1[2] * x1[2] + x1[3] * x1[3]);
                        if (XN) { const f32x4 xn = x1 * gs; u32x2 w; w.x = cvt_pk_bf16(xn[0], xn[1]); w.y = cvt_pk_bf16(xn[2], xn[3]); *(u32x2*)(XN + og) = w; } } }
#pragma unroll
        for (int ai = 0; ai < 2; ++ai)
#pragma unroll
            for (int m = 0; m < 4; ++m) { float s = ss[ai][m]; s += __shfl_xor(s, 16); s += __shfl_xor(s, 32);
                if (fq == 0) ssq[(size_t)(rg0 + ai * HALF + m * 16) * 16 + u.pn * 4 + wc] = s; }
    }
};
struct EpiResWide {
    static constexpr bool PERM = false, AFTER_DRAIN = true;
    const float* src_lat; float* dst_lat; bf16_t* XN; float* ssq; const float* gate; const float* sc; const float* g; float gmul;
    __device__ __forceinline__ void fused(f32x4 (&acc)[2][2][4][2], const Unit& u, int wr, int wc, int fr, int fq, PG8_LAS unsigned char* lds, int wid, int lane) const {
        constexpr int ROWB = 1024 + 16;
        const int set = row_set(u.pm), col = u.pn * BM + 4 * lane;
        const f32x4 ga = *(const f32x4*)(gate + set * 6144 + col) * gmul; f32x4 gs = {0.f, 0.f, 0.f, 0.f};
        if (XN) gs = *(const f32x4*)(g + col) * (*(const f32x4*)(sc + set * 6144 + col) + 1.0f);
#pragma unroll 1
        for (int ai = 0; ai < 2; ++ai) {
            f32x4 xs[16];
            const size_t grow0 = (size_t)u.pm * BM + ai * HALF + wid;
#pragma unroll
            for (int i = 0; i < 16; ++i) xs[i] = *(const f32x4*)(src_lat + (grow0 + 8 * i) * DM + col);
            asm volatile("s_waitcnt lgkmcnt(0)" ::: "memory"); __builtin_amdgcn_s_barrier(); asm volatile("" ::: "memory");
#pragma unroll
            for (int bj = 0; bj < 2; ++bj)
#pragma unroll
                for (int m = 0; m < 4; ++m)
#pragma unroll
                    for (int n = 0; n < 2; ++n) *(PG8_LAS f32x4*)(lds + (wr * 64 + m * 16 + fr) * ROWB + (bj * HALF + wc * 32 + n * 16 + 4 * fq) * 4) = ai == 0 ? acc[0][bj][m][n] : acc[1][bj][m][n];
            asm volatile("s_waitcnt lgkmcnt(0)" ::: "memory"); __builtin_amdgcn_s_barrier(); asm volatile("" ::: "memory");
#pragma unroll
            for (int i = 0; i < 16; ++i) { const size_t grow = grow0 + 8 * i; const f32x4 v = *(const PG8_LAS f32x4*)(lds + (wid + 8 * i) * ROWB + lane * 16);
                const f32x4 x1 = xs[i] + ga * v; *(f32x4*)(dst_lat + grow * DM + col) = x1;
                float ss = (x1[0] * x1[0] + x1[1] * x1[1]) + (x1[2] * x1[2] + x1[3] * x1[3]);
                if (XN) { const f32x4 xn = x1 * gs; u32x2 w; w.x = cvt_pk_bf16(xn[0], xn[1]); w.y = cvt_pk_bf16(xn[2], xn[3]); *(u32x2*)(XN + grow * DM + col) = w; }
#pragma unroll
                for (int o = 1; o < 64; o <<= 1) ss += __shfl_xor(ss, o);
                if (lane == 0) *(f32x4*)(ssq + grow * 16 + u.pn * 4) = (f32x4){ss, 0.f, 0.f, 0.f}; }
        }
    }
};

template <class Epi, class Sched, bool ALIGN_EPI = false, bool SP2 = false>
__device__ __forceinline__ void gemm_phase(PG8_LAS unsigned char* lds, const Gemm g, const Sched& S, const Epi& E) {
    int tid_ = threadIdx.x; asm volatile("" : "+v"(tid_));
    const int tid = tid_, wid = __builtin_amdgcn_readfirstlane(tid >> 6), lane = tid & 63, wr = wid >> 2, wc = wid & 3, fr = lane & 15, fq = lane >> 4;
    const int K = g.K, nt = K / BK;
    unsigned voffA[2], voffB[2];
#pragma unroll
    for (int i = 0; i < 2; ++i) { int R, C; stage_rc(tid * 16 + i * 8192, R, C); const int Rb = Epi::PERM ? ((R & ~31) + perm32(R & 31)) : R;
        voffA[i] = (unsigned)(R * K + C) * 2u; voffB[i] = (unsigned)(Rb * K + C) * 2u; }
    const size_t kstep = (size_t)(BK * 2);
    const size_t hstep = (size_t)HALF * K * 2;
    const size_t tstep = 2 * hstep;
    const unsigned ldsw = (unsigned)wid * 1024u;
    const int aoff = lds_byte(wr * 64 + fr, fq * 8), boff = lds_byte(wc * 32 + fr, fq * 8);
#define PG8_SA(b, h) (((b) * 2 + (h)) * HTB)
#define PG8_SB(b, h) ((4 + (b) * 2 + (h)) * HTB)
#define PG8_STAGE(bufoff, gbase, voff) do { _Pragma("unroll") for (int _i = 0; _i < 2; ++_i) \
        __builtin_amdgcn_global_load_lds((const unsigned*)((const char*)(gbase) + (voff)[_i]), (PG8_LAS unsigned*)(lds + (bufoff) + ldsw + _i * 8192), 16, 0, 0); } while (0)
#define PG8_LDA(dst, b, h) do { _Pragma("unroll") for (int m = 0; m < 4; ++m) _Pragma("unroll") for (int k = 0; k < 2; ++k) dst[m][k] = *(const PG8_LAS bf16x8*)(lds + PG8_SA(b, h) + aoff + m * 2048 + k * 1024); } while (0)
#define PG8_LDB(dst, b, h) do { _Pragma("unroll") for (int n = 0; n < 2; ++n) _Pragma("unroll") for (int k = 0; k < 2; ++k) dst[n][k] = *(const PG8_LAS bf16x8*)(lds + PG8_SB(b, h) + boff + n * 2048 + k * 1024); } while (0)
#define PG8_MMA(ai, bj, At, Bt) do { __builtin_amdgcn_s_setprio(1); _Pragma("unroll") for (int m = 0; m < 4; ++m) _Pragma("unroll") for (int n = 0; n < 2; ++n) _Pragma("unroll") for (int k = 0; k < 2; ++k) \
        acc[ai][bj][m][n] = __builtin_amdgcn_mfma_f32_16x16x32_bf16(Bt[n][k], At[m][k], acc[ai][bj][m][n], 0, 0, 0); __builtin_amdgcn_s_setprio(0); } while (0)
#define PG8_WAIT_V(n) asm volatile("s_waitcnt vmcnt(" #n ")" ::: "memory")
#define PG8_WAIT_L(n) asm volatile("s_waitcnt lgkmcnt(" #n ")" ::: "memory")
#define PG8_BAR __builtin_amdgcn_s_barrier()
#define PG8_SCHED __builtin_amdgcn_sched_barrier(0)
    Unit cur, nxt; int ui = 0;
    if (!S.next(0, cur)) return;
    f32x4 acc[2][2][4][2];
#pragma unroll
    for (int a = 0; a < 2; ++a)
#pragma unroll
        for (int b = 0; b < 2; ++b)
#pragma unroll
            for (int m = 0; m < 4; ++m)
#pragma unroll
                for (int n = 0; n < 2; ++n) acc[a][b][m][n] = (f32x4){0.f, 0.f, 0.f, 0.f};
    bf16x8 At[4][2], B0[2][2], B1[2][2];
    const char* cA = (const char*)g.A + (size_t)cur.pm * tstep; const char* cB = (const char*)g.Bt + (size_t)cur.pn * tstep;
    S.a_ready(cur);
    if constexpr (SP2) {
        PG8_STAGE(PG8_SB(0, 0), cB, voffB); PG8_STAGE(PG8_SB(0, 1), cB + hstep, voffB); PG8_STAGE(PG8_SA(0, 0), cA, voffA); PG8_STAGE(PG8_SA(0, 1), cA + hstep, voffA);
        if (wr == 1) PG8_BAR;
        PG8_WAIT_V(2); PG8_BAR;
        PG8_STAGE(PG8_SB(1, 0), cB + kstep, voffB); PG8_STAGE(PG8_SA(1, 0), cA + kstep, voffA); PG8_STAGE(PG8_SB(1, 1), cB + hstep + kstep, voffB);
        PG8_WAIT_V(6); PG8_BAR;
    } else {
        PG8_STAGE(PG8_SB(0, 0), cB, voffB); PG8_STAGE(PG8_SA(0, 0), cA, voffA); PG8_STAGE(PG8_SB(0, 1), cB + hstep, voffB); PG8_STAGE(PG8_SA(0, 1), cA + hstep, voffA);
        if (wr == 1) PG8_BAR;
        PG8_WAIT_V(4); PG8_BAR;
        PG8_STAGE(PG8_SB(1, 0), cB + kstep, voffB); PG8_STAGE(PG8_SA(1, 0), cA + kstep, voffA); PG8_STAGE(PG8_SB(1, 1), cB + hstep + kstep, voffB);
        PG8_WAIT_V(6); PG8_BAR;
    }
    for (;;) {
        const bool has_next = S.next(ui + 1, nxt);
        const char* nA = has_next ? (const char*)g.A + (size_t)nxt.pm * tstep : cA; const char* nB = has_next ? (const char*)g.Bt + (size_t)nxt.pn * tstep : cB;
        for (int t = 0; t < nt; t += 2) {
            const bool last = (t == nt - 2);
            const char* a1 = cA + (size_t)(t + 1) * kstep;
            const char* a2 = last ? nA : cA + (size_t)(t + 2) * kstep; const char* b2 = last ? nB : cB + (size_t)(t + 2) * kstep;
            const char* a3 = a2 + kstep; const char* b3 = b2 + kstep;
            if (last && has_next) S.a_ready(nxt);
            if constexpr (SP2) {
            PG8_LDB(B0, 0, 0); PG8_LDB(B1, 0, 1); PG8_SCHED; PG8_LDA(At, 0, 0); PG8_STAGE(PG8_SA(1, 1), a1 + hstep, voffA);
            PG8_WAIT_V(8); PG8_WAIT_L(0); PG8_BAR; PG8_MMA(0, 0, At, B0); PG8_MMA(0, 1, At, B1); PG8_BAR; PG8_SCHED;
            PG8_LDA(At, 0, 1); PG8_STAGE(PG8_SB(0, 0), b2, voffB); PG8_STAGE(PG8_SB(0, 1), b2 + hstep, voffB); PG8_STAGE(PG8_SA(0, 0), a2, voffA);
            PG8_WAIT_V(8); PG8_WAIT_L(0); PG8_BAR; PG8_MMA(1, 0, At, B0); PG8_MMA(1, 1, At, B1); PG8_BAR; PG8_SCHED;
            PG8_LDB(B0, 1, 0); PG8_LDB(B1, 1, 1); PG8_SCHED; PG8_LDA(At, 1, 0); PG8_STAGE(PG8_SA(0, 1), a2 + hstep, voffA);
            PG8_WAIT_V(8); PG8_WAIT_L(0); PG8_BAR; PG8_MMA(0, 0, At, B0); PG8_MMA(0, 1, At, B1); PG8_BAR; PG8_SCHED;
            PG8_LDA(At, 1, 1); PG8_STAGE(PG8_SB(1, 0), b3, voffB); PG8_STAGE(PG8_SB(1, 1), b3 + hstep, voffB); PG8_STAGE(PG8_SA(1, 0), a3, voffA);
            PG8_WAIT_V(8); PG8_WAIT_L(0); PG8_BAR; PG8_MMA(1, 0, At, B0); PG8_MMA(1, 1, At, B1); PG8_BAR; PG8_SCHED;
            } else {
            PG8_LDB(B0, 0, 0); PG8_SCHED; PG8_LDA(At, 0, 0); PG8_STAGE(PG8_SA(1, 1), a1 + hstep, voffA);
            PG8_WAIT_L(8); PG8_BAR; PG8_WAIT_L(0); PG8_MMA(0, 0, At, B0); PG8_BAR; PG8_SCHED;
            PG8_LDB(B1, 0, 1); PG8_STAGE(PG8_SB(0, 0), b2, voffB);
            PG8_BAR; PG8_WAIT_L(0); PG8_MMA(0, 1, At, B1); PG8_BAR;
            PG8_LDA(At, 0, 1); PG8_STAGE(PG8_SA(0, 0), a2, voffA);
            PG8_BAR; PG8_WAIT_L(0); PG8_MMA(1, 0, At, B0); PG8_BAR; PG8_SCHED;
            PG8_STAGE(PG8_SB(0, 1), b2 + hstep, voffB);
            PG8_WAIT_V(6); PG8_BAR; PG8_MMA(1, 1, At, B1); PG8_BAR;
            PG8_LDB(B0, 1, 0); PG8_SCHED; PG8_LDA(At, 1, 0); PG8_STAGE(PG8_SA(0, 1), a2 + hstep, voffA);
            PG8_WAIT_L(8); PG8_BAR; PG8_WAIT_L(0); PG8_MMA(0, 0, At, B0); PG8_BAR; PG8_SCHED;
            PG8_LDB(B1, 1, 1); PG8_STAGE(PG8_SB(1, 0), b3, voffB);
            PG8_BAR; PG8_WAIT_L(0); PG8_MMA(0, 1, At, B1); PG8_BAR;
            PG8_LDA(At, 1, 1); PG8_STAGE(PG8_SA(1, 0), a3, voffA);
            PG8_BAR; PG8_WAIT_L(0); PG8_MMA(1, 0, At, B0); PG8_BAR; PG8_SCHED;
            PG8_STAGE(PG8_SB(1, 1), b3 + hstep, voffB);
            PG8_WAIT_V(6); PG8_BAR; PG8_MMA(1, 1, At, B1); PG8_BAR;
            }
        }
        if constexpr (ALIGN_EPI) { if (wr == 0) PG8_BAR; }
        if constexpr (!Epi::AFTER_DRAIN) { E(acc, cur, wr, wc, fr, fq); S.done(cur); }
        if (!has_next) break;
#pragma unroll
        for (int a = 0; a < 2; ++a)
#pragma unroll
            for (int b = 0; b < 2; ++b)
#pragma unroll
                for (int m = 0; m < 4; ++m)
#pragma unroll
                    for (int n = 0; n < 2; ++n) acc[a][b][m][n] = (f32x4){0.f, 0.f, 0.f, 0.f};
        cur = nxt; cA = nA; cB = nB; ++ui;
        if constexpr (ALIGN_EPI) { if (wr == 1) PG8_BAR; }
    }
    PG8_WAIT_V(0);
    if constexpr (!ALIGN_EPI) { if (wr == 0) PG8_BAR; }
    PG8_BAR;
    if constexpr (Epi::AFTER_DRAIN) { E.fused(acc, cur, wr, wc, fr, fq, lds, wid, lane); S.done(cur); }
#undef PG8_SA
#undef PG8_SB
#undef PG8_STAGE
#undef PG8_LDA
#undef PG8_LDB
#undef PG8_MMA
#undef PG8_WAIT_V
#undef PG8_WAIT_L
#undef PG8_BAR
#undef PG8_SCHED
}
}

constexpr int NWAVES = 8, NTHR = 512;
constexpr size_t MiB = 1u << 20;
constexpr size_t WS_CTL = 0, CTL_ZERO_BYTES = 64 * 1024;
constexpr size_t WS_MOD = 1 * MiB;
constexpr size_t WS_SHWIN = WS_MOD + 2 * 3 * 6144 * 4;
constexpr size_t WS_SHW13 = WS_SHWIN + 2 * 3 * PWP * 4;
constexpr size_t WS_ROPE = WS_SHW13 + 2 * 3 * FF2 * 4;
constexpr size_t WS_LG = WS_ROPE + (128 + 64) * 24 * 2 * 4;
constexpr size_t WS_CT256 = WS_LG + 256;
constexpr size_t WS_SSQ = 2 * MiB;
constexpr size_t WS_XC = 4 * MiB;
constexpr size_t WS_W = 6 * MiB;
constexpr size_t W_WIN = 0, W_WOUT = (size_t)PWP * DM * 2, W_W13 = W_WOUT + (size_t)DM * DM * 2, W_W2 = W_W13 + (size_t)FF2 * DM * 2, W_LAYER = W_W2 + (size_t)DM * FF * 2;
static_assert(W_LAYER * 2 == 49 * MiB, "weight region");
constexpr size_t WS_TAB = 55 * MiB;
constexpr size_t T_WFT = 0, T_TWA = 2 * 256 * 256 * 2, T_TD2 = T_TWA + 256 * 256 * 2, T_TW8 = T_TD2 + 64 * 128 * 2, T_TC = T_TW8 + 65536;
constexpr size_t WS_XN = 56 * MiB;
constexpr size_t WS_CAT = 89 * MiB;
constexpr size_t WS_PROJ = 122 * MiB;
constexpr size_t WS_STATE = 217 * MiB;
constexpr size_t WS_END = WS_STATE + (size_t)16 * 66 * 9216 * 2;
static_assert(WS_END <= 256 * MiB && WS_PROJ + (size_t)MTOT * PW * 2 <= WS_STATE && WS_CAT + (size_t)MTOT * DM * 2 <= WS_PROJ && WS_XN + (size_t)MTOT * DM * 2 <= WS_CAT, "d_ws map");
static_assert(WS_CT256 + 2048 <= WS_SSQ && WS_SSQ + (size_t)MTOT * 64 <= WS_XC && WS_TAB + T_TC + 262144 <= WS_XN, "d_ws map (small)");
constexpr int CW_BAR = 1024;
constexpr int LDS_BYTES = 163840, MISC_OFF = LDS_BYTES - 256;

#define RLX_AGENT __ATOMIC_RELAXED, __HIP_MEMORY_SCOPE_AGENT
#define XB_TMO      128
#define XB_XCNT(j)  (256  + 64 * (j))
#define XB_XSUB(j)  (1280 + 64 * (j))
#define XB_XGEN(j)  (2304 + 64 * (j))
#define XB_TOP      3328
#define XB_TOPGEN   3392
#define XCD_BAR_WORDS 3456
#define XB_SPIN_CAP (1u << 18)
static_assert((CW_BAR + XCD_BAR_WORDS) * 4 <= (int)CTL_ZERO_BYTES, "barrier words inside the memset region");
__device__ __forceinline__ unsigned xb_ld(unsigned* p)              { return __hip_atomic_load(p, __ATOMIC_RELAXED, __HIP_MEMORY_SCOPE_AGENT); }
__device__ __forceinline__ unsigned xb_add(unsigned* p, unsigned v) { return __hip_atomic_fetch_add(p, v, __ATOMIC_RELAXED, __HIP_MEMORY_SCOPE_AGENT); }
__device__ __forceinline__ unsigned xb_xcc_id() { return (unsigned)__builtin_amdgcn_s_getreg((3 << 11) | 20) & 0xFu; }
#define XB_SPIN(cond, bar) do { unsigned _sp = 0; while (cond) { __builtin_amdgcn_s_sleep(1); \
    if ((++_sp & 255u) == 0u) { if (xb_ld(&(bar)[XB_TMO])) break; if (_sp > XB_SPIN_CAP) { atomicAdd(&(bar)[XB_TMO], 1u); break; } } } } while (0)
struct XcdBarrier { unsigned* bar; unsigned x; volatile LAS unsigned* st; };
__device__ __forceinline__ XcdBarrier xcd_barrier_post(unsigned* bar, volatile LAS unsigned* st) {
    XcdBarrier b; b.bar = bar; b.x = xb_xcc_id(); b.st = st;
    if (threadIdx.x == 0) (void)xb_add(&bar[XB_XCNT(b.x)], 1u);
    return b;
}
__device__ __forceinline__ void xcd_barrier_complete(unsigned* bar, unsigned x, unsigned& nloc, unsigned& nx) {
    const unsigned G = gridDim.x * gridDim.y * gridDim.z;
    unsigned sum, cnt, mine, sp = 0u;
    for (;;) {
        sum = 0u; cnt = 0u; mine = 0u;
#pragma unroll
        for (unsigned j = 0; j < 16; ++j) { const unsigned c = xb_ld(&bar[XB_XCNT(j)]); sum += c; cnt += (c > 0u) ? 1u : 0u; mine = (j == x) ? c : mine; }
        if (sum == G) break;
        __builtin_amdgcn_s_sleep(1);
        if ((++sp & 255u) == 0u) { if (xb_ld(&bar[XB_TMO])) break; if (sp > XB_SPIN_CAP) { atomicAdd(&bar[XB_TMO], 1u); break; } }
    }
    nloc = mine > 0u ? mine : 1u; nx = cnt > 0u ? cnt : 1u;
}
__device__ __forceinline__ void xcd_barrier(const XcdBarrier& b) {
    asm volatile("s_waitcnt vmcnt(0)" ::: "memory");
    __syncthreads();
    if (threadIdx.x == 0) {
        unsigned* bar = b.bar;
        __builtin_amdgcn_s_waitcnt(0);
        unsigned nloc = b.st[0], nx = b.st[1];
        if (nloc == 0u) { xcd_barrier_complete(bar, b.x, nloc, nx); b.st[0] = nloc; b.st[1] = nx; }
        const unsigned old = xb_add(&bar[XB_XSUB(b.x)], 1u);
        const unsigned gen = old / nloc;
        if (old + 1u == (gen + 1u) * nloc) {
            __builtin_amdgcn_fence(__ATOMIC_RELEASE, "agent");
            asm volatile("s_waitcnt vmcnt(0)" ::: "memory");
            const unsigned og = xb_add(&bar[XB_TOP], 1u);
            const unsigned tg = og / nx;
            if (og + 1u == (tg + 1u) * nx) xb_add(&bar[XB_TOPGEN], 1u);
            else XB_SPIN(xb_ld(&bar[XB_TOPGEN]) == tg, bar);
            __builtin_amdgcn_fence(__ATOMIC_ACQUIRE, "agent");
            xb_add(&bar[XB_XGEN(b.x)], 1u);
            asm volatile("s_waitcnt vmcnt(0)" ::: "memory");
        } else {
            XB_SPIN(xb_ld(&bar[XB_XGEN(b.x)]) == gen, bar);
            __builtin_amdgcn_fence(__ATOMIC_ACQUIRE, "agent");
            asm volatile("s_waitcnt vmcnt(0)" ::: "memory");
        }
    }
    __syncthreads();
}

#ifndef PROF_A
#define PROF_A -1
#endif
#ifndef PROF_B
#define PROF_B -1
#endif
#define USTAMP(k) do { if ((PROF_A >= 0 || PROF_B >= 0) && F.prof && blockIdx.x == 0 && F.tid == 0) ((unsigned long long*)(F.ws + WS_CTL + 61440 + 512))[k] = __builtin_amdgcn_s_memrealtime(); } while (0)
struct Frame {
    LAS unsigned char* lds;
    int tid, lane, wave, G, vcu; bool prof;
    __device__ __forceinline__ void fresh() { int t = threadIdx.x; asm volatile("" : "+v"(t)); tid = t; lane = t & 63; wave = __builtin_amdgcn_readfirstlane(t >> 6); }
    const float *x, *c, *ctx, *c_ctx, *w_ada, *b_ada, *g_mix, *w_in, *dlogit, *ret_g, *w_four, *rpb, *w_out, *g_ffn, *w1, *w3, *w2, *g_final;
    float* out; unsigned char* ws;
    float *MOD, *SHWIN, *SHW13, *ROPE, *LG, *CT256, *SSQ, *XC, *ADAP; const float* TW8; bf16_t* STATE;
    bf16_t *XN, *CAT, *PROJ, *HID, *WFT, *TWA, *TD2, *TC256; unsigned* Y;
    __device__ __forceinline__ bf16_t* W(int layer, size_t off) const { return (bf16_t*)(ws + WS_W + (size_t)layer * W_LAYER + off); }
};

__device__ __forceinline__ float wave_sum(float v) {
#pragma unroll
    for (int o = 1; o < 64; o <<= 1) v += __shfl_xor(v, o);
    return v;
}

__device__ __forceinline__ bf16x8 ld8(LAS const unsigned char* p) { return *(LAS const bf16x8*)p; }
__device__ __forceinline__ bf16x8 ld8(const unsigned char* p) { return *(const bf16x8*)p; }
template <int MT, int NT, class PA, class PB>
__device__ __forceinline__ void wave_mma(f32x4 (&acc)[MT][NT], PA A, int lda, PB B, int ldb, int ksteps, int fr, int fq) {
    PA a0 = A + fr * lda + fq * 16; PB b0 = B + fr * ldb + fq * 16;
    for (int s = 0; s < ksteps; ++s) {
        bf16x8 a[MT], b[NT];
#pragma unroll
        for (int m = 0; m < MT; ++m) a[m] = ld8(a0 + m * 16 * lda + s * 64);
#pragma unroll
        for (int n = 0; n < NT; ++n) b[n] = ld8(b0 + n * 16 * ldb + s * 64);
#pragma unroll
        for (int m = 0; m < MT; ++m)
#pragma unroll
            for (int n = 0; n < NT; ++n) acc[m][n] = __builtin_amdgcn_mfma_f32_16x16x32_bf16(a[m], b[n], acc[m][n], 0, 0, 0);
    }
}
template <int MT, int NT> __device__ __forceinline__ void zero_acc(f32x4 (&acc)[MT][NT]) {
#pragma unroll
    for (int m = 0; m < MT; ++m)
#pragma unroll
        for (int n = 0; n < NT; ++n) acc[m][n] = (f32x4){0.f, 0.f, 0.f, 0.f};
}

#define LDS_WAIT() asm volatile("s_waitcnt lgkmcnt(0)" ::: "memory")
__device__ __forceinline__ void p0_transpose_item(const float* W, int ldw, int K, int nblk, bf16_t* WT, int mapkind, int roff, LAS float* scr, int item, int lane) {
    const int kb = item / nblk, nb = item % nblk, k0 = 64 * kb, n0 = 32 * nb;
    { f32x4 v[8]; const int r = lane >> 3, c4 = lane & 7;
#pragma unroll
      for (int i = 0; i < 8; ++i) v[i] = *(const f32x4*)(W + (size_t)(k0 + 8 * i + r) * ldw + n0 + 4 * c4);
#pragma unroll
      for (int i = 0; i < 8; ++i) { LAS float* d = scr + (8 * i + r) * 33 + 4 * c4; d[0] = v[i][0]; d[1] = v[i][1]; d[2] = v[i][2]; d[3] = v[i][3]; } }
    LDS_WAIT(); asm volatile("" ::: "memory");
    const int c = lane & 7;
#pragma unroll
    for (int j = 0; j < 4; ++j) { const int n = (lane >> 3) + 8 * j; const LAS float* s = scr + (8 * c) * 33 + n;
        u32x4 o; o.x = pk2(s[0 * 33], s[1 * 33]); o.y = pk2(s[2 * 33], s[3 * 33]); o.z = pk2(s[4 * 33], s[5 * 33]); o.w = pk2(s[6 * 33], s[7 * 33]);
        const int nn = n0 + n; const int row = mapkind == 0 ? roff + nn : ((nn >> 7) * 256 + (nn & 127) + (mapkind == 2 ? 128 : 0));
        *(u32x4*)(WT + (size_t)row * K + k0 + 8 * c) = o; }
    LDS_WAIT(); asm volatile("" ::: "memory");
}

__device__ __forceinline__ void phase_p0a(Frame& F) {
    F.fresh();
    const int tid = F.tid, lane = F.lane, wave = F.wave;
    {
        LAS float* wt = (LAS float*)F.lds; LAS float* T = (LAS float*)(F.lds + 8 * 257 * 4);
        for (int e = tid; e < 4096; e += NTHR) { const int c = e >> 6, p = e & 63; float sv, cv;
            if (p <= 32) { sincospif((float)((p * c) & 63) * (1.0f / 32.0f), &sv, &cv); T[e] = cv; }
            else { sincospif((float)(((p - 32) * c) & 63) * (1.0f / 32.0f), &sv, &cv); T[e] = -sv; } }
        for (int it = blockIdx.x; it < 256; it += F.G) {
            const int l = it >> 7, k0 = (it & 127) * 8;
            __syncthreads();
            for (int e = tid; e < 8 * 64; e += NTHR) { const int kk = e >> 6, c4 = e & 63; const f32x4 v = *(const f32x4*)(F.w_in + ((size_t)l * DM + k0 + kk) * PW + 4 * c4);
                LAS float* d = wt + kk * 257 + 4 * c4; d[0] = v[0]; d[1] = v[1]; d[2] = v[2]; d[3] = v[3]; }
            __syncthreads();
            const int k = tid & 7, cb = tid >> 3; bf16_t* WT = F.W(l, W_WIN);
#pragma unroll
            for (int i = 0; i < 4; ++i) { const int col = cb + 64 * i, g = col >> 6, p = col & 63; float a = 0.f;
#pragma unroll 16
                for (int c = 0; c < 64; ++c) a += wt[k * 257 + g * 64 + c] * T[c * 64 + p];
                WT[(size_t)col * DM + k0 + k] = (bf16_t)f2bf(a); }
        }
        __syncthreads();
    }
    LAS float* sc = (LAS float*)(F.lds + 131072);
    for (int e = tid; e < 3072; e += NTHR) { const int s = e >> 10, k = e & 1023; const float v = s < 2 ? F.c[s * DM + k] : F.c_ctx[k]; sc[e] = v / (1.0f + expf(-v)); }
    __syncthreads();
    const int gw = F.vcu * NWAVES + wave, NGW = F.G * NWAVES;
    for (int it = gw; it < 2 * 8 * 24; it += NGW) {
        const int l = it / 192, rem = it % 192, kc = rem / 24, cb = rem % 24, col = cb * 256 + 4 * lane;
        const float* wp = F.w_ada + ((size_t)l * DM + kc * 128) * 6144 + col; f32x4 a0 = {0.f, 0.f, 0.f, 0.f}, a1 = a0, a2 = a0;
#pragma unroll 1
        for (int h2 = 0; h2 < 8; ++h2) { f32x4 w[16];
#pragma unroll
            for (int k = 0; k < 16; ++k) w[k] = *(const f32x4*)(wp + (size_t)(h2 * 16 + k) * 6144);
#pragma unroll
            for (int k = 0; k < 16; ++k) { const int kk = kc * 128 + h2 * 16 + k; a0 += w[k] * sc[kk]; a1 += w[k] * sc[1024 + kk]; a2 += w[k] * sc[2048 + kk]; } }
        float* o = F.ADAP + ((size_t)(l * 8 + kc) * 3) * 6144 + col; *(f32x4*)o = a0; *(f32x4*)(o + 6144) = a1; *(f32x4*)(o + 2 * 6144) = a2;
    }
    LAS float* scr = (LAS float*)(F.lds + wave * 16384);
    constexpr int I0 = 16 * 84, I1 = 16 * 32, I2 = 16 * 88, I3 = I2, I4 = 44 * 32, I5 = 4 * 8, IL = I0 + I1 + I2 + I3 + I4 + I5;
    for (int it = gw; it < 2 * IL; it += NGW) {
        const int l = it / IL; int r = it % IL;
        if (r < I0) { p0_transpose_item(F.w_in + (size_t)l * DM * PW + 256, PW, DM, 84, F.W(l, W_WIN), 0, 256, scr, r, lane); continue; } r -= I0;
        if (r < I1) { p0_transpose_item(F.w_out + (size_t)l * DM * DM, DM, DM, 32, F.W(l, W_WOUT), 0, 0, scr, r, lane); continue; } r -= I1;
        if (r < I2) { p0_transpose_item(F.w1 + (size_t)l * DM * FF, FF, DM, 88, F.W(l, W_W13), 1, 0, scr, r, lane); continue; } r -= I2;
        if (r < I3) { p0_transpose_item(F.w3 + (size_t)l * DM * FF, FF, DM, 88, F.W(l, W_W13), 2, 0, scr, r, lane); continue; } r -= I3;
        if (r < I4) { p0_transpose_item(F.w2 + (size_t)l * FF * DM, DM, FF, 32, F.W(l, W_W2), 0, 0, scr, r, lane); continue; } r -= I4;
        p0_transpose_item(F.w_four + (size_t)l * 65536, 256, 256, 8, F.WFT + (size_t)l * 65536, 0, 0, scr, r, lane);
    }
    const int gt = F.vcu * NTHR + tid, GT = F.G * NTHR;
    for (int e = gt; e < 2 * 128 * 128; e += GT) { const int l = e >> 14, q = e & 16383; *(u32x4*)(F.W(l, W_WIN) + (size_t)PW * DM + (size_t)q * 8) = (u32x4){0u, 0u, 0u, 0u}; }
    for (int e = gt; e < 192 * 24; e += GT) { const int pos = e < 128 * 24 ? e / 24 : (e - 128 * 24) / 24, i = e % 24;
        const float inv = powf(10000.0f, -(float)i / 24.0f), ang = (float)pos * inv; F.ROPE[2 * e] = cosf(ang); F.ROPE[2 * e + 1] = sinf(ang); }
    for (int e = gt; e < 16; e += GT) { const float xv = F.dlogit[e]; F.LG[e] = -log1pf(expf(-xv)); }
    for (int e = gt; e < 256; e += GT) { float sv, cv; sincospif((float)e * (2.0f / 256.0f), &sv, &cv); F.CT256[2 * e] = cv; F.CT256[2 * e + 1] = sv; }
    for (int e = gt; e < 8192; e += GT) { float sv, cv; sincospif((float)e * (2.0f / 8192.0f), &sv, &cv); ((float*)F.TW8)[2 * e] = cv; ((float*)F.TW8)[2 * e + 1] = sv; }
    for (int e = gt; e < 32768; e += GT) { const int row = e >> 7, l1 = e & 127, cs = row >> 7, k1 = row & 127; float sv, cv;
        sincospif((float)((k1 * l1) & 127) * (2.0f / 128.0f), &sv, &cv); F.TWA[e] = (bf16_t)f2bf(cs == 0 ? cv : sv); }
    for (int e = gt; e < 131072; e += GT) { const int cs = e >> 16, k = (e >> 8) & 255, l = e & 255; float sv, cv;
        sincospif((float)((k * l) & 255) * (2.0f / 256.0f), &sv, &cv); F.TC256[e] = (bf16_t)f2bf(cs == 0 ? cv : sv); }
    for (int e = gt; e < 8192; e += GT) { const int k2 = e >> 7, col = e & 127, l2 = col >> 1, ri = col & 1; float sv, cv;
        sincospif((float)((k2 * l2) & 63) * (2.0f / 64.0f), &sv, &cv); F.TD2[e] = (bf16_t)f2bf(ri == 0 ? cv : sv); }
}

__device__ __forceinline__ float ada_val(const Frame& F, int l, int s, int j) {
    const float* p = F.ADAP + ((size_t)(l * 8) * 3 + s) * 6144 + j; float a = 0.f;
#pragma unroll
    for (int kc = 0; kc < 8; ++kc) a += p[(size_t)kc * 3 * 6144];
    return a + F.b_ada[l * 6144 + j];
}
__device__ __forceinline__ void phase_p0b(Frame& F) {
    F.fresh();
    const int tid = F.tid, lane = F.lane, wave = F.wave;
    const int gt = F.vcu * NTHR + tid, GT = F.G * NTHR, gw = F.vcu * NWAVES + wave, NGW = F.G * NWAVES;
    for (int e = gt; e < 2 * 3 * 6144; e += GT) { const int l = e / 18432, s = (e / 6144) % 3, j = e % 6144; F.MOD[e] = ada_val(F, l, s, j); }
    LAS float* vec = (LAS float*)F.lds;
#pragma unroll
    for (int i = 0; i < 6; ++i) { const int e = tid + NTHR * i, s = e >> 10, k = e & 1023; vec[e] = F.g_mix[k] * (1.0f + ada_val(F, 0, s, 1024 + k)); }
    __syncthreads();
    for (int m0 = gw; m0 < MTOT; m0 += 2 * NGW) {
        f32x4 v[2][4]; float ss[2] = {0.f, 0.f}; const int m1 = m0 + NGW; const bool has1 = m1 < MTOT;
#pragma unroll
        for (int q = 0; q < 2; ++q) { const int m = q ? m1 : m0; if (q == 0 || has1) { const float* src = m < MLAT ? F.x + (size_t)m * DM : F.ctx + (size_t)(m - MLAT) * DM;
#pragma unroll
            for (int j = 0; j < 4; ++j) v[q][j] = *(const f32x4*)(src + 4 * lane + 256 * j); } }
#pragma unroll
        for (int q = 0; q < 2; ++q) { const int m = q ? m1 : m0; if (q == 0 || has1) { const int set = m < SEQ ? 0 : (m < MLAT ? 1 : 2);
#pragma unroll
            for (int j = 0; j < 4; ++j) ss[q] += (v[q][j][0] * v[q][j][0] + v[q][j][1] * v[q][j][1]) + (v[q][j][2] * v[q][j][2] + v[q][j][3] * v[q][j][3]);
            ss[q] = wave_sum(ss[q]);
#pragma unroll
            for (int j = 0; j < 4; ++j) { const f32x4 g = *(LAS const f32x4*)(vec + set * 1024 + 4 * lane + 256 * j); const f32x4 o = v[q][j] * g;
                u32x2 w; w.x = pk2(o[0], o[1]); w.y = pk2(o[2], o[3]); *(u32x2*)(F.XN + (size_t)m * DM + 4 * lane + 256 * j) = w; }
            if (lane < 16) F.SSQ[(size_t)m * 16 + lane] = lane == 0 ? ss[q] : 0.f; } }
    }
    for (int combo = 0; combo < 4; ++combo) {
        const int l = combo >> 1, which = combo & 1;
        __syncthreads();
#pragma unroll
        for (int i = 0; i < 6; ++i) { const int e = tid + NTHR * i, s = e >> 10, k = e & 1023; vec[e] = ada_val(F, l, s, (which ? 3072 : 0) + k); }
        __syncthreads();
        const int nrows = which ? FF2 : PWP; const bf16_t* Wt = F.W(l, which ? W_W13 : W_WIN); float* dstv = (which ? F.SHW13 : F.SHWIN) + (size_t)l * 3 * nrows;
        for (int r0 = gw; r0 < nrows; r0 += 2 * NGW) { const int r1 = r0 + NGW; const bool has1 = r1 < nrows;
            u32x4 w[2][2];
#pragma unroll
            for (int q = 0; q < 2; ++q) if (q == 0 || has1) {
#pragma unroll
                for (int j = 0; j < 2; ++j) w[q][j] = *(const u32x4*)(Wt + (size_t)(q ? r1 : r0) * DM + lane * 8 + 512 * j); }
#pragma unroll
            for (int q = 0; q < 2; ++q) if (q == 0 || has1) { float a0 = 0.f, a1 = 0.f, a2 = 0.f;
#pragma unroll
                for (int j = 0; j < 2; ++j) { const int k0 = lane * 8 + 512 * j; const u32x4 ww = w[q][j];
                    const float wf[8] = {bflo(ww.x), bfhi(ww.x), bflo(ww.y), bfhi(ww.y), bflo(ww.z), bfhi(ww.z), bflo(ww.w), bfhi(ww.w)};
#pragma unroll
                    for (int e = 0; e < 8; ++e) { a0 += wf[e] * vec[k0 + e]; a1 += wf[e] * vec[1024 + k0 + e]; a2 += wf[e] * vec[2048 + k0 + e]; } }
                a0 = wave_sum(a0); a1 = wave_sum(a1); a2 = wave_sum(a2); const int r = q ? r1 : r0;
                if (lane == 0) { dstv[r] = a0; dstv[nrows + r] = a1; dstv[2 * nrows + r] = a2; } }
        }
    }
}
__device__ __forceinline__ void phase_final(Frame& F, bool dry = false, float delta = 0.f) {
    F.fresh();
    const int gw = F.vcu * NWAVES + F.wave, NGW = F.G * NWAVES, lane = F.lane;
    for (int m = gw; m < MLAT; m += NGW) {
        const float ri = pg8::row_rinv(F.SSQ, m); float* row = F.out + (size_t)m * DM;
#pragma unroll
        for (int j = 0; j < 4; ++j) { const int c = 4 * lane + 256 * j; const f32x4 v = *(const f32x4*)(row + c), g = *(const f32x4*)(F.g_final + c); *(f32x4*)(row + c) = dry ? v : v * g * ri + delta; }
    }
}

typedef LAS const unsigned char* lptr;
typedef const unsigned char* gptr;
constexpr float LOG2E = 1.4426950408889634f;
template <int NPW, class RowFn>
__device__ __forceinline__ void stage_T_load(unsigned (&a)[NPW], unsigned (&b)[NPW], RowFn rowp, int nd, int wave, int lane) {
    const int ndb = nd / 16, dl = lane & 7, kl = lane >> 3;
#pragma unroll
    for (int it = 0; it < NPW; ++it) { const int wi = wave + NWAVES * it, dvp = (wi % ndb) * 8 + dl, kp = (wi / ndb) * 8 + kl;
        a[it] = *(const unsigned*)(rowp(2 * kp) + 2 * dvp); b[it] = *(const unsigned*)(rowp(2 * kp + 1) + 2 * dvp); }
}
template <int NPW>
__device__ __forceinline__ void stage_T_store(const unsigned (&a)[NPW], const unsigned (&b)[NPW], LAS unsigned char* dst, int dstride, int nd, int wave, int lane) {
    const int ndb = nd / 16, dl = lane & 7, kl = lane >> 3;
#pragma unroll
    for (int it = 0; it < NPW; ++it) { const int wi = wave + NWAVES * it, dvp = (wi % ndb) * 8 + dl, kp = (wi / ndb) * 8 + kl;
        *(LAS unsigned*)(dst + (2 * dvp) * dstride + kp * 4) = (a[it] & 0xffffu) | (b[it] << 16);
        *(LAS unsigned*)(dst + (2 * dvp + 1) * dstride + kp * 4) = (a[it] >> 16) | (b[it] & 0xffff0000u); }
}
template <int NPW, class RowFn>
__device__ __forceinline__ void stage_T(LAS unsigned char* dst, int dstride, RowFn rowp, int nd, int wave, int lane) {
    unsigned a[NPW], b[NPW]; stage_T_load<NPW>(a, b, rowp, nd, wave, lane); stage_T_store<NPW>(a, b, dst, dstride, nd, wave, lane);
}
__device__ __forceinline__ bf16x4 vtr(LAS const unsigned char* p) { return __builtin_amdgcn_ds_read_tr16_b64_v4i16((LAS bf16x4*)p); }
__device__ __forceinline__ bf16x8 pack8(const f32x4& a, const f32x4& b) { u32x4 w; w.x = pk2(a[0], a[1]); w.y = pk2(a[2], a[3]); w.z = pk2(b[0], b[1]); w.w = pk2(b[2], b[3]); return __builtin_bit_cast(bf16x8, w); }

constexpr int NA_KC = 65536, NA_Q = 98304, NA_RPB = 106496, NA_COMB = 108544;
static_assert(NA_COMB + 8 * 4224 <= MISC_OFF, "NA LDS map");
__device__ __forceinline__ void na_units(Frame& F, int layer, bool ctxq, int total, int k0 = 0, int k1 = 1 << 20) {
    F.fresh();
    const int tid = F.tid, lane = F.lane, wave = F.wave, fr = lane & 15, fq = lane >> 4;
    LAS unsigned char* lds = F.lds; const bf16_t* P = F.PROJ;
    const int sch = tid & 7, skey = tid >> 3;
    const unsigned sdst = (unsigned)(skey * 128 + ((sch ^ (skey & 7)) << 4));
    const int jb = wave & 3, half = wave >> 2; const bool active = !(ctxq && half == 0);
    const int cstart = min(max(16 * jb - 8, 0), 32);
    u32x4 kv[12], qv; float rpv = 0.f;
    int it = blockIdx.x + k0 * F.G; { const long lim = (long)blockIdx.x + (long)k1 * F.G; if (lim < total) total = (int)lim; }
    if (it >= total) return;
#define NA_DECODE(itx, b_, h_, r_) do { if (ctxq) { b_ = (itx) / 24; h_ = ((itx) % 24) / 4; r_ = (itx) & 3; } else { b_ = (itx) / 768; h_ = ((itx) % 768) / 128; r_ = (itx) % 128; } } while (0)
#define NA_LOADK(b_, h_, r_) do { const int rs_ = ctxq ? 0 : min(max((r_) - 4, 0), 120); const int tq_ = ctxq ? MLAT + (b_) * CTXL + (r_) * 64 : (b_) * SEQ + (r_) * 64; \
        if (!ctxq) { _Pragma("unroll") for (int i = 0; i < 8; ++i) { const size_t tok = (size_t)(b_) * SEQ + (rs_ + i) * 64 + skey; kv[i] = *(const u32x4*)(P + tok * PW + C_NK + (h_) * 64 + sch * 8); } } \
        _Pragma("unroll") for (int i = 0; i < 4; ++i) { const size_t tok = (size_t)MLAT + (b_) * CTXL + skey + 64 * i; kv[8 + i] = *(const u32x4*)(P + tok * PW + C_NK + (h_) * 64 + sch * 8); } \
        qv = *(const u32x4*)(P + (size_t)(tq_ + skey) * PW + C_NQ + (h_) * 64 + sch * 8); \
        if (tid < 465) rpv = F.rpb[((size_t)layer * 6 + (h_)) * 465 + tid] * 8.0f; } while (0)
    int b, h, r; NA_DECODE(it, b, h, r); NA_LOADK(b, h, r);
    for (; it < total; it += F.G) {
        NA_DECODE(it, b, h, r);
        const int rs = ctxq ? 0 : min(max(r - 4, 0), 120);
        const int tokq0 = ctxq ? MLAT + b * CTXL + r * 64 : b * SEQ + r * 64;
        __syncthreads();
        USTAMP(0);
        if (!ctxq) {
#pragma unroll
            for (int i = 0; i < 8; ++i) *(LAS u32x4*)(lds + sdst + i * 8192) = kv[i];
        }
#pragma unroll
        for (int i = 0; i < 4; ++i) *(LAS u32x4*)(lds + NA_KC + sdst + i * 8192) = kv[8 + i];
        *(LAS u32x4*)(lds + NA_Q + sdst) = qv;
        if (tid < 465) ((LAS float*)(lds + NA_RPB))[tid] = rpv;
        __syncthreads();
        USTAMP(1);
        bf16x8 pa[8]; float mx = -3.0e38f, lsum = 0.f; f32x4 st[16];
        if (active) {
            const int sw0 = (fq ^ (fr & 7)) << 4, sw1 = ((4 + fq) ^ (fr & 7)) << 4;
            lptr qb = (lptr)(lds + NA_Q + (jb * 16 + fr) * 128);
            const bf16x8 qf0 = ld8(qb + sw0), qf1 = ld8(qb + sw1);
            if (half == 0) {
                const int qc = jb * 16 + fr, wsx = min(max(qc - 8, 0), 48); LAS const float* rp = (LAS const float*)(lds + NA_RPB) + (rs - r + 7) * 31 + (cstart + 4 * fq - qc + 15);
                bool ok[2][4];
#pragma unroll
                for (int hf = 0; hf < 2; ++hf)
#pragma unroll
                    for (int reg = 0; reg < 4; ++reg) { const int kc = cstart + 16 * hf + 4 * fq + reg; ok[hf][reg] = kc >= wsx && kc < wsx + 16; }
#pragma unroll
                for (int t = 0; t < 16; ++t) { LAS const float* bp = rp + (t >> 1) * 31 + 16 * (t & 1);
#pragma unroll
                    for (int reg = 0; reg < 4; ++reg) { const float x = bp[reg]; st[t][reg] = ok[t & 1][reg] ? x : -1.0e30f; } }
            } else {
#pragma unroll
                for (int t = 0; t < 16; ++t) st[t] = (f32x4){0.f, 0.f, 0.f, 0.f};
            }
#pragma unroll
            for (int t = 0; t < 16; ++t) {
                const int kidx = half == 0 ? (t >> 1) * 64 + cstart + 16 * (t & 1) + fr : 16 * t + fr;
                lptr kp = (lptr)(lds + (half == 0 ? 0 : NA_KC) + kidx * 128);
                st[t] = __builtin_amdgcn_mfma_f32_16x16x32_bf16(ld8(kp + sw0), qf0, st[t], 0, 0, 0);
                st[t] = __builtin_amdgcn_mfma_f32_16x16x32_bf16(ld8(kp + sw1), qf1, st[t], 0, 0, 0);
            }
        }
        USTAMP(2);
        if (!ctxq) {
#pragma unroll
            for (int i = 0; i < 8; ++i) { const size_t tok = (size_t)b * SEQ + (rs + i) * 64 + skey; kv[i] = *(const u32x4*)(P + tok * PW + C_NV + h * 64 + sch * 8); }
        }
#pragma unroll
        for (int i = 0; i < 4; ++i) { const size_t tok = (size_t)MLAT + b * CTXL + skey + 64 * i; kv[8 + i] = *(const u32x4*)(P + tok * PW + C_NV + h * 64 + sch * 8); }
        if (active) {
            constexpr float SC = 0.125f * LOG2E;
#pragma unroll
            for (int t = 0; t < 16; ++t) st[t] = st[t] * SC;
#pragma unroll
            for (int t = 0; t < 16; ++t) mx = fmaxf(mx, fmaxf(fmaxf(st[t][0], st[t][1]), fmaxf(st[t][2], st[t][3])));
            mx = fmaxf(mx, __shfl_xor(mx, 16)); mx = fmaxf(mx, __shfl_xor(mx, 32));
#pragma unroll
            for (int t = 0; t < 16; ++t)
#pragma unroll
                for (int reg = 0; reg < 4; ++reg) { const float p = __builtin_amdgcn_exp2f(st[t][reg] - mx); st[t][reg] = p; lsum += p; }
            lsum += __shfl_xor(lsum, 16); lsum += __shfl_xor(lsum, 32);
#pragma unroll
            for (int s = 0; s < 8; ++s) pa[s] = pack8(st[2 * s], st[2 * s + 1]);
        } else {
#pragma unroll
            for (int s = 0; s < 8; ++s) pa[s] = (bf16x8){0, 0, 0, 0, 0, 0, 0, 0};
        }
        USTAMP(3);
        __syncthreads();
        if (!ctxq) {
#pragma unroll
            for (int i = 0; i < 8; ++i) *(LAS u32x4*)(lds + sdst + i * 8192) = kv[i];
        }
#pragma unroll
        for (int i = 0; i < 4; ++i) *(LAS u32x4*)(lds + NA_KC + sdst + i * 8192) = kv[8 + i];
        __syncthreads();
        USTAMP(4);
        if (it + F.G < total) { int b2, h2, r2; NA_DECODE(it + F.G, b2, h2, r2); NA_LOADK(b2, h2, r2); }
        f32x4 o[4];
#pragma unroll
        for (int n = 0; n < 4; ++n) o[n] = (f32x4){0.f, 0.f, 0.f, 0.f};
        if (active) {
            const int q4 = (lane & 15) >> 2, p4 = lane & 3, c7 = 4 * (fq & 1) + q4;
            lptr vb = (lptr)(lds + (half == 0 ? 0 : NA_KC) + (4 * fq + q4) * 128 + 8 * (p4 & 1));
            int xo[4];
#pragma unroll
            for (int n = 0; n < 4; ++n) xo[n] = ((2 * n + (p4 >> 1)) ^ c7) << 4;
#pragma unroll
            for (int s = 0; s < 8; ++s) { const int k0 = half == 0 ? s * 64 + cstart : 32 * s;
#pragma unroll
                for (int n = 0; n < 4; ++n) { lptr rb = vb + k0 * 128 + xo[n];
                    const bf16x4 lo = vtr(rb), hi = vtr(rb + 16 * 128);
                    const bf16x8 bv = {lo[0], lo[1], lo[2], lo[3], hi[0], hi[1], hi[2], hi[3]};
                    o[n] = __builtin_amdgcn_mfma_f32_16x16x32_bf16(pa[s], bv, o[n], 0, 0, 0); } }
        }
        USTAMP(5);
        LAS float* cb = (LAS float*)(lds + NA_COMB + wave * 4224);
#pragma unroll
        for (int n = 0; n < 4; ++n)
#pragma unroll
            for (int reg = 0; reg < 4; ++reg) cb[(4 * fq + reg) * 64 + n * 16 + fr] = o[n][reg];
        if (fq == 0) { cb[1024 + 2 * fr] = mx; cb[1025 + 2 * fr] = lsum; }
        __syncthreads();
        if (wave < 4) {
            LAS const float* c2 = (LAS const float*)(lds + NA_COMB + (wave + 4) * 4224);
#pragma unroll
            for (int reg = 0; reg < 4; ++reg) { const int q = 4 * fq + reg;
                const float m1 = cb[1024 + 2 * q], l1 = cb[1025 + 2 * q], m2 = c2[1024 + 2 * q], l2 = c2[1025 + 2 * q], M = fmaxf(m1, m2);
                const float w1 = __builtin_amdgcn_exp2f(m1 - M), w2 = __builtin_amdgcn_exp2f(m2 - M), inv = 1.0f / (w1 * l1 + w2 * l2);
                bf16_t* orow = F.CAT + (size_t)(tokq0 + jb * 16 + q) * DM + 640 + h * 64;
#pragma unroll
                for (int n = 0; n < 4; ++n) orow[n * 16 + fr] = (bf16_t)f2bf((w1 * o[n][reg] + w2 * c2[q * 64 + n * 16 + fr]) * inv); }
        }
        USTAMP(6);
    }
#undef NA_DECODE
#undef NA_LOADK
}

__device__ __forceinline__ int ret_row0(int b, int t) { return t >= 2 ? b * SEQ + (t - 2) * 128 : MLAT + b * CTXL + t * 128; }
constexpr int R1_K = 0, R1_VF = 32768, R1_VB = 65536;
__device__ __forceinline__ unsigned r1_swz(int row, int ch) { return (unsigned)(row * 256 + ((ch ^ (row & 15)) << 4)); }
__device__ __forceinline__ u32x4 scale8(const u32x4& v, float w) { u32x4 o; o.x = pk2(bflo(v.x) * w, bfhi(v.x) * w); o.y = pk2(bflo(v.y) * w, bfhi(v.y) * w); o.z = pk2(bflo(v.z) * w, bfhi(v.z) * w); o.w = pk2(bflo(v.w) * w, bfhi(v.w) * w); return o; }
__device__ __forceinline__ void r1_unit(Frame& F, int layer, int b, int h, int t) {
    F.fresh();
    const int tid = F.tid, lane = F.lane, wave = F.wave, fr = lane & 15, fq = lane >> 4;
    LAS unsigned char* lds = F.lds; bf16_t* P = F.PROJ;
    const bool lat = t >= 2; const int row0 = ret_row0(b, t);
    const float lgf = F.LG[layer * 8 + h], lgb = F.LG[layer * 8 + 4 + h], ks = 0.10206207261596575f;
    __syncthreads();
    u32x4 xa[3], xb[3], vv[3]; f32x4 tb[3][4];
#pragma unroll
    for (int it = 0; it < 3; ++it) { const int e = tid + NTHR * it, X = e / 768, rem = e % 768, j = rem / 6, cp = rem % 6, c0 = cp < 3 ? cp : cp + 3;
        const bf16_t* xr = P + (size_t)(row0 + j) * PW + (X ? C_RQ : C_RK) + h * 96;
        xa[it] = *(const u32x4*)(xr + c0 * 8); xb[it] = *(const u32x4*)(xr + (c0 + 3) * 8);
        if (lat) { const int pos = (t - 2) * 128 + j, prow = pos >> 6, pcol = pos & 63; const float* tp = F.ROPE + ((cp < 3 ? prow * 24 : 3072 + pcol * 24) + 8 * (cp % 3)) * 2;
#pragma unroll
            for (int q = 0; q < 4; ++q) tb[it][q] = *(const f32x4*)(tp + 4 * q); } }
#pragma unroll
    for (int it = 0; it < 3; ++it) { const int e = tid + NTHR * it, j = e / 12, ch = e % 12; vv[it] = *(const u32x4*)(P + (size_t)(row0 + j) * PW + C_RV + h * 96 + ch * 8); }
#pragma unroll
    for (int it = 0; it < 3; ++it) { const int e = tid + NTHR * it, X = e / 768, rem = e % 768, j = rem / 6, cp = rem % 6, c0 = cp < 3 ? cp : cp + 3;
        const float scl = X ? 1.0f : ks; u32x4 oa, ob;
        if (lat) { float ra[8], rb[8]; const unsigned ua[4] = {xa[it].x, xa[it].y, xa[it].z, xa[it].w}, ub[4] = {xb[it].x, xb[it].y, xb[it].z, xb[it].w};
#pragma unroll
            for (int q = 0; q < 4; ++q) { const float a0 = bflo(ua[q]), a1 = bfhi(ua[q]), b0 = bflo(ub[q]), b1 = bfhi(ub[q]); const f32x4 cs = tb[it][q];
                ra[2 * q] = (a0 * cs[0] - b0 * cs[1]) * scl; rb[2 * q] = (a0 * cs[1] + b0 * cs[0]) * scl; ra[2 * q + 1] = (a1 * cs[2] - b1 * cs[3]) * scl; rb[2 * q + 1] = (a1 * cs[3] + b1 * cs[2]) * scl; }
            oa.x = pk2(ra[0], ra[1]); oa.y = pk2(ra[2], ra[3]); oa.z = pk2(ra[4], ra[5]); oa.w = pk2(ra[6], ra[7]);
            ob.x = pk2(rb[0], rb[1]); ob.y = pk2(rb[2], rb[3]); ob.z = pk2(rb[4], rb[5]); ob.w = pk2(rb[6], rb[7]);
        } else { oa = X ? xa[it] : scale8(xa[it], ks); ob = X ? xb[it] : scale8(xb[it], ks); }
        if (lat || X == 0) { bf16_t* xr = P + (size_t)(row0 + j) * PW + (X ? C_RQ : C_RK) + h * 96; *(u32x4*)(xr + c0 * 8) = oa; *(u32x4*)(xr + (c0 + 3) * 8) = ob; }
        if (X == 0) { *(LAS u32x4*)(lds + R1_K + r1_swz(j, c0)) = oa; *(LAS u32x4*)(lds + R1_K + r1_swz(j, c0 + 3)) = ob; } }
#pragma unroll
    for (int it = 0; it < 3; ++it) { const int e = tid + NTHR * it, j = e / 12, ch = e % 12;
        *(LAS u32x4*)(lds + R1_VF + r1_swz(j, ch)) = scale8(vv[it], expf(lgf * (float)(127 - j))); *(LAS u32x4*)(lds + R1_VB + r1_swz(j, ch)) = scale8(vv[it], expf(lgb * (float)j)); }
    __syncthreads();
    const int dir = wave >> 2, q = wave & 3, mb = q >> 1, nb = q & 1, q4 = (lane & 15) >> 2, p4 = lane & 3; f32x4 acc[3][3]; zero_acc(acc);
    lptr vbase = (lptr)(lds + (dir ? R1_VB : R1_VF)), kbase = (lptr)(lds + R1_K);
#pragma unroll
    for (int s = 0; s < 4; ++s) { bf16x8 a[3], bb[3]; const int r0 = 32 * s + 8 * fq + q4, r1 = r0 + 4;
#pragma unroll
        for (int m = 0; m < 3; ++m) { const int ch = 2 * (mb * 3 + m) + (p4 >> 1); const bf16x4 lo = vtr(vbase + r1_swz(r0, ch) + 8 * (p4 & 1)), hi = vtr(vbase + r1_swz(r1, ch) + 8 * (p4 & 1));
            a[m] = (bf16x8){lo[0], lo[1], lo[2], lo[3], hi[0], hi[1], hi[2], hi[3]}; }
#pragma unroll
        for (int n = 0; n < 3; ++n) { const int ch = 2 * (nb * 3 + n) + (p4 >> 1); const bf16x4 lo = vtr(kbase + r1_swz(r0, ch) + 8 * (p4 & 1)), hi = vtr(kbase + r1_swz(r1, ch) + 8 * (p4 & 1));
            bb[n] = (bf16x8){lo[0], lo[1], lo[2], lo[3], hi[0], hi[1], hi[2], hi[3]}; }
#pragma unroll
        for (int m = 0; m < 3; ++m)
#pragma unroll
            for (int n = 0; n < 3; ++n) acc[m][n] = __builtin_amdgcn_mfma_f32_16x16x32_bf16(a[m], bb[n], acc[m][n], 0, 0, 0); }
    const int u = dir == 0 ? t : (t < 2 ? 1 - t : 67 - t);
    bf16_t* ST = F.STATE + (size_t)(((b * 4 + h) * 2 + dir) * 66 + u) * 9216;
#pragma unroll
    for (int m = 0; m < 3; ++m)
#pragma unroll
        for (int n = 0; n < 3; ++n)
#pragma unroll
            for (int reg = 0; reg < 4; ++reg) ST[(mb * 48 + m * 16 + 4 * fq + reg) * 96 + nb * 48 + n * 16 + fr] = (bf16_t)f2bf(acc[m][n][reg]);
}
__device__ __forceinline__ void r2_scan(Frame& F, int layer) {
    F.fresh();
    const int gt = F.vcu * NTHR + F.tid, GT = F.G * NTHR;
    for (int e = gt; e < 16 * 4608; e += GT) { const int combo = e / 4608, idx = (e % 4608) * 2, h = (combo >> 1) & 3, dir = combo & 1;
        const float dcy = expf(128.0f * F.LG[layer * 8 + dir * 4 + h]); unsigned* p = (unsigned*)(F.STATE + (size_t)combo * 66 * 9216 + idx); float s0 = 0.f, s1 = 0.f;
#pragma unroll 1
        for (int u0 = 0; u0 < 66; u0 += 33) { unsigned kv[33];
#pragma unroll
            for (int q = 0; q < 33; ++q) kv[q] = p[(size_t)(u0 + q) * 4608];
#pragma unroll
            for (int q = 0; q < 33; ++q) { p[(size_t)(u0 + q) * 4608] = pk2(s0, s1); s0 = s0 * dcy + bflo(kv[q]); s1 = s1 * dcy + bfhi(kv[q]); } } }
}
constexpr int R3_Q = 0, R3_K = 26624, R3_V = 53248, R3_P = 86016, R3_SF = 120832, R3_SB = 140800;
static_assert(R3_SB + 96 * 208 <= MISC_OFF, "R3 LDS map");
__device__ __forceinline__ void r3_units(Frame& F, int layer) {
    F.fresh();
    const int tid = F.tid, lane = F.lane, wave = F.wave, fr = lane & 15, fq = lane >> 4, q4 = (lane & 15) >> 2, p4 = lane & 3;
    LAS unsigned char* lds = F.lds; const bf16_t* P = F.PROJ;
    const int nt = layer == 0 ? 66 : 64, t0 = layer == 0 ? 0 : 2, total = 8 * nt;
    int it = blockIdx.x; if (it >= total) return;
    u32x4 rq[3], rk[3], rv[3], sv[5];
#define R3_DECODE(itx, b_, h_, t_) do { b_ = (itx) / (4 * nt); h_ = ((itx) / nt) & 3; t_ = t0 + (itx) % nt; } while (0)
#define R3_LOAD(b_, h_, t_) do { const int r0_ = ret_row0(b_, t_); \
        _Pragma("unroll") for (int i_ = 0; i_ < 3; ++i_) { const int e_ = tid + NTHR * i_, j_ = e_ / 12, c_ = e_ % 12; const bf16_t* rp_ = P + (size_t)(r0_ + j_) * PW + (h_) * 96 + c_ * 8; \
            rq[i_] = *(const u32x4*)(rp_ + C_RQ); rk[i_] = *(const u32x4*)(rp_ + C_RK); rv[i_] = *(const u32x4*)(rp_ + C_RV); } \
        const int ub_ = (t_) < 2 ? 1 - (t_) : 67 - (t_); \
        _Pragma("unroll") for (int i_ = 0; i_ < 5; ++i_) { const int e_ = tid + NTHR * i_; if (e_ < 2304) { const int d_ = e_ >= 1152, c_ = d_ ? e_ - 1152 : e_; \
            sv[i_] = *(const u32x4*)(F.STATE + (size_t)((((b_) * 4 + (h_)) * 2 + d_) * 66 + (d_ ? ub_ : (t_))) * 9216 + c_ * 8); } } } while (0)
    int b, h, t; R3_DECODE(it, b, h, t); R3_LOAD(b, h, t);
    for (; it < total; it += F.G) {
        R3_DECODE(it, b, h, t);
        const int row0 = ret_row0(b, t);
        const float lf2 = F.LG[layer * 8 + h] * LOG2E, lb2 = F.LG[layer * 8 + 4 + h] * LOG2E;
        __syncthreads();
        USTAMP(10);
#pragma unroll
        for (int i = 0; i < 3; ++i) { const int e = tid + NTHR * i, j = e / 12, c = e % 12;
            *(LAS u32x4*)(lds + R3_Q + j * 208 + c * 16) = rq[i]; *(LAS u32x4*)(lds + R3_K + j * 208 + c * 16) = rk[i]; *(LAS u32x4*)(lds + R3_V + r1_swz(j, c)) = rv[i]; }
#pragma unroll
        for (int i = 0; i < 5; ++i) { const int e = tid + NTHR * i; if (e < 2304) { const int d = e >= 1152, c = d ? e - 1152 : e;
            *(LAS u32x4*)(lds + (d ? R3_SB : R3_SF) + (c / 12) * 208 + (c % 12) * 16) = sv[i]; } }
        __syncthreads();
        USTAMP(11);
        unsigned short gtv[4][6]; float gnv[6];
#pragma unroll
        for (int reg = 0; reg < 4; ++reg)
#pragma unroll
            for (int n = 0; n < 6; ++n) gtv[reg][n] = P[(size_t)(row0 + wave * 16 + 4 * fq + reg) * PW + C_RG + h * 96 + n * 16 + fr];
#pragma unroll
        for (int n = 0; n < 6; ++n) gnv[n] = F.ret_g[layer * 384 + h * 96 + n * 16 + fr];
        if (it + F.G < total) { int b2, h2, t2; R3_DECODE(it + F.G, b2, h2, t2); R3_LOAD(b2, h2, t2); }
        f32x4 ao[1][6];
        {
            f32x4 af[1][6], ab[1][6]; zero_acc(af); zero_acc(ab);
            wave_mma<1, 6>(af, (lptr)(lds + R3_Q + wave * 16 * 208), 208, (lptr)(lds + R3_SF), 208, 3, fr, fq);
            wave_mma<1, 6>(ab, (lptr)(lds + R3_Q + wave * 16 * 208), 208, (lptr)(lds + R3_SB), 208, 3, fr, fq);
#pragma unroll
            for (int reg = 0; reg < 4; ++reg) { const int il = wave * 16 + 4 * fq + reg; const float qdf = __builtin_amdgcn_exp2f(lf2 * (float)(il + 1)), qdb = __builtin_amdgcn_exp2f(lb2 * (float)(128 - il));
#pragma unroll
                for (int n = 0; n < 6; ++n) ao[0][n][reg] = qdf * af[0][n][reg] + qdb * ab[0][n][reg]; }
        }
        {
            bf16x8 qf[3];
#pragma unroll
            for (int s = 0; s < 3; ++s) qf[s] = ld8((lptr)(lds + R3_Q + (wave * 16 + fr) * 208 + s * 64 + fq * 16));
            const int i = wave * 16 + fr;
#pragma unroll 1
            for (int m = 0; m < 8; ++m) { f32x4 a = {0.f, 0.f, 0.f, 0.f};
#pragma unroll
                for (int s = 0; s < 3; ++s) a = __builtin_amdgcn_mfma_f32_16x16x32_bf16(ld8((lptr)(lds + R3_K + (m * 16 + fr) * 208 + s * 64 + fq * 16)), qf[s], a, 0, 0, 0);
                float pv[4];
#pragma unroll
                for (int reg = 0; reg < 4; ++reg) { const int diff = i - (m * 16 + 4 * fq + reg);
                    const float ex = __builtin_amdgcn_exp2f((diff > 0 ? lf2 : lb2) * (float)(diff > 0 ? diff : -diff)); const float dec = diff == 0 ? 2.0f : ex; pv[reg] = a[reg] * dec; }
                u32x2 w; w.x = pk2(pv[0], pv[1]); w.y = pk2(pv[2], pv[3]); *(LAS u32x2*)(lds + R3_P + i * 272 + (m * 16 + 4 * fq) * 2) = w; }
        }
        asm volatile("s_waitcnt lgkmcnt(0)" ::: "memory");
        USTAMP(12);
#pragma unroll 1
        for (int s = 0; s < 4; ++s) { const bf16x8 a = ld8((lptr)(lds + R3_P + (wave * 16 + fr) * 272 + s * 64 + fq * 16)); const int r0 = 32 * s + 8 * fq + q4;
#pragma unroll
            for (int n = 0; n < 6; ++n) { const int ch = 2 * n + (p4 >> 1); const bf16x4 lo = vtr((lptr)(lds + R3_V + r1_swz(r0, ch) + 8 * (p4 & 1))), hi = vtr((lptr)(lds + R3_V + r1_swz(r0 + 4, ch) + 8 * (p4 & 1)));
                const bf16x8 bv = {lo[0], lo[1], lo[2], lo[3], hi[0], hi[1], hi[2], hi[3]};
                ao[0][n] = __builtin_amdgcn_mfma_f32_16x16x32_bf16(a, bv, ao[0][n], 0, 0, 0); } }
        USTAMP(13);
#pragma unroll
        for (int reg = 0; reg < 4; ++reg) { const int il = wave * 16 + 4 * fq + reg;
            float ov[6], ss = 0.f;
#pragma unroll
            for (int n = 0; n < 6; ++n) { ov[n] = ao[0][n][reg]; ss += ov[n] * ov[n]; }
            ss += __shfl_xor(ss, 1); ss += __shfl_xor(ss, 2); ss += __shfl_xor(ss, 4); ss += __shfl_xor(ss, 8);
            const float rn = rsqrtf(ss * (1.0f / 96.0f) + NORM_EPS); const size_t row = (size_t)(row0 + il);
#pragma unroll
            for (int n = 0; n < 6; ++n) { const int col = n * 16 + fr; const float gt = bf2f(gtv[reg][n]);
                F.CAT[row * DM + 256 + h * 96 + col] = (bf16_t)f2bf(ov[n] * rn * gnv[n] * silu_f(gt)); } }
        USTAMP(14);
    }
#undef R3_DECODE
#undef R3_LOAD
}

__device__ __forceinline__ void d1_unit(Frame& F, int b, int l2, int g) {
    F.fresh();
    const int tid = F.tid, lane = F.lane, wave = F.wave, fr = lane & 15, fq = lane >> 4;
    LAS unsigned char* lds = F.lds; const bf16_t* P = F.PROJ;
    __syncthreads();
    {
        u32x4 v[2];
#pragma unroll
        for (int i = 0; i < 2; ++i) { const int row = (tid >> 3) + 64 * i, ch = tid & 7; v[i] = *(const u32x4*)(P + ((size_t)b * SEQ + row * 64 + l2) * PW + g * 64 + ch * 8); }
#pragma unroll
        for (int i = 0; i < 2; ++i) { const int row = (tid >> 3) + 64 * i, ch = tid & 7; *(LAS u32x4*)(lds + row * 128 + ((ch ^ (row & 7)) << 4)) = v[i]; }
    }
    bf16x8 bfr[2][4];
#pragma unroll
    for (int cs = 0; cs < 2; ++cs)
#pragma unroll
        for (int s = 0; s < 4; ++s) bfr[cs][s] = *(const bf16x8*)(F.TWA + (size_t)(cs * 128 + 16 * wave + fr) * 128 + 32 * s + 8 * fq);
    __syncthreads();
    f32x4 acc[4][2]; zero_acc(acc);
    const int q4 = (lane & 15) >> 2, p4 = lane & 3;
#pragma unroll
    for (int s = 0; s < 4; ++s)
#pragma unroll
        for (int mt = 0; mt < 4; ++mt) {
            lptr rb = (lptr)(lds + (32 * s + 8 * fq + q4) * 128 + 8 * (p4 & 1));
            const bf16x4 lo = vtr(rb + (((2 * mt + (p4 >> 1)) ^ q4) << 4)), hi = vtr(rb + 4 * 128 + (((2 * mt + (p4 >> 1)) ^ (4 + q4)) << 4));
            const bf16x8 av = {lo[0], lo[1], lo[2], lo[3], hi[0], hi[1], hi[2], hi[3]};
            acc[mt][0] = __builtin_amdgcn_mfma_f32_16x16x32_bf16(av, bfr[0][s], acc[mt][0], 0, 0, 0);
            acc[mt][1] = __builtin_amdgcn_mfma_f32_16x16x32_bf16(av, bfr[1][s], acc[mt][1], 0, 0, 0);
        }
    const int k1 = 16 * wave + fr; const f32x2 cs2 = *(const f32x2*)(F.TW8 + 2 * (k1 * l2));
    unsigned* yb = F.Y + ((((size_t)b * 128 + k1) * 4 + g) * 64) * 64 + l2;
#pragma unroll
    for (int mt = 0; mt < 2; ++mt)
#pragma unroll
        for (int reg = 0; reg < 4; ++reg) { const int p = 16 * mt + 4 * fq + reg;
            const float cp = acc[mt][0][reg], sp = acc[mt][1][reg], cq = acc[mt + 2][0][reg], sq = acc[mt + 2][1][reg];
            float yr0, yi0, yr1, yi1; int m0, m1;
            if (p == 0) { m0 = 0; yr0 = cp; yi0 = -sp; m1 = 32; yr1 = cq; yi1 = -sq; }
            else { m0 = p; yr0 = cp + sq; yi0 = cq - sp; m1 = 64 - p; yr1 = cp - sq; yi1 = -cq - sp; }
            yb[(size_t)m0 * 64] = pk2(yr0 * cs2[0] + yi0 * cs2[1], yi0 * cs2[0] - yr0 * cs2[1]);
            yb[(size_t)m1 * 64] = pk2(yr1 * cs2[0] + yi1 * cs2[1], yi1 * cs2[0] - yr1 * cs2[1]); }
}
constexpr int D2_Y = 0, D2_A = 69632, D2_F = 87040;
__device__ __forceinline__ void d2_unit(Frame& F, int layer, int b, int k1) {
    F.fresh();
    const int tid = F.tid, lane = F.lane, wave = F.wave, fr = lane & 15, fq = lane >> 4;
    LAS unsigned char* lds = F.lds;
    __syncthreads();
    const unsigned* ysrc = F.Y + (size_t)(b * 128 + k1) * 4 * 64 * 64;
    for (int e = tid; e < 4096; e += NTHR) { const int row = e >> 4, ch = e & 15; *(LAS u32x4*)(lds + D2_Y + row * 272 + ch * 16) = *(const u32x4*)(ysrc + row * 64 + ch * 4); }
    for (int e = tid; e < 1024; e += NTHR) { const int row = e >> 4, ch = e & 15; *(LAS u32x4*)(lds + D2_A + row * 272 + ch * 16) = *(const u32x4*)(F.TD2 + row * 128 + ch * 8); }
    __syncthreads();
    f32x4 acc[4][2]; zero_acc(acc);
    wave_mma<4, 2>(acc, (lptr)(lds + D2_A), 272, (lptr)(lds + D2_Y + wave * 32 * 272), 272, 4, fr, fq);
    const float scale = 0.0013810679320049757f;
#pragma unroll
    for (int mt = 0; mt < 4; ++mt)
#pragma unroll
        for (int nt = 0; nt < 2; ++nt)
#pragma unroll
            for (int reg = 0; reg < 4; ++reg) *(LAS bf16_t*)(lds + D2_F + (mt * 16 + 4 * fq + reg) * 528 + (wave * 32 + nt * 16 + fr) * 2) = (bf16_t)f2bf(acc[mt][nt][reg] * scale);
    __syncthreads();
    zero_acc(acc);
    wave_mma<4, 2>(acc, (lptr)(lds + D2_F), 528, (gptr)(F.WFT + (size_t)layer * 65536) + (size_t)(wave * 32) * 512, 512, 8, fr, fq);
#pragma unroll
    for (int mt = 0; mt < 4; ++mt)
#pragma unroll
        for (int nt = 0; nt < 2; ++nt)
#pragma unroll
            for (int reg = 0; reg < 4; ++reg) { const int k2 = mt * 16 + 4 * fq + reg, oc = wave * 32 + nt * 16 + fr;
                F.CAT[((size_t)b * SEQ + k1 + 128 * k2) * DM + oc] = (bf16_t)f2bf(acc[mt][nt][reg]); }
}
constexpr int DC_H = 0, DC_F = 131072;
__device__ __forceinline__ void dctx_item(Frame& F, int layer, int it) {
    F.fresh();
    const int tid = F.tid, lane = F.lane, wave = F.wave, fr = lane & 15, fq = lane >> 4; LAS unsigned char* lds = F.lds; const bf16_t* P = F.PROJ;
    const int b = it >> 5, k0 = (it & 31) * 8;
    __syncthreads();
    { u32x4 v[16];
#pragma unroll
      for (int i = 0; i < 16; ++i) { const int e = tid + NTHR * i, row = e >> 5, ch = e & 31; v[i] = *(const u32x4*)(P + ((size_t)MLAT + b * CTXL + row) * PW + ch * 8); }
#pragma unroll
      for (int i = 0; i < 16; ++i) { const int e = tid + NTHR * i, row = e >> 5, ch = e & 31; *(LAS u32x4*)(lds + DC_H + row * 512 + ((ch ^ (row & 15)) << 4)) = v[i]; } }
    for (int e = tid; e < 16 * 132; e += NTHR) ((LAS unsigned*)(lds + DC_F))[e] = 0u;
    bf16x8 bfr[8];
    { const bf16_t* tb = F.TC256 + ((size_t)((fr >> 3) * 256 + k0 + (fr & 7))) * 256 + 8 * fq;
#pragma unroll
      for (int s = 0; s < 8; ++s) bfr[s] = *(const bf16x8*)(tb + 32 * s); }
    __syncthreads();
    const int g = wave >> 1, jj = wave & 1, q4 = (lane & 15) >> 2, p4 = lane & 3;
    f32x4 acc[2]; acc[0] = (f32x4){0.f, 0.f, 0.f, 0.f}; acc[1] = acc[0];
#pragma unroll
    for (int s = 0; s < 8; ++s)
#pragma unroll
        for (int mt = 0; mt < 2; ++mt) { const int chunk = 2 * (g * 4 + jj + 2 * mt) + (p4 >> 1); const int r0 = 32 * s + 8 * fq + q4;
            const bf16x4 lo = vtr((lptr)(lds + DC_H + r0 * 512 + ((chunk ^ (r0 & 15)) << 4) + 8 * (p4 & 1)));
            const bf16x4 hi = vtr((lptr)(lds + DC_H + (r0 + 4) * 512 + ((chunk ^ ((r0 + 4) & 15)) << 4) + 8 * (p4 & 1)));
            const bf16x8 av = {lo[0], lo[1], lo[2], lo[3], hi[0], hi[1], hi[2], hi[3]};
            acc[mt] = __builtin_amdgcn_mfma_f32_16x16x32_bf16(av, bfr[s], acc[mt], 0, 0, 0); }
    const int kk = fr & 7; const bool hiLane = fr >= 8;
#pragma unroll
    for (int reg = 0; reg < 4; ++reg) { const int pp = jj * 16 + 4 * fq + reg;
        const float vp = acc[0][reg], vq = acc[1][reg], op = __shfl_xor(vp, 8), oq = __shfl_xor(vq, 8);
        const float c_p = hiLane ? op : vp, c_q = hiLane ? oq : vq, s_q = hiLane ? vq : oq;
        float x; int m;
        if (pp == 0) { m = hiLane ? 32 : 0; x = hiLane ? c_q : c_p; } else { m = hiLane ? 64 - pp : pp; x = hiLane ? c_p - s_q : c_p + s_q; }
        *(LAS bf16_t*)(lds + DC_F + kk * 528 + (g * 64 + m) * 2) = (bf16_t)f2bf(x * (1.0f / 128.0f)); }
    __syncthreads();
    f32x4 o2[1][2]; zero_acc(o2);
    wave_mma<1, 2>(o2, (lptr)(lds + DC_F), 528, (gptr)(F.WFT + (size_t)layer * 65536) + (size_t)(wave * 32) * 512, 512, 8, fr, fq);
    if (fq < 2) {
#pragma unroll
        for (int nt = 0; nt < 2; ++nt)
#pragma unroll
            for (int reg = 0; reg < 4; ++reg) F.CAT[((size_t)MLAT + b * CTXL + k0 + 4 * fq + reg) * DM + wave * 32 + nt * 16 + fr] = (bf16_t)f2bf(o2[0][nt][reg]);
    }
}

#ifndef DUP_PHASE
#define DUP_PHASE 0
#endif
__device__ __forceinline__ void phase_m1(Frame& F, int layer) {
    const int nNA = 1536, nCQ = layer == 0 ? 48 : 0, nR1 = 528, nD1 = 512;
    for (int q = blockIdx.x; q < nR1; q += F.G) r1_unit(F, layer, q / 264, (q % 264) / 66, q % 66);
#pragma unroll 1
    for (int rep = 0; rep < (DUP_PHASE == 8 ? 2 : 1); ++rep)
        for (int q = blockIdx.x; q < nD1; q += F.G) d1_unit(F, q >> 8, (q >> 2) & 63, q & 3);
    na_units(F, layer, true, nCQ);
    na_units(F, layer, false, nNA, 0, 1);
}
__device__ __forceinline__ void phase_m2(Frame& F, int layer) {
    r2_scan(F, layer);
    const int nD2 = 256, nDC = layer == 0 ? 64 : 0;
    for (int it = blockIdx.x; it < nD2; it += F.G) d2_unit(F, layer, it >> 7, it & 127);
    for (int it = blockIdx.x; it < nDC; it += F.G) dctx_item(F, layer, it);
    F.prof = (layer == 1); na_units(F, layer, false, 1536, 1, 4); F.prof = false;
}
__device__ __forceinline__ void phase_m3(Frame& F, int layer) {
    F.prof = (layer == 1); r3_units(F, layer); F.prof = false;
    na_units(F, layer, false, 1536, 4, 6);
}

struct SgParams {
    const bf16_t* A; int lda; const bf16_t* Bt; int K;
    int mode;
    const float* ssq; const float* shw;
    bf16_t* O;
    const float* src; float* dst; bf16_t* XN; float* ssq_out; const float* gate; const float* sc; const float* g; float gmul;
};
constexpr int SG_A = 0, SG_B = 16384;
template <int NTW>
__device__ __forceinline__ void sg_unit(Frame& F, const SgParams& p, int mblk, int ntile) {
    F.fresh();
    constexpr int NB = NTW, BSTAGE = NTW * 8192, UW = 64 * NTW;
    const int tid = F.tid, lane = F.lane, wave = F.wave, fr = lane & 15, fq = lane >> 4, wr = wave & 1, wc = wave >> 1;
    LAS unsigned char* lds = F.lds;
    const int srow = tid >> 3, sch = tid & 7; const unsigned sdst = (unsigned)(srow * 128 + ((sch ^ (srow & 7)) << 4));
    const bf16_t* ap = p.A + (size_t)(mblk * 64 + srow) * p.lda + sch * 8;
    const bf16_t* bp = p.Bt + (size_t)(ntile * UW + srow) * p.K + sch * 8;
    int boff[NTW];
#pragma unroll
    for (int n = 0; n < NTW; ++n) boff[n] = NTW == 1 ? wc * 16 : (p.mode == 2 ? ((n >> 1) * 128 + wc * 32 + (n & 1) * 16) : (wc * 64 + n * 16));
    const int sw0 = (fq ^ (fr & 7)) << 4, sw1 = ((4 + fq) ^ (fr & 7)) << 4;
    f32x4 acc[2][NTW]; zero_acc(acc);
    const int nk = p.K / 64;
    u32x4 ra0, ra1, rb0[NB], rb1[NB];
#define SG_LOAD(RA, RB, kt) do { RA = *(const u32x4*)(ap + (kt) * 64); _Pragma("unroll") for (int i_ = 0; i_ < NB; ++i_) RB[i_] = *(const u32x4*)(bp + (size_t)(64 * i_) * p.K + (kt) * 64); } while (0)
#define SG_WRITE(RA, RB, buf) do { *(LAS u32x4*)(lds + SG_A + (buf) * 8192 + sdst) = RA; _Pragma("unroll") for (int i_ = 0; i_ < NB; ++i_) *(LAS u32x4*)(lds + SG_B + (buf) * BSTAGE + sdst + i_ * 8192) = RB[i_]; } while (0)
#define SG_MMA(buf) do { lptr Ab_ = (lptr)(lds + SG_A + (buf) * 8192 + (wr * 32 + fr) * 128), Bb_ = (lptr)(lds + SG_B + (buf) * BSTAGE + fr * 128); \
        _Pragma("unroll") for (int s_ = 0; s_ < 2; ++s_) { const int sw_ = s_ ? sw1 : sw0; bf16x8 a_[2], b_[NTW]; \
            _Pragma("unroll") for (int m_ = 0; m_ < 2; ++m_) a_[m_] = ld8(Ab_ + m_ * 16 * 128 + sw_); \
            _Pragma("unroll") for (int n_ = 0; n_ < NTW; ++n_) b_[n_] = ld8(Bb_ + boff[n_] * 128 + sw_); \
            _Pragma("unroll") for (int m_ = 0; m_ < 2; ++m_) _Pragma("unroll") for (int n_ = 0; n_ < NTW; ++n_) acc[m_][n_] = __builtin_amdgcn_mfma_f32_16x16x32_bf16(b_[n_], a_[m_], acc[m_][n_], 0, 0, 0); } } while (0)
    __syncthreads();
    SG_LOAD(ra0, rb0, 0); SG_LOAD(ra1, rb1, 1);
    SG_WRITE(ra0, rb0, 0);
    __syncthreads();
    for (int kt = 0; kt < nk; kt += 2) {
        if (kt + 2 < nk) SG_LOAD(ra0, rb0, kt + 2);
        SG_MMA(0);
        SG_WRITE(ra1, rb1, 1);
        __syncthreads();
        if (kt + 3 < nk) SG_LOAD(ra1, rb1, kt + 3);
        SG_MMA(1);
        if (kt + 2 < nk) SG_WRITE(ra0, rb0, 0);
        __syncthreads();
    }
#undef SG_LOAD
#undef SG_WRITE
#undef SG_MMA
    LAS float* red = (LAS float*)(lds + 98304);
#pragma unroll
    for (int m = 0; m < 2; ++m) { const int rl = mblk * 64 + wr * 32 + m * 16 + fr; const size_t rg = (size_t)MLAT + rl;
        if (p.mode == 0) { const float ri = pg8::row_rinv(p.ssq, (int)rg);
#pragma unroll
            for (int n = 0; n < NTW; ++n) { const int col = ntile * UW + boff[n] + 4 * fq; if (col < PW) { const f32x4 v = acc[m][n] * ri + *(const f32x4*)(p.shw + col);
                u32x2 w; w.x = pk2(v[0], v[1]); w.y = pk2(v[2], v[3]); *(u32x2*)(p.O + rg * PW + col) = w; } }
        } else if (p.mode == 2) { if constexpr (NTW == 4) { const float ri = pg8::row_rinv(p.ssq, (int)rg);
#pragma unroll
            for (int n = 0; n < 2; ++n) { const int wcol = ntile * 256 + boff[n] + 4 * fq, hcol = ntile * 128 + wc * 32 + n * 16 + 4 * fq;
                const f32x4 a = acc[m][n] * ri + *(const f32x4*)(p.shw + wcol), b = acc[m][n + 2] * ri + *(const f32x4*)(p.shw + wcol + 128);
                u32x2 w; w.x = pk2(silu_f(a[0]) * b[0], silu_f(a[1]) * b[1]); w.y = pk2(silu_f(a[2]) * b[2], silu_f(a[3]) * b[3]); *(u32x2*)(p.O + rg * FF + hcol) = w; } }
        } else { float ss = 0.f;
#pragma unroll
            for (int n = 0; n < NTW; ++n) { const int col = ntile * UW + boff[n] + 4 * fq; const size_t ol = (size_t)rl * DM + col;
                const f32x4 x1 = *(const f32x4*)(p.src + ol) + *(const f32x4*)(p.gate + col) * p.gmul * acc[m][n];
                *(f32x4*)(p.dst + ol) = x1; ss += (x1[0] * x1[0] + x1[1] * x1[1]) + (x1[2] * x1[2] + x1[3] * x1[3]);
                if (p.XN) { const f32x4 xn = x1 * (*(const f32x4*)(p.g + col) * (*(const f32x4*)(p.sc + col) + 1.0f)); u32x2 w; w.x = pk2(xn[0], xn[1]); w.y = pk2(xn[2], xn[3]); *(u32x2*)(p.XN + rg * DM + col) = w; } }
            ss += __shfl_xor(ss, 16); ss += __shfl_xor(ss, 32);
            if (NTW == 4) { if (fq == 0) p.ssq_out[rg * 16 + ntile * 4 + wc] = ss; }
            else { if (fq == 0) red[wc * 64 + wr * 32 + m * 16 + fr] = ss; } }
    }
    if (NTW == 1 && p.mode == 1) { __syncthreads(); if (tid < 64) p.ssq_out[((size_t)MLAT + mblk * 64 + tid) * 16 + ntile] = (red[tid] + red[64 + tid]) + (red[128 + tid] + red[192 + tid]); }
}
template <int NTW>
__device__ __forceinline__ void sg_phase(Frame& F, const SgParams& p, int ntiles, int big_units) {
    const int first_free = big_units % F.G, nfree = F.G - first_free, c = (int)blockIdx.x;
    if (c < first_free) return;
    for (int u = c - first_free; u < 8 * ntiles; u += nfree) sg_unit<NTW>(F, p, u % 8, u / 8);
}

#ifndef USE_COOP
#define USE_COOP 1
#endif
#ifndef MK_N_LAUNCHES
#define MK_N_LAUNCHES 1
#endif
constexpr int N_PHASES = 17;
struct Args { const float* in[18]; float* out; unsigned char* ws; int ph_lo, ph_hi; };
__global__ void __launch_bounds__(NTHR, 2) hymba_fwd(Args args) {
    extern __shared__ __attribute__((aligned(16))) unsigned char lds_raw[];
    Frame F;
    F.lds = (LAS unsigned char*)lds_raw;
    F.tid = threadIdx.x; F.lane = F.tid & 63; F.wave = __builtin_amdgcn_readfirstlane(F.tid >> 6);
    F.prof = false; F.G = gridDim.x; { const int bx = blockIdx.x; F.vcu = (F.G % 8 == 0) ? (bx % 8) * (F.G / 8) + bx / 8 : bx; }
    F.x = args.in[0]; F.c = args.in[1]; F.ctx = args.in[2]; F.c_ctx = args.in[3]; F.w_ada = args.in[4]; F.b_ada = args.in[5]; F.g_mix = args.in[6]; F.w_in = args.in[7];
    F.dlogit = args.in[8]; F.ret_g = args.in[9]; F.w_four = args.in[10]; F.rpb = args.in[11]; F.w_out = args.in[12]; F.g_ffn = args.in[13]; F.w1 = args.in[14]; F.w3 = args.in[15];
    F.w2 = args.in[16]; F.g_final = args.in[17]; F.out = args.out; F.ws = args.ws;
    unsigned char* ws = args.ws;
    F.MOD = (float*)(ws + WS_MOD); F.SHWIN = (float*)(ws + WS_SHWIN); F.SHW13 = (float*)(ws + WS_SHW13); F.ROPE = (float*)(ws + WS_ROPE); F.LG = (float*)(ws + WS_LG); F.CT256 = (float*)(ws + WS_CT256);
    F.SSQ = (float*)(ws + WS_SSQ); F.XC = (float*)(ws + WS_XC); F.STATE = (bf16_t*)(ws + WS_STATE); F.ADAP = (float*)(ws + WS_PROJ); F.TW8 = (const float*)(ws + WS_TAB + T_TW8);
    F.XN = (bf16_t*)(ws + WS_XN); F.CAT = (bf16_t*)(ws + WS_CAT); F.PROJ = (bf16_t*)(ws + WS_PROJ); F.HID = (bf16_t*)(ws + WS_PROJ);
    F.WFT = (bf16_t*)(ws + WS_TAB + T_WFT); F.TWA = (bf16_t*)(ws + WS_TAB + T_TWA); F.TD2 = (bf16_t*)(ws + WS_TAB + T_TD2); F.TC256 = (bf16_t*)(ws + WS_TAB + T_TC); F.Y = (unsigned*)(ws + WS_XN);
    volatile LAS unsigned* MISC = (volatile LAS unsigned*)(F.lds + MISC_OFF);
    if (F.tid < 64) MISC[F.tid] = 0u;
    __syncthreads();
    const int lo = args.ph_lo, hi = args.ph_hi;
#if MK_N_LAUNCHES == 1
    XcdBarrier bar = xcd_barrier_post((unsigned*)(ws + WS_CTL) + CW_BAR, MISC + 8);
    cg::grid_group grid = cg::this_grid();
#define SEAM(k) do { if (USE_COOP && args.ph_lo < 0) grid.sync();     \
    else { _Pragma("unroll 1") for (int rep_ = 0; rep_ < (DUP_PHASE == 19 ? 5 : 1); ++rep_) xcd_barrier(bar); } } while (0)
#else
#define SEAM(k) do { } while (0)
#endif
#define IN(k) (lo <= (k) && (k) < hi)
#ifndef STAMP_SEL
#define STAMP_SEL -1
#endif
    unsigned long long* stamps = (unsigned long long*)(ws + WS_CTL + 61440);
#define STAMP(k) do { if (STAMP_SEL >= 0 && blockIdx.x == 0 && threadIdx.x == 0) stamps[k] = __builtin_amdgcn_s_memrealtime(); } while (0)
    STAMP(0);
    if (IN(0)) { _Pragma("unroll 1") for (int rep = 0; rep < (DUP_PHASE == 5 ? 2 : 1); ++rep) { __syncthreads(); phase_p0a(F); } if (IN(1)) SEAM(0); } STAMP(1);
    if (IN(1)) { _Pragma("unroll 1") for (int rep = 0; rep < (DUP_PHASE == 21 ? 2 : 1); ++rep) { __syncthreads(); phase_p0b(F); } if (IN(2)) SEAM(1); } STAMP(2);
#pragma unroll 1
    for (int layer = 0; layer < 2; ++layer) {
        const int pb = 2 + 7 * layer; const bool last = layer == 1;
        const float* mod = F.MOD + (size_t)layer * 3 * 6144;
        if (IN(pb + 0)) {
            pg8::Gemm g{F.XN, F.W(layer, W_WIN), MLAT, PWP, DM}; pg8::StaticOrder S; S.init(MLAT, PWP, F.G, (int)blockIdx.x);
            pg8::EpiProj E{F.PROJ, F.SSQ, F.SHWIN + (size_t)layer * 3 * PWP};
            _Pragma("unroll 1") for (int rep = 0; rep < (DUP_PHASE == 1 ? 2 : 1); ++rep) { __syncthreads(); pg8::gemm_phase<pg8::EpiProj, pg8::StaticOrder, true, true>(F.lds, g, S, E); }
            { SgParams sp{}; sp.A = F.XN + (size_t)MLAT * DM; sp.lda = DM; sp.Bt = F.W(layer, W_WIN); sp.K = DM; sp.mode = 0; sp.ssq = F.SSQ; sp.shw = F.SHWIN + (size_t)(layer * 3 + 2) * PWP; sp.O = F.PROJ;
              _Pragma("unroll 1") for (int rep = 0; rep < (DUP_PHASE == 12 ? 3 : 1); ++rep) sg_phase<1>(F, sp, 46, 768); }
            if (IN(pb + 1)) SEAM(pb);
        }
        STAMP(pb + 1);
        if (IN(pb + 1)) { _Pragma("unroll 1") for (int rep = 0; rep < (DUP_PHASE == 2 ? 2 : 1); ++rep) phase_m1(F, layer); if (IN(pb + 2)) SEAM(pb + 1); } STAMP(pb + 2);
        if (IN(pb + 2)) { phase_m2(F, layer); if (IN(pb + 3)) SEAM(pb + 2); } STAMP(pb + 3);
        if (IN(pb + 3)) { _Pragma("unroll 1") for (int rep = 0; rep < (DUP_PHASE == 3 ? 2 : 1); ++rep) phase_m3(F, layer); if (IN(pb + 4)) SEAM(pb + 3); } STAMP(pb + 4);
        const int Mrows = MLAT;
        if (IN(pb + 4)) {
            pg8::Gemm g{F.CAT, F.W(layer, W_WOUT), Mrows, DM, DM}; pg8::StaticOrder S; S.init(Mrows, DM, F.G, (int)blockIdx.x);
            pg8::EpiResWide E{last ? F.out : F.x, F.out, F.XN, F.SSQ, mod + 2048, mod + 4096, F.g_ffn + layer * DM, 1.0f};
            pg8::gemm_phase<pg8::EpiResWide, pg8::StaticOrder, false, true>(F.lds, g, S, E);
            if (!last) { SgParams sp{}; sp.A = F.CAT + (size_t)MLAT * DM; sp.lda = DM; sp.Bt = F.W(layer, W_WOUT); sp.K = DM; sp.mode = 1; sp.src = F.ctx; sp.dst = F.XC; sp.XN = F.XN; sp.ssq_out = F.SSQ;
              sp.gate = mod + 2048 + 2 * 6144; sp.sc = mod + 4096 + 2 * 6144; sp.g = F.g_ffn + layer * DM; sp.gmul = 1.0f; _Pragma("unroll 1") for (int rep = 0; rep < (DUP_PHASE == 13 ? 3 : 1); ++rep) sg_phase<1>(F, sp, 16, 256); }
            if (IN(pb + 5)) SEAM(pb + 4);
        }
        STAMP(pb + 5);
        if (IN(pb + 5)) {
            pg8::Gemm g{F.XN, F.W(layer, W_W13), Mrows, FF2, DM}; pg8::StaticOrder S; S.init(Mrows, FF2, F.G, (int)blockIdx.x);
            pg8::EpiSwiGLU E{F.HID, F.SSQ, F.SHW13 + (size_t)layer * 3 * FF2};
            _Pragma("unroll 1") for (int rep = 0; rep < (DUP_PHASE == 4 ? 2 : 1); ++rep) { __syncthreads(); pg8::gemm_phase<pg8::EpiSwiGLU, pg8::StaticOrder, true, true>(F.lds, g, S, E); }
            if (!last) { SgParams sp{}; sp.A = F.XN + (size_t)MLAT * DM; sp.lda = DM; sp.Bt = F.W(layer, W_W13); sp.K = DM; sp.mode = 2; sp.ssq = F.SSQ; sp.shw = F.SHW13 + (size_t)(layer * 3 + 2) * FF2; sp.O = F.HID;
              _Pragma("unroll 1") for (int rep = 0; rep < (DUP_PHASE == 14 ? 3 : 1); ++rep) sg_phase<4>(F, sp, 22, 1408); }
            if (IN(pb + 6)) SEAM(pb + 5);
        }
        STAMP(pb + 6);
        if (IN(pb + 6)) {
            pg8::Gemm g{F.HID, F.W(layer, W_W2), Mrows, DM, FF}; pg8::StaticOrder S; S.init(Mrows, DM, F.G, (int)blockIdx.x);
            pg8::EpiResWide E{F.out, F.out, last ? nullptr : F.XN, F.SSQ, mod + 5120, F.MOD + 3 * 6144 + 1024, F.g_mix + DM, 1.0f};
            pg8::gemm_phase<pg8::EpiResWide, pg8::StaticOrder, false, true>(F.lds, g, S, E);
            if (!last) { SgParams sp{}; sp.A = F.HID + (size_t)MLAT * FF; sp.lda = FF; sp.Bt = F.W(layer, W_W2); sp.K = FF; sp.mode = 1; sp.src = F.XC; sp.dst = F.XC; sp.XN = F.XN; sp.ssq_out = F.SSQ;
              sp.gate = mod + 5120 + 2 * 6144; sp.sc = F.MOD + 3 * 6144 + 1024 + 2 * 6144; sp.g = F.g_mix + DM; _Pragma("unroll 1") for (int rep = 0; rep < (DUP_PHASE == 15 ? 3 : 1); ++rep) { sp.gmul = (DUP_PHASE == 15 && rep < 2) ? 0.0f : 1.0f; sg_phase<1>(F, sp, 16, 256); } }
            if (IN(pb + 7)) SEAM(pb + 6);
        }
        STAMP(pb + 7);
    }
    float delta = 0.f;
    if (STAMP_SEL >= 0) { const unsigned long long t0 = stamps[STAMP_SEL], t1 = stamps[STAMP_SEL + 1]; delta = sqrtf(1e-7f * 0.01f * (float)(t1 - t0)); }
    if (PROF_A >= 0) { const unsigned long long* us = (const unsigned long long*)(ws + WS_CTL + 61440 + 512); delta = sqrtf(1e-6f * 0.01f * (float)(us[PROF_A + 1] - us[PROF_A])); }
    if (PROF_B >= 0 && blockIdx.x == 0 && threadIdx.x == 0) { const unsigned long long* us = (const unsigned long long*)(ws + WS_CTL + 61440 + 512); const unsigned long long d = (us[PROF_B + 1] - us[PROF_B]) * 20ull, t0 = __builtin_amdgcn_s_memrealtime(); while (__builtin_amdgcn_s_memrealtime() - t0 < d) __builtin_amdgcn_s_sleep(8); }
    if (IN(16)) { if (DUP_PHASE == 23) phase_final(F, true); phase_final(F, false, delta); }
#undef IN
#undef SEAM
}

extern "C" void kernel_launch(void* const* d_in, const int* in_sizes, int n_in, void* d_out, int out_size, void* d_ws, size_t ws_size, hipStream_t stream) {
    static int grid = 0;
    if (grid == 0) {
        if (n_in != 18 || in_sizes[0] != MLAT * DM || out_size != MLAT * DM || ws_size < WS_END) {
            fprintf(stderr, "kernel_launch: built for 18 inputs, x/out of %d floats, >= %zu bytes of workspace; got n_in %d, in0 %d, out %d, ws %zu\n", MLAT * DM, (size_t)WS_END, n_in, n_in > 0 ? in_sizes[0] : -1, out_size, ws_size); grid = -1; return; }
        int dev = 0, cus = 0, per_cu = 0;
        if (hipGetDevice(&dev) != hipSuccess || hipDeviceGetAttribute(&cus, hipDeviceAttributeMultiprocessorCount, dev) != hipSuccess) { fprintf(stderr, "kernel_launch: device query failed\n"); grid = -1; return; }
        if (hipFuncSetAttribute((const void*)hymba_fwd, hipFuncAttributeMaxDynamicSharedMemorySize, LDS_BYTES) != hipSuccess) { fprintf(stderr, "kernel_launch: hipFuncSetAttribute failed\n"); grid = -1; return; }
        if (hipOccupancyMaxActiveBlocksPerMultiprocessor(&per_cu, (const void*)hymba_fwd, NTHR, LDS_BYTES) != hipSuccess || per_cu < 1) { fprintf(stderr, "kernel_launch: occupancy query says %d blocks per CU\n", per_cu); (void)hipGetLastError(); grid = -1; return; }
        grid = cus;
        fprintf(stderr, "kernel_launch: grid %d (cus %d, occupancy %d/CU), ws %zu\n", grid, cus, per_cu, ws_size);
    }
    if (grid < 0) return;
    if (hipMemsetAsync((char*)d_ws + WS_CTL, 0, CTL_ZERO_BYTES, stream) != hipSuccess) { fprintf(stderr, "kernel_launch: memset failed\n"); return; }
    Args a{};
    for (int i = 0; i < 18; ++i) a.in[i] = (const float*)d_in[i];
    a.out = (float*)d_out; a.ws = (unsigned char*)d_ws;
#if MK_N_LAUNCHES == 1
    a.ph_lo = 0; a.ph_hi = N_PHASES;
    void* kargs[] = {&a};
    if (DUP_PHASE == 30) { (void)hipLaunchCooperativeKernel((const void*)hymba_fwd, dim3(grid), dim3(NTHR), kargs, LDS_BYTES, stream); (void)hipMemsetAsync((char*)d_ws + WS_CTL, 0, CTL_ZERO_BYTES, stream); }
    hipError_t le = hipSuccess;
    if (USE_COOP) le = hipLaunchCooperativeKernel((const void*)hymba_fwd, dim3(grid), dim3(NTHR), kargs, LDS_BYTES, stream);
    else { hipLaunchKernelGGL(hymba_fwd, dim3(grid), dim3(NTHR), LDS_BYTES, stream, a); le = hipPeekAtLastError(); }
    if (le != hipSuccess) fprintf(stderr, "kernel_launch: cooperative launch failed: %s (grid %d)\n", hipGetErrorString(le), grid);
#else
    for (int p = 0; p < N_PHASES; ++p) { a.ph_lo = p; a.ph_hi = p + 1; hipLaunchKernelGGL(hymba_fwd, dim3(grid), dim3(NTHR), LDS_BYTES, stream, a); }
#endif
}
```

```cpp
#include <hip/hip_runtime.h>
#include <hip/hip_cooperative_groups.h>
#include <cstdio>
#include <cstdint>
namespace cg = cooperative_groups;

#define LAS __attribute__((address_space(3)))
#define GAS __attribute__((address_space(1)))
typedef unsigned short bf16_t;
typedef short bf16x8 __attribute__((ext_vector_type(8)));
typedef short bf16x4 __attribute__((ext_vector_type(4)));
typedef float f32x4 __attribute__((ext_vector_type(4)));
typedef float f32x2 __attribute__((ext_vector_type(2)));
typedef unsigned u32x4 __attribute__((ext_vector_type(4)));
typedef unsigned u32x2 __attribute__((ext_vector_type(2)));

typedef __bf16 hwbf16x2 __attribute__((ext_vector_type(2)));
__device__ __forceinline__ unsigned pk2(float lo, float hi) { const f32x2 v = {lo, hi}; return __builtin_bit_cast(unsigned, __builtin_convertvector(v, hwbf16x2)); }
__device__ __forceinline__ unsigned f2bf(float f) { return pk2(f, f) & 0xffffu; }
__device__ __forceinline__ float bf2f(unsigned h) { return __builtin_bit_cast(float, h << 16); }
__device__ __forceinline__ float bflo(unsigned w) { return __builtin_bit_cast(float, w << 16); }
__device__ __forceinline__ float bfhi(unsigned w) { return __builtin_bit_cast(float, w & 0xffff0000u); }
__device__ __forceinline__ float silu_f(float a) { return a * __builtin_amdgcn_rcpf(1.0f + __expf(-a)); }

constexpr int NB = 2, SEQ = 8192, DM = 1024, CTXL = 256, MLAT = NB * SEQ, MCTX = NB * CTXL, MTOT = MLAT + MCTX;
constexpr int PW = 2944, PWP = 3072, FF = 2816, FF2 = 5632;
constexpr int C_RQ = 256, C_RK = 640, C_RV = 1024, C_RG = 1408, C_NQ = 1792, C_NK = 2176, C_NV = 2560;
constexpr float NORM_EPS = 1e-6f;

namespace pg8 {
#define PG8_LAS __attribute__((address_space(3)))
constexpr int BM = 256, BK = 64, HALF = 128, HTB = HALF * BK * 2, STAGE_BYTES = 8 * HTB, NXCD = 8, WGM = 8;
__host__ __device__ __forceinline__ int lds_byte(int r, int c) { const int st = (r >> 4) * 2 + (c >> 5), rr = r & 15, cc = c & 31, ob = rr * 64 + cc * 2; return st * 1024 + (ob ^ (((ob >> 9) & 1) << 5)); }
__host__ __device__ __forceinline__ void stage_rc(int b, int& R, int& C) { const int st = b / 1024, sb = b % 1024, swz = sb ^ (((sb >> 9) & 1) << 5); R = (st >> 1) * 16 + swz / 64; C = (st & 1) * 32 + (swz % 64) / 2; }
__host__ __device__ __forceinline__ int perm32(int rho) { const int n = rho >> 4, i = rho & 15; return 8 * (i >> 2) + 4 * n + (i & 3); }
struct Unit { int pm, pn; };
struct Gemm { const bf16_t* A; const bf16_t* Bt; int M, N, K; };
struct StaticOrder {
    int nM, nN, nwg, G, c;
    __host__ __device__ void init(int M, int N, int G_, int c_) { nM = M / BM; nN = N / BM; nwg = nM * nN; G = G_; c = c_; }
    __host__ __device__ bool next(int i, Unit& u) const {
        const long L = (long)i * G + c; if (L >= nwg) return false;
        int wgid = (int)L; { const int q = nwg / NXCD, r = nwg % NXCD, xcd = wgid % NXCD, off = wgid / NXCD; wgid = (xcd < r ? xcd * (q + 1) : r * (q + 1) + (xcd - r) * q) + off; }
        const int nig = WGM * nN, gid = wgid / nig, fm = gid * WGM, gsz = (nM - fm) < WGM ? (nM - fm) : WGM;
        u.pm = fm + ((wgid % nig) % gsz); u.pn = (wgid % nig) / gsz; return true;
    }
    __device__ __forceinline__ void a_ready(const Unit&) const {}
    __device__ __forceinline__ void done(const Unit&) const {}
};
__device__ __forceinline__ unsigned cvt_pk_bf16(float lo, float hi) { unsigned r; asm volatile("v_cvt_pk_bf16_f32 %0, %1, %2" : "=v"(r) : "v"(lo), "v"(hi)); return r; }

__device__ __forceinline__ float row_rinv(const float* ssq, int row) {
    const f32x4* p = (const f32x4*)(ssq + (size_t)row * 16);
    const f32x4 a = p[0], b = p[1], c = p[2], d = p[3];
    const float s = (((a[0] + a[1]) + (a[2] + a[3])) + ((b[0] + b[1]) + (b[2] + b[3]))) + (((c[0] + c[1]) + (c[2] + c[3])) + ((d[0] + d[1]) + (d[2] + d[3])));
    return rsqrtf(s * (1.0f / 1024.0f) + NORM_EPS);
}
__device__ __forceinline__ int row_set(int pm) { return pm < 32 ? 0 : (pm < 64 ? 1 : 2); }

struct EpiProj {
    static constexpr bool PERM = true, AFTER_DRAIN = false;
    bf16_t* O; const PG8_LAS float* rinv; const float* shw; mutable int ui;
    __device__ __forceinline__ void operator()(const f32x4 (&acc)[2][2][4][2], const Unit& u, int wr, int wc, int fr, int fq) const {
        const int row0 = u.pm * BM + wr * 64 + fr, col0 = u.pn * BM + wc * 32 + 8 * fq; const int set = row_set(u.pm); const PG8_LAS float* rt = rinv + ui * 256 + wr * 64 + fr; ++ui;
        f32x4 bv[2][2];
#pragma unroll
        for (int bj = 0; bj < 2; ++bj)
#pragma unroll
            for (int n = 0; n < 2; ++n) bv[bj][n] = *(const f32x4*)(shw + set * PWP + col0 + bj * HALF + 4 * n);
#pragma unroll
        for (int ai = 0; ai < 2; ++ai)
#pragma unroll
            for (int m = 0; m < 4; ++m) { const int r = row0 + ai * HALF + m * 16; const float ri = rt[ai * HALF + m * 16]; bf16_t* rowp = O + (size_t)r * PW + col0;
#pragma unroll
                for (int bj = 0; bj < 2; ++bj) { if (col0 + bj * HALF < PW) { const f32x4 v0 = acc[ai][bj][m][0] * ri + bv[bj][0], v1 = acc[ai][bj][m][1] * ri + bv[bj][1];
                    u32x4 w; w.x = cvt_pk_bf16(v0[0], v0[1]); w.y = cvt_pk_bf16(v0[2], v0[3]); w.z = cvt_pk_bf16(v1[0], v1[1]); w.w = cvt_pk_bf16(v1[2], v1[3]);
                    *(u32x4*)(rowp + bj * HALF) = w; } } }
    }
};
struct EpiSwiGLU {
    static constexpr bool PERM = true, AFTER_DRAIN = false;
    bf16_t* O; const PG8_LAS float* rinv; const float* shw; mutable int ui;
    __device__ __forceinline__ void operator()(const f32x4 (&acc)[2][2][4][2], const Unit& u, int wr, int wc, int fr, int fq) const {
        const int row0 = u.pm * BM + wr * 64 + fr, col0 = u.pn * BM + wc * 32 + 8 * fq, ocol = u.pn * HALF + wc * 32 + 8 * fq; const int set = row_set(u.pm); const PG8_LAS float* rt = rinv + ui * 256 + wr * 64 + fr; ++ui;
        f32x4 ba[2], bb[2];
#pragma unroll
        for (int n = 0; n < 2; ++n) { ba[n] = *(const f32x4*)(shw + set * FF2 + col0 + 4 * n); bb[n] = *(const f32x4*)(shw + set * FF2 + col0 + HALF + 4 * n); }
#pragma unroll
        for (int ai = 0; ai < 2; ++ai)
#pragma unroll
            for (int m = 0; m < 4; ++m) { const int r = row0 + ai * HALF + m * 16; const float ri = rt[ai * HALF + m * 16];
                float hv[8];
#pragma unroll
                for (int n = 0; n < 2; ++n) { const f32x4 a = acc[ai][0][m][n] * ri + ba[n], b = acc[ai][1][m][n] * ri + bb[n];
#pragma unroll
                    for (int e = 0; e < 4; ++e) hv[4 * n + e] = silu_f(a[e]) * b[e]; }
                u32x4 w; w.x = cvt_pk_bf16(hv[0], hv[1]); w.y = cvt_pk_bf16(hv[2], hv[3]); w.z = cvt_pk_bf16(hv[4], hv[5]); w.w = cvt_pk_bf16(hv[6], hv[7]);
                *(u32x4*)(O + (size_t)r * FF + ocol) = w; }
    }
};
struct EpiRes {
    static constexpr bool PERM = false, AFTER_DRAIN = false;
    const float* src_lat; const float* src_ctx; float* dst_lat; float* dst_ctx; bf16_t* XN; float* ssq; const float* gate; const float* sc; const float* g; float gmul;
    __device__ __forceinline__ void operator()(const f32x4 (&acc)[2][2][4][2], const Unit& u, int wr, int wc, int fr, int fq) const {
        const bool lat = u.pm < 64; const int set = row_set(u.pm);
        const int rg0 = u.pm * BM + wr * 64 + fr, rl0 = (lat ? u.pm : u.pm - 64) * BM + wr * 64 + fr;
        const float* src = lat ? src_lat : src_ctx; float* dst = lat ? dst_lat : dst_ctx;
        const int col0 = u.pn * BM + wc * 32 + 4 * fq;
        float ss[2][4];
#pragma unroll
        for (int ai = 0; ai < 2; ++ai)
#pragma unroll
            for (int m = 0; m < 4; ++m) ss[ai][m] = 0.f;
#pragma unroll
        for (int bj = 0; bj < 2; ++bj)
#pragma unroll
            for (int n = 0; n < 2; ++n) { const int c = col0 + bj * HALF + n * 16;
                const f32x4 ga = *(const f32x4*)(gate + set * 6144 + c) * gmul; f32x4 gs = {0.f, 0.f, 0.f, 0.f};
                if (XN) { const f32x4 s4 = *(const f32x4*)(sc + set * 6144 + c), g4 = *(const f32x4*)(g + c); gs = g4 * (s4 + 1.0f); }
#pragma unroll
                for (int ai = 0; ai < 2; ++ai)
#pragma unroll
                    for (int m = 0; m < 4; ++m) { const size_t ol = (size_t)(rl0 + ai * HALF + m * 16) * DM + c, og = (size_t)(rg0 + ai * HALF + m * 16) * DM + c;
                        const f32x4 x1 = *(const f32x4*)(src + ol) + ga * acc[ai][bj][m][n];
                        *(f32x4*)(dst + ol) = x1; ss[ai][m] += (x1[0] * x1[0] + x1[1] * x1[1]) + (x1[2] * x1[2] + x1[3] * x1[3]);
                        if (XN) { const f32x4 xn = x1 * gs; u32x2 w; w.x = cvt_pk_bf16(xn[0], xn[1]); w.y = cvt_pk_bf16(xn[2], xn[3]); *(u32x2*)(XN + og) = w; } } }
#pragma unroll
        for (int ai = 0; ai < 2; ++ai)
#pragma unroll
            for (int m = 0; m < 4; ++m) { float s = ss[ai][m]; s += __shfl_xor(s, 16); s += __shfl_xor(s, 32);
                if (fq == 0) ssq[(size_t)(rg0 + ai * HALF + m * 16) * 16 + u.pn * 4 + wc] = s; }
    }
};
struct EpiResWide {
    static constexpr bool PERM = false, AFTER_DRAIN = true;
    const float* src_lat; float* dst_lat; bf16_t* XN; float* ssq; const float* gate; const float* sc; const float* g; float gmul;
    __device__ __forceinline__ void fused(f32x4 (&acc)[2][2][4][2], const Unit& u, int wr, int wc, int fr, int fq, PG8_LAS unsigned char* lds, int wid, int lane) const {
        constexpr int ROWB = 1024 + 16;
        const int set = row_set(u.pm), col = u.pn * BM + 4 * lane;
        const f32x4 ga = *(const f32x4*)(gate + set * 6144 + col) * gmul; f32x4 gs = {0.f, 0.f, 0.f, 0.f};
        if (XN) gs = *(const f32x4*)(g + col) * (*(const f32x4*)(sc + set * 6144 + col) + 1.0f);
#pragma unroll 1
        for (int ai = 0; ai < 2; ++ai) {
            f32x4 xs[16];
            const size_t grow0 = (size_t)u.pm * BM + ai * HALF + wid;
#pragma unroll
            for (int i = 0; i < 16; ++i) xs[i] = *(const f32x4*)(src_lat + (grow0 + 8 * i) * DM + col);
            asm volatile("s_waitcnt lgkmcnt(0)" ::: "memory"); __builtin_amdgcn_s_barrier(); asm volatile("" ::: "memory");
#pragma unroll
            for (int bj = 0; bj < 2; ++bj)
#pragma unroll
                for (int m = 0; m < 4; ++m)
#pragma unroll
                    for (int n = 0; n < 2; ++n) *(PG8_LAS f32x4*)(lds + (wr * 64 + m * 16 + fr) * ROWB + (bj * HALF + wc * 32 + n * 16 + 4 * fq) * 4) = ai == 0 ? acc[0][bj][m][n] : acc[1][bj][m][n];
            asm volatile("s_waitcnt lgkmcnt(0)" ::: "memory"); __builtin_amdgcn_s_barrier(); asm volatile("" ::: "memory");
#pragma unroll
            for (int i = 0; i < 16; ++i) { const size_t grow = grow0 + 8 * i; const f32x4 v = *(const PG8_LAS f32x4*)(lds + (wid + 8 * i) * ROWB + lane * 16);
                const f32x4 x1 = xs[i] + ga * v; *(f32x4*)(dst_lat + grow * DM + col) = x1;
                float ss = (x1[0] * x1[0] + x1[1] * x1[1]) + (x1[2] * x1[2] + x1[3] * x1[3]);
                if (XN) { const f32x4 xn = x1 * gs; u32x2 w; w.x = cvt_pk_bf16(xn[0], xn[1]); w.y = cvt_pk_bf16(xn[2], xn[3]); *(u32x2*)(XN + grow * DM + col) = w; }
#pragma unroll
                for (int o = 1; o < 64; o <<= 1) ss += __shfl_xor(ss, o);
                if (lane == 0) *(f32x4*)(ssq + grow * 16 + u.pn * 4) = (f32x4){ss, 0.f, 0.f, 0.f}; }
        }
    }
};

template <class Epi, class Sched, bool ALIGN_EPI = false, bool SP2 = false>
__device__ __forceinline__ void gemm_phase(PG8_LAS unsigned char* lds, const Gemm g, const Sched& S, const Epi& E) {
    int tid_ = threadIdx.x; asm volatile("" : "+v"(tid_));
    const int tid = tid_, wid = __builtin_amdgcn_readfirstlane(tid >> 6), lane = tid & 63, wr = wid >> 2, wc = wid & 3, fr = lane & 15, fq = lane >> 4;
    const int K = g.K, nt = K / BK;
    unsigned voffA[2], voffB[2];
#pragma unroll
    for (int i = 0; i < 2; ++i) { int R, C; stage_rc(tid * 16 + i * 8192, R, C); const int Rb = Epi::PERM ? ((R & ~31) + perm32(R & 31)) : R;
        voffA[i] = (unsigned)(R * K + C) * 2u; voffB[i] = (unsigned)(Rb * K + C) * 2u; }
    const size_t kstep = (size_t)(BK * 2);
    const size_t hstep = (size_t)HALF * K * 2;
    const size_t tstep = 2 * hstep;
    const unsigned ldsw = (unsigned)wid * 1024u;
    const int aoff = lds_byte(wr * 64 + fr, fq * 8), boff = lds_byte(wc * 32 + fr, fq * 8);
#define PG8_SA(b, h) (((b) * 2 + (h)) * HTB)
#define PG8_SB(b, h) ((4 + (b) * 2 + (h)) * HTB)
#define PG8_STAGE(bufoff, gbase, voff) do { _Pragma("unroll") for (int _i = 0; _i < 2; ++_i) \
        __builtin_amdgcn_global_load_lds((const unsigned*)((const char*)(gbase) + (voff)[_i]), (PG8_LAS unsigned*)(lds + (bufoff) + ldsw + _i * 8192), 16, 0, 0); } while (0)
#define PG8_LDA(dst, b, h) do { _Pragma("unroll") for (int m = 0; m < 4; ++m) _Pragma("unroll") for (int k = 0; k < 2; ++k) dst[m][k] = *(const PG8_LAS bf16x8*)(lds + PG8_SA(b, h) + aoff + m * 2048 + k * 1024); } while (0)
#define PG8_LDB(dst, b, h) do { _Pragma("unroll") for (int n = 0; n < 2; ++n) _Pragma("unroll") for (int k = 0; k < 2; ++k) dst[n][k] = *(const PG8_LAS bf16x8*)(lds + PG8_SB(b, h) + boff + n * 2048 + k * 1024); } while (0)
#define PG8_MMA(ai, bj, At, Bt) do { __builtin_amdgcn_s_setprio(1); _Pragma("unroll") for (int m = 0; m < 4; ++m) _Pragma("unroll") for (int n = 0; n < 2; ++n) _Pragma("unroll") for (int k = 0; k < 2; ++k) \
        acc[ai][bj][m][n] = __builtin_amdgcn_mfma_f32_16x16x32_bf16(Bt[n][k], At[m][k], acc[ai][bj][m][n], 0, 0, 0); __builtin_amdgcn_s_setprio(0); } while (0)
#define PG8_WAIT_V(n) asm volatile("s_waitcnt vmcnt(" #n ")" ::: "memory")
#define PG8_WAIT_L(n) asm volatile("s_waitcnt lgkmcnt(" #n ")" ::: "memory")
#define PG8_BAR __builtin_amdgcn_s_barrier()
#define PG8_SCHED __builtin_amdgcn_sched_barrier(0)
    Unit cur, nxt; int ui = 0;
    if (!S.next(0, cur)) return;
    f32x4 acc[2][2][4][2];
#pragma unroll
    for (int a = 0; a < 2; ++a)
#pragma unroll
        for (int b = 0; b < 2; ++b)
#pragma unroll
            for (int m = 0; m < 4; ++m)
#pragma unroll
                for (int n = 0; n < 2; ++n) acc[a][b][m][n] = (f32x4){0.f, 0.f, 0.f, 0.f};
    bf16x8 At[4][2], B0[2][2], B1[2][2];
    const char* cA = (const char*)g.A + (size_t)cur.pm * tstep; const char* cB = (const char*)g.Bt + (size_t)cur.pn * tstep;
    S.a_ready(cur);
    if constexpr (SP2) {
        PG8_STAGE(PG8_SB(0, 0), cB, voffB); PG8_STAGE(PG8_SB(0, 1), cB + hstep, voffB); PG8_STAGE(PG8_SA(0, 0), cA, voffA); PG8_STAGE(PG8_SA(0, 1), cA + hstep, voffA);
        if (wr == 1) PG8_BAR;
        PG8_WAIT_V(2); PG8_BAR;
        PG8_STAGE(PG8_SB(1, 0), cB + kstep, voffB); PG8_STAGE(PG8_SA(1, 0), cA + kstep, voffA); PG8_STAGE(PG8_SB(1, 1), cB + hstep + kstep, voffB);
        PG8_WAIT_V(6); PG8_BAR;
    } else {
        PG8_STAGE(PG8_SB(0, 0), cB, voffB); PG8_STAGE(PG8_SA(0, 0), cA, voffA); PG8_STAGE(PG8_SB(0, 1), cB + hstep, voffB); PG8_STAGE(PG8_SA(0, 1), cA + hstep, voffA);
        if (wr == 1) PG8_BAR;
        PG8_WAIT_V(4); PG8_BAR;
        PG8_STAGE(PG8_SB(1, 0), cB + kstep, voffB); PG8_STAGE(PG8_SA(1, 0), cA + kstep, voffA); PG8_STAGE(PG8_SB(1, 1), cB + hstep + kstep, voffB);
        PG8_WAIT_V(6); PG8_BAR;
    }
    for (;;) {
        const bool has_next = S.next(ui + 1, nxt);
        const char* nA = has_next ? (const char*)g.A + (size_t)nxt.pm * tstep : cA; const char* nB = has_next ? (const char*)g.Bt + (size_t)nxt.pn * tstep : cB;
        for (int t = 0; t < nt; t += 2) {
            const bool last = (t == nt - 2);
            const char* a1 = cA + (size_t)(t + 1) * kstep;
            const char* a2 = last ? nA : cA + (size_t)(t + 2) * kstep; const char* b2 = last ? nB : cB + (size_t)(t + 2) * kstep;
            const char* a3 = a2 + kstep; const char* b3 = b2 + kstep;
            if (last && has_next) S.a_ready(nxt);
            if constexpr (SP2) {
            PG8_LDB(B0, 0, 0); PG8_LDB(B1, 0, 1); PG8_SCHED; PG8_LDA(At, 0, 0); PG8_STAGE(PG8_SA(1, 1), a1 + hstep, voffA);
            PG8_WAIT_V(8); PG8_WAIT_L(0); PG8_BAR; PG8_MMA(0, 0, At, B0); PG8_MMA(0, 1, At, B1); PG8_BAR; PG8_SCHED;
            PG8_LDA(At, 0, 1); PG8_STAGE(PG8_SB(0, 0), b2, voffB); PG8_STAGE(PG8_SB(0, 1), b2 + hstep, voffB); PG8_STAGE(PG8_SA(0, 0), a2, voffA);
            PG8_WAIT_V(8); PG8_WAIT_L(0); PG8_BAR; PG8_MMA(1, 0, At, B0); PG8_MMA(1, 1, At, B1); PG8_BAR; PG8_SCHED;
            PG8_LDB(B0, 1, 0); PG8_LDB(B1, 1, 1); PG8_SCHED; PG8_LDA(At, 1, 0); PG8_STAGE(PG8_SA(0, 1), a2 + hstep, voffA);
            PG8_WAIT_V(8); PG8_WAIT_L(0); PG8_BAR; PG8_MMA(0, 0, At, B0); PG8_MMA(0, 1, At, B1); PG8_BAR; PG8_SCHED;
            PG8_LDA(At, 1, 1); PG8_STAGE(PG8_SB(1, 0), b3, voffB); PG8_STAGE(PG8_SB(1, 1), b3 + hstep, voffB); PG8_STAGE(PG8_SA(1, 0), a3, voffA);
            PG8_WAIT_V(8); PG8_WAIT_L(0); PG8_BAR; PG8_MMA(1, 0, At, B0); PG8_MMA(1, 1, At, B1); PG8_BAR; PG8_SCHED;
            } else {
            PG8_LDB(B0, 0, 0); PG8_SCHED; PG8_LDA(At, 0, 0); PG8_STAGE(PG8_SA(1, 1), a1 + hstep, voffA);
            PG8_WAIT_L(8); PG8_BAR; PG8_WAIT_L(0); PG8_MMA(0, 0, At, B0); PG8_BAR; PG8_SCHED;
            PG8_LDB(B1, 0, 1); PG8_STAGE(PG8_SB(0, 0), b2, voffB);
            PG8_BAR; PG8_WAIT_L(0); PG8_MMA(0, 1, At, B1); PG8_BAR;
            PG8_LDA(At, 0, 1); PG8_STAGE(PG8_SA(0, 0), a2, voffA);
            PG8_BAR; PG8_WAIT_L(0); PG8_MMA(1, 0, At, B0); PG8_BAR; PG8_SCHED;
            PG8_STAGE(PG8_SB(0, 1), b2 + hstep, voffB);
            PG8_WAIT_V(6); PG8_BAR; PG8_MMA(1, 1, At, B1); PG8_BAR;
            PG8_LDB(B0, 1, 0); PG8_SCHED; PG8_LDA(At, 1, 0); PG8_STAGE(PG8_SA(0, 1), a2 + hstep, voffA);
            PG8_WAIT_L(8); PG8_BAR; PG8_WAIT_L(0); PG8_MMA(0, 0, At, B0); PG8_BAR; PG8_SCHED;
            PG8_LDB(B1, 1, 1); PG8_STAGE(PG8_SB(1, 0), b3, voffB);
            PG8_BAR; PG8_WAIT_L(0); PG8_MMA(0, 1, At, B1); PG8_BAR;
            PG8_LDA(At, 1, 1); PG8_STAGE(PG8_SA(1, 0), a3, voffA);
            PG8_BAR; PG8_WAIT_L(0); PG8_MMA(1, 0, At, B0); PG8_BAR; PG8_SCHED;
            PG8_STAGE(PG8_SB(1, 1), b3 + hstep, voffB);
            PG8_WAIT_V(6); PG8_BAR; PG8_MMA(1, 1, At, B1); PG8_BAR;
            }
        }
        if constexpr (ALIGN_EPI) { if (wr == 0) PG8_BAR; }
        if constexpr (!Epi::AFTER_DRAIN) { E(acc, cur, wr, wc, fr, fq); S.done(cur); }
        if (!has_next) break;
#pragma unroll
        for (int a = 0; a < 2; ++a)
#pragma unroll
            for (int b = 0; b < 2; ++b)
#pragma unroll
                for (int m = 0; m < 4; ++m)
#pragma unroll
                    for (int n = 0; n < 2; ++n) acc[a][b][m][n] = (f32x4){0.f, 0.f, 0.f, 0.f};
        cur = nxt; cA = nA; cB = nB; ++ui;
        if constexpr (ALIGN_EPI) { if (wr == 1) PG8_BAR; }
    }
    PG8_WAIT_V(0);
    if constexpr (!ALIGN_EPI) { if (wr == 0) PG8_BAR; }
    PG8_BAR;
    if constexpr (Epi::AFTER_DRAIN) { E.fused(acc, cur, wr, wc, fr, fq, lds, wid, lane); S.done(cur); }
#undef PG8_SA
#undef PG8_SB
#undef PG8_STAGE
#undef PG8_LDA
#undef PG8_LDB
#undef PG8_MMA
#undef PG8_WAIT_V
#undef PG8_WAIT_L
#undef PG8_BAR
#undef PG8_SCHED
}
}

constexpr int NWAVES = 8, NTHR = 512;
constexpr size_t MiB = 1u << 20;
constexpr size_t WS_CTL = 0, CTL_ZERO_BYTES = 64 * 1024;
constexpr size_t WS_MOD = 1 * MiB;
constexpr size_t WS_SHWIN = WS_MOD + 2 * 3 * 6144 * 4;
constexpr size_t WS_SHW13 = WS_SHWIN + 2 * 3 * PWP * 4;
constexpr size_t WS_ROPE = WS_SHW13 + 2 * 3 * FF2 * 4;
constexpr size_t WS_LG = WS_ROPE + (128 + 64) * 24 * 2 * 4;
constexpr size_t WS_CT256 = WS_LG + 256;
constexpr size_t WS_SSQ = 2 * MiB;
constexpr size_t WS_XC = 4 * MiB;
constexpr size_t WS_W = 6 * MiB;
constexpr size_t W_WIN = 0, W_WOUT = (size_t)PWP * DM * 2, W_W13 = W_WOUT + (size_t)DM * DM * 2, W_W2 = W_W13 + (size_t)FF2 * DM * 2, W_LAYER = W_W2 + (size_t)DM * FF * 2;
static_assert(W_LAYER * 2 == 49 * MiB, "weight region");
constexpr size_t WS_TAB = 55 * MiB;
constexpr size_t T_WFT = 0, T_TWA = 2 * 256 * 256 * 2, T_TD2 = T_TWA + 256 * 256 * 2, T_TW8 = T_TD2 + 64 * 128 * 2, T_TC = T_TW8 + 65536;
constexpr size_t WS_XN = 56 * MiB;
constexpr size_t WS_CAT = 89 * MiB;
constexpr size_t WS_PROJ = 122 * MiB;
constexpr size_t WS_STATE = 217 * MiB;
constexpr size_t WS_END = WS_STATE + (size_t)16 * 66 * 9216 * 2;
static_assert(WS_END <= 256 * MiB && WS_PROJ + (size_t)MTOT * PW * 2 <= WS_STATE && WS_CAT + (size_t)MTOT * DM * 2 <= WS_PROJ && WS_XN + (size_t)MTOT * DM * 2 <= WS_CAT, "d_ws map");
static_assert(WS_CT256 + 2048 <= WS_SSQ && WS_SSQ + (size_t)MTOT * 64 <= WS_XC && WS_TAB + T_TC + 262144 <= WS_XN, "d_ws map (small)");
constexpr int CW_BAR = 1024;
constexpr int LDS_BYTES = 163840, MISC_OFF = LDS_BYTES - 256;

#define RLX_AGENT __ATOMIC_RELAXED, __HIP_MEMORY_SCOPE_AGENT
#define XB_TMO      128
#define XB_XCNT(j)  (256  + 64 * (j))
#define XB_XSUB(j)  (1280 + 64 * (j))
#define XB_XGEN(j)  (2304 + 64 * (j))
#define XB_TOP      3328
#define XB_TOPGEN   3392
#define XCD_BAR_WORDS 3456
#define XB_SPIN_CAP (1u << 18)
static_assert((CW_BAR + XCD_BAR_WORDS) * 4 <= (int)CTL_ZERO_BYTES, "barrier words inside the memset region");
__device__ __forceinline__ unsigned xb_ld(unsigned* p)              { return __hip_atomic_load(p, __ATOMIC_RELAXED, __HIP_MEMORY_SCOPE_AGENT); }
__device__ __forceinline__ unsigned xb_add(unsigned* p, unsigned v) { return __hip_atomic_fetch_add(p, v, __ATOMIC_RELAXED, __HIP_MEMORY_SCOPE_AGENT); }
__device__ __forceinline__ unsigned xb_xcc_id() { return (unsigned)__builtin_amdgcn_s_getreg((3 << 11) | 20) & 0xFu; }
#define XB_SPIN(cond, bar) do { unsigned _sp = 0; while (cond) { __builtin_amdgcn_s_sleep(1); \
    if ((++_sp & 255u) == 0u) { if (xb_ld(&(bar)[XB_TMO])) break; if (_sp > XB_SPIN_CAP) { atomicAdd(&(bar)[XB_TMO], 1u); break; } } } } while (0)
struct XcdBarrier { unsigned* bar; unsigned x; volatile LAS unsigned* st; };
__device__ __forceinline__ XcdBarrier xcd_barrier_post(unsigned* bar, volatile LAS unsigned* st) {
    XcdBarrier b; b.bar = bar; b.x = xb_xcc_id(); b.st = st;
    if (threadIdx.x == 0) (void)xb_add(&bar[XB_XCNT(b.x)], 1u);
    return b;
}
__device__ __forceinline__ void xcd_barrier_complete(unsigned* bar, unsigned x, unsigned& nloc, unsigned& nx) {
    const unsigned G = gridDim.x * gridDim.y * gridDim.z;
    unsigned sum, cnt, mine, sp = 0u;
    for (;;) {
        sum = 0u; cnt = 0u; mine = 0u;
#pragma unroll
        for (unsigned j = 0; j < 16; ++j) { const unsigned c = xb_ld(&bar[XB_XCNT(j)]); sum += c; cnt += (c > 0u) ? 1u : 0u; mine = (j == x) ? c : mine; }
        if (sum == G) break;
        __builtin_amdgcn_s_sleep(1);
        if ((++sp & 255u) == 0u) { if (xb_ld(&bar[XB_TMO])) break; if (sp > XB_SPIN_CAP) { atomicAdd(&bar[XB_TMO], 1u); break; } }
    }
    nloc = mine > 0u ? mine : 1u; nx = cnt > 0u ? cnt : 1u;
}
__device__ __forceinline__ void xcd_barrier(const XcdBarrier& b) {
    asm volatile("s_waitcnt vmcnt(0)" ::: "memory");
    __syncthreads();
    if (threadIdx.x == 0) {
        unsigned* bar = b.bar;
        __builtin_amdgcn_s_waitcnt(0);
        unsigned nloc = b.st[0], nx = b.st[1];
        if (nloc == 0u) { xcd_barrier_complete(bar, b.x, nloc, nx); b.st[0] = nloc; b.st[1] = nx; }
        const unsigned old = xb_add(&bar[XB_XSUB(b.x)], 1u);
        const unsigned gen = old / nloc;
        if (old + 1u == (gen + 1u) * nloc) {
            __builtin_amdgcn_fence(__ATOMIC_RELEASE, "agent");
            asm volatile("s_waitcnt vmcnt(0)" ::: "memory");
            const unsigned og = xb_add(&bar[XB_TOP], 1u);
            const unsigned tg = og / nx;
            if (og + 1u == (tg + 1u) * nx) xb_add(&bar[XB_TOPGEN], 1u);
            else XB_SPIN(xb_ld(&bar[XB_TOPGEN]) == tg, bar);
            __builtin_amdgcn_fence(__ATOMIC_ACQUIRE, "agent");
            xb_add(&bar[XB_XGEN(b.x)], 1u);
            asm volatile("s_waitcnt vmcnt(0)" ::: "memory");
        } else {
            XB_SPIN(xb_ld(&bar[XB_XGEN(b.x)]) == gen, bar);
            __builtin_amdgcn_fence(__ATOMIC_ACQUIRE, "agent");
            asm volatile("s_waitcnt vmcnt(0)" ::: "memory");
        }
    }
    __syncthreads();
}

#ifndef PROF_A
#define PROF_A -1
#endif
#ifndef PROF_B
#define PROF_B -1
#endif
#define USTAMP(k) do { if ((PROF_A >= 0 || PROF_B >= 0) && F.prof && blockIdx.x == 0 && F.tid == 0) ((unsigned long long*)(F.ws + WS_CTL + 61440 + 512))[k] = __builtin_amdgcn_s_memrealtime(); } while (0)
struct Frame {
    LAS unsigned char* lds;
    int tid, lane, wave, G, vcu; bool prof;
    __device__ __forceinline__ void fresh() { int t = threadIdx.x; asm volatile("" : "+v"(t)); tid = t; lane = t & 63; wave = __builtin_amdgcn_readfirstlane(t >> 6); }
    const float *x, *c, *ctx, *c_ctx, *w_ada, *b_ada, *g_mix, *w_in, *dlogit, *ret_g, *w_four, *rpb, *w_out, *g_ffn, *w1, *w3, *w2, *g_final;
    float* out; unsigned char* ws;
    float *MOD, *SHWIN, *SHW13, *ROPE, *LG, *CT256, *SSQ, *XC, *ADAP; const float* TW8; bf16_t* STATE;
    bf16_t *XN, *CAT, *PROJ, *HID, *WFT, *TWA, *TD2, *TC256; unsigned* Y;
    __device__ __forceinline__ bf16_t* W(int layer, size_t off) const { return (bf16_t*)(ws + WS_W + (size_t)layer * W_LAYER + off); }
};

__device__ __forceinline__ float wave_sum(float v) {
#pragma unroll
    for (int o = 1; o < 64; o <<= 1) v += __shfl_xor(v, o);
    return v;
}

__device__ __forceinline__ bf16x8 ld8(LAS const unsigned char* p) { return *(LAS const bf16x8*)p; }
__device__ __forceinline__ bf16x8 ld8(const unsigned char* p) { return *(const bf16x8*)p; }
template <int MT, int NT, class PA, class PB>
__device__ __forceinline__ void wave_mma(f32x4 (&acc)[MT][NT], PA A, int lda, PB B, int ldb, int ksteps, int fr, int fq) {
    PA a0 = A + fr * lda + fq * 16; PB b0 = B + fr * ldb + fq * 16;
    for (int s = 0; s < ksteps; ++s) {
        bf16x8 a[MT], b[NT];
#pragma unroll
        for (int m = 0; m < MT; ++m) a[m] = ld8(a0 + m * 16 * lda + s * 64);
#pragma unroll
        for (int n = 0; n < NT; ++n) b[n] = ld8(b0 + n * 16 * ldb + s * 64);
#pragma unroll
        for (int m = 0; m < MT; ++m)
#pragma unroll
            for (int n = 0; n < NT; ++n) acc[m][n] = __builtin_amdgcn_mfma_f32_16x16x32_bf16(a[m], b[n], acc[m][n], 0, 0, 0);
    }
}
template <int MT, int NT> __device__ __forceinline__ void zero_acc(f32x4 (&acc)[MT][NT]) {
#pragma unroll
    for (int m = 0; m < MT; ++m)
#pragma unroll
        for (int n = 0; n < NT; ++n) acc[m][n] = (f32x4){0.f, 0.f, 0.f, 0.f};
}

#define LDS_WAIT() asm volatile("s_waitcnt lgkmcnt(0)" ::: "memory")
__device__ __forceinline__ void p0_transpose_item(const float* W, int ldw, int K, int nblk, bf16_t* WT, int mapkind, int roff, LAS float* scr, int item, int lane) {
    const int kb = item / nblk, nb = item % nblk, k0 = 64 * kb, n0 = 32 * nb;
    { f32x4 v[8]; const int r = lane >> 3, c4 = lane & 7;
#pragma unroll
      for (int i = 0; i < 8; ++i) v[i] = *(const f32x4*)(W + (size_t)(k0 + 8 * i + r) * ldw + n0 + 4 * c4);
#pragma unroll
      for (int i = 0; i < 8; ++i) { LAS float* d = scr + (8 * i + r) * 33 + 4 * c4; d[0] = v[i][0]; d[1] = v[i][1]; d[2] = v[i][2]; d[3] = v[i][3]; } }
    LDS_WAIT(); asm volatile("" ::: "memory");
    const int c = lane & 7;
#pragma unroll
    for (int j = 0; j < 4; ++j) { const int n = (lane >> 3) + 8 * j; const LAS float* s = scr + (8 * c) * 33 + n;
        u32x4 o; o.x = pk2(s[0 * 33], s[1 * 33]); o.y = pk2(s[2 * 33], s[3 * 33]); o.z = pk2(s[4 * 33], s[5 * 33]); o.w = pk2(s[6 * 33], s[7 * 33]);
        const int nn = n0 + n; const int row = mapkind == 0 ? roff + nn : ((nn >> 7) * 256 + (nn & 127) + (mapkind == 2 ? 128 : 0));
        *(u32x4*)(WT + (size_t)row * K + k0 + 8 * c) = o; }
    LDS_WAIT(); asm volatile("" ::: "memory");
}

__device__ __forceinline__ void phase_p0a(Frame& F) {
    F.fresh();
    const int tid = F.tid, lane = F.lane, wave = F.wave;
    {
        LAS float* wt = (LAS float*)F.lds; LAS float* T = (LAS float*)(F.lds + 8 * 257 * 4);
        for (int e = tid; e < 4096; e += NTHR) { const int c = e >> 6, p = e & 63; float sv, cv;
            if (p <= 32) { sincospif((float)((p * c) & 63) * (1.0f / 32.0f), &sv, &cv); T[e] = cv; }
            else { sincospif((float)(((p - 32) * c) & 63) * (1.0f / 32.0f), &sv, &cv); T[e] = -sv; } }
        for (int it = blockIdx.x; it < 256; it += F.G) {
            const int l = it >> 7, k0 = (it & 127) * 8;
            __syncthreads();
            for (int e = tid; e < 8 * 64; e += NTHR) { const int kk = e >> 6, c4 = e & 63; const f32x4 v = *(const f32x4*)(F.w_in + ((size_t)l * DM + k0 + kk) * PW + 4 * c4);
                LAS float* d = wt + kk * 257 + 4 * c4; d[0] = v[0]; d[1] = v[1]; d[2] = v[2]; d[3] = v[3]; }
            __syncthreads();
            const int k = tid & 7, cb = tid >> 3; bf16_t* WT = F.W(l, W_WIN);
#pragma unroll
            for (int i = 0; i < 4; ++i) { const int col = cb + 64 * i, g = col >> 6, p = col & 63; float a = 0.f;
#pragma unroll 16
                for (int c = 0; c < 64; ++c) a += wt[k * 257 + g * 64 + c] * T[c * 64 + p];
                WT[(size_t)col * DM + k0 + k] = (bf16_t)f2bf(a); }
        }
        __syncthreads();
    }
    LAS float* sc = (LAS float*)(F.lds + 131072);
    for (int e = tid; e < 3072; e += NTHR) { const int s = e >> 10, k = e & 1023; const float v = s < 2 ? F.c[s * DM + k] : F.c_ctx[k]; sc[e] = v / (1.0f + expf(-v)); }
    __syncthreads();
    const int gw = F.vcu * NWAVES + wave, NGW = F.G * NWAVES;
    for (int it = gw; it < 2 * 8 * 24; it += NGW) {
        const int l = it / 192, rem = it % 192, kc = rem / 24, cb = rem % 24, col = cb * 256 + 4 * lane;
        const float* wp = F.w_ada + ((size_t)l * DM + kc * 128) * 6144 + col; f32x4 a0 = {0.f, 0.f, 0.f, 0.f}, a1 = a0, a2 = a0;
#pragma unroll 1
        for (int h2 = 0; h2 < 8; ++h2) { f32x4 w[16];
#pragma unroll
            for (int k = 0; k < 16; ++k) w[k] = *(const f32x4*)(wp + (size_t)(h2 * 16 + k) * 6144);
#pragma unroll
            for (int k = 0; k < 16; ++k) { const int kk = kc * 128 + h2 * 16 + k; a0 += w[k] * sc[kk]; a1 += w[k] * sc[1024 + kk]; a2 += w[k] * sc[2048 + kk]; } }
        float* o = F.ADAP + ((size_t)(l * 8 + kc) * 3) * 6144 + col; *(f32x4*)o = a0; *(f32x4*)(o + 6144) = a1; *(f32x4*)(o + 2 * 6144) = a2;
    }
    LAS float* scr = (LAS float*)(F.lds + wave * 16384);
    constexpr int I0 = 16 * 84, I1 = 16 * 32, I2 = 16 * 88, I3 = I2, I4 = 44 * 32, I5 = 4 * 8, IL = I0 + I1 + I2 + I3 + I4 + I5;
    for (int it = gw; it < 2 * IL; it += NGW) {
        const int l = it / IL; int r = it % IL;
        if (r < I0) { p0_transpose_item(F.w_in + (size_t)l * DM * PW + 256, PW, DM, 84, F.W(l, W_WIN), 0, 256, scr, r, lane); continue; } r -= I0;
        if (r < I1) { p0_transpose_item(F.w_out + (size_t)l * DM * DM, DM, DM, 32, F.W(l, W_WOUT), 0, 0, scr, r, lane); continue; } r -= I1;
        if (r < I2) { p0_transpose_item(F.w1 + (size_t)l * DM * FF, FF, DM, 88, F.W(l, W_W13), 1, 0, scr, r, lane); continue; } r -= I2;
        if (r < I3) { p0_transpose_item(F.w3 + (size_t)l * DM * FF, FF, DM, 88, F.W(l, W_W13), 2, 0, scr, r, lane); continue; } r -= I3;
        if (r < I4) { p0_transpose_item(F.w2 + (size_t)l * FF * DM, DM, FF, 32, F.W(l, W_W2), 0, 0, scr, r, lane); continue; } r -= I4;
        p0_transpose_item(F.w_four + (size_t)l * 65536, 256, 256, 8, F.WFT + (size_t)l * 65536, 0, 0, scr, r, lane);
    }
    const int gt = F.vcu * NTHR + tid, GT = F.G * NTHR;
    for (int e = gt; e < 2 * 128 * 128; e += GT) { const int l = e >> 14, q = e & 16383; *(u32x4*)(F.W(l, W_WIN) + (size_t)PW * DM + (size_t)q * 8) = (u32x4){0u, 0u, 0u, 0u}; }
    for (int e = gt; e < 192 * 24; e += GT) { const int pos = e < 128 * 24 ? e / 24 : (e - 128 * 24) / 24, i = e % 24;
        const float inv = powf(10000.0f, -(float)i / 24.0f), ang = (float)pos * inv; F.ROPE[2 * e] = cosf(ang); F.ROPE[2 * e + 1] = sinf(ang); }
    for (int e = gt; e < 16; e += GT) { const float xv = F.dlogit[e]; F.LG[e] = -log1pf(expf(-xv)); }
    for (int e = gt; e < 256; e += GT) { float sv, cv; sincospif((float)e * (2.0f / 256.0f), &sv, &cv); F.CT256[2 * e] = cv; F.CT256[2 * e + 1] = sv; }
    for (int e = gt; e < 8192; e += GT) { float sv, cv; sincospif((float)e * (2.0f / 8192.0f), &sv, &cv); ((float*)F.TW8)[2 * e] = cv; ((float*)F.TW8)[2 * e + 1] = sv; }
    for (int e = gt; e < 32768; e += GT) { const int row = e >> 7, l1 = e & 127, cs = row >> 7, k1 = row & 127; float sv, cv;
        sincospif((float)((k1 * l1) & 127) * (2.0f / 128.0f), &sv, &cv); F.TWA[e] = (bf16_t)f2bf(cs == 0 ? cv : sv); }
    for (int e = gt; e < 131072; e += GT) { const int cs = e >> 16, k = (e >> 8) & 255, l = e & 255; float sv, cv;
        sincospif((float)((k * l) & 255) * (2.0f / 256.0f), &sv, &cv); F.TC256[e] = (bf16_t)f2bf(cs == 0 ? cv : sv); }
    for (int e = gt; e < 8192; e += GT) { const int k2 = e >> 7, col = e & 127, l2 = col >> 1, ri = col & 1; float sv, cv;
        sincospif((float)((k2 * l2) & 63) * (2.0f / 64.0f), &sv, &cv); F.TD2[e] = (bf16_t)f2bf(ri == 0 ? cv : sv); }
}

__device__ __forceinline__ float ada_val(const Frame& F, int l, int s, int j) {
    const float* p = F.ADAP + ((size_t)(l * 8) * 3 + s) * 6144 + j; float a = 0.f;
#pragma unroll
    for (int kc = 0; kc < 8; ++kc) a += p[(size_t)kc * 3 * 6144];
    return a + F.b_ada[l * 6144 + j];
}
__device__ __forceinline__ void phase_p0b(Frame& F) {
    F.fresh();
    const int tid = F.tid, lane = F.lane, wave = F.wave;
    const int gt = F.vcu * NTHR + tid, GT = F.G * NTHR, gw = F.vcu * NWAVES + wave, NGW = F.G * NWAVES;
    for (int e = gt; e < 2 * 3 * 6144; e += GT) { const int l = e / 18432, s = (e / 6144) % 3, j = e % 6144; F.MOD[e] = ada_val(F, l, s, j); }
    LAS float* vec = (LAS float*)F.lds;
#pragma unroll
    for (int i = 0; i < 6; ++i) { const int e = tid + NTHR * i, s = e >> 10, k = e & 1023; vec[e] = F.g_mix[k] * (1.0f + ada_val(F, 0, s, 1024 + k)); }
    __syncthreads();
    for (int m0 = gw; m0 < MTOT; m0 += 2 * NGW) {
        f32x4 v[2][4]; float ss[2] = {0.f, 0.f}; const int m1 = m0 + NGW; const bool has1 = m1 < MTOT;
#pragma unroll
        for (int q = 0; q < 2; ++q) { const int m = q ? m1 : m0; if (q == 0 || has1) { const float* src = m < MLAT ? F.x + (size_t)m * DM : F.ctx + (size_t)(m - MLAT) * DM;
#pragma unroll
            for (int j = 0; j < 4; ++j) v[q][j] = *(const f32x4*)(src + 4 * lane + 256 * j); } }
#pragma unroll
        for (int q = 0; q < 2; ++q) { const int m = q ? m1 : m0; if (q == 0 || has1) { const int set = m < SEQ ? 0 : (m < MLAT ? 1 : 2);
#pragma unroll
            for (int j = 0; j < 4; ++j) ss[q] += (v[q][j][0] * v[q][j][0] + v[q][j][1] * v[q][j][1]) + (v[q][j][2] * v[q][j][2] + v[q][j][3] * v[q][j][3]);
            ss[q] = wave_sum(ss[q]);
#pragma unroll
            for (int j = 0; j < 4; ++j) { const f32x4 g = *(LAS const f32x4*)(vec + set * 1024 + 4 * lane + 256 * j); const f32x4 o = v[q][j] * g;
                u32x2 w; w.x = pk2(o[0], o[1]); w.y = pk2(o[2], o[3]); *(u32x2*)(F.XN + (size_t)m * DM + 4 * lane + 256 * j) = w; }
            if (lane < 16) F.SSQ[(size_t)m * 16 + lane] = lane == 0 ? ss[q] : 0.f; } }
    }
    for (int combo = 0; combo < 4; ++combo) {
        const int l = combo >> 1, which = combo & 1;
        __syncthreads();
#pragma unroll
        for (int i = 0; i < 6; ++i) { const int e = tid + NTHR * i, s = e >> 10, k = e & 1023; vec[e] = ada_val(F, l, s, (which ? 3072 : 0) + k); }
        __syncthreads();
        const int nrows = which ? FF2 : PWP; const bf16_t* Wt = F.W(l, which ? W_W13 : W_WIN); float* dstv = (which ? F.SHW13 : F.SHWIN) + (size_t)l * 3 * nrows;
        for (int r0 = gw; r0 < nrows; r0 += 4 * NGW) {
            u32x4 w[4][2];
#pragma unroll
            for (int q = 0; q < 4; ++q) { const int r = r0 + q * NGW; if (r < nrows) {
#pragma unroll
                for (int j = 0; j < 2; ++j) w[q][j] = *(const u32x4*)(Wt + (size_t)r * DM + lane * 8 + 512 * j); } }
#pragma unroll
            for (int q = 0; q < 4; ++q) { const int r = r0 + q * NGW; if (r < nrows) { float a0 = 0.f, a1 = 0.f, a2 = 0.f;
#pragma unroll
                for (int j = 0; j < 2; ++j) { const int k0 = lane * 8 + 512 * j; const u32x4 ww = w[q][j];
                    const float wf[8] = {bflo(ww.x), bfhi(ww.x), bflo(ww.y), bfhi(ww.y), bflo(ww.z), bfhi(ww.z), bflo(ww.w), bfhi(ww.w)};
#pragma unroll
                    for (int e = 0; e < 8; ++e) { a0 += wf[e] * vec[k0 + e]; a1 += wf[e] * vec[1024 + k0 + e]; a2 += wf[e] * vec[2048 + k0 + e]; } }
                a0 = wave_sum(a0); a1 = wave_sum(a1); a2 = wave_sum(a2);
                if (lane == 0) { dstv[r] = a0; dstv[nrows + r] = a1; dstv[2 * nrows + r] = a2; } } }
        }
    }
}
__device__ __forceinline__ void phase_final(Frame& F, bool dry = false, float delta = 0.f) {
    F.fresh();
    const int gw = F.vcu * NWAVES + F.wave, NGW = F.G * NWAVES, lane = F.lane;
    for (int m = gw; m < MLAT; m += NGW) {
        const float ri = pg8::row_rinv(F.SSQ, m); float* row = F.out + (size_t)m * DM;
#pragma unroll
        for (int j = 0; j < 4; ++j) { const int c = 4 * lane + 256 * j; const f32x4 v = *(const f32x4*)(row + c), g = *(const f32x4*)(F.g_final + c); *(f32x4*)(row + c) = dry ? v : v * g * ri + delta; }
    }
}

typedef LAS const unsigned char* lptr;
typedef const unsigned char* gptr;
constexpr float LOG2E = 1.4426950408889634f;
template <int NPW, class RowFn>
__device__ __forceinline__ void stage_T_load(unsigned (&a)[NPW], unsigned (&b)[NPW], RowFn rowp, int nd, int wave, int lane) {
    const int ndb = nd / 16, dl = lane & 7, kl = lane >> 3;
#pragma unroll
    for (int it = 0; it < NPW; ++it) { const int wi = wave + NWAVES * it, dvp = (wi % ndb) * 8 + dl, kp = (wi / ndb) * 8 + kl;
        a[it] = *(const unsigned*)(rowp(2 * kp) + 2 * dvp); b[it] = *(const unsigned*)(rowp(2 * kp + 1) + 2 * dvp); }
}
template <int NPW>
__device__ __forceinline__ void stage_T_store(const unsigned (&a)[NPW], const unsigned (&b)[NPW], LAS unsigned char* dst, int dstride, int nd, int wave, int lane) {
    const int ndb = nd / 16, dl = lane & 7, kl = lane >> 3;
#pragma unroll
    for (int it = 0; it < NPW; ++it) { const int wi = wave + NWAVES * it, dvp = (wi % ndb) * 8 + dl, kp = (wi / ndb) * 8 + kl;
        *(LAS unsigned*)(dst + (2 * dvp) * dstride + kp * 4) = (a[it] & 0xffffu) | (b[it] << 16);
        *(LAS unsigned*)(dst + (2 * dvp + 1) * dstride + kp * 4) = (a[it] >> 16) | (b[it] & 0xffff0000u); }
}
template <int NPW, class RowFn>
__device__ __forceinline__ void stage_T(LAS unsigned char* dst, int dstride, RowFn rowp, int nd, int wave, int lane) {
    unsigned a[NPW], b[NPW]; stage_T_load<NPW>(a, b, rowp, nd, wave, lane); stage_T_store<NPW>(a, b, dst, dstride, nd, wave, lane);
}
__device__ __forceinline__ bf16x4 vtr(LAS const unsigned char* p) { return __builtin_amdgcn_ds_read_tr16_b64_v4i16((LAS bf16x4*)p); }
__device__ __forceinline__ bf16x8 pack8(const f32x4& a, const f32x4& b) { u32x4 w; w.x = pk2(a[0], a[1]); w.y = pk2(a[2], a[3]); w.z = pk2(b[0], b[1]); w.w = pk2(b[2], b[3]); return __builtin_bit_cast(bf16x8, w); }

constexpr int NA_KC = 65536, NA_Q = 98304, NA_RPB = 106496, NA_COMB = 108544, NA_CSLOT = 4480;
static_assert(NA_COMB + 8 * NA_CSLOT <= MISC_OFF, "NA LDS map");
__device__ __forceinline__ void na_units(Frame& F, int layer, bool ctxq, int total, int k0 = 0, int k1 = 1 << 20) {
    F.fresh();
    const int tid = F.tid, lane = F.lane, wave = F.wave, fr = lane & 15, fq = lane >> 4;
    LAS unsigned char* lds = F.lds; const bf16_t* P = F.PROJ;
    const int sch = tid & 7, skey = tid >> 3;
    const unsigned sdst = (unsigned)(skey * 128 + ((sch ^ (skey & 7)) << 4));
    const int jb = wave & 3, half = wave >> 2; const bool active = !(ctxq && half == 0);
    const int cstart = min(max(16 * jb - 8, 0), 32);
    u32x4 kv[12], qv; float rpv = 0.f;
    int it = blockIdx.x + k0 * F.G; { const long lim = (long)blockIdx.x + (long)k1 * F.G; if (lim < total) total = (int)lim; }
    if (it >= total) return;
#define NA_DECODE(itx, b_, h_, r_) do { if (ctxq) { b_ = (itx) / 24; h_ = ((itx) % 24) / 4; r_ = (itx) & 3; } else { b_ = (itx) / 768; h_ = ((itx) % 768) / 128; r_ = (itx) % 128; } } while (0)
#define NA_LOADK(b_, h_, r_) do { const int rs_ = ctxq ? 0 : min(max((r_) - 4, 0), 120); const int tq_ = ctxq ? MLAT + (b_) * CTXL + (r_) * 64 : (b_) * SEQ + (r_) * 64; \
        if (!ctxq) { _Pragma("unroll") for (int i = 0; i < 8; ++i) { const size_t tok = (size_t)(b_) * SEQ + (rs_ + i) * 64 + skey; kv[i] = *(const u32x4*)(P + tok * PW + C_NK + (h_) * 64 + sch * 8); } } \
        _Pragma("unroll") for (int i = 0; i < 4; ++i) { const size_t tok = (size_t)MLAT + (b_) * CTXL + skey + 64 * i; kv[8 + i] = *(const u32x4*)(P + tok * PW + C_NK + (h_) * 64 + sch * 8); } \
        qv = *(const u32x4*)(P + (size_t)(tq_ + skey) * PW + C_NQ + (h_) * 64 + sch * 8); \
        if (tid < 465) rpv = F.rpb[((size_t)layer * 6 + (h_)) * 465 + tid] * 8.0f; } while (0)
    int b, h, r; NA_DECODE(it, b, h, r); NA_LOADK(b, h, r);
    for (; it < total; it += F.G) {
        NA_DECODE(it, b, h, r);
        const int rs = ctxq ? 0 : min(max(r - 4, 0), 120);
        const int tokq0 = ctxq ? MLAT + b * CTXL + r * 64 : b * SEQ + r * 64;
        __syncthreads();
        USTAMP(0);
        if (!ctxq) {
#pragma unroll
            for (int i = 0; i < 8; ++i) *(LAS u32x4*)(lds + sdst + i * 8192) = kv[i];
        }
#pragma unroll
        for (int i = 0; i < 4; ++i) *(LAS u32x4*)(lds + NA_KC + sdst + i * 8192) = kv[8 + i];
        *(LAS u32x4*)(lds + NA_Q + sdst) = qv;
        if (tid < 465) ((LAS float*)(lds + NA_RPB))[tid] = rpv;
        __syncthreads();
        USTAMP(1);
        bf16x8 pa[8]; float mx = -3.0e38f, lsum = 0.f; f32x4 st[16];
        if (active) {
            const int sw0 = (fq ^ (fr & 7)) << 4, sw1 = ((4 + fq) ^ (fr & 7)) << 4;
            lptr qb = (lptr)(lds + NA_Q + (jb * 16 + fr) * 128);
            const bf16x8 qf0 = ld8(qb + sw0), qf1 = ld8(qb + sw1);
            if (half == 0) {
                const int qc = jb * 16 + fr, wsx = min(max(qc - 8, 0), 48); LAS const float* rp = (LAS const float*)(lds + NA_RPB) + (rs - r + 7) * 31 + (cstart + 4 * fq - qc + 15);
                bool ok[2][4];
#pragma unroll
                for (int hf = 0; hf < 2; ++hf)
#pragma unroll
                    for (int reg = 0; reg < 4; ++reg) { const int kc = cstart + 16 * hf + 4 * fq + reg; ok[hf][reg] = kc >= wsx && kc < wsx + 16; }
#pragma unroll
                for (int t = 0; t < 16; ++t) { LAS const float* bp = rp + (t >> 1) * 31 + 16 * (t & 1);
#pragma unroll
                    for (int reg = 0; reg < 4; ++reg) { const float x = bp[reg]; st[t][reg] = ok[t & 1][reg] ? x : -1.0e30f; } }
            } else {
#pragma unroll
                for (int t = 0; t < 16; ++t) st[t] = (f32x4){0.f, 0.f, 0.f, 0.f};
            }
#pragma unroll
            for (int t = 0; t < 16; ++t) {
                const int kidx = half == 0 ? (t >> 1) * 64 + cstart + 16 * (t & 1) + fr : 16 * t + fr;
                lptr kp = (lptr)(lds + (half == 0 ? 0 : NA_KC) + kidx * 128);
                st[t] = __builtin_amdgcn_mfma_f32_16x16x32_bf16(ld8(kp + sw0), qf0, st[t], 0, 0, 0);
                st[t] = __builtin_amdgcn_mfma_f32_16x16x32_bf16(ld8(kp + sw1), qf1, st[t], 0, 0, 0);
            }
        }
        USTAMP(2);
        if (!ctxq) {
#pragma unroll
            for (int i = 0; i < 8; ++i) { const size_t tok = (size_t)b * SEQ + (rs + i) * 64 + skey; kv[i] = *(const u32x4*)(P + tok * PW + C_NV + h * 64 + sch * 8); }
        }
#pragma unroll
        for (int i = 0; i < 4; ++i) { const size_t tok = (size_t)MLAT + b * CTXL + skey + 64 * i; kv[8 + i] = *(const u32x4*)(P + tok * PW + C_NV + h * 64 + sch * 8); }
        if (active) {
            constexpr float SC = 0.125f * LOG2E;
#pragma unroll
            for (int t = 0; t < 16; ++t) st[t] = st[t] * SC;
#pragma unroll
            for (int t = 0; t < 16; ++t) mx = fmaxf(mx, fmaxf(fmaxf(st[t][0], st[t][1]), fmaxf(st[t][2], st[t][3])));
            mx = fmaxf(mx, __shfl_xor(mx, 16)); mx = fmaxf(mx, __shfl_xor(mx, 32));
#pragma unroll
            for (int t = 0; t < 16; ++t)
#pragma unroll
                for (int reg = 0; reg < 4; ++reg) { const float p = __builtin_amdgcn_exp2f(st[t][reg] - mx); st[t][reg] = p; lsum += p; }
            lsum += __shfl_xor(lsum, 16); lsum += __shfl_xor(lsum, 32);
#pragma unroll
            for (int s = 0; s < 8; ++s) pa[s] = pack8(st[2 * s], st[2 * s + 1]);
        } else {
#pragma unroll
            for (int s = 0; s < 8; ++s) pa[s] = (bf16x8){0, 0, 0, 0, 0, 0, 0, 0};
        }
        USTAMP(3);
        __syncthreads();
        if (!ctxq) {
#pragma unroll
            for (int i = 0; i < 8; ++i) *(LAS u32x4*)(lds + sdst + i * 8192) = kv[i];
        }
#pragma unroll
        for (int i = 0; i < 4; ++i) *(LAS u32x4*)(lds + NA_KC + sdst + i * 8192) = kv[8 + i];
        __syncthreads();
        USTAMP(4);
        if (it + F.G < total) { int b2, h2, r2; NA_DECODE(it + F.G, b2, h2, r2); NA_LOADK(b2, h2, r2); }
        f32x4 o[4];
#pragma unroll
        for (int n = 0; n < 4; ++n) o[n] = (f32x4){0.f, 0.f, 0.f, 0.f};
        if (active) {
            const int q4 = (lane & 15) >> 2, p4 = lane & 3, c7 = 4 * (fq & 1) + q4;
            lptr vb = (lptr)(lds + (half == 0 ? 0 : NA_KC) + (4 * fq + q4) * 128 + 8 * (p4 & 1));
            int xo[4];
#pragma unroll
            for (int n = 0; n < 4; ++n) xo[n] = ((2 * n + (p4 >> 1)) ^ c7) << 4;
#pragma unroll
            for (int s = 0; s < 8; ++s) { const int k0 = half == 0 ? s * 64 + cstart : 32 * s;
#pragma unroll
                for (int n = 0; n < 4; ++n) { lptr rb = vb + k0 * 128 + xo[n];
                    const bf16x4 lo = vtr(rb), hi = vtr(rb + 16 * 128);
                    const bf16x8 bv = {lo[0], lo[1], lo[2], lo[3], hi[0], hi[1], hi[2], hi[3]};
                    o[n] = __builtin_amdgcn_mfma_f32_16x16x32_bf16(pa[s], bv, o[n], 0, 0, 0); } }
        }
        USTAMP(5);
        LAS float* cb = (LAS float*)(lds + NA_COMB + wave * NA_CSLOT);
#pragma unroll
        for (int n = 0; n < 4; ++n)
#pragma unroll
            for (int reg = 0; reg < 4; ++reg) cb[(4 * fq + reg) * 68 + n * 16 + fr] = o[n][reg];
        if (fq == 0) { cb[1088 + 2 * fr] = mx; cb[1089 + 2 * fr] = lsum; }
        __syncthreads();
        if (wave < 4) {
            LAS const float* c1 = (LAS const float*)(lds + NA_COMB + wave * NA_CSLOT); LAS const float* c2 = (LAS const float*)(lds + NA_COMB + (wave + 4) * NA_CSLOT);
            const int q = lane >> 2, part = lane & 3;
            const float m1 = c1[1088 + 2 * q], l1 = c1[1089 + 2 * q], m2 = c2[1088 + 2 * q], l2 = c2[1089 + 2 * q], M = fmaxf(m1, m2);
            const float w1 = __builtin_amdgcn_exp2f(m1 - M), w2 = __builtin_amdgcn_exp2f(m2 - M), inv = 1.0f / (w1 * l1 + w2 * l2), s1 = w1 * inv, s2 = w2 * inv;
            u32x4 ov[2];
#pragma unroll
            for (int j = 0; j < 2; ++j) { const f32x4 a0 = *(LAS const f32x4*)(c1 + q * 68 + part * 16 + 8 * j), a1 = *(LAS const f32x4*)(c1 + q * 68 + part * 16 + 8 * j + 4);
                const f32x4 b0 = *(LAS const f32x4*)(c2 + q * 68 + part * 16 + 8 * j), b1 = *(LAS const f32x4*)(c2 + q * 68 + part * 16 + 8 * j + 4);
                const f32x4 r0 = a0 * s1 + b0 * s2, r1 = a1 * s1 + b1 * s2;
                ov[j].x = pk2(r0[0], r0[1]); ov[j].y = pk2(r0[2], r0[3]); ov[j].z = pk2(r1[0], r1[1]); ov[j].w = pk2(r1[2], r1[3]); }
            bf16_t* orow = F.CAT + (size_t)(tokq0 + jb * 16 + q) * DM + 640 + h * 64 + part * 16;
            *(u32x4*)orow = ov[0]; *(u32x4*)(orow + 8) = ov[1];
        }
        USTAMP(6);
    }
#undef NA_DECODE
#undef NA_LOADK
}

__device__ __forceinline__ int ret_row0(int b, int t) { return t >= 2 ? b * SEQ + (t - 2) * 128 : MLAT + b * CTXL + t * 128; }
constexpr int R1_K = 0, R1_VF = 32768, R1_VB = 65536;
__device__ __forceinline__ unsigned r1_swz(int row, int ch) { return (unsigned)(row * 256 + ((ch ^ (row & 15)) << 4)); }
__device__ __forceinline__ u32x4 scale8(const u32x4& v, float w) { u32x4 o; o.x = pk2(bflo(v.x) * w, bfhi(v.x) * w); o.y = pk2(bflo(v.y) * w, bfhi(v.y) * w); o.z = pk2(bflo(v.z) * w, bfhi(v.z) * w); o.w = pk2(bflo(v.w) * w, bfhi(v.w) * w); return o; }
__device__ __forceinline__ void r1_unit(Frame& F, int layer, int b, int h, int t) {
    F.fresh();
    const int tid = F.tid, lane = F.lane, wave = F.wave, fr = lane & 15, fq = lane >> 4;
    LAS unsigned char* lds = F.lds; bf16_t* P = F.PROJ;
    const bool lat = t >= 2; const int row0 = ret_row0(b, t);
    const float lgf = F.LG[layer * 8 + h], lgb = F.LG[layer * 8 + 4 + h], ks = 0.10206207261596575f;
    __syncthreads();
    u32x4 xa[3], xb[3], vv[3]; f32x4 tb[3][4];
#pragma unroll
    for (int it = 0; it < 3; ++it) { const int e = tid + NTHR * it, X = e / 768, rem = e % 768, j = rem / 6, cp = rem % 6, c0 = cp < 3 ? cp : cp + 3;
        const bf16_t* xr = P + (size_t)(row0 + j) * PW + (X ? C_RQ : C_RK) + h * 96;
        xa[it] = *(const u32x4*)(xr + c0 * 8); xb[it] = *(const u32x4*)(xr + (c0 + 3) * 8);
        if (lat) { const int pos = (t - 2) * 128 + j, prow = pos >> 6, pcol = pos & 63; const float* tp = F.ROPE + ((cp < 3 ? prow * 24 : 3072 + pcol * 24) + 8 * (cp % 3)) * 2;
#pragma unroll
            for (int q = 0; q < 4; ++q) tb[it][q] = *(const f32x4*)(tp + 4 * q); } }
#pragma unroll
    for (int it = 0; it < 3; ++it) { const int e = tid + NTHR * it, j = e / 12, ch = e % 12; vv[it] = *(const u32x4*)(P + (size_t)(row0 + j) * PW + C_RV + h * 96 + ch * 8); }
#pragma unroll
    for (int it = 0; it < 3; ++it) { const int e = tid + NTHR * it, X = e / 768, rem = e % 768, j = rem / 6, cp = rem % 6, c0 = cp < 3 ? cp : cp + 3;
        const float scl = X ? 1.0f : ks; u32x4 oa, ob;
        if (lat) { float ra[8], rb[8]; const unsigned ua[4] = {xa[it].x, xa[it].y, xa[it].z, xa[it].w}, ub[4] = {xb[it].x, xb[it].y, xb[it].z, xb[it].w};
#pragma unroll
            for (int q = 0; q < 4; ++q) { const float a0 = bflo(ua[q]), a1 = bfhi(ua[q]), b0 = bflo(ub[q]), b1 = bfhi(ub[q]); const f32x4 cs = tb[it][q];
                ra[2 * q] = (a0 * cs[0] - b0 * cs[1]) * scl; rb[2 * q] = (a0 * cs[1] + b0 * cs[0]) * scl; ra[2 * q + 1] = (a1 * cs[2] - b1 * cs[3]) * scl; rb[2 * q + 1] = (a1 * cs[3] + b1 * cs[2]) * scl; }
            oa.x = pk2(ra[0], ra[1]); oa.y = pk2(ra[2], ra[3]); oa.z = pk2(ra[4], ra[5]); oa.w = pk2(ra[6], ra[7]);
            ob.x = pk2(rb[0], rb[1]); ob.y = pk2(rb[2], rb[3]); ob.z = pk2(rb[4], rb[5]); ob.w = pk2(rb[6], rb[7]);
        } else { oa = X ? xa[it] : scale8(xa[it], ks); ob = X ? xb[it] : scale8(xb[it], ks); }
        if (lat || X == 0) { bf16_t* xr = P + (size_t)(row0 + j) * PW + (X ? C_RQ : C_RK) + h * 96; *(u32x4*)(xr + c0 * 8) = oa; *(u32x4*)(xr + (c0 + 3) * 8) = ob; }
        if (X == 0) { *(LAS u32x4*)(lds + R1_K + r1_swz(j, c0)) = oa; *(LAS u32x4*)(lds + R1_K + r1_swz(j, c0 + 3)) = ob; } }
#pragma unroll
    for (int it = 0; it < 3; ++it) { const int e = tid + NTHR * it, j = e / 12, ch = e % 12;
        *(LAS u32x4*)(lds + R1_VF + r1_swz(j, ch)) = scale8(vv[it], expf(lgf * (float)(127 - j))); *(LAS u32x4*)(lds + R1_VB + r1_swz(j, ch)) = scale8(vv[it], expf(lgb * (float)j)); }
    __syncthreads();
    const int dir = wave >> 2, q = wave & 3, mb = q >> 1, nb = q & 1, q4 = (lane & 15) >> 2, p4 = lane & 3; f32x4 acc[3][3]; zero_acc(acc);
    lptr vbase = (lptr)(lds + (dir ? R1_VB : R1_VF)), kbase = (lptr)(lds + R1_K);
#pragma unroll
    for (int s = 0; s < 4; ++s) { bf16x8 a[3], bb[3]; const int r0 = 32 * s + 8 * fq + q4, r1 = r0 + 4;
#pragma unroll
        for (int m = 0; m < 3; ++m) { const int ch = 2 * (mb * 3 + m) + (p4 >> 1); const bf16x4 lo = vtr(vbase + r1_swz(r0, ch) + 8 * (p4 & 1)), hi = vtr(vbase + r1_swz(r1, ch) + 8 * (p4 & 1));
            a[m] = (bf16x8){lo[0], lo[1], lo[2], lo[3], hi[0], hi[1], hi[2], hi[3]}; }
#pragma unroll
        for (int n = 0; n < 3; ++n) { const int ch = 2 * (nb * 3 + n) + (p4 >> 1); const bf16x4 lo = vtr(kbase + r1_swz(r0, ch) + 8 * (p4 & 1)), hi = vtr(kbase + r1_swz(r1, ch) + 8 * (p4 & 1));
            bb[n] = (bf16x8){lo[0], lo[1], lo[2], lo[3], hi[0], hi[1], hi[2], hi[3]}; }
#pragma unroll
        for (int m = 0; m < 3; ++m)
#pragma unroll
            for (int n = 0; n < 3; ++n) acc[m][n] = __builtin_amdgcn_mfma_f32_16x16x32_bf16(bb[n], a[m], acc[m][n], 0, 0, 0); }
    const int u = dir == 0 ? t : (t < 2 ? 1 - t : 67 - t);
    bf16_t* ST = F.STATE + (size_t)(((b * 4 + h) * 2 + dir) * 66 + u) * 9216;
#pragma unroll
    for (int m = 0; m < 3; ++m)
#pragma unroll
        for (int n = 0; n < 3; ++n)
            { u32x2 w; w.x = pk2(acc[m][n][0], acc[m][n][1]); w.y = pk2(acc[m][n][2], acc[m][n][3]); *(u32x2*)(ST + (mb * 48 + m * 16 + fr) * 96 + nb * 48 + n * 16 + 4 * fq) = w; }
}
__device__ __forceinline__ void r2_scan(Frame& F, int layer) {
    F.fresh();
    const int gt = F.vcu * NTHR + F.tid, GT = F.G * NTHR;
    for (int e = gt; e < 16 * 4608; e += GT) { const int combo = e / 4608, idx = (e % 4608) * 2, h = (combo >> 1) & 3, dir = combo & 1;
        const float dcy = expf(128.0f * F.LG[layer * 8 + dir * 4 + h]); unsigned* p = (unsigned*)(F.STATE + (size_t)combo * 66 * 9216 + idx); float s0 = 0.f, s1 = 0.f;
#pragma unroll 1
        for (int u0 = 0; u0 < 66; u0 += 33) { unsigned kv[33];
#pragma unroll
            for (int q = 0; q < 33; ++q) kv[q] = p[(size_t)(u0 + q) * 4608];
#pragma unroll
            for (int q = 0; q < 33; ++q) { p[(size_t)(u0 + q) * 4608] = pk2(s0, s1); s0 = s0 * dcy + bflo(kv[q]); s1 = s1 * dcy + bfhi(kv[q]); } } }
}
constexpr int R3_Q = 0, R3_K = 26624, R3_V = 53248, R3_P = 86016, R3_SF = 120832, R3_SB = 140800;
static_assert(R3_SB + 96 * 208 <= MISC_OFF, "R3 LDS map");
__device__ __forceinline__ void r3_units(Frame& F, int layer) {
    F.fresh();
    const int tid = F.tid, lane = F.lane, wave = F.wave, fr = lane & 15, fq = lane >> 4, q4 = (lane & 15) >> 2, p4 = lane & 3;
    LAS unsigned char* lds = F.lds; const bf16_t* P = F.PROJ;
    const int nt = layer == 0 ? 66 : 64, t0 = layer == 0 ? 0 : 2, total = 8 * nt;
    int it = blockIdx.x; if (it >= total) return;
    u32x4 rq[3], rk[3], rv[3], sv[5];
#define R3_DECODE(itx, b_, h_, t_) do { b_ = (itx) / (4 * nt); h_ = ((itx) / nt) & 3; t_ = t0 + (itx) % nt; } while (0)
#define R3_LOAD(b_, h_, t_) do { const int r0_ = ret_row0(b_, t_); \
        _Pragma("unroll") for (int i_ = 0; i_ < 3; ++i_) { const int e_ = tid + NTHR * i_, j_ = e_ / 12, c_ = e_ % 12; const bf16_t* rp_ = P + (size_t)(r0_ + j_) * PW + (h_) * 96 + c_ * 8; \
            rq[i_] = *(const u32x4*)(rp_ + C_RQ); rk[i_] = *(const u32x4*)(rp_ + C_RK); rv[i_] = *(const u32x4*)(rp_ + C_RV); } \
        const int ub_ = (t_) < 2 ? 1 - (t_) : 67 - (t_); \
        _Pragma("unroll") for (int i_ = 0; i_ < 5; ++i_) { const int e_ = tid + NTHR * i_; if (e_ < 2304) { const int d_ = e_ >= 1152, c_ = d_ ? e_ - 1152 : e_; \
            sv[i_] = *(const u32x4*)(F.STATE + (size_t)((((b_) * 4 + (h_)) * 2 + d_) * 66 + (d_ ? ub_ : (t_))) * 9216 + c_ * 8); } } } while (0)
    int b, h, t; R3_DECODE(it, b, h, t); R3_LOAD(b, h, t);
    for (; it < total; it += F.G) {
        R3_DECODE(it, b, h, t);
        const int row0 = ret_row0(b, t);
        const float lf2 = F.LG[layer * 8 + h] * LOG2E, lb2 = F.LG[layer * 8 + 4 + h] * LOG2E;
        __syncthreads();
        USTAMP(10);
#pragma unroll
        for (int i = 0; i < 3; ++i) { const int e = tid + NTHR * i, j = e / 12, c = e % 12;
            *(LAS u32x4*)(lds + R3_Q + j * 208 + c * 16) = rq[i]; *(LAS u32x4*)(lds + R3_K + j * 208 + c * 16) = rk[i]; *(LAS u32x4*)(lds + R3_V + r1_swz(j, c)) = rv[i]; }
#pragma unroll
        for (int i = 0; i < 5; ++i) { const int e = tid + NTHR * i; if (e < 2304) { const int d = e >= 1152, c = d ? e - 1152 : e;
            *(LAS u32x4*)(lds + (d ? R3_SB : R3_SF) + (c / 12) * 208 + (c % 12) * 16) = sv[i]; } }
        __syncthreads();
        USTAMP(11);
        unsigned short gtv[4][6]; float gnv[6];
#pragma unroll
        for (int reg = 0; reg < 4; ++reg)
#pragma unroll
            for (int n = 0; n < 6; ++n) gtv[reg][n] = P[(size_t)(row0 + wave * 16 + 4 * fq + reg) * PW + C_RG + h * 96 + n * 16 + fr];
#pragma unroll
        for (int n = 0; n < 6; ++n) gnv[n] = F.ret_g[layer * 384 + h * 96 + n * 16 + fr];
        if (it + F.G < total) { int b2, h2, t2; R3_DECODE(it + F.G, b2, h2, t2); R3_LOAD(b2, h2, t2); }
        f32x4 ao[1][6];
        {
            f32x4 af[1][6], ab[1][6]; zero_acc(af); zero_acc(ab);
            wave_mma<1, 6>(af, (lptr)(lds + R3_Q + wave * 16 * 208), 208, (lptr)(lds + R3_SF), 208, 3, fr, fq);
            wave_mma<1, 6>(ab, (lptr)(lds + R3_Q + wave * 16 * 208), 208, (lptr)(lds + R3_SB), 208, 3, fr, fq);
#pragma unroll
            for (int reg = 0; reg < 4; ++reg) { const int il = wave * 16 + 4 * fq + reg; const float qdf = __builtin_amdgcn_exp2f(lf2 * (float)(il + 1)), qdb = __builtin_amdgcn_exp2f(lb2 * (float)(128 - il));
#pragma unroll
                for (int n = 0; n < 6; ++n) ao[0][n][reg] = qdf * af[0][n][reg] + qdb * ab[0][n][reg]; }
        }
        {
            bf16x8 qf[3];
#pragma unroll
            for (int s = 0; s < 3; ++s) qf[s] = ld8((lptr)(lds + R3_Q + (wave * 16 + fr) * 208 + s * 64 + fq * 16));
            const int i = wave * 16 + fr;
#pragma unroll 1
            for (int m = 0; m < 8; ++m) { f32x4 a = {0.f, 0.f, 0.f, 0.f};
#pragma unroll
                for (int s = 0; s < 3; ++s) a = __builtin_amdgcn_mfma_f32_16x16x32_bf16(ld8((lptr)(lds + R3_K + (m * 16 + fr) * 208 + s * 64 + fq * 16)), qf[s], a, 0, 0, 0);
                float pv[4];
#pragma unroll
                for (int reg = 0; reg < 4; ++reg) { const int diff = i - (m * 16 + 4 * fq + reg);
                    const float ex = __builtin_amdgcn_exp2f((diff > 0 ? lf2 : lb2) * (float)(diff > 0 ? diff : -diff)); const float dec = diff == 0 ? 2.0f : ex; pv[reg] = a[reg] * dec; }
                u32x2 w; w.x = pk2(pv[0], pv[1]); w.y = pk2(pv[2], pv[3]); *(LAS u32x2*)(lds + R3_P + i * 272 + (m * 16 + 4 * fq) * 2) = w; }
        }
        asm volatile("s_waitcnt lgkmcnt(0)" ::: "memory");
        USTAMP(12);
#pragma unroll 1
        for (int s = 0; s < 4; ++s) { const bf16x8 a = ld8((lptr)(lds + R3_P + (wave * 16 + fr) * 272 + s * 64 + fq * 16)); const int r0 = 32 * s + 8 * fq + q4;
#pragma unroll
            for (int n = 0; n < 6; ++n) { const int ch = 2 * n + (p4 >> 1); const bf16x4 lo = vtr((lptr)(lds + R3_V + r1_swz(r0, ch) + 8 * (p4 & 1))), hi = vtr((lptr)(lds + R3_V + r1_swz(r0 + 4, ch) + 8 * (p4 & 1)));
                const bf16x8 bv = {lo[0], lo[1], lo[2], lo[3], hi[0], hi[1], hi[2], hi[3]};
                ao[0][n] = __builtin_amdgcn_mfma_f32_16x16x32_bf16(a, bv, ao[0][n], 0, 0, 0); } }
        USTAMP(13);
#pragma unroll
        for (int reg = 0; reg < 4; ++reg) { const int il = wave * 16 + 4 * fq + reg;
            float ov[6], ss = 0.f;
#pragma unroll
            for (int n = 0; n < 6; ++n) { ov[n] = ao[0][n][reg]; ss += ov[n] * ov[n]; }
            ss += __shfl_xor(ss, 1); ss += __shfl_xor(ss, 2); ss += __shfl_xor(ss, 4); ss += __shfl_xor(ss, 8);
            const float rn = rsqrtf(ss * (1.0f / 96.0f) + NORM_EPS);
#pragma unroll
            for (int n = 0; n < 6; ++n) { const int col = n * 16 + fr; const float gt = bf2f(gtv[reg][n]);
                *(LAS bf16_t*)(lds + R3_P + (wave * 16 + 4 * fq + reg) * 272 + col * 2) = (bf16_t)f2bf(ov[n] * rn * gnv[n] * silu_f(gt)); } }
        asm volatile("s_waitcnt lgkmcnt(0)" ::: "memory");
#pragma unroll
        for (int i = 0; i < 3; ++i) { const int c = lane + 64 * i, rr = c / 12, ch = c % 12;
            *(u32x4*)(F.CAT + (size_t)(row0 + wave * 16 + rr) * DM + 256 + h * 96 + ch * 8) = *(LAS const u32x4*)(lds + R3_P + (wave * 16 + rr) * 272 + ch * 16); }
        USTAMP(14);
    }
#undef R3_DECODE
#undef R3_LOAD
}

__device__ __forceinline__ void d1_unit(Frame& F, int b, int l2, int g) {
    F.fresh();
    const int tid = F.tid, lane = F.lane, wave = F.wave, fr = lane & 15, fq = lane >> 4;
    LAS unsigned char* lds = F.lds; const bf16_t* P = F.PROJ;
    __syncthreads();
    {
        u32x4 v[2];
#pragma unroll
        for (int i = 0; i < 2; ++i) { const int row = (tid >> 3) + 64 * i, ch = tid & 7; v[i] = *(const u32x4*)(P + ((size_t)b * SEQ + row * 64 + l2) * PW + g * 64 + ch * 8); }
#pragma unroll
        for (int i = 0; i < 2; ++i) { const int row = (tid >> 3) + 64 * i, ch = tid & 7; *(LAS u32x4*)(lds + row * 128 + ((ch ^ (row & 7)) << 4)) = v[i]; }
    }
    bf16x8 bfr[2][4];
#pragma unroll
    for (int cs = 0; cs < 2; ++cs)
#pragma unroll
        for (int s = 0; s < 4; ++s) bfr[cs][s] = *(const bf16x8*)(F.TWA + (size_t)(cs * 128 + 16 * wave + fr) * 128 + 32 * s + 8 * fq);
    __syncthreads();
    f32x4 acc[4][2]; zero_acc(acc);
    const int q4 = (lane & 15) >> 2, p4 = lane & 3;
#pragma unroll
    for (int s = 0; s < 4; ++s)
#pragma unroll
        for (int mt = 0; mt < 4; ++mt) {
            lptr rb = (lptr)(lds + (32 * s + 8 * fq + q4) * 128 + 8 * (p4 & 1));
            const bf16x4 lo = vtr(rb + (((2 * mt + (p4 >> 1)) ^ q4) << 4)), hi = vtr(rb + 4 * 128 + (((2 * mt + (p4 >> 1)) ^ (4 + q4)) << 4));
            const bf16x8 av = {lo[0], lo[1], lo[2], lo[3], hi[0], hi[1], hi[2], hi[3]};
            acc[mt][0] = __builtin_amdgcn_mfma_f32_16x16x32_bf16(av, bfr[0][s], acc[mt][0], 0, 0, 0);
            acc[mt][1] = __builtin_amdgcn_mfma_f32_16x16x32_bf16(av, bfr[1][s], acc[mt][1], 0, 0, 0);
        }
    const int k1 = 16 * wave + fr; const f32x2 cs2 = *(const f32x2*)(F.TW8 + 2 * (k1 * l2));
    unsigned* yb = F.Y + ((((size_t)b * 64 + l2) * 128 + k1) * 4 + g) * 64;
#pragma unroll
    for (int mt = 0; mt < 2; ++mt)
#pragma unroll
        for (int reg = 0; reg < 4; ++reg) { const int p = 16 * mt + 4 * fq + reg;
            const float cp = acc[mt][0][reg], sp = acc[mt][1][reg], cq = acc[mt + 2][0][reg], sq = acc[mt + 2][1][reg];
            float yr0, yi0, yr1, yi1; int m0, m1;
            if (p == 0) { m0 = 0; yr0 = cp; yi0 = -sp; m1 = 32; yr1 = cq; yi1 = -sq; }
            else { m0 = p; yr0 = cp + sq; yi0 = cq - sp; m1 = 64 - p; yr1 = cp - sq; yi1 = -cq - sp; }
            yb[m0] = pk2(yr0 * cs2[0] + yi0 * cs2[1], yi0 * cs2[0] - yr0 * cs2[1]);
            yb[m1] = pk2(yr1 * cs2[0] + yi1 * cs2[1], yi1 * cs2[0] - yr1 * cs2[1]); }
}
constexpr int D2_Y = 0, D2_A = 69632, D2_F = 87040;
__device__ __forceinline__ void d2_unit(Frame& F, int layer, int b, int k1) {
    F.fresh();
    const int tid = F.tid, lane = F.lane, wave = F.wave, fr = lane & 15, fq = lane >> 4;
    LAS unsigned char* lds = F.lds;
    __syncthreads();
    {
        u32x4 yv[8];
#pragma unroll
        for (int i = 0; i < 8; ++i) { const int e = tid + NTHR * i, l2 = (e & 15) + 16 * ((e >> 6) & 3), q = ((e >> 4) & 3) + 4 * (e >> 8);
            yv[i] = *(const u32x4*)(F.Y + (((size_t)b * 64 + l2) * 128 + k1) * 256 + 4 * q); }
#pragma unroll
        for (int i = 0; i < 8; ++i) { const int e = tid + NTHR * i, l2 = (e & 15) + 16 * ((e >> 6) & 3), q = ((e >> 4) & 3) + 4 * (e >> 8);
            LAS unsigned char* d = lds + D2_Y + (4 * q) * 272 + l2 * 4;
            *(LAS unsigned*)(d) = yv[i].x; *(LAS unsigned*)(d + 272) = yv[i].y; *(LAS unsigned*)(d + 544) = yv[i].z; *(LAS unsigned*)(d + 816) = yv[i].w; }
    }
    for (int e = tid; e < 1024; e += NTHR) { const int row = e >> 4, ch = e & 15; *(LAS u32x4*)(lds + D2_A + row * 272 + ch * 16) = *(const u32x4*)(F.TD2 + row * 128 + ch * 8); }
    __syncthreads();
    f32x4 acc[4][2]; zero_acc(acc);
    wave_mma<4, 2>(acc, (lptr)(lds + D2_A), 272, (lptr)(lds + D2_Y + wave * 32 * 272), 272, 4, fr, fq);
    const float scale = 0.0013810679320049757f;
#pragma unroll
    for (int mt = 0; mt < 4; ++mt)
#pragma unroll
        for (int nt = 0; nt < 2; ++nt)
#pragma unroll
            for (int reg = 0; reg < 4; ++reg) *(LAS bf16_t*)(lds + D2_F + (mt * 16 + 4 * fq + reg) * 528 + (wave * 32 + nt * 16 + fr) * 2) = (bf16_t)f2bf(acc[mt][nt][reg] * scale);
    __syncthreads();
    zero_acc(acc);
    wave_mma<4, 2>(acc, (lptr)(lds + D2_F), 528, (gptr)(F.WFT + (size_t)layer * 65536) + (size_t)(wave * 32) * 512, 512, 8, fr, fq);
    __syncthreads();
#pragma unroll
    for (int mt = 0; mt < 4; ++mt)
#pragma unroll
        for (int nt = 0; nt < 2; ++nt)
#pragma unroll
            for (int reg = 0; reg < 4; ++reg) *(LAS bf16_t*)(lds + D2_F + (mt * 16 + 4 * fq + reg) * 528 + (wave * 32 + nt * 16 + fr) * 2) = (bf16_t)f2bf(acc[mt][nt][reg]);
    __syncthreads();
#pragma unroll
    for (int i = 0; i < 4; ++i) { const int e = tid + NTHR * i, k2 = e >> 5, ch = e & 31;
        *(u32x4*)(F.CAT + ((size_t)b * SEQ + k1 + 128 * k2) * DM + ch * 8) = *(LAS const u32x4*)(lds + D2_F + k2 * 528 + ch * 16); }
}
constexpr int DC_H = 0, DC_F = 131072;
__device__ __forceinline__ void dctx_item(Frame& F, int layer, int it) {
    F.fresh();
    const int tid = F.tid, lane = F.lane, wave = F.wave, fr = lane & 15, fq = lane >> 4; LAS unsigned char* lds = F.lds; const bf16_t* P = F.PROJ;
    const int b = it >> 5, k0 = (it & 31) * 8;
    __syncthreads();
    { u32x4 v[16];
#pragma unroll
      for (int i = 0; i < 16; ++i) { const int e = tid + NTHR * i, row = e >> 5, ch = e & 31; v[i] = *(const u32x4*)(P + ((size_t)MLAT + b * CTXL + row) * PW + ch * 8); }
#pragma unroll
      for (int i = 0; i < 16; ++i) { const int e = tid + NTHR * i, row = e >> 5, ch = e & 31; *(LAS u32x4*)(lds + DC_H + row * 512 + ((ch ^ (row & 15)) << 4)) = v[i]; } }
    for (int e = tid; e < 16 * 132; e += NTHR) ((LAS unsigned*)(lds + DC_F))[e] = 0u;
    bf16x8 bfr[8];
    { const bf16_t* tb = F.TC256 + ((size_t)((fr >> 3) * 256 + k0 + (fr & 7))) * 256 + 8 * fq;
#pragma unroll
      for (int s = 0; s < 8; ++s) bfr[s] = *(const bf16x8*)(tb + 32 * s); }
    __syncthreads();
    const int g = wave >> 1, jj = wave & 1, q4 = (lane & 15) >> 2, p4 = lane & 3;
    f32x4 acc[2]; acc[0] = (f32x4){0.f, 0.f, 0.f, 0.f}; acc[1] = acc[0];
#pragma unroll
    for (int s = 0; s < 8; ++s)
#pragma unroll
        for (int mt = 0; mt < 2; ++mt) { const int chunk = 2 * (g * 4 + jj + 2 * mt) + (p4 >> 1); const int r0 = 32 * s + 8 * fq + q4;
            const bf16x4 lo = vtr((lptr)(lds + DC_H + r0 * 512 + ((chunk ^ (r0 & 15)) << 4) + 8 * (p4 & 1)));
            const bf16x4 hi = vtr((lptr)(lds + DC_H + (r0 + 4) * 512 + ((chunk ^ ((r0 + 4) & 15)) << 4) + 8 * (p4 & 1)));
            const bf16x8 av = {lo[0], lo[1], lo[2], lo[3], hi[0], hi[1], hi[2], hi[3]};
            acc[mt] = __builtin_amdgcn_mfma_f32_16x16x32_bf16(av, bfr[s], acc[mt], 0, 0, 0); }
    const int kk = fr & 7; const bool hiLane = fr >= 8;
#pragma unroll
    for (int reg = 0; reg < 4; ++reg) { const int pp = jj * 16 + 4 * fq + reg;
        const float vp = acc[0][reg], vq = acc[1][reg], op = __shfl_xor(vp, 8), oq = __shfl_xor(vq, 8);
        const float c_p = hiLane ? op : vp, c_q = hiLane ? oq : vq, s_q = hiLane ? vq : oq;
        float x; int m;
        if (pp == 0) { m = hiLane ? 32 : 0; x = hiLane ? c_q : c_p; } else { m = hiLane ? 64 - pp : pp; x = hiLane ? c_p - s_q : c_p + s_q; }
        *(LAS bf16_t*)(lds + DC_F + kk * 528 + (g * 64 + m) * 2) = (bf16_t)f2bf(x * (1.0f / 128.0f)); }
    __syncthreads();
    f32x4 o2[1][2]; zero_acc(o2);
    wave_mma<1, 2>(o2, (lptr)(lds + DC_F), 528, (gptr)(F.WFT + (size_t)layer * 65536) + (size_t)(wave * 32) * 512, 512, 8, fr, fq);
    if (fq < 2) {
#pragma unroll
        for (int nt = 0; nt < 2; ++nt)
#pragma unroll
            for (int reg = 0; reg < 4; ++reg) F.CAT[((size_t)MLAT + b * CTXL + k0 + 4 * fq + reg) * DM + wave * 32 + nt * 16 + fr] = (bf16_t)f2bf(o2[0][nt][reg]);
    }
}

#ifndef DUP_PHASE
#define DUP_PHASE 0
#endif
__device__ __forceinline__ void phase_m1(Frame& F, int layer) {
    const int nNA = 1536, nCQ = layer == 0 ? 48 : 0, nR1 = 528, nD1 = 512;
    for (int q = blockIdx.x; q < nR1; q += F.G) r1_unit(F, layer, q / 264, (q % 264) / 66, q % 66);
#pragma unroll 1
    for (int rep = 0; rep < (DUP_PHASE == 8 ? 2 : 1); ++rep)
        for (int q = blockIdx.x; q < nD1; q += F.G) d1_unit(F, q >> 8, (q >> 2) & 63, q & 3);
    na_units(F, layer, true, nCQ);
    na_units(F, layer, false, nNA, 0, 1);
}
__device__ __forceinline__ void phase_m2(Frame& F, int layer) {
    r2_scan(F, layer);
    const int nD2 = 256, nDC = layer == 0 ? 64 : 0;
    for (int it = blockIdx.x; it < nD2; it += F.G) d2_unit(F, layer, it >> 7, it & 127);
    for (int it = blockIdx.x; it < nDC; it += F.G) dctx_item(F, layer, it);
    F.prof = (layer == 1); na_units(F, layer, false, 1536, 1, 4); F.prof = false;
}
__device__ __forceinline__ void phase_m3(Frame& F, int layer) {
    F.prof = (layer == 1); r3_units(F, layer); F.prof = false;
    na_units(F, layer, false, 1536, 4, 6);
}

struct SgParams {
    const bf16_t* A; int lda; const bf16_t* Bt; int K;
    int mode;
    const float* ssq; const float* shw;
    bf16_t* O;
    const float* src; float* dst; bf16_t* XN; float* ssq_out; const float* gate; const float* sc; const float* g; float gmul;
};
constexpr int SG_A = 0, SG_B = 16384;
template <int NTW>
__device__ __forceinline__ void sg_unit(Frame& F, const SgParams& p, int mblk, int ntile) {
    F.fresh();
    constexpr int NB = NTW, BSTAGE = NTW * 8192, UW = 64 * NTW;
    const int tid = F.tid, lane = F.lane, wave = F.wave, fr = lane & 15, fq = lane >> 4, wr = wave & 1, wc = wave >> 1;
    LAS unsigned char* lds = F.lds;
    const int srow = tid >> 3, sch = tid & 7; const unsigned sdst = (unsigned)(srow * 128 + ((sch ^ (srow & 7)) << 4));
    const bf16_t* ap = p.A + (size_t)(mblk * 64 + srow) * p.lda + sch * 8;
    const bf16_t* bp = p.Bt + (size_t)(ntile * UW + srow) * p.K + sch * 8;
    int boff[NTW];
#pragma unroll
    for (int n = 0; n < NTW; ++n) boff[n] = NTW == 1 ? wc * 16 : (p.mode == 2 ? ((n >> 1) * 128 + wc * 32 + (n & 1) * 16) : (wc * 64 + n * 16));
    const int sw0 = (fq ^ (fr & 7)) << 4, sw1 = ((4 + fq) ^ (fr & 7)) << 4;
    f32x4 acc[2][NTW]; zero_acc(acc);
    const int nk = p.K / 64;
    u32x4 ra0, ra1, rb0[NB], rb1[NB];
#define SG_LOAD(RA, RB, kt) do { RA = *(const u32x4*)(ap + (kt) * 64); _Pragma("unroll") for (int i_ = 0; i_ < NB; ++i_) RB[i_] = *(const u32x4*)(bp + (size_t)(64 * i_) * p.K + (kt) * 64); } while (0)
#define SG_WRITE(RA, RB, buf) do { *(LAS u32x4*)(lds + SG_A + (buf) * 8192 + sdst) = RA; _Pragma("unroll") for (int i_ = 0; i_ < NB; ++i_) *(LAS u32x4*)(lds + SG_B + (buf) * BSTAGE + sdst + i_ * 8192) = RB[i_]; } while (0)
#define SG_MMA(buf) do { lptr Ab_ = (lptr)(lds + SG_A + (buf) * 8192 + (wr * 32 + fr) * 128), Bb_ = (lptr)(lds + SG_B + (buf) * BSTAGE + fr * 128); \
        _Pragma("unroll") for (int s_ = 0; s_ < 2; ++s_) { const int sw_ = s_ ? sw1 : sw0; bf16x8 a_[2], b_[NTW]; \
            _Pragma("unroll") for (int m_ = 0; m_ < 2; ++m_) a_[m_] = ld8(Ab_ + m_ * 16 * 128 + sw_); \
            _Pragma("unroll") for (int n_ = 0; n_ < NTW; ++n_) b_[n_] = ld8(Bb_ + boff[n_] * 128 + sw_); \
            _Pragma("unroll") for (int m_ = 0; m_ < 2; ++m_) _Pragma("unroll") for (int n_ = 0; n_ < NTW; ++n_) acc[m_][n_] = __builtin_amdgcn_mfma_f32_16x16x32_bf16(b_[n_], a_[m_], acc[m_][n_], 0, 0, 0); } } while (0)
    __syncthreads();
    SG_LOAD(ra0, rb0, 0); SG_LOAD(ra1, rb1, 1);
    SG_WRITE(ra0, rb0, 0);
    __syncthreads();
    for (int kt = 0; kt < nk; kt += 2) {
        if (kt + 2 < nk) SG_LOAD(ra0, rb0, kt + 2);
        SG_MMA(0);
        SG_WRITE(ra1, rb1, 1);
        __syncthreads();
        if (kt + 3 < nk) SG_LOAD(ra1, rb1, kt + 3);
        SG_MMA(1);
        if (kt + 2 < nk) SG_WRITE(ra0, rb0, 0);
        __syncthreads();
    }
#undef SG_LOAD
#undef SG_WRITE
#undef SG_MMA
    LAS float* red = (LAS float*)(lds + 98304);
#pragma unroll
    for (int m = 0; m < 2; ++m) { const int rl = mblk * 64 + wr * 32 + m * 16 + fr; const size_t rg = (size_t)MLAT + rl;
        if (p.mode == 0) { const float ri = pg8::row_rinv(p.ssq, (int)rg);
#pragma unroll
            for (int n = 0; n < NTW; ++n) { const int col = ntile * UW + boff[n] + 4 * fq; if (col < PW) { const f32x4 v = acc[m][n] * ri + *(const f32x4*)(p.shw + col);
                u32x2 w; w.x = pk2(v[0], v[1]); w.y = pk2(v[2], v[3]); *(u32x2*)(p.O + rg * PW + col) = w; } }
        } else if (p.mode == 2) { if constexpr (NTW == 4) { const float ri = pg8::row_rinv(p.ssq, (int)rg);
#pragma unroll
            for (int n = 0; n < 2; ++n) { const int wcol = ntile * 256 + boff[n] + 4 * fq, hcol = ntile * 128 + wc * 32 + n * 16 + 4 * fq;
                const f32x4 a = acc[m][n] * ri + *(const f32x4*)(p.shw + wcol), b = acc[m][n + 2] * ri + *(const f32x4*)(p.shw + wcol + 128);
                u32x2 w; w.x = pk2(silu_f(a[0]) * b[0], silu_f(a[1]) * b[1]); w.y = pk2(silu_f(a[2]) * b[2], silu_f(a[3]) * b[3]); *(u32x2*)(p.O + rg * FF + hcol) = w; } }
        } else { float ss = 0.f;
#pragma unroll
            for (int n = 0; n < NTW; ++n) { const int col = ntile * UW + boff[n] + 4 * fq; const size_t ol = (size_t)rl * DM + col;
                const f32x4 x1 = *(const f32x4*)(p.src + ol) + *(const f32x4*)(p.gate + col) * p.gmul * acc[m][n];
                *(f32x4*)(p.dst + ol) = x1; ss += (x1[0] * x1[0] + x1[1] * x1[1]) + (x1[2] * x1[2] + x1[3] * x1[3]);
                if (p.XN) { const f32x4 xn = x1 * (*(const f32x4*)(p.g + col) * (*(const f32x4*)(p.sc + col) + 1.0f)); u32x2 w; w.x = pk2(xn[0], xn[1]); w.y = pk2(xn[2], xn[3]); *(u32x2*)(p.XN + rg * DM + col) = w; } }
            ss += __shfl_xor(ss, 16); ss += __shfl_xor(ss, 32);
            if (NTW == 4) { if (fq == 0) p.ssq_out[rg * 16 + ntile * 4 + wc] = ss; }
            else { if (fq == 0) red[wc * 64 + wr * 32 + m * 16 + fr] = ss; } }
    }
    if (NTW == 1 && p.mode == 1) { __syncthreads(); if (tid < 64) p.ssq_out[((size_t)MLAT + mblk * 64 + tid) * 16 + ntile] = (red[tid] + red[64 + tid]) + (red[128 + tid] + red[192 + tid]); }
}
template <int NTW>
__device__ __forceinline__ void sg_phase(Frame& F, const SgParams& p, int ntiles, int big_units) {
    const int first_free = big_units % F.G, nfree = F.G - first_free, c = (int)blockIdx.x;
    if (c < first_free) return;
    for (int u = c - first_free; u < 8 * ntiles; u += nfree) sg_unit<NTW>(F, p, u % 8, u / 8);
}

#ifndef USE_COOP
#define USE_COOP 1
#endif
#ifndef MK_N_LAUNCHES
#define MK_N_LAUNCHES 1
#endif
constexpr int N_PHASES = 17;
constexpr int RINV_OFF = 133120;
__device__ __forceinline__ void fill_rinv(Frame& F, const pg8::StaticOrder& S) {
    LAS float* t = (LAS float*)(F.lds + RINV_OFF); pg8::Unit u;
    __syncthreads();
    for (int i0 = 0; i0 < 6; i0 += 2) { const int i = i0 + (F.tid >> 8); if (S.next(i, u)) t[i * 256 + (F.tid & 255)] = pg8::row_rinv(F.SSQ, u.pm * 256 + (F.tid & 255)); }
    __syncthreads();
}
struct Args { const float* in[18]; float* out; unsigned char* ws; int ph_lo, ph_hi; };
__global__ void __launch_bounds__(NTHR, 2) hymba_fwd(Args args) {
    extern __shared__ __attribute__((aligned(16))) unsigned char lds_raw[];
    Frame F;
    F.lds = (LAS unsigned char*)lds_raw;
    F.tid = threadIdx.x; F.lane = F.tid & 63; F.wave = __builtin_amdgcn_readfirstlane(F.tid >> 6);
    F.prof = false; F.G = gridDim.x; { const int bx = blockIdx.x; F.vcu = (F.G % 8 == 0) ? (bx % 8) * (F.G / 8) + bx / 8 : bx; }
    F.x = args.in[0]; F.c = args.in[1]; F.ctx = args.in[2]; F.c_ctx = args.in[3]; F.w_ada = args.in[4]; F.b_ada = args.in[5]; F.g_mix = args.in[6]; F.w_in = args.in[7];
    F.dlogit = args.in[8]; F.ret_g = args.in[9]; F.w_four = args.in[10]; F.rpb = args.in[11]; F.w_out = args.in[12]; F.g_ffn = args.in[13]; F.w1 = args.in[14]; F.w3 = args.in[15];
    F.w2 = args.in[16]; F.g_final = args.in[17]; F.out = args.out; F.ws = args.ws;
    unsigned char* ws = args.ws;
    F.MOD = (float*)(ws + WS_MOD); F.SHWIN = (float*)(ws + WS_SHWIN); F.SHW13 = (float*)(ws + WS_SHW13); F.ROPE = (float*)(ws + WS_ROPE); F.LG = (float*)(ws + WS_LG); F.CT256 = (float*)(ws + WS_CT256);
    F.SSQ = (float*)(ws + WS_SSQ); F.XC = (float*)(ws + WS_XC); F.STATE = (bf16_t*)(ws + WS_STATE); F.ADAP = (float*)(ws + WS_PROJ); F.TW8 = (const float*)(ws + WS_TAB + T_TW8);
    F.XN = (bf16_t*)(ws + WS_XN); F.CAT = (bf16_t*)(ws + WS_CAT); F.PROJ = (bf16_t*)(ws + WS_PROJ); F.HID = (bf16_t*)(ws + WS_PROJ);
    F.WFT = (bf16_t*)(ws + WS_TAB + T_WFT); F.TWA = (bf16_t*)(ws + WS_TAB + T_TWA); F.TD2 = (bf16_t*)(ws + WS_TAB + T_TD2); F.TC256 = (bf16_t*)(ws + WS_TAB + T_TC); F.Y = (unsigned*)(ws + WS_XN);
    volatile LAS unsigned* MISC = (volatile LAS unsigned*)(F.lds + MISC_OFF);
    if (F.tid < 64) MISC[F.tid] = 0u;
    __syncthreads();
    const int lo = args.ph_lo, hi = args.ph_hi;
#if MK_N_LAUNCHES == 1
    XcdBarrier bar = xcd_barrier_post((unsigned*)(ws + WS_CTL) + CW_BAR, MISC + 8);
    cg::grid_group grid = cg::this_grid();
#define SEAM(k) do { if (USE_COOP && args.ph_lo < 0) grid.sync();     \
    else { _Pragma("unroll 1") for (int rep_ = 0; rep_ < (DUP_PHASE == 19 ? 5 : 1); ++rep_) xcd_barrier(bar); } } while (0)
#else
#define SEAM(k) do { } while (0)
#endif
#define IN(k) (lo <= (k) && (k) < hi)
#ifndef STAMP_SEL
#define STAMP_SEL -1
#endif
    unsigned long long* stamps = (unsigned long long*)(ws + WS_CTL + 61440);
#define STAMP(k) do { if (STAMP_SEL >= 0 && blockIdx.x == 0 && threadIdx.x == 0) stamps[k] = __builtin_amdgcn_s_memrealtime(); } while (0)
    STAMP(0);
    if (IN(0)) { _Pragma("unroll 1") for (int rep = 0; rep < (DUP_PHASE == 5 ? 2 : 1); ++rep) { __syncthreads(); phase_p0a(F); } if (IN(1)) SEAM(0); } STAMP(1);
    if (IN(1)) { _Pragma("unroll 1") for (int rep = 0; rep < (DUP_PHASE == 21 ? 2 : 1); ++rep) { __syncthreads(); phase_p0b(F); } if (IN(2)) SEAM(1); } STAMP(2);
#pragma unroll 1
    for (int layer = 0; layer < 2; ++layer) {
        const int pb = 2 + 7 * layer; const bool last = layer == 1;
        const float* mod = F.MOD + (size_t)layer * 3 * 6144;
        if (IN(pb + 0)) {
            pg8::Gemm g{F.XN, F.W(layer, W_WIN), MLAT, PWP, DM}; pg8::StaticOrder S; S.init(MLAT, PWP, F.G, (int)blockIdx.x);
            fill_rinv(F, S);
            pg8::EpiProj E{F.PROJ, (const LAS float*)(F.lds + RINV_OFF), F.SHWIN + (size_t)layer * 3 * PWP, 0};
            _Pragma("unroll 1") for (int rep = 0; rep < (DUP_PHASE == 1 ? 2 : 1); ++rep) { __syncthreads(); pg8::gemm_phase<pg8::EpiProj, pg8::StaticOrder, true, true>(F.lds, g, S, E); }
            { SgParams sp{}; sp.A = F.XN + (size_t)MLAT * DM; sp.lda = DM; sp.Bt = F.W(layer, W_WIN); sp.K = DM; sp.mode = 0; sp.ssq = F.SSQ; sp.shw = F.SHWIN + (size_t)(layer * 3 + 2) * PWP; sp.O = F.PROJ;
              _Pragma("unroll 1") for (int rep = 0; rep < (DUP_PHASE == 12 ? 3 : 1); ++rep) sg_phase<1>(F, sp, 46, 768); }
            if (IN(pb + 1)) SEAM(pb);
        }
        STAMP(pb + 1);
        if (IN(pb + 1)) { _Pragma("unroll 1") for (int rep = 0; rep < (DUP_PHASE == 2 ? 2 : 1); ++rep) phase_m1(F, layer); if (IN(pb + 2)) SEAM(pb + 1); } STAMP(pb + 2);
        if (IN(pb + 2)) { phase_m2(F, layer); if (IN(pb + 3)) SEAM(pb + 2); } STAMP(pb + 3);
        if (IN(pb + 3)) { _Pragma("unroll 1") for (int rep = 0; rep < (DUP_PHASE == 3 ? 2 : 1); ++rep) phase_m3(F, layer); if (IN(pb + 4)) SEAM(pb + 3); } STAMP(pb + 4);
        const int Mrows = MLAT;
        if (IN(pb + 4)) {
            pg8::Gemm g{F.CAT, F.W(layer, W_WOUT), Mrows, DM, DM}; pg8::StaticOrder S; S.init(Mrows, DM, F.G, (int)blockIdx.x);
            pg8::EpiResWide E{last ? F.out : F.x, F.out, F.XN, F.SSQ, mod + 2048, mod + 4096, F.g_ffn + layer * DM, 1.0f};
            pg8::gemm_phase<pg8::EpiResWide, pg8::StaticOrder, false, true>(F.lds, g, S, E);
            if (!last) { SgParams sp{}; sp.A = F.CAT + (size_t)MLAT * DM; sp.lda = DM; sp.Bt = F.W(layer, W_WOUT); sp.K = DM; sp.mode = 1; sp.src = F.ctx; sp.dst = F.XC; sp.XN = F.XN; sp.ssq_out = F.SSQ;
              sp.gate = mod + 2048 + 2 * 6144; sp.sc = mod + 4096 + 2 * 6144; sp.g = F.g_ffn + layer * DM; sp.gmul = 1.0f; _Pragma("unroll 1") for (int rep = 0; rep < (DUP_PHASE == 13 ? 3 : 1); ++rep) sg_phase<1>(F, sp, 16, 256); }
            if (IN(pb + 5)) SEAM(pb + 4);
        }
        STAMP(pb + 5);
        if (IN(pb + 5)) {
            pg8::Gemm g{F.XN, F.W(layer, W_W13), Mrows, FF2, DM}; pg8::StaticOrder S; S.init(Mrows, FF2, F.G, (int)blockIdx.x);
            fill_rinv(F, S);
            pg8::EpiSwiGLU E{F.HID, (const LAS float*)(F.lds + RINV_OFF), F.SHW13 + (size_t)layer * 3 * FF2, 0};
            _Pragma("unroll 1") for (int rep = 0; rep < (DUP_PHASE == 4 ? 2 : 1); ++rep) { __syncthreads(); pg8::gemm_phase<pg8::EpiSwiGLU, pg8::StaticOrder, true, true>(F.lds, g, S, E); }
            if (!last) { SgParams sp{}; sp.A = F.XN + (size_t)MLAT * DM; sp.lda = DM; sp.Bt = F.W(layer, W_W13); sp.K = DM; sp.mode = 2; sp.ssq = F.SSQ; sp.shw = F.SHW13 + (size_t)(layer * 3 + 2) * FF2; sp.O = F.HID;
              _Pragma("unroll 1") for (int rep = 0; rep < (DUP_PHASE == 14 ? 3 : 1); ++rep) sg_phase<4>(F, sp, 22, 1408); }
            if (IN(pb + 6)) SEAM(pb + 5);
        }
        STAMP(pb + 6);
        if (IN(pb + 6)) {
            pg8::Gemm g{F.HID, F.W(layer, W_W2), Mrows, DM, FF}; pg8::StaticOrder S; S.init(Mrows, DM, F.G, (int)blockIdx.x);
            pg8::EpiResWide E{F.out, F.out, last ? nullptr : F.XN, F.SSQ, mod + 5120, F.MOD + 3 * 6144 + 1024, F.g_mix + DM, 1.0f};
            pg8::gemm_phase<pg8::EpiResWide, pg8::StaticOrder, false, true>(F.lds, g, S, E);
            if (!last) { SgParams sp{}; sp.A = F.HID + (size_t)MLAT * FF; sp.lda = FF; sp.Bt = F.W(layer, W_W2); sp.K = FF; sp.mode = 1; sp.src = F.XC; sp.dst = F.XC; sp.XN = F.XN; sp.ssq_out = F.SSQ;
              sp.gate = mod + 5120 + 2 * 6144; sp.sc = F.MOD + 3 * 6144 + 1024 + 2 * 6144; sp.g = F.g_mix + DM; _Pragma("unroll 1") for (int rep = 0; rep < (DUP_PHASE == 15 ? 3 : 1); ++rep) { sp.gmul = (DUP_PHASE == 15 && rep < 2) ? 0.0f : 1.0f; sg_phase<1>(F, sp, 16, 256); } }
            if (IN(pb + 7)) SEAM(pb + 6);
        }
        STAMP(pb + 7);
    }
    float delta = 0.f;
    if (STAMP_SEL >= 0) { const unsigned long long t0 = stamps[STAMP_SEL], t1 = stamps[STAMP_SEL + 1]; delta = sqrtf(1e-7f * 0.01f * (float)(t1 - t0)); }
    if (PROF_A >= 0) { const unsigned long long* us = (const unsigned long long*)(ws + WS_CTL + 61440 + 512); delta = sqrtf(1e-6f * 0.01f * (float)(us[PROF_A + 1] - us[PROF_A])); }
    if (PROF_B >= 0 && blockIdx.x == 0 && threadIdx.x == 0) { const unsigned long long* us = (const unsigned long long*)(ws + WS_CTL + 61440 + 512); const unsigned long long d = (us[PROF_B + 1] - us[PROF_B]) * 20ull, t0 = __builtin_amdgcn_s_memrealtime(); while (__builtin_amdgcn_s_memrealtime() - t0 < d) __builtin_amdgcn_s_sleep(8); }
    if (IN(16)) { if (DUP_PHASE == 23) phase_final(F, true); phase_final(F, false, delta); }
#undef IN
#undef SEAM
}

extern "C" void kernel_launch(void* const* d_in, const int* in_sizes, int n_in, void* d_out, int out_size, void* d_ws, size_t ws_size, hipStream_t stream) {
    static int grid = 0;
    if (grid == 0) {
        if (n_in != 18 || in_sizes[0] != MLAT * DM || out_size != MLAT * DM || ws_size < WS_END) {
            fprintf(stderr, "kernel_launch: built for 18 inputs, x/out of %d floats, >= %zu bytes of workspace; got n_in %d, in0 %d, out %d, ws %zu\n", MLAT * DM, (size_t)WS_END, n_in, n_in > 0 ? in_sizes[0] : -1, out_size, ws_size); grid = -1; return; }
        int dev = 0, cus = 0, per_cu = 0;
        if (hipGetDevice(&dev) != hipSuccess || hipDeviceGetAttribute(&cus, hipDeviceAttributeMultiprocessorCount, dev) != hipSuccess) { fprintf(stderr, "kernel_launch: device query failed\n"); grid = -1; return; }
        if (hipFuncSetAttribute((const void*)hymba_fwd, hipFuncAttributeMaxDynamicSharedMemorySize, LDS_BYTES) != hipSuccess) { fprintf(stderr, "kernel_launch: hipFuncSetAttribute failed\n"); grid = -1; return; }
        if (hipOccupancyMaxActiveBlocksPerMultiprocessor(&per_cu, (const void*)hymba_fwd, NTHR, LDS_BYTES) != hipSuccess || per_cu < 1) { fprintf(stderr, "kernel_launch: occupancy query says %d blocks per CU\n", per_cu); (void)hipGetLastError(); grid = -1; return; }
        grid = cus;
        fprintf(stderr, "kernel_launch: grid %d (cus %d, occupancy %d/CU), ws %zu\n", grid, cus, per_cu, ws_size);
    }
    if (grid < 0) return;
    if (hipMemsetAsync((char*)d_ws + WS_CTL, 0, CTL_ZERO_BYTES, stream) != hipSuccess) { fprintf(stderr, "kernel_launch: memset failed\n"); return; }
    Args a{};
    for (int i = 0; i < 18; ++i) a.in[i] = (const float*)d_in[i];
    a.out = (float*)d_out; a.ws = (unsigned char*)d_ws;
#if MK_N_LAUNCHES == 1
    a.ph_lo = 0; a.ph_hi = N_PHASES;
    void* kargs[] = {&a};
    if (DUP_PHASE == 30) { (void)hipLaunchCooperativeKernel((const void*)hymba_fwd, dim3(grid), dim3(NTHR), kargs, LDS_BYTES, stream); (void)hipMemsetAsync((char*)d_ws + WS_CTL, 0, CTL_ZERO_BYTES, stream); }
    hipError_t le = hipSuccess;
    if (USE_COOP) le = hipLaunchCooperativeKernel((const void*)hymba_fwd, dim3(grid), dim3(NTHR), kargs, LDS_BYTES, stream);
    else { hipLaunchKernelGGL(hymba_fwd, dim3(grid), dim3(NTHR), LDS_BYTES, stream, a); le = hipPeekAtLastError(); }
    if (le != hipSuccess) fprintf(stderr, "kernel_launch: cooperative launch failed: %s (grid %d)\n", hipGetErrorString(le), grid);
#else
    for (int p = 0; p < N_PHASES; ++p) { a.ph_lo = p; a.ph_hi = p + 1; hipLaunchKernelGGL(hymba_fwd, dim3(grid), dim3(NTHR), LDS_BYTES, stream, a); }
#endif
}
```

```cpp
#include <hip/hip_runtime.h>
#include <hip/hip_cooperative_groups.h>
#include <cstdio>
#include <cstdint>
namespace cg = cooperative_groups;

#define LAS __attribute__((address_space(3)))
#define GAS __attribute__((address_space(1)))
typedef unsigned short bf16_t;
typedef short bf16x8 __attribute__((ext_vector_type(8)));
typedef short bf16x4 __attribute__((ext_vector_type(4)));
typedef float f32x4 __attribute__((ext_vector_type(4)));
typedef float f32x2 __attribute__((ext_vector_type(2)));
typedef unsigned u32x4 __attribute__((ext_vector_type(4)));
typedef unsigned u32x2 __attribute__((ext_vector_type(2)));

typedef __bf16 hwbf16x2 __attribute__((ext_vector_type(2)));
__device__ __forceinline__ unsigned pk2(float lo, float hi) { const f32x2 v = {lo, hi}; return __builtin_bit_cast(unsigned, __builtin_convertvector(v, hwbf16x2)); }
__device__ __forceinline__ unsigned f2bf(float f) { return pk2(f, f) & 0xffffu; }
__device__ __forceinline__ float bf2f(unsigned h) { return __builtin_bit_cast(float, h << 16); }
__device__ __forceinline__ float bflo(unsigned w) { return __builtin_bit_cast(float, w << 16); }
__device__ __forceinline__ float bfhi(unsigned w) { return __builtin_bit_cast(float, w & 0xffff0000u); }
__device__ __forceinline__ void st16_wt(void* p, u32x4 v) { asm volatile("global_store_dwordx4 %0, %1, off sc1\n\ts_nop 1" :: "v"(p), "v"(v) : "memory"); }
__device__ __forceinline__ void st16_wt(void* p, f32x4 v) { asm volatile("global_store_dwordx4 %0, %1, off sc1\n\ts_nop 1" :: "v"(p), "v"(v) : "memory"); }
__device__ __forceinline__ void st8_wt(void* p, u32x2 v) { asm volatile("global_store_dwordx2 %0, %1, off sc1\n\ts_nop 1" :: "v"(p), "v"(v) : "memory"); }
__device__ __forceinline__ float silu_f(float a) { return a * __builtin_amdgcn_rcpf(1.0f + __expf(-a)); }

constexpr int NB = 2, SEQ = 8192, DM = 1024, CTXL = 256, MLAT = NB * SEQ, MCTX = NB * CTXL, MTOT = MLAT + MCTX;
constexpr int PW = 2944, PWP = 3072, FF = 2816, FF2 = 5632;
constexpr int C_RQ = 256, C_RK = 640, C_RV = 1024, C_RG = 1408, C_NQ = 1792, C_NK = 2176, C_NV = 2560;
constexpr float NORM_EPS = 1e-6f;

namespace pg8 {
#define PG8_LAS __attribute__((address_space(3)))
constexpr int BM = 256, BK = 64, HALF = 128, HTB = HALF * BK * 2, STAGE_BYTES = 8 * HTB, NXCD = 8, WGM = 8;
__host__ __device__ __forceinline__ int lds_byte(int r, int c) { const int st = (r >> 4) * 2 + (c >> 5), rr = r & 15, cc = c & 31, ob = rr * 64 + cc * 2; return st * 1024 + (ob ^ (((ob >> 9) & 1) << 5)); }
__host__ __device__ __forceinline__ void stage_rc(int b, int& R, int& C) { const int st = b / 1024, sb = b % 1024, swz = sb ^ (((sb >> 9) & 1) << 5); R = (st >> 1) * 16 + swz / 64; C = (st & 1) * 32 + (swz % 64) / 2; }
__host__ __device__ __forceinline__ int perm32(int rho) { const int n = rho >> 4, i = rho & 15; return 8 * (i >> 2) + 4 * n + (i & 3); }
struct Unit { int pm, pn; };
struct Gemm { const bf16_t* A; const bf16_t* Bt; int M, N, K; };
struct StaticOrder {
    int nM, nN, nwg, G, c;
    __host__ __device__ void init(int M, int N, int G_, int c_) { nM = M / BM; nN = N / BM; nwg = nM * nN; G = G_; c = c_; }
    __host__ __device__ bool next(int i, Unit& u) const {
        const long L = (long)i * G + c; if (L >= nwg) return false;
        int wgid = (int)L; { const int q = nwg / NXCD, r = nwg % NXCD, xcd = wgid % NXCD, off = wgid / NXCD; wgid = (xcd < r ? xcd * (q + 1) : r * (q + 1) + (xcd - r) * q) + off; }
        const int nig = WGM * nN, gid = wgid / nig, fm = gid * WGM, gsz = (nM - fm) < WGM ? (nM - fm) : WGM;
        u.pm = fm + ((wgid % nig) % gsz); u.pn = (wgid % nig) / gsz; return true;
    }
    __device__ __forceinline__ void a_ready(const Unit&) const {}
    __device__ __forceinline__ void done(const Unit&) const {}
};
__device__ __forceinline__ unsigned cvt_pk_bf16(float lo, float hi) { unsigned r; asm volatile("v_cvt_pk_bf16_f32 %0, %1, %2" : "=v"(r) : "v"(lo), "v"(hi)); return r; }

__device__ __forceinline__ float row_rinv(const float* ssq, int row) {
    const f32x4* p = (const f32x4*)(ssq + (size_t)row * 16);
    const f32x4 a = p[0], b = p[1], c = p[2], d = p[3];
    const float s = (((a[0] + a[1]) + (a[2] + a[3])) + ((b[0] + b[1]) + (b[2] + b[3]))) + (((c[0] + c[1]) + (c[2] + c[3])) + ((d[0] + d[1]) + (d[2] + d[3])));
    return rsqrtf(s * (1.0f / 1024.0f) + NORM_EPS);
}
__device__ __forceinline__ int row_set(int pm) { return pm < 32 ? 0 : (pm < 64 ? 1 : 2); }

struct EpiProj {
    static constexpr bool PERM = true, AFTER_DRAIN = false;
    bf16_t* O; const PG8_LAS float* rinv; const float* shw; mutable int ui;
    __device__ __forceinline__ void operator()(const f32x4 (&acc)[2][2][4][2], const Unit& u, int wr, int wc, int fr, int fq) const {
        const int row0 = u.pm * BM + wr * 64 + fr, col0 = u.pn * BM + wc * 32 + 8 * fq; const int set = row_set(u.pm); const PG8_LAS float* rt = rinv + ui * 256 + wr * 64 + fr; ++ui;
        f32x4 bv[2][2];
#pragma unroll
        for (int bj = 0; bj < 2; ++bj)
#pragma unroll
            for (int n = 0; n < 2; ++n) bv[bj][n] = *(const f32x4*)(shw + set * PWP + col0 + bj * HALF + 4 * n);
#pragma unroll
        for (int ai = 0; ai < 2; ++ai)
#pragma unroll
            for (int m = 0; m < 4; ++m) { const int r = row0 + ai * HALF + m * 16; const float ri = rt[ai * HALF + m * 16]; bf16_t* rowp = O + (size_t)r * PW + col0;
#pragma unroll
                for (int bj = 0; bj < 2; ++bj) { if (col0 + bj * HALF < PW) { const f32x4 v0 = acc[ai][bj][m][0] * ri + bv[bj][0], v1 = acc[ai][bj][m][1] * ri + bv[bj][1];
                    u32x4 w; w.x = cvt_pk_bf16(v0[0], v0[1]); w.y = cvt_pk_bf16(v0[2], v0[3]); w.z = cvt_pk_bf16(v1[0], v1[1]); w.w = cvt_pk_bf16(v1[2], v1[3]);
                    st16_wt(rowp + bj * HALF, w); } } }
    }
};
struct EpiSwiGLU {
    static constexpr bool PERM = true, AFTER_DRAIN = false;
    bf16_t* O; const PG8_LAS float* rinv; const float* shw; mutable int ui;
    __device__ __forceinline__ void operator()(const f32x4 (&acc)[2][2][4][2], const Unit& u, int wr, int wc, int fr, int fq) const {
        const int row0 = u.pm * BM + wr * 64 + fr, col0 = u.pn * BM + wc * 32 + 8 * fq, ocol = u.pn * HALF + wc * 32 + 8 * fq; const int set = row_set(u.pm); const PG8_LAS float* rt = rinv + ui * 256 + wr * 64 + fr; ++ui;
        f32x4 ba[2], bb[2];
#pragma unroll
        for (int n = 0; n < 2; ++n) { ba[n] = *(const f32x4*)(shw + set * FF2 + col0 + 4 * n); bb[n] = *(const f32x4*)(shw + set * FF2 + col0 + HALF + 4 * n); }
#pragma unroll
        for (int ai = 0; ai < 2; ++ai)
#pragma unroll
            for (int m = 0; m < 4; ++m) { const int r = row0 + ai * HALF + m * 16; const float ri = rt[ai * HALF + m * 16];
                float hv[8];
#pragma unroll
                for (int n = 0; n < 2; ++n) { const f32x4 a = acc[ai][0][m][n] * ri + ba[n], b = acc[ai][1][m][n] * ri + bb[n];
#pragma unroll
                    for (int e = 0; e < 4; ++e) hv[4 * n + e] = silu_f(a[e]) * b[e]; }
                u32x4 w; w.x = cvt_pk_bf16(hv[0], hv[1]); w.y = cvt_pk_bf16(hv[2], hv[3]); w.z = cvt_pk_bf16(hv[4], hv[5]); w.w = cvt_pk_bf16(hv[6], hv[7]);
                st16_wt(O + (size_t)r * FF + ocol, w); }
    }
};
struct EpiRes {
    static constexpr bool PERM = false, AFTER_DRAIN = false;
    const float* src_lat; const float* src_ctx; float* dst_lat; float* dst_ctx; bf16_t* XN; float* ssq; const float* gate; const float* sc; const float* g; float gmul;
    __device__ __forceinline__ void operator()(const f32x4 (&acc)[2][2][4][2], const Unit& u, int wr, int wc, int fr, int fq) const {
        const bool lat = u.pm < 64; const int set = row_set(u.pm);
        const int rg0 = u.pm * BM + wr * 64 + fr, rl0 = (lat ? u.pm : u.pm - 64) * BM + wr * 64 + fr;
        const float* src = lat ? src_lat : src_ctx; float* dst = lat ? dst_lat : dst_ctx;
        const int col0 = u.pn * BM + wc * 32 + 4 * fq;
        float ss[2][4];
#pragma unroll
        for (int ai = 0; ai < 2; ++ai)
#pragma unroll
            for (int m = 0; m < 4; ++m) ss[ai][m] = 0.f;
#pragma unroll
        for (int bj = 0; bj < 2; ++bj)
#pragma unroll
            for (int n = 0; n < 2; ++n) { const int c = col0 + bj * HALF + n * 16;
                const f32x4 ga = *(const f32x4*)(gate + set * 6144 + c) * gmul; f32x4 gs = {0.f, 0.f, 0.f, 0.f};
                if (XN) { const f32x4 s4 = *(const f32x4*)(sc + set * 6144 + c), g4 = *(const f32x4*)(g + c); gs = g4 * (s4 + 1.0f); }
#pragma unroll
                for (int ai = 0; ai < 2; ++ai)
#pragma unroll
                    for (int m = 0; m < 4; ++m) { const size_t ol = (size_t)(rl0 + ai * HALF + m * 16) * DM + c, og = (size_t)(rg0 + ai * HALF + m * 16) * DM + c;
                        const f32x4 x1 = *(const f32x4*)(src + ol) + ga * acc[ai][bj][m][n];
                        *(f32x4*)(dst + ol) = x1; ss[ai][m] += (x1[0] * x1[0] + x1[1] * x1[1]) + (x1[2] * x1[2] + x1[3] * x1[3]);
                        if (XN) { const f32x4 xn = x1 * gs; u32x2 w; w.x = cvt_pk_bf16(xn[0], xn[1]); w.y = cvt_pk_bf16(xn[2], xn[3]); *(u32x2*)(XN + og) = w; } } }
#pragma unroll
        for (int ai = 0; ai < 2; ++ai)
#pragma unroll
            for (int m = 0; m < 4; ++m) { float s = ss[ai][m]; s += __shfl_xor(s, 16); s += __shfl_xor(s, 32);
                if (fq == 0) ssq[(size_t)(rg0 + ai * HALF + m * 16) * 16 + u.pn * 4 + wc] = s; }
    }
};
struct EpiResWide {
    static constexpr bool PERM = false, AFTER_DRAIN = true;
    const float* src_lat; float* dst_lat; bf16_t* XN; float* ssq; const float* gate; const float* sc; const float* g; float gmul;
    __device__ __forceinline__ void fused(f32x4 (&acc)[2][2][4][2], const Unit& u, int wr, int wc, int fr, int fq, PG8_LAS unsigned char* lds, int wid, int lane) const {
        constexpr int ROWB = 1024 + 16;
        const int set = row_set(u.pm), col = u.pn * BM + 4 * lane;
        const f32x4 ga = *(const f32x4*)(gate + set * 6144 + col) * gmul; f32x4 gs = {0.f, 0.f, 0.f, 0.f};
        if (XN) gs = *(const f32x4*)(g + col) * (*(const f32x4*)(sc + set * 6144 + col) + 1.0f);
#pragma unroll 1
        for (int ai = 0; ai < 2; ++ai) {
            f32x4 xs[16];
            const size_t grow0 = (size_t)u.pm * BM + ai * HALF + wid;
#pragma unroll
            for (int i = 0; i < 16; ++i) xs[i] = *(const f32x4*)(src_lat + (grow0 + 8 * i) * DM + col);
            asm volatile("s_waitcnt lgkmcnt(0)" ::: "memory"); __builtin_amdgcn_s_barrier(); asm volatile("" ::: "memory");
#pragma unroll
            for (int bj = 0; bj < 2; ++bj)
#pragma unroll
                for (int m = 0; m < 4; ++m)
#pragma unroll
                    for (int n = 0; n < 2; ++n) *(PG8_LAS f32x4*)(lds + (wr * 64 + m * 16 + fr) * ROWB + (bj * HALF + wc * 32 + n * 16 + 4 * fq) * 4) = ai == 0 ? acc[0][bj][m][n] : acc[1][bj][m][n];
            asm volatile("s_waitcnt lgkmcnt(0)" ::: "memory"); __builtin_amdgcn_s_barrier(); asm volatile("" ::: "memory");
#pragma unroll
            for (int i = 0; i < 16; ++i) { const size_t grow = grow0 + 8 * i; const f32x4 v = *(const PG8_LAS f32x4*)(lds + (wid + 8 * i) * ROWB + lane * 16);
                const f32x4 x1 = xs[i] + ga * v; st16_wt(dst_lat + grow * DM + col, x1);
                float ss = (x1[0] * x1[0] + x1[1] * x1[1]) + (x1[2] * x1[2] + x1[3] * x1[3]);
                if (XN) { const f32x4 xn = x1 * gs; u32x2 w; w.x = cvt_pk_bf16(xn[0], xn[1]); w.y = cvt_pk_bf16(xn[2], xn[3]); st8_wt(XN + grow * DM + col, w); }
#pragma unroll
                for (int o = 1; o < 64; o <<= 1) ss += __shfl_xor(ss, o);
                if (lane == 0) *(f32x4*)(ssq + grow * 16 + u.pn * 4) = (f32x4){ss, 0.f, 0.f, 0.f}; }
        }
    }
};

template <class Epi, class Sched, bool ALIGN_EPI = false, bool SP2 = false>
__device__ __forceinline__ void gemm_phase(PG8_LAS unsigned char* lds, const Gemm g, const Sched& S, const Epi& E) {
    int tid_ = threadIdx.x; asm volatile("" : "+v"(tid_));
    const int tid = tid_, wid = __builtin_amdgcn_readfirstlane(tid >> 6), lane = tid & 63, wr = wid >> 2, wc = wid & 3, fr = lane & 15, fq = lane >> 4;
    const int K = g.K, nt = K / BK;
    unsigned voffA[2], voffB[2];
#pragma unroll
    for (int i = 0; i < 2; ++i) { int R, C; stage_rc(tid * 16 + i * 8192, R, C); const int Rb = Epi::PERM ? ((R & ~31) + perm32(R & 31)) : R;
        voffA[i] = (unsigned)(R * K + C) * 2u; voffB[i] = (unsigned)(Rb * K + C) * 2u; }
    const size_t kstep = (size_t)(BK * 2);
    const size_t hstep = (size_t)HALF * K * 2;
    const size_t tstep = 2 * hstep;
    const unsigned ldsw = (unsigned)wid * 1024u;
    const int aoff = lds_byte(wr * 64 + fr, fq * 8), boff = lds_byte(wc * 32 + fr, fq * 8);
#define PG8_SA(b, h) (((b) * 2 + (h)) * HTB)
#define PG8_SB(b, h) ((4 + (b) * 2 + (h)) * HTB)
#define PG8_STAGE(bufoff, gbase, voff) do { _Pragma("unroll") for (int _i = 0; _i < 2; ++_i) \
        __builtin_amdgcn_global_load_lds((const unsigned*)((const char*)(gbase) + (voff)[_i]), (PG8_LAS unsigned*)(lds + (bufoff) + ldsw + _i * 8192), 16, 0, 0); } while (0)
#define PG8_LDA(dst, b, h) do { _Pragma("unroll") for (int m = 0; m < 4; ++m) _Pragma("unroll") for (int k = 0; k < 2; ++k) dst[m][k] = *(const PG8_LAS bf16x8*)(lds + PG8_SA(b, h) + aoff + m * 2048 + k * 1024); } while (0)
#define PG8_LDB(dst, b, h) do { _Pragma("unroll") for (int n = 0; n < 2; ++n) _Pragma("unroll") for (int k = 0; k < 2; ++k) dst[n][k] = *(const PG8_LAS bf16x8*)(lds + PG8_SB(b, h) + boff + n * 2048 + k * 1024); } while (0)
#define PG8_MMA(ai, bj, At, Bt) do { __builtin_amdgcn_s_setprio(1); _Pragma("unroll") for (int m = 0; m < 4; ++m) _Pragma("unroll") for (int n = 0; n < 2; ++n) _Pragma("unroll") for (int k = 0; k < 2; ++k) \
        acc[ai][bj][m][n] = __builtin_amdgcn_mfma_f32_16x16x32_bf16(Bt[n][k], At[m][k], acc[ai][bj][m][n], 0, 0, 0); __builtin_amdgcn_s_setprio(0); } while (0)
#define PG8_WAIT_V(n) asm volatile("s_waitcnt vmcnt(" #n ")" ::: "memory")
#define PG8_WAIT_L(n) asm volatile("s_waitcnt lgkmcnt(" #n ")" ::: "memory")
#define PG8_BAR __builtin_amdgcn_s_barrier()
#define PG8_SCHED __builtin_amdgcn_sched_barrier(0)
    Unit cur, nxt; int ui = 0;
    if (!S.next(0, cur)) return;
    f32x4 acc[2][2][4][2];
#pragma unroll
    for (int a = 0; a < 2; ++a)
#pragma unroll
        for (int b = 0; b < 2; ++b)
#pragma unroll
            for (int m = 0; m < 4; ++m)
#pragma unroll
                for (int n = 0; n < 2; ++n) acc[a][b][m][n] = (f32x4){0.f, 0.f, 0.f, 0.f};
    bf16x8 At[4][2], B0[2][2], B1[2][2];
    const char* cA = (const char*)g.A + (size_t)cur.pm * tstep; const char* cB = (const char*)g.Bt + (size_t)cur.pn * tstep;
    S.a_ready(cur);
    if constexpr (SP2) {
        PG8_STAGE(PG8_SB(0, 0), cB, voffB); PG8_STAGE(PG8_SB(0, 1), cB + hstep, voffB); PG8_STAGE(PG8_SA(0, 0), cA, voffA); PG8_STAGE(PG8_SA(0, 1), cA + hstep, voffA);
        if (wr == 1) PG8_BAR;
        PG8_WAIT_V(2); PG8_BAR;
        PG8_STAGE(PG8_SB(1, 0), cB + kstep, voffB); PG8_STAGE(PG8_SA(1, 0), cA + kstep, voffA); PG8_STAGE(PG8_SB(1, 1), cB + hstep + kstep, voffB);
        PG8_WAIT_V(6); PG8_BAR;
    } else {
        PG8_STAGE(PG8_SB(0, 0), cB, voffB); PG8_STAGE(PG8_SA(0, 0), cA, voffA); PG8_STAGE(PG8_SB(0, 1), cB + hstep, voffB); PG8_STAGE(PG8_SA(0, 1), cA + hstep, voffA);
        if (wr == 1) PG8_BAR;
        PG8_WAIT_V(4); PG8_BAR;
        PG8_STAGE(PG8_SB(1, 0), cB + kstep, voffB); PG8_STAGE(PG8_SA(1, 0), cA + kstep, voffA); PG8_STAGE(PG8_SB(1, 1), cB + hstep + kstep, voffB);
        PG8_WAIT_V(6); PG8_BAR;
    }
    for (;;) {
        const bool has_next = S.next(ui + 1, nxt);
        const char* nA = has_next ? (const char*)g.A + (size_t)nxt.pm * tstep : cA; const char* nB = has_next ? (const char*)g.Bt + (size_t)nxt.pn * tstep : cB;
        for (int t = 0; t < nt; t += 2) {
            const bool last = (t == nt - 2);
            const char* a1 = cA + (size_t)(t + 1) * kstep;
            const char* a2 = last ? nA : cA + (size_t)(t + 2) * kstep; const char* b2 = last ? nB : cB + (size_t)(t + 2) * kstep;
            const char* a3 = a2 + kstep; const char* b3 = b2 + kstep;
            if (last && has_next) S.a_ready(nxt);
            if constexpr (SP2) {
            PG8_LDB(B0, 0, 0); PG8_LDB(B1, 0, 1); PG8_SCHED; PG8_LDA(At, 0, 0); PG8_STAGE(PG8_SA(1, 1), a1 + hstep, voffA);
            PG8_WAIT_V(8); PG8_WAIT_L(0); PG8_BAR; PG8_MMA(0, 0, At, B0); PG8_MMA(0, 1, At, B1); PG8_BAR; PG8_SCHED;
            PG8_LDA(At, 0, 1); PG8_STAGE(PG8_SB(0, 0), b2, voffB); PG8_STAGE(PG8_SB(0, 1), b2 + hstep, voffB); PG8_STAGE(PG8_SA(0, 0), a2, voffA);
            PG8_WAIT_V(8); PG8_WAIT_L(0); PG8_BAR; PG8_MMA(1, 0, At, B0); PG8_MMA(1, 1, At, B1); PG8_BAR; PG8_SCHED;
            PG8_LDB(B0, 1, 0); PG8_LDB(B1, 1, 1); PG8_SCHED; PG8_LDA(At, 1, 0); PG8_STAGE(PG8_SA(0, 1), a2 + hstep, voffA);
            PG8_WAIT_V(8); PG8_WAIT_L(0); PG8_BAR; PG8_MMA(0, 0, At, B0); PG8_MMA(0, 1, At, B1); PG8_BAR; PG8_SCHED;
            PG8_LDA(At, 1, 1); PG8_STAGE(PG8_SB(1, 0), b3, voffB); PG8_STAGE(PG8_SB(1, 1), b3 + hstep, voffB); PG8_STAGE(PG8_SA(1, 0), a3, voffA);
            PG8_WAIT_V(8); PG8_WAIT_L(0); PG8_BAR; PG8_MMA(1, 0, At, B0); PG8_MMA(1, 1, At, B1); PG8_BAR; PG8_SCHED;
            } else {
            PG8_LDB(B0, 0, 0); PG8_SCHED; PG8_LDA(At, 0, 0); PG8_STAGE(PG8_SA(1, 1), a1 + hstep, voffA);
            PG8_WAIT_L(8); PG8_BAR; PG8_WAIT_L(0); PG8_MMA(0, 0, At, B0); PG8_BAR; PG8_SCHED;
            PG8_LDB(B1, 0, 1); PG8_STAGE(PG8_SB(0, 0), b2, voffB);
            PG8_BAR; PG8_WAIT_L(0); PG8_MMA(0, 1, At, B1); PG8_BAR;
            PG8_LDA(At, 0, 1); PG8_STAGE(PG8_SA(0, 0), a2, voffA);
            PG8_BAR; PG8_WAIT_L(0); PG8_MMA(1, 0, At, B0); PG8_BAR; PG8_SCHED;
            PG8_STAGE(PG8_SB(0, 1), b2 + hstep, voffB);
            PG8_WAIT_V(6); PG8_BAR; PG8_MMA(1, 1, At, B1); PG8_BAR;
            PG8_LDB(B0, 1, 0); PG8_SCHED; PG8_LDA(At, 1, 0); PG8_STAGE(PG8_SA(0, 1), a2 + hstep, voffA);
            PG8_WAIT_L(8); PG8_BAR; PG8_WAIT_L(0); PG8_MMA(0, 0, At, B0); PG8_BAR; PG8_SCHED;
            PG8_LDB(B1, 1, 1); PG8_STAGE(PG8_SB(1, 0), b3, voffB);
            PG8_BAR; PG8_WAIT_L(0); PG8_MMA(0, 1, At, B1); PG8_BAR;
            PG8_LDA(At, 1, 1); PG8_STAGE(PG8_SA(1, 0), a3, voffA);
            PG8_BAR; PG8_WAIT_L(0); PG8_MMA(1, 0, At, B0); PG8_BAR; PG8_SCHED;
            PG8_STAGE(PG8_SB(1, 1), b3 + hstep, voffB);
            PG8_WAIT_V(6); PG8_BAR; PG8_MMA(1, 1, At, B1); PG8_BAR;
            }
        }
        if constexpr (ALIGN_EPI) { if (wr == 0) PG8_BAR; }
        if constexpr (!Epi::AFTER_DRAIN) { E(acc, cur, wr, wc, fr, fq); S.done(cur); }
        if (!has_next) break;
#pragma unroll
        for (int a = 0; a < 2; ++a)
#pragma unroll
            for (int b = 0; b < 2; ++b)
#pragma unroll
                for (int m = 0; m < 4; ++m)
#pragma unroll
                    for (int n = 0; n < 2; ++n) acc[a][b][m][n] = (f32x4){0.f, 0.f, 0.f, 0.f};
        cur = nxt; cA = nA; cB = nB; ++ui;
        if constexpr (ALIGN_EPI) { if (wr == 1) PG8_BAR; }
    }
    PG8_WAIT_V(0);
    if constexpr (!ALIGN_EPI) { if (wr == 0) PG8_BAR; }
    PG8_BAR;
    if constexpr (Epi::AFTER_DRAIN) { E.fused(acc, cur, wr, wc, fr, fq, lds, wid, lane); S.done(cur); }
#undef PG8_SA
#undef PG8_SB
#undef PG8_STAGE
#undef PG8_LDA
#undef PG8_LDB
#undef PG8_MMA
#undef PG8_WAIT_V
#undef PG8_WAIT_L
#undef PG8_BAR
#undef PG8_SCHED
}
}

constexpr int NWAVES = 8, NTHR = 512;
constexpr size_t MiB = 1u << 20;
constexpr size_t WS_CTL = 0, CTL_ZERO_BYTES = 64 * 1024;
constexpr size_t WS_MOD = 1 * MiB;
constexpr size_t WS_SHWIN = WS_MOD + 2 * 3 * 6144 * 4;
constexpr size_t WS_SHW13 = WS_SHWIN + 2 * 3 * PWP * 4;
constexpr size_t WS_ROPE = WS_SHW13 + 2 * 3 * FF2 * 4;
constexpr size_t WS_LG = WS_ROPE + (128 + 64) * 24 * 2 * 4;
constexpr size_t WS_CT256 = WS_LG + 256;
constexpr size_t WS_SSQ = 2 * MiB;
constexpr size_t WS_XC = 4 * MiB;
constexpr size_t WS_W = 6 * MiB;
constexpr size_t W_WIN = 0, W_WOUT = (size_t)PWP * DM * 2, W_W13 = W_WOUT + (size_t)DM * DM * 2, W_W2 = W_W13 + (size_t)FF2 * DM * 2, W_LAYER = W_W2 + (size_t)DM * FF * 2;
static_assert(W_LAYER * 2 == 49 * MiB, "weight region");
constexpr size_t WS_TAB = 55 * MiB;
constexpr size_t T_WFT = 0, T_TWA = 2 * 256 * 256 * 2, T_TD2 = T_TWA + 256 * 256 * 2, T_TW8 = T_TD2 + 64 * 128 * 2, T_TC = T_TW8 + 65536;
constexpr size_t WS_XN = 56 * MiB;
constexpr size_t WS_CAT = 89 * MiB;
constexpr size_t WS_PROJ = 122 * MiB;
constexpr size_t WS_STATE = 217 * MiB;
constexpr size_t WS_END = WS_STATE + (size_t)16 * 66 * 9216 * 2;
static_assert(WS_END <= 256 * MiB && WS_PROJ + (size_t)MTOT * PW * 2 <= WS_STATE && WS_CAT + (size_t)MTOT * DM * 2 <= WS_PROJ && WS_XN + (size_t)MTOT * DM * 2 <= WS_CAT, "d_ws map");
static_assert(WS_CT256 + 2048 <= WS_SSQ && WS_SSQ + (size_t)MTOT * 64 <= WS_XC && WS_TAB + T_TC + 262144 <= WS_XN, "d_ws map (small)");
constexpr int CW_BAR = 1024;
constexpr int LDS_BYTES = 163840, MISC_OFF = LDS_BYTES - 256;

#define RLX_AGENT __ATOMIC_RELAXED, __HIP_MEMORY_SCOPE_AGENT
#define XB_TMO      128
#define XB_XCNT(j)  (256  + 64 * (j))
#define XB_XSUB(j)  (1280 + 64 * (j))
#define XB_XGEN(j)  (2304 + 64 * (j))
#define XB_TOP      3328
#define XB_TOPGEN   3392
#define XCD_BAR_WORDS 3456
#define XB_SPIN_CAP (1u << 18)
static_assert((CW_BAR + XCD_BAR_WORDS) * 4 <= (int)CTL_ZERO_BYTES, "barrier words inside the memset region");
__device__ __forceinline__ unsigned xb_ld(unsigned* p)              { return __hip_atomic_load(p, __ATOMIC_RELAXED, __HIP_MEMORY_SCOPE_AGENT); }
__device__ __forceinline__ unsigned xb_add(unsigned* p, unsigned v) { return __hip_atomic_fetch_add(p, v, __ATOMIC_RELAXED, __HIP_MEMORY_SCOPE_AGENT); }
__device__ __forceinline__ unsigned xb_xcc_id() { return (unsigned)__builtin_amdgcn_s_getreg((3 << 11) | 20) & 0xFu; }
#define XB_SPIN(cond, bar) do { unsigned _sp = 0; while (cond) { __builtin_amdgcn_s_sleep(1); \
    if ((++_sp & 255u) == 0u) { if (xb_ld(&(bar)[XB_TMO])) break; if (_sp > XB_SPIN_CAP) { atomicAdd(&(bar)[XB_TMO], 1u); break; } } } } while (0)
struct XcdBarrier { unsigned* bar; unsigned x; volatile LAS unsigned* st; };
__device__ __forceinline__ XcdBarrier xcd_barrier_post(unsigned* bar, volatile LAS unsigned* st) {
    XcdBarrier b; b.bar = bar; b.x = xb_xcc_id(); b.st = st;
    if (threadIdx.x == 0) (void)xb_add(&bar[XB_XCNT(b.x)], 1u);
    return b;
}
__device__ __forceinline__ void xcd_barrier_complete(unsigned* bar, unsigned x, unsigned& nloc, unsigned& nx) {
    const unsigned G = gridDim.x * gridDim.y * gridDim.z;
    unsigned sum, cnt, mine, sp = 0u;
    for (;;) {
        sum = 0u; cnt = 0u; mine = 0u;
#pragma unroll
        for (unsigned j = 0; j < 16; ++j) { const unsigned c = xb_ld(&bar[XB_XCNT(j)]); sum += c; cnt += (c > 0u) ? 1u : 0u; mine = (j == x) ? c : mine; }
        if (sum == G) break;
        __builtin_amdgcn_s_sleep(1);
        if ((++sp & 255u) == 0u) { if (xb_ld(&bar[XB_TMO])) break; if (sp > XB_SPIN_CAP) { atomicAdd(&bar[XB_TMO], 1u); break; } }
    }
    nloc = mine > 0u ? mine : 1u; nx = cnt > 0u ? cnt : 1u;
}
__device__ __forceinline__ void xcd_barrier(const XcdBarrier& b) {
    asm volatile("s_waitcnt vmcnt(0)" ::: "memory");
    __syncthreads();
    if (threadIdx.x == 0) {
        unsigned* bar = b.bar;
        __builtin_amdgcn_s_waitcnt(0);
        unsigned nloc = b.st[0], nx = b.st[1];
        if (nloc == 0u) { xcd_barrier_complete(bar, b.x, nloc, nx); b.st[0] = nloc; b.st[1] = nx; }
        const unsigned old = xb_add(&bar[XB_XSUB(b.x)], 1u);
        const unsigned gen = old / nloc;
        if (old + 1u == (gen + 1u) * nloc) {
            __builtin_amdgcn_fence(__ATOMIC_RELEASE, "agent");
            asm volatile("s_waitcnt vmcnt(0)" ::: "memory");
            const unsigned og = xb_add(&bar[XB_TOP], 1u);
            const unsigned tg = og / nx;
            if (og + 1u == (tg + 1u) * nx) xb_add(&bar[XB_TOPGEN], 1u);
            else XB_SPIN(xb_ld(&bar[XB_TOPGEN]) == tg, bar);
            __builtin_amdgcn_fence(__ATOMIC_ACQUIRE, "agent");
            xb_add(&bar[XB_XGEN(b.x)], 1u);
            asm volatile("s_waitcnt vmcnt(0)" ::: "memory");
        } else {
            XB_SPIN(xb_ld(&bar[XB_XGEN(b.x)]) == gen, bar);
            __builtin_amdgcn_fence(__ATOMIC_ACQUIRE, "agent");
            asm volatile("s_waitcnt vmcnt(0)" ::: "memory");
        }
    }
    __syncthreads();
}

#ifndef PROF_A
#define PROF_A -1
#endif
#ifndef PROF_B
#define PROF_B -1
#endif
#define USTAMP(k) do { if ((PROF_A >= 0 || PROF_B >= 0) && F.prof && blockIdx.x == 0 && F.tid == 0) ((unsigned long long*)(F.ws + WS_CTL + 61440 + 512))[k] = __builtin_amdgcn_s_memrealtime(); } while (0)
struct Frame {
    LAS unsigned char* lds;
    int tid, lane, wave, G, vcu; bool prof;
    __device__ __forceinline__ void fresh() { int t = threadIdx.x; asm volatile("" : "+v"(t)); tid = t; lane = t & 63; wave = __builtin_amdgcn_readfirstlane(t >> 6); }
    const float *x, *c, *ctx, *c_ctx, *w_ada, *b_ada, *g_mix, *w_in, *dlogit, *ret_g, *w_four, *rpb, *w_out, *g_ffn, *w1, *w3, *w2, *g_final;
    float* out; unsigned char* ws;
    float *MOD, *SHWIN, *SHW13, *ROPE, *LG, *CT256, *SSQ, *XC, *ADAP; const float* TW8; bf16_t* STATE;
    bf16_t *XN, *CAT, *PROJ, *HID, *WFT, *TWA, *TD2, *TC256; unsigned* Y;
    __device__ __forceinline__ bf16_t* W(int layer, size_t off) const { return (bf16_t*)(ws + WS_W + (size_t)layer * W_LAYER + off); }
};

__device__ __forceinline__ float wave_sum(float v) {
#pragma unroll
    for (int o = 1; o < 64; o <<= 1) v += __shfl_xor(v, o);
    return v;
}

__device__ __forceinline__ bf16x8 ld8(LAS const unsigned char* p) { return *(LAS const bf16x8*)p; }
__device__ __forceinline__ bf16x8 ld8(const unsigned char* p) { return *(const bf16x8*)p; }
template <int MT, int NT, class PA, class PB>
__device__ __forceinline__ void wave_mma(f32x4 (&acc)[MT][NT], PA A, int lda, PB B, int ldb, int ksteps, int fr, int fq) {
    PA a0 = A + fr * lda + fq * 16; PB b0 = B + fr * ldb + fq * 16;
    for (int s = 0; s < ksteps; ++s) {
        bf16x8 a[MT], b[NT];
#pragma unroll
        for (int m = 0; m < MT; ++m) a[m] = ld8(a0 + m * 16 * lda + s * 64);
#pragma unroll
        for (int n = 0; n < NT; ++n) b[n] = ld8(b0 + n * 16 * ldb + s * 64);
#pragma unroll
        for (int m = 0; m < MT; ++m)
#pragma unroll
            for (int n = 0; n < NT; ++n) acc[m][n] = __builtin_amdgcn_mfma_f32_16x16x32_bf16(a[m], b[n], acc[m][n], 0, 0, 0);
    }
}
template <int MT, int NT> __device__ __forceinline__ void zero_acc(f32x4 (&acc)[MT][NT]) {
#pragma unroll
    for (int m = 0; m < MT; ++m)
#pragma unroll
        for (int n = 0; n < NT; ++n) acc[m][n] = (f32x4){0.f, 0.f, 0.f, 0.f};
}

#define LDS_WAIT() asm volatile("s_waitcnt lgkmcnt(0)" ::: "memory")
__device__ __forceinline__ void p0_transpose_item(const float* W, int ldw, int K, int nblk, bf16_t* WT, int mapkind, int roff, LAS float* scr, int item, int lane) {
    const int kb = item / nblk, nb = item % nblk, k0 = 64 * kb, n0 = 32 * nb;
    { f32x4 v[8]; const int r = lane >> 3, c4 = lane & 7;
#pragma unroll
      for (int i = 0; i < 8; ++i) v[i] = *(const f32x4*)(W + (size_t)(k0 + 8 * i + r) * ldw + n0 + 4 * c4);
#pragma unroll
      for (int i = 0; i < 8; ++i) { LAS float* d = scr + (8 * i + r) * 33 + 4 * c4; d[0] = v[i][0]; d[1] = v[i][1]; d[2] = v[i][2]; d[3] = v[i][3]; } }
    LDS_WAIT(); asm volatile("" ::: "memory");
    const int c = lane & 7;
#pragma unroll
    for (int j = 0; j < 4; ++j) { const int n = (lane >> 3) + 8 * j; const LAS float* s = scr + (8 * c) * 33 + n;
        u32x4 o; o.x = pk2(s[0 * 33], s[1 * 33]); o.y = pk2(s[2 * 33], s[3 * 33]); o.z = pk2(s[4 * 33], s[5 * 33]); o.w = pk2(s[6 * 33], s[7 * 33]);
        const int nn = n0 + n; const int row = mapkind == 0 ? roff + nn : ((nn >> 7) * 256 + (nn & 127) + (mapkind == 2 ? 128 : 0));
        *(u32x4*)(WT + (size_t)row * K + k0 + 8 * c) = o; }
    LDS_WAIT(); asm volatile("" ::: "memory");
}

__device__ __forceinline__ void phase_p0a(Frame& F) {
    F.fresh();
    const int tid = F.tid, lane = F.lane, wave = F.wave;
    {
        LAS float* wt = (LAS float*)F.lds; LAS float* T = (LAS float*)(F.lds + 8 * 257 * 4);
        for (int e = tid; e < 4096; e += NTHR) { const int c = e >> 6, p = e & 63; float sv, cv;
            if (p <= 32) { sincospif((float)((p * c) & 63) * (1.0f / 32.0f), &sv, &cv); T[e] = cv; }
            else { sincospif((float)(((p - 32) * c) & 63) * (1.0f / 32.0f), &sv, &cv); T[e] = -sv; } }
        for (int it = blockIdx.x; it < 256; it += F.G) {
            const int l = it >> 7, k0 = (it & 127) * 8;
            __syncthreads();
            for (int e = tid; e < 8 * 64; e += NTHR) { const int kk = e >> 6, c4 = e & 63; const f32x4 v = *(const f32x4*)(F.w_in + ((size_t)l * DM + k0 + kk) * PW + 4 * c4);
                LAS float* d = wt + kk * 257 + 4 * c4; d[0] = v[0]; d[1] = v[1]; d[2] = v[2]; d[3] = v[3]; }
            __syncthreads();
            const int k = tid & 7, cb = tid >> 3; bf16_t* WT = F.W(l, W_WIN);
#pragma unroll
            for (int i = 0; i < 4; ++i) { const int col = cb + 64 * i, g = col >> 6, p = col & 63; float a = 0.f;
#pragma unroll 16
                for (int c = 0; c < 64; ++c) a += wt[k * 257 + g * 64 + c] * T[c * 64 + p];
                WT[(size_t)col * DM + k0 + k] = (bf16_t)f2bf(a); }
        }
        __syncthreads();
    }
    LAS float* sc = (LAS float*)(F.lds + 131072);
    for (int e = tid; e < 3072; e += NTHR) { const int s = e >> 10, k = e & 1023; const float v = s < 2 ? F.c[s * DM + k] : F.c_ctx[k]; sc[e] = v / (1.0f + expf(-v)); }
    __syncthreads();
    const int gw = F.vcu * NWAVES + wave, NGW = F.G * NWAVES;
    for (int it = gw; it < 2 * 8 * 24; it += NGW) {
        const int l = it / 192, rem = it % 192, kc = rem / 24, cb = rem % 24, col = cb * 256 + 4 * lane;
        const float* wp = F.w_ada + ((size_t)l * DM + kc * 128) * 6144 + col; f32x4 a0 = {0.f, 0.f, 0.f, 0.f}, a1 = a0, a2 = a0;
#pragma unroll 1
        for (int h2 = 0; h2 < 8; ++h2) { f32x4 w[16];
#pragma unroll
            for (int k = 0; k < 16; ++k) w[k] = *(const f32x4*)(wp + (size_t)(h2 * 16 + k) * 6144);
#pragma unroll
            for (int k = 0; k < 16; ++k) { const int kk = kc * 128 + h2 * 16 + k; a0 += w[k] * sc[kk]; a1 += w[k] * sc[1024 + kk]; a2 += w[k] * sc[2048 + kk]; } }
        float* o = F.ADAP + ((size_t)(l * 8 + kc) * 3) * 6144 + col; *(f32x4*)o = a0; *(f32x4*)(o + 6144) = a1; *(f32x4*)(o + 2 * 6144) = a2;
    }
    LAS float* scr = (LAS float*)(F.lds + wave * 16384);
    constexpr int I0 = 16 * 84, I1 = 16 * 32, I2 = 16 * 88, I3 = I2, I4 = 44 * 32, I5 = 4 * 8, IL = I0 + I1 + I2 + I3 + I4 + I5;
    for (int it = gw; it < 2 * IL; it += NGW) {
        const int l = it / IL; int r = it % IL;
        if (r < I0) { p0_transpose_item(F.w_in + (size_t)l * DM * PW + 256, PW, DM, 84, F.W(l, W_WIN), 0, 256, scr, r, lane); continue; } r -= I0;
        if (r < I1) { p0_transpose_item(F.w_out + (size_t)l * DM * DM, DM, DM, 32, F.W(l, W_WOUT), 0, 0, scr, r, lane); continue; } r -= I1;
        if (r < I2) { p0_transpose_item(F.w1 + (size_t)l * DM * FF, FF, DM, 88, F.W(l, W_W13), 1, 0, scr, r, lane); continue; } r -= I2;
        if (r < I3) { p0_transpose_item(F.w3 + (size_t)l * DM * FF, FF, DM, 88, F.W(l, W_W13), 2, 0, scr, r, lane); continue; } r -= I3;
        if (r < I4) { p0_transpose_item(F.w2 + (size_t)l * FF * DM, DM, FF, 32, F.W(l, W_W2), 0, 0, scr, r, lane); continue; } r -= I4;
        p0_transpose_item(F.w_four + (size_t)l * 65536, 256, 256, 8, F.WFT + (size_t)l * 65536, 0, 0, scr, r, lane);
    }
    const int gt = F.vcu * NTHR + tid, GT = F.G * NTHR;
    for (int e = gt; e < 2 * 128 * 128; e += GT) { const int l = e >> 14, q = e & 16383; *(u32x4*)(F.W(l, W_WIN) + (size_t)PW * DM + (size_t)q * 8) = (u32x4){0u, 0u, 0u, 0u}; }
    for (int e = gt; e < 192 * 24; e += GT) { const int pos = e < 128 * 24 ? e / 24 : (e - 128 * 24) / 24, i = e % 24;
        const float inv = powf(10000.0f, -(float)i / 24.0f), ang = (float)pos * inv; F.ROPE[2 * e] = cosf(ang); F.ROPE[2 * e + 1] = sinf(ang); }
    for (int e = gt; e < 16; e += GT) { const float xv = F.dlogit[e]; F.LG[e] = -log1pf(expf(-xv)); }
    for (int e = gt; e < 256; e += GT) { float sv, cv; sincospif((float)e * (2.0f / 256.0f), &sv, &cv); F.CT256[2 * e] = cv; F.CT256[2 * e + 1] = sv; }
    for (int e = gt; e < 8192; e += GT) { float sv, cv; sincospif((float)e * (2.0f / 8192.0f), &sv, &cv); ((float*)F.TW8)[2 * e] = cv; ((float*)F.TW8)[2 * e + 1] = sv; }
    for (int e = gt; e < 32768; e += GT) { const int row = e >> 7, l1 = e & 127, cs = row >> 7, k1 = row & 127; float sv, cv;
        sincospif((float)((k1 * l1) & 127) * (2.0f / 128.0f), &sv, &cv); F.TWA[e] = (bf16_t)f2bf(cs == 0 ? cv : sv); }
    for (int e = gt; e < 131072; e += GT) { const int cs = e >> 16, k = (e >> 8) & 255, l = e & 255; float sv, cv;
        sincospif((float)((k * l) & 255) * (2.0f / 256.0f), &sv, &cv); F.TC256[e] = (bf16_t)f2bf(cs == 0 ? cv : sv); }
    for (int e = gt; e < 8192; e += GT) { const int k2 = e >> 7, col = e & 127, l2 = col >> 1, ri = col & 1; float sv, cv;
        sincospif((float)((k2 * l2) & 63) * (2.0f / 64.0f), &sv, &cv); F.TD2[e] = (bf16_t)f2bf(ri == 0 ? cv : sv); }
}

__device__ __forceinline__ float ada_val(const Frame& F, int l, int s, int j) {
    const float* p = F.ADAP + ((size_t)(l * 8) * 3 + s) * 6144 + j; float a = 0.f;
#pragma unroll
    for (int kc = 0; kc < 8; ++kc) a += p[(size_t)kc * 3 * 6144];
    return a + F.b_ada[l * 6144 + j];
}
__device__ __forceinline__ void phase_p0b(Frame& F) {
    F.fresh();
    const int tid = F.tid, lane = F.lane, wave = F.wave;
    const int gt = F.vcu * NTHR + tid, GT = F.G * NTHR, gw = F.vcu * NWAVES + wave, NGW = F.G * NWAVES;
    for (int e = gt; e < 2 * 3 * 6144; e += GT) { const int l = e / 18432, s = (e / 6144) % 3, j = e % 6144; F.MOD[e] = ada_val(F, l, s, j); }
    LAS float* vec = (LAS float*)F.lds;
#pragma unroll
    for (int i = 0; i < 6; ++i) { const int e = tid + NTHR * i, s = e >> 10, k = e & 1023; vec[e] = F.g_mix[k] * (1.0f + ada_val(F, 0, s, 1024 + k)); }
    __syncthreads();
    for (int m0 = gw; m0 < MTOT; m0 += 2 * NGW) {
        f32x4 v[2][4]; float ss[2] = {0.f, 0.f}; const int m1 = m0 + NGW; const bool has1 = m1 < MTOT;
#pragma unroll
        for (int q = 0; q < 2; ++q) { const int m = q ? m1 : m0; if (q == 0 || has1) { const float* src = m < MLAT ? F.x + (size_t)m * DM : F.ctx + (size_t)(m - MLAT) * DM;
#pragma unroll
            for (int j = 0; j < 4; ++j) v[q][j] = *(const f32x4*)(src + 4 * lane + 256 * j); } }
#pragma unroll
        for (int q = 0; q < 2; ++q) { const int m = q ? m1 : m0; if (q == 0 || has1) { const int set = m < SEQ ? 0 : (m < MLAT ? 1 : 2);
#pragma unroll
            for (int j = 0; j < 4; ++j) ss[q] += (v[q][j][0] * v[q][j][0] + v[q][j][1] * v[q][j][1]) + (v[q][j][2] * v[q][j][2] + v[q][j][3] * v[q][j][3]);
            ss[q] = wave_sum(ss[q]);
#pragma unroll
            for (int j = 0; j < 4; ++j) { const f32x4 g = *(LAS const f32x4*)(vec + set * 1024 + 4 * lane + 256 * j); const f32x4 o = v[q][j] * g;
                u32x2 w; w.x = pk2(o[0], o[1]); w.y = pk2(o[2], o[3]); *(u32x2*)(F.XN + (size_t)m * DM + 4 * lane + 256 * j) = w; }
            if (lane < 16) F.SSQ[(size_t)m * 16 + lane] = lane == 0 ? ss[q] : 0.f; } }
    }
    for (int combo = 0; combo < 4; ++combo) {
        const int l = combo >> 1, which = combo & 1;
        __syncthreads();
#pragma unroll
        for (int i = 0; i < 6; ++i) { const int e = tid + NTHR * i, s = e >> 10, k = e & 1023; vec[e] = ada_val(F, l, s, (which ? 3072 : 0) + k); }
        __syncthreads();
        const int nrows = which ? FF2 : PWP; const bf16_t* Wt = F.W(l, which ? W_W13 : W_WIN); float* dstv = (which ? F.SHW13 : F.SHWIN) + (size_t)l * 3 * nrows;
        for (int r0 = gw; r0 < nrows; r0 += 4 * NGW) {
            u32x4 w[4][2];
#pragma unroll
            for (int q = 0; q < 4; ++q) { const int r = r0 + q * NGW; if (r < nrows) {
#pragma unroll
                for (int j = 0; j < 2; ++j) w[q][j] = *(const u32x4*)(Wt + (size_t)r * DM + lane * 8 + 512 * j); } }
#pragma unroll
            for (int q = 0; q < 4; ++q) { const int r = r0 + q * NGW; if (r < nrows) { float a0 = 0.f, a1 = 0.f, a2 = 0.f;
#pragma unroll
                for (int j = 0; j < 2; ++j) { const int k0 = lane * 8 + 512 * j; const u32x4 ww = w[q][j];
                    const float wf[8] = {bflo(ww.x), bfhi(ww.x), bflo(ww.y), bfhi(ww.y), bflo(ww.z), bfhi(ww.z), bflo(ww.w), bfhi(ww.w)};
#pragma unroll
                    for (int e = 0; e < 8; ++e) { a0 += wf[e] * vec[k0 + e]; a1 += wf[e] * vec[1024 + k0 + e]; a2 += wf[e] * vec[2048 + k0 + e]; } }
                a0 = wave_sum(a0); a1 = wave_sum(a1); a2 = wave_sum(a2);
                if (lane == 0) { dstv[r] = a0; dstv[nrows + r] = a1; dstv[2 * nrows + r] = a2; } } }
        }
    }
}
__device__ __forceinline__ void phase_final(Frame& F, bool dry = false, float delta = 0.f) {
    F.fresh();
    const int gw = F.vcu * NWAVES + F.wave, NGW = F.G * NWAVES, lane = F.lane;
    for (int m = gw; m < MLAT; m += NGW) {
        const float ri = pg8::row_rinv(F.SSQ, m); float* row = F.out + (size_t)m * DM;
#pragma unroll
        for (int j = 0; j < 4; ++j) { const int c = 4 * lane + 256 * j; const f32x4 v = *(const f32x4*)(row + c), g = *(const f32x4*)(F.g_final + c); *(f32x4*)(row + c) = dry ? v : v * g * ri + delta; }
    }
}

typedef LAS const unsigned char* lptr;
typedef const unsigned char* gptr;
constexpr float LOG2E = 1.4426950408889634f;
template <int NPW, class RowFn>
__device__ __forceinline__ void stage_T_load(unsigned (&a)[NPW], unsigned (&b)[NPW], RowFn rowp, int nd, int wave, int lane) {
    const int ndb = nd / 16, dl = lane & 7, kl = lane >> 3;
#pragma unroll
    for (int it = 0; it < NPW; ++it) { const int wi = wave + NWAVES * it, dvp = (wi % ndb) * 8 + dl, kp = (wi / ndb) * 8 + kl;
        a[it] = *(const unsigned*)(rowp(2 * kp) + 2 * dvp); b[it] = *(const unsigned*)(rowp(2 * kp + 1) + 2 * dvp); }
}
template <int NPW>
__device__ __forceinline__ void stage_T_store(const unsigned (&a)[NPW], const unsigned (&b)[NPW], LAS unsigned char* dst, int dstride, int nd, int wave, int lane) {
    const int ndb = nd / 16, dl = lane & 7, kl = lane >> 3;
#pragma unroll
    for (int it = 0; it < NPW; ++it) { const int wi = wave + NWAVES * it, dvp = (wi % ndb) * 8 + dl, kp = (wi / ndb) * 8 + kl;
        *(LAS unsigned*)(dst + (2 * dvp) * dstride + kp * 4) = (a[it] & 0xffffu) | (b[it] << 16);
        *(LAS unsigned*)(dst + (2 * dvp + 1) * dstride + kp * 4) = (a[it] >> 16) | (b[it] & 0xffff0000u); }
}
template <int NPW, class RowFn>
__device__ __forceinline__ void stage_T(LAS unsigned char* dst, int dstride, RowFn rowp, int nd, int wave, int lane) {
    unsigned a[NPW], b[NPW]; stage_T_load<NPW>(a, b, rowp, nd, wave, lane); stage_T_store<NPW>(a, b, dst, dstride, nd, wave, lane);
}
__device__ __forceinline__ bf16x4 vtr(LAS const unsigned char* p) { return __builtin_amdgcn_ds_read_tr16_b64_v4i16((LAS bf16x4*)p); }
__device__ __forceinline__ bf16x8 pack8(const f32x4& a, const f32x4& b) { u32x4 w; w.x = pk2(a[0], a[1]); w.y = pk2(a[2], a[3]); w.z = pk2(b[0], b[1]); w.w = pk2(b[2], b[3]); return __builtin_bit_cast(bf16x8, w); }

constexpr int NA_KC = 65536, NA_Q = 98304, NA_RPB = 106496, NA_COMB = 108544, NA_CSLOT = 4480;
static_assert(NA_COMB + 8 * NA_CSLOT <= MISC_OFF, "NA LDS map");
__device__ __forceinline__ void na_units(Frame& F, int layer, bool ctxq, int total, int k0 = 0, int k1 = 1 << 20) {
    F.fresh();
    const int tid = F.tid, lane = F.lane, wave = F.wave, fr = lane & 15, fq = lane >> 4;
    LAS unsigned char* lds = F.lds; const bf16_t* P = F.PROJ;
    const int sch = tid & 7, skey = tid >> 3;
    const unsigned sdst = (unsigned)(skey * 128 + ((sch ^ (skey & 7)) << 4));
    const int jb = wave & 3, half = wave >> 2; const bool active = !(ctxq && half == 0);
    const int cstart = min(max(16 * jb - 8, 0), 32);
    u32x4 kv[12], qv; float rpv = 0.f;
    int it = F.vcu + k0 * F.G; { const long lim = (long)F.vcu + (long)k1 * F.G; if (lim < total) total = (int)lim; }
    if (it >= total) return;
#define NA_DECODE(itx, b_, h_, r_) do { if (ctxq) { b_ = (itx) / 24; h_ = ((itx) % 24) / 4; r_ = (itx) & 3; } else { b_ = (itx) / 768; h_ = ((itx) % 768) / 128; r_ = (itx) % 128; } } while (0)
#define NA_LOADK(b_, h_, r_) do { const int rs_ = ctxq ? 0 : min(max((r_) - 4, 0), 120); const int tq_ = ctxq ? MLAT + (b_) * CTXL + (r_) * 64 : (b_) * SEQ + (r_) * 64; \
        if (!ctxq) { _Pragma("unroll") for (int i = 0; i < 8; ++i) { const size_t tok = (size_t)(b_) * SEQ + (rs_ + i) * 64 + skey; kv[i] = *(const u32x4*)(P + tok * PW + C_NK + (h_) * 64 + sch * 8); } } \
        _Pragma("unroll") for (int i = 0; i < 4; ++i) { const size_t tok = (size_t)MLAT + (b_) * CTXL + skey + 64 * i; kv[8 + i] = *(const u32x4*)(P + tok * PW + C_NK + (h_) * 64 + sch * 8); } \
        qv = *(const u32x4*)(P + (size_t)(tq_ + skey) * PW + C_NQ + (h_) * 64 + sch * 8); \
        if (tid < 465) rpv = F.rpb[((size_t)layer * 6 + (h_)) * 465 + tid] * 8.0f; } while (0)
    int b, h, r; NA_DECODE(it, b, h, r); NA_LOADK(b, h, r);
    for (; it < total; it += F.G) {
        NA_DECODE(it, b, h, r);
        const int rs = ctxq ? 0 : min(max(r - 4, 0), 120);
        const int tokq0 = ctxq ? MLAT + b * CTXL + r * 64 : b * SEQ + r * 64;
        __syncthreads();
        USTAMP(0);
        if (!ctxq) {
#pragma unroll
            for (int i = 0; i < 8; ++i) *(LAS u32x4*)(lds + sdst + i * 8192) = kv[i];
        }
#pragma unroll
        for (int i = 0; i < 4; ++i) *(LAS u32x4*)(lds + NA_KC + sdst + i * 8192) = kv[8 + i];
        *(LAS u32x4*)(lds + NA_Q + sdst) = qv;
        if (tid < 465) ((LAS float*)(lds + NA_RPB))[tid] = rpv;
        __syncthreads();
        USTAMP(1);
        bf16x8 pa[8]; float mx = -3.0e38f, lsum = 0.f; f32x4 st[16];
        if (active) {
            const int sw0 = (fq ^ (fr & 7)) << 4, sw1 = ((4 + fq) ^ (fr & 7)) << 4;
            lptr qb = (lptr)(lds + NA_Q + (jb * 16 + fr) * 128);
            const bf16x8 qf0 = ld8(qb + sw0), qf1 = ld8(qb + sw1);
            if (half == 0) {
                const int qc = jb * 16 + fr, wsx = min(max(qc - 8, 0), 48); LAS const float* rp = (LAS const float*)(lds + NA_RPB) + (rs - r + 7) * 31 + (cstart + 4 * fq - qc + 15);
                bool ok[2][4];
#pragma unroll
                for (int hf = 0; hf < 2; ++hf)
#pragma unroll
                    for (int reg = 0; reg < 4; ++reg) { const int kc = cstart + 16 * hf + 4 * fq + reg; ok[hf][reg] = kc >= wsx && kc < wsx + 16; }
#pragma unroll
                for (int t = 0; t < 16; ++t) { LAS const float* bp = rp + (t >> 1) * 31 + 16 * (t & 1);
#pragma unroll
                    for (int reg = 0; reg < 4; ++reg) { const float x = bp[reg]; st[t][reg] = ok[t & 1][reg] ? x : -1.0e30f; } }
            } else {
#pragma unroll
                for (int t = 0; t < 16; ++t) st[t] = (f32x4){0.f, 0.f, 0.f, 0.f};
            }
#pragma unroll
            for (int t = 0; t < 16; ++t) {
                const int kidx = half == 0 ? (t >> 1) * 64 + cstart + 16 * (t & 1) + fr : 16 * t + fr;
                lptr kp = (lptr)(lds + (half == 0 ? 0 : NA_KC) + kidx * 128);
                st[t] = __builtin_amdgcn_mfma_f32_16x16x32_bf16(ld8(kp + sw0), qf0, st[t], 0, 0, 0);
                st[t] = __builtin_amdgcn_mfma_f32_16x16x32_bf16(ld8(kp + sw1), qf1, st[t], 0, 0, 0);
            }
        }
        USTAMP(2);
        if (!ctxq) {
#pragma unroll
            for (int i = 0; i < 8; ++i) { const size_t tok = (size_t)b * SEQ + (rs + i) * 64 + skey; kv[i] = *(const u32x4*)(P + tok * PW + C_NV + h * 64 + sch * 8); }
        }
#pragma unroll
        for (int i = 0; i < 4; ++i) { const size_t tok = (size_t)MLAT + b * CTXL + skey + 64 * i; kv[8 + i] = *(const u32x4*)(P + tok * PW + C_NV + h * 64 + sch * 8); }
        if (active) {
            constexpr float SC = 0.125f * LOG2E;
#pragma unroll
            for (int t = 0; t < 16; ++t) st[t] = st[t] * SC;
#pragma unroll
            for (int t = 0; t < 16; ++t) mx = fmaxf(mx, fmaxf(fmaxf(st[t][0], st[t][1]), fmaxf(st[t][2], st[t][3])));
            mx = fmaxf(mx, __shfl_xor(mx, 16)); mx = fmaxf(mx, __shfl_xor(mx, 32));
#pragma unroll
            for (int t = 0; t < 16; ++t)
#pragma unroll
                for (int reg = 0; reg < 4; ++reg) { const float p = __builtin_amdgcn_exp2f(st[t][reg] - mx); st[t][reg] = p; lsum += p; }
            lsum += __shfl_xor(lsum, 16); lsum += __shfl_xor(lsum, 32);
#pragma unroll
            for (int s = 0; s < 8; ++s) pa[s] = pack8(st[2 * s], st[2 * s + 1]);
        } else {
#pragma unroll
            for (int s = 0; s < 8; ++s) pa[s] = (bf16x8){0, 0, 0, 0, 0, 0, 0, 0};
        }
        USTAMP(3);
        __syncthreads();
        if (!ctxq) {
#pragma unroll
            for (int i = 0; i < 8; ++i) *(LAS u32x4*)(lds + sdst + i * 8192) = kv[i];
        }
#pragma unroll
        for (int i = 0; i < 4; ++i) *(LAS u32x4*)(lds + NA_KC + sdst + i * 8192) = kv[8 + i];
        __syncthreads();
        USTAMP(4);
        if (it + F.G < total) { int b2, h2, r2; NA_DECODE(it + F.G, b2, h2, r2); NA_LOADK(b2, h2, r2); }
        f32x4 o[4];
#pragma unroll
        for (int n = 0; n < 4; ++n) o[n] = (f32x4){0.f, 0.f, 0.f, 0.f};
        if (active) {
            const int q4 = (lane & 15) >> 2, p4 = lane & 3, c7 = 4 * (fq & 1) + q4;
            lptr vb = (lptr)(lds + (half == 0 ? 0 : NA_KC) + (4 * fq + q4) * 128 + 8 * (p4 & 1));
            int xo[4];
#pragma unroll
            for (int n = 0; n < 4; ++n) xo[n] = ((2 * n + (p4 >> 1)) ^ c7) << 4;
#pragma unroll
            for (int s = 0; s < 8; ++s) { const int k0 = half == 0 ? s * 64 + cstart : 32 * s;
#pragma unroll
                for (int n = 0; n < 4; ++n) { lptr rb = vb + k0 * 128 + xo[n];
                    const bf16x4 lo = vtr(rb), hi = vtr(rb + 16 * 128);
                    const bf16x8 bv = {lo[0], lo[1], lo[2], lo[3], hi[0], hi[1], hi[2], hi[3]};
                    o[n] = __builtin_amdgcn_mfma_f32_16x16x32_bf16(pa[s], bv, o[n], 0, 0, 0); } }
        }
        USTAMP(5);
        LAS float* cb = (LAS float*)(lds + NA_COMB + wave * NA_CSLOT);
#pragma unroll
        for (int n = 0; n < 4; ++n)
#pragma unroll
            for (int reg = 0; reg < 4; ++reg) cb[(4 * fq + reg) * 68 + n * 16 + fr] = o[n][reg];
        if (fq == 0) { cb[1088 + 2 * fr] = mx; cb[1089 + 2 * fr] = lsum; }
        __syncthreads();
        if (wave < 4) {
            LAS const float* c1 = (LAS const float*)(lds + NA_COMB + wave * NA_CSLOT); LAS const float* c2 = (LAS const float*)(lds + NA_COMB + (wave + 4) * NA_CSLOT);
            const int q = lane >> 2, part = lane & 3;
            const float m1 = c1[1088 + 2 * q], l1 = c1[1089 + 2 * q], m2 = c2[1088 + 2 * q], l2 = c2[1089 + 2 * q], M = fmaxf(m1, m2);
            const float w1 = __builtin_amdgcn_exp2f(m1 - M), w2 = __builtin_amdgcn_exp2f(m2 - M), inv = 1.0f / (w1 * l1 + w2 * l2), s1 = w1 * inv, s2 = w2 * inv;
            u32x4 ov[2];
#pragma unroll
            for (int j = 0; j < 2; ++j) { const f32x4 a0 = *(LAS const f32x4*)(c1 + q * 68 + part * 16 + 8 * j), a1 = *(LAS const f32x4*)(c1 + q * 68 + part * 16 + 8 * j + 4);
                const f32x4 b0 = *(LAS const f32x4*)(c2 + q * 68 + part * 16 + 8 * j), b1 = *(LAS const f32x4*)(c2 + q * 68 + part * 16 + 8 * j + 4);
                const f32x4 r0 = a0 * s1 + b0 * s2, r1 = a1 * s1 + b1 * s2;
                ov[j].x = pk2(r0[0], r0[1]); ov[j].y = pk2(r0[2], r0[3]); ov[j].z = pk2(r1[0], r1[1]); ov[j].w = pk2(r1[2], r1[3]); }
            bf16_t* orow = F.CAT + (size_t)(tokq0 + jb * 16 + q) * DM + 640 + h * 64 + part * 16;
            *(u32x4*)orow = ov[0]; *(u32x4*)(orow + 8) = ov[1];
        }
        USTAMP(6);
    }
#undef NA_DECODE
#undef NA_LOADK
}

__device__ __forceinline__ int ret_row0(int b, int t) { return t >= 2 ? b * SEQ + (t - 2) * 128 : MLAT + b * CTXL + t * 128; }
constexpr int R1_K = 0, R1_VF = 32768, R1_VB = 65536;
__device__ __forceinline__ unsigned r1_swz(int row, int ch) { return (unsigned)(row * 256 + ((ch ^ (row & 15)) << 4)); }
__device__ __forceinline__ u32x4 scale8(const u32x4& v, float w) { u32x4 o; o.x = pk2(bflo(v.x) * w, bfhi(v.x) * w); o.y = pk2(bflo(v.y) * w, bfhi(v.y) * w); o.z = pk2(bflo(v.z) * w, bfhi(v.z) * w); o.w = pk2(bflo(v.w) * w, bfhi(v.w) * w); return o; }
__device__ __forceinline__ void r1_unit(Frame& F, int layer, int b, int h, int t) {
    F.fresh();
    const int tid = F.tid, lane = F.lane, wave = F.wave, fr = lane & 15, fq = lane >> 4;
    LAS unsigned char* lds = F.lds; bf16_t* P = F.PROJ;
    const bool lat = t >= 2; const int row0 = ret_row0(b, t);
    const float lgf = F.LG[layer * 8 + h], lgb = F.LG[layer * 8 + 4 + h], ks = 0.10206207261596575f;
    __syncthreads();
    u32x4 xa[3], xb[3], vv[3]; f32x4 tb[3][4];
#pragma unroll
    for (int it = 0; it < 3; ++it) { const int e = tid + NTHR * it, X = e / 768, rem = e % 768, j = rem / 6, cp = rem % 6, c0 = cp < 3 ? cp : cp + 3;
        const bf16_t* xr = P + (size_t)(row0 + j) * PW + (X ? C_RQ : C_RK) + h * 96;
        xa[it] = *(const u32x4*)(xr + c0 * 8); xb[it] = *(const u32x4*)(xr + (c0 + 3) * 8);
        if (lat) { const int pos = (t - 2) * 128 + j, prow = pos >> 6, pcol = pos & 63; const float* tp = F.ROPE + ((cp < 3 ? prow * 24 : 3072 + pcol * 24) + 8 * (cp % 3)) * 2;
#pragma unroll
            for (int q = 0; q < 4; ++q) tb[it][q] = *(const f32x4*)(tp + 4 * q); } }
#pragma unroll
    for (int it = 0; it < 3; ++it) { const int e = tid + NTHR * it, j = e / 12, ch = e % 12; vv[it] = *(const u32x4*)(P + (size_t)(row0 + j) * PW + C_RV + h * 96 + ch * 8); }
#pragma unroll
    for (int it = 0; it < 3; ++it) { const int e = tid + NTHR * it, X = e / 768, rem = e % 768, j = rem / 6, cp = rem % 6, c0 = cp < 3 ? cp : cp + 3;
        const float scl = X ? 1.0f : ks; u32x4 oa, ob;
        if (lat) { float ra[8], rb[8]; const unsigned ua[4] = {xa[it].x, xa[it].y, xa[it].z, xa[it].w}, ub[4] = {xb[it].x, xb[it].y, xb[it].z, xb[it].w};
#pragma unroll
            for (int q = 0; q < 4; ++q) { const float a0 = bflo(ua[q]), a1 = bfhi(ua[q]), b0 = bflo(ub[q]), b1 = bfhi(ub[q]); const f32x4 cs = tb[it][q];
                ra[2 * q] = (a0 * cs[0] - b0 * cs[1]) * scl; rb[2 * q] = (a0 * cs[1] + b0 * cs[0]) * scl; ra[2 * q + 1] = (a1 * cs[2] - b1 * cs[3]) * scl; rb[2 * q + 1] = (a1 * cs[3] + b1 * cs[2]) * scl; }
            oa.x = pk2(ra[0], ra[1]); oa.y = pk2(ra[2], ra[3]); oa.z = pk2(ra[4], ra[5]); oa.w = pk2(ra[6], ra[7]);
            ob.x = pk2(rb[0], rb[1]); ob.y = pk2(rb[2], rb[3]); ob.z = pk2(rb[4], rb[5]); ob.w = pk2(rb[6], rb[7]);
        } else { oa = X ? xa[it] : scale8(xa[it], ks); ob = X ? xb[it] : scale8(xb[it], ks); }
        if (lat || X == 0) { bf16_t* xr = P + (size_t)(row0 + j) * PW + (X ? C_RQ : C_RK) + h * 96; *(u32x4*)(xr + c0 * 8) = oa; *(u32x4*)(xr + (c0 + 3) * 8) = ob; }
        if (X == 0) { *(LAS u32x4*)(lds + R1_K + r1_swz(j, c0)) = oa; *(LAS u32x4*)(lds + R1_K + r1_swz(j, c0 + 3)) = ob; } }
#pragma unroll
    for (int it = 0; it < 3; ++it) { const int e = tid + NTHR * it, j = e / 12, ch = e % 12;
        *(LAS u32x4*)(lds + R1_VF + r1_swz(j, ch)) = scale8(vv[it], expf(lgf * (float)(127 - j))); *(LAS u32x4*)(lds + R1_VB + r1_swz(j, ch)) = scale8(vv[it], expf(lgb * (float)j)); }
    __syncthreads();
    const int dir = wave >> 2, q = wave & 3, mb = q >> 1, nb = q & 1, q4 = (lane & 15) >> 2, p4 = lane & 3; f32x4 acc[3][3]; zero_acc(acc);
    lptr vbase = (lptr)(lds + (dir ? R1_VB : R1_VF)), kbase = (lptr)(lds + R1_K);
#pragma unroll
    for (int s = 0; s < 4; ++s) { bf16x8 a[3], bb[3]; const int r0 = 32 * s + 8 * fq + q4, r1 = r0 + 4;
#pragma unroll
        for (int m = 0; m < 3; ++m) { const int ch = 2 * (mb * 3 + m) + (p4 >> 1); const bf16x4 lo = vtr(vbase + r1_swz(r0, ch) + 8 * (p4 & 1)), hi = vtr(vbase + r1_swz(r1, ch) + 8 * (p4 & 1));
            a[m] = (bf16x8){lo[0], lo[1], lo[2], lo[3], hi[0], hi[1], hi[2], hi[3]}; }
#pragma unroll
        for (int n = 0; n < 3; ++n) { const int ch = 2 * (nb * 3 + n) + (p4 >> 1); const bf16x4 lo = vtr(kbase + r1_swz(r0, ch) + 8 * (p4 & 1)), hi = vtr(kbase + r1_swz(r1, ch) + 8 * (p4 & 1));
            bb[n] = (bf16x8){lo[0], lo[1], lo[2], lo[3], hi[0], hi[1], hi[2], hi[3]}; }
#pragma unroll
        for (int m = 0; m < 3; ++m)
#pragma unroll
            for (int n = 0; n < 3; ++n) acc[m][n] = __builtin_amdgcn_mfma_f32_16x16x32_bf16(bb[n], a[m], acc[m][n], 0, 0, 0); }
    const int u = dir == 0 ? t : (t < 2 ? 1 - t : 67 - t);
    bf16_t* ST = F.STATE + (size_t)(((b * 4 + h) * 2 + dir) * 66 + u) * 9216;
#pragma unroll
    for (int m = 0; m < 3; ++m)
#pragma unroll
        for (int n = 0; n < 3; ++n)
            { u32x2 w; w.x = pk2(acc[m][n][0], acc[m][n][1]); w.y = pk2(acc[m][n][2], acc[m][n][3]); *(u32x2*)(ST + (mb * 48 + m * 16 + fr) * 96 + nb * 48 + n * 16 + 4 * fq) = w; }
}
__device__ __forceinline__ void r2_scan(Frame& F, int layer) {
    F.fresh();
    const int gt = F.vcu * NTHR + F.tid, GT = F.G * NTHR;
    for (int e = gt; e < 16 * 4608; e += GT) { const int combo = e / 4608, idx = (e % 4608) * 2, h = (combo >> 1) & 3, dir = combo & 1;
        const float dcy = expf(128.0f * F.LG[layer * 8 + dir * 4 + h]); unsigned* p = (unsigned*)(F.STATE + (size_t)combo * 66 * 9216 + idx); float s0 = 0.f, s1 = 0.f;
#pragma unroll 1
        for (int u0 = 0; u0 < 66; u0 += 33) { unsigned kv[33];
#pragma unroll
            for (int q = 0; q < 33; ++q) kv[q] = p[(size_t)(u0 + q) * 4608];
#pragma unroll
            for (int q = 0; q < 33; ++q) { p[(size_t)(u0 + q) * 4608] = pk2(s0, s1); s0 = s0 * dcy + bflo(kv[q]); s1 = s1 * dcy + bfhi(kv[q]); } } }
}
constexpr int R3_Q = 0, R3_K = 26624, R3_V = 53248, R3_P = 86016, R3_SF = 120832, R3_SB = 140800;
static_assert(R3_SB + 96 * 208 <= MISC_OFF, "R3 LDS map");
__device__ __forceinline__ void r3_units(Frame& F, int layer) {
    F.fresh();
    const int tid = F.tid, lane = F.lane, wave = F.wave, fr = lane & 15, fq = lane >> 4, q4 = (lane & 15) >> 2, p4 = lane & 3;
    LAS unsigned char* lds = F.lds; const bf16_t* P = F.PROJ;
    const int nt = layer == 0 ? 66 : 64, t0 = layer == 0 ? 0 : 2, total = 8 * nt;
    int it = F.vcu; if (it >= total) return;
    u32x4 rq[3], rk[3], rv[3], sv[5];
#define R3_DECODE(itx, b_, h_, t_) do { b_ = (itx) / (4 * nt); h_ = ((itx) / nt) & 3; t_ = t0 + (itx) % nt; } while (0)
#define R3_LOAD(b_, h_, t_) do { const int r0_ = ret_row0(b_, t_); \
        _Pragma("unroll") for (int i_ = 0; i_ < 3; ++i_) { const int e_ = tid + NTHR * i_, j_ = e_ / 12, c_ = e_ % 12; const bf16_t* rp_ = P + (size_t)(r0_ + j_) * PW + (h_) * 96 + c_ * 8; \
            rq[i_] = *(const u32x4*)(rp_ + C_RQ); rk[i_] = *(const u32x4*)(rp_ + C_RK); rv[i_] = *(const u32x4*)(rp_ + C_RV); } \
        const int ub_ = (t_) < 2 ? 1 - (t_) : 67 - (t_); \
        _Pragma("unroll") for (int i_ = 0; i_ < 5; ++i_) { const int e_ = tid + NTHR * i_; if (e_ < 2304) { const int d_ = e_ >= 1152, c_ = d_ ? e_ - 1152 : e_; \
            sv[i_] = *(const u32x4*)(F.STATE + (size_t)((((b_) * 4 + (h_)) * 2 + d_) * 66 + (d_ ? ub_ : (t_))) * 9216 + c_ * 8); } } } while (0)
    int b, h, t; R3_DECODE(it, b, h, t); R3_LOAD(b, h, t);
    for (; it < total; it += F.G) {
        R3_DECODE(it, b, h, t);
        const int row0 = ret_row0(b, t);
        const float lf2 = F.LG[layer * 8 + h] * LOG2E, lb2 = F.LG[layer * 8 + 4 + h] * LOG2E;
        __syncthreads();
        USTAMP(10);
#pragma unroll
        for (int i = 0; i < 3; ++i) { const int e = tid + NTHR * i, j = e / 12, c = e % 12;
            *(LAS u32x4*)(lds + R3_Q + j * 208 + c * 16) = rq[i]; *(LAS u32x4*)(lds + R3_K + j * 208 + c * 16) = rk[i]; *(LAS u32x4*)(lds + R3_V + r1_swz(j, c)) = rv[i]; }
#pragma unroll
        for (int i = 0; i < 5; ++i) { const int e = tid + NTHR * i; if (e < 2304) { const int d = e >= 1152, c = d ? e - 1152 : e;
            *(LAS u32x4*)(lds + (d ? R3_SB : R3_SF) + (c / 12) * 208 + (c % 12) * 16) = sv[i]; } }
        __syncthreads();
        USTAMP(11);
        unsigned short gtv[4][6]; float gnv[6];
#pragma unroll
        for (int reg = 0; reg < 4; ++reg)
#pragma unroll
            for (int n = 0; n < 6; ++n) gtv[reg][n] = P[(size_t)(row0 + wave * 16 + 4 * fq + reg) * PW + C_RG + h * 96 + n * 16 + fr];
#pragma unroll
        for (int n = 0; n < 6; ++n) gnv[n] = F.ret_g[layer * 384 + h * 96 + n * 16 + fr];
        if (it + F.G < total) { int b2, h2, t2; R3_DECODE(it + F.G, b2, h2, t2); R3_LOAD(b2, h2, t2); }
        f32x4 ao[1][6];
        {
            f32x4 af[1][6], ab[1][6]; zero_acc(af); zero_acc(ab);
            wave_mma<1, 6>(af, (lptr)(lds + R3_Q + wave * 16 * 208), 208, (lptr)(lds + R3_SF), 208, 3, fr, fq);
            wave_mma<1, 6>(ab, (lptr)(lds + R3_Q + wave * 16 * 208), 208, (lptr)(lds + R3_SB), 208, 3, fr, fq);
#pragma unroll
            for (int reg = 0; reg < 4; ++reg) { const int il = wave * 16 + 4 * fq + reg; const float qdf = __builtin_amdgcn_exp2f(lf2 * (float)(il + 1)), qdb = __builtin_amdgcn_exp2f(lb2 * (float)(128 - il));
#pragma unroll
                for (int n = 0; n < 6; ++n) ao[0][n][reg] = qdf * af[0][n][reg] + qdb * ab[0][n][reg]; }
        }
        {
            bf16x8 qf[3];
#pragma unroll
            for (int s = 0; s < 3; ++s) qf[s] = ld8((lptr)(lds + R3_Q + (wave * 16 + fr) * 208 + s * 64 + fq * 16));
            const int i = wave * 16 + fr;
#pragma unroll 1
            for (int m = 0; m < 8; ++m) { f32x4 a = {0.f, 0.f, 0.f, 0.f};
#pragma unroll
                for (int s = 0; s < 3; ++s) a = __builtin_amdgcn_mfma_f32_16x16x32_bf16(ld8((lptr)(lds + R3_K + (m * 16 + fr) * 208 + s * 64 + fq * 16)), qf[s], a, 0, 0, 0);
                float pv[4];
#pragma unroll
                for (int reg = 0; reg < 4; ++reg) { const int diff = i - (m * 16 + 4 * fq + reg);
                    const float ex = __builtin_amdgcn_exp2f((diff > 0 ? lf2 : lb2) * (float)(diff > 0 ? diff : -diff)); const float dec = diff == 0 ? 2.0f : ex; pv[reg] = a[reg] * dec; }
                u32x2 w; w.x = pk2(pv[0], pv[1]); w.y = pk2(pv[2], pv[3]); *(LAS u32x2*)(lds + R3_P + i * 272 + (m * 16 + 4 * fq) * 2) = w; }
        }
        asm volatile("s_waitcnt lgkmcnt(0)" ::: "memory");
        USTAMP(12);
#pragma unroll 1
        for (int s = 0; s < 4; ++s) { const bf16x8 a = ld8((lptr)(lds + R3_P + (wave * 16 + fr) * 272 + s * 64 + fq * 16)); const int r0 = 32 * s + 8 * fq + q4;
#pragma unroll
            for (int n = 0; n < 6; ++n) { const int ch = 2 * n + (p4 >> 1); const bf16x4 lo = vtr((lptr)(lds + R3_V + r1_swz(r0, ch) + 8 * (p4 & 1))), hi = vtr((lptr)(lds + R3_V + r1_swz(r0 + 4, ch) + 8 * (p4 & 1)));
                const bf16x8 bv = {lo[0], lo[1], lo[2], lo[3], hi[0], hi[1], hi[2], hi[3]};
                ao[0][n] = __builtin_amdgcn_mfma_f32_16x16x32_bf16(a, bv, ao[0][n], 0, 0, 0); } }
        USTAMP(13);
#pragma unroll
        for (int reg = 0; reg < 4; ++reg) { const int il = wave * 16 + 4 * fq + reg;
            float ov[6], ss = 0.f;
#pragma unroll
            for (int n = 0; n < 6; ++n) { ov[n] = ao[0][n][reg]; ss += ov[n] * ov[n]; }
            ss += __shfl_xor(ss, 1); ss += __shfl_xor(ss, 2); ss += __shfl_xor(ss, 4); ss += __shfl_xor(ss, 8);
            const float rn = rsqrtf(ss * (1.0f / 96.0f) + NORM_EPS);
#pragma unroll
            for (int n = 0; n < 6; ++n) { const int col = n * 16 + fr; const float gt = bf2f(gtv[reg][n]);
                *(LAS bf16_t*)(lds + R3_P + (wave * 16 + 4 * fq + reg) * 272 + col * 2) = (bf16_t)f2bf(ov[n] * rn * gnv[n] * silu_f(gt)); } }
        asm volatile("s_waitcnt lgkmcnt(0)" ::: "memory");
#pragma unroll
        for (int i = 0; i < 3; ++i) { const int c = lane + 64 * i, rr = c / 12, ch = c % 12;
            *(u32x4*)(F.CAT + (size_t)(row0 + wave * 16 + rr) * DM + 256 + h * 96 + ch * 8) = *(LAS const u32x4*)(lds + R3_P + (wave * 16 + rr) * 272 + ch * 16); }
        USTAMP(14);
    }
#undef R3_DECODE
#undef R3_LOAD
}

__device__ __forceinline__ void d1_unit(Frame& F, int b, int l2, int g) {
    F.fresh();
    const int tid = F.tid, lane = F.lane, wave = F.wave, fr = lane & 15, fq = lane >> 4;
    LAS unsigned char* lds = F.lds; const bf16_t* P = F.PROJ;
    __syncthreads();
    {
        u32x4 v[2];
#pragma unroll
        for (int i = 0; i < 2; ++i) { const int row = (tid >> 3) + 64 * i, ch = tid & 7; v[i] = *(const u32x4*)(P + ((size_t)b * SEQ + row * 64 + l2) * PW + g * 64 + ch * 8); }
#pragma unroll
        for (int i = 0; i < 2; ++i) { const int row = (tid >> 3) + 64 * i, ch = tid & 7; *(LAS u32x4*)(lds + row * 128 + ((ch ^ (row & 7)) << 4)) = v[i]; }
    }
    bf16x8 bfr[2][4];
#pragma unroll
    for (int cs = 0; cs < 2; ++cs)
#pragma unroll
        for (int s = 0; s < 4; ++s) bfr[cs][s] = *(const bf16x8*)(F.TWA + (size_t)(cs * 128 + 16 * wave + fr) * 128 + 32 * s + 8 * fq);
    __syncthreads();
    f32x4 acc[4][2]; zero_acc(acc);
    const int q4 = (lane & 15) >> 2, p4 = lane & 3;
#pragma unroll
    for (int s = 0; s < 4; ++s)
#pragma unroll
        for (int mt = 0; mt < 4; ++mt) {
            lptr rb = (lptr)(lds + (32 * s + 8 * fq + q4) * 128 + 8 * (p4 & 1));
            const bf16x4 lo = vtr(rb + (((2 * mt + (p4 >> 1)) ^ q4) << 4)), hi = vtr(rb + 4 * 128 + (((2 * mt + (p4 >> 1)) ^ (4 + q4)) << 4));
            const bf16x8 av = {lo[0], lo[1], lo[2], lo[3], hi[0], hi[1], hi[2], hi[3]};
            acc[mt][0] = __builtin_amdgcn_mfma_f32_16x16x32_bf16(av, bfr[0][s], acc[mt][0], 0, 0, 0);
            acc[mt][1] = __builtin_amdgcn_mfma_f32_16x16x32_bf16(av, bfr[1][s], acc[mt][1], 0, 0, 0);
        }
    const int k1 = 16 * wave + fr; const f32x2 cs2 = *(const f32x2*)(F.TW8 + 2 * (k1 * l2));
    unsigned* yb = F.Y + ((((size_t)b * 64 + l2) * 128 + k1) * 4 + g) * 64;
#pragma unroll
    for (int mt = 0; mt < 2; ++mt)
#pragma unroll
        for (int reg = 0; reg < 4; ++reg) { const int p = 16 * mt + 4 * fq + reg;
            const float cp = acc[mt][0][reg], sp = acc[mt][1][reg], cq = acc[mt + 2][0][reg], sq = acc[mt + 2][1][reg];
            float yr0, yi0, yr1, yi1; int m0, m1;
            if (p == 0) { m0 = 0; yr0 = cp; yi0 = -sp; m1 = 32; yr1 = cq; yi1 = -sq; }
            else { m0 = p; yr0 = cp + sq; yi0 = cq - sp; m1 = 64 - p; yr1 = cp - sq; yi1 = -cq - sp; }
            yb[m0] = pk2(yr0 * cs2[0] + yi0 * cs2[1], yi0 * cs2[0] - yr0 * cs2[1]);
            yb[m1] = pk2(yr1 * cs2[0] + yi1 * cs2[1], yi1 * cs2[0] - yr1 * cs2[1]); }
}
constexpr int D2_Y = 0, D2_A = 69632, D2_F = 87040;
__device__ __forceinline__ void d2_unit(Frame& F, int layer, int b, int k1) {
    F.fresh();
    const int tid = F.tid, lane = F.lane, wave = F.wave, fr = lane & 15, fq = lane >> 4;
    LAS unsigned char* lds = F.lds;
    __syncthreads();
    {
        u32x4 yv[8];
#pragma unroll
        for (int i = 0; i < 8; ++i) { const int e = tid + NTHR * i, l2 = (e & 15) + 16 * ((e >> 6) & 3), q = ((e >> 4) & 3) + 4 * (e >> 8);
            yv[i] = *(const u32x4*)(F.Y + (((size_t)b * 64 + l2) * 128 + k1) * 256 + 4 * q); }
#pragma unroll
        for (int i = 0; i < 8; ++i) { const int e = tid + NTHR * i, l2 = (e & 15) + 16 * ((e >> 6) & 3), q = ((e >> 4) & 3) + 4 * (e >> 8);
            LAS unsigned char* d = lds + D2_Y + (4 * q) * 272 + l2 * 4;
            *(LAS unsigned*)(d) = yv[i].x; *(LAS unsigned*)(d + 272) = yv[i].y; *(LAS unsigned*)(d + 544) = yv[i].z; *(LAS unsigned*)(d + 816) = yv[i].w; }
    }
    for (int e = tid; e < 1024; e += NTHR) { const int row = e >> 4, ch = e & 15; *(LAS u32x4*)(lds + D2_A + row * 272 + ch * 16) = *(const u32x4*)(F.TD2 + row * 128 + ch * 8); }
    __syncthreads();
    f32x4 acc[4][2]; zero_acc(acc);
    wave_mma<4, 2>(acc, (lptr)(lds + D2_A), 272, (lptr)(lds + D2_Y + wave * 32 * 272), 272, 4, fr, fq);
    const float scale = 0.0013810679320049757f;
#pragma unroll
    for (int mt = 0; mt < 4; ++mt)
#pragma unroll
        for (int nt = 0; nt < 2; ++nt)
#pragma unroll
            for (int reg = 0; reg < 4; ++reg) *(LAS bf16_t*)(lds + D2_F + (mt * 16 + 4 * fq + reg) * 528 + (wave * 32 + nt * 16 + fr) * 2) = (bf16_t)f2bf(acc[mt][nt][reg] * scale);
    __syncthreads();
    zero_acc(acc);
    wave_mma<4, 2>(acc, (lptr)(lds + D2_F), 528, (gptr)(F.WFT + (size_t)layer * 65536) + (size_t)(wave * 32) * 512, 512, 8, fr, fq);
    __syncthreads();
#pragma unroll
    for (int mt = 0; mt < 4; ++mt)
#pragma unroll
        for (int nt = 0; nt < 2; ++nt)
#pragma unroll
            for (int reg = 0; reg < 4; ++reg) *(LAS bf16_t*)(lds + D2_F + (mt * 16 + 4 * fq + reg) * 528 + (wave * 32 + nt * 16 + fr) * 2) = (bf16_t)f2bf(acc[mt][nt][reg]);
    __syncthreads();
#pragma unroll
    for (int i = 0; i < 4; ++i) { const int e = tid + NTHR * i, k2 = e >> 5, ch = e & 31;
        *(u32x4*)(F.CAT + ((size_t)b * SEQ + k1 + 128 * k2) * DM + ch * 8) = *(LAS const u32x4*)(lds + D2_F + k2 * 528 + ch * 16); }
}
constexpr int DC_H = 0, DC_F = 131072;
__device__ __forceinline__ void dctx_item(Frame& F, int layer, int it) {
    F.fresh();
    const int tid = F.tid, lane = F.lane, wave = F.wave, fr = lane & 15, fq = lane >> 4; LAS unsigned char* lds = F.lds; const bf16_t* P = F.PROJ;
    const int b = it >> 5, k0 = (it & 31) * 8;
    __syncthreads();
    { u32x4 v[16];
#pragma unroll
      for (int i = 0; i < 16; ++i) { const int e = tid + NTHR * i, row = e >> 5, ch = e & 31; v[i] = *(const u32x4*)(P + ((size_t)MLAT + b * CTXL + row) * PW + ch * 8); }
#pragma unroll
      for (int i = 0; i < 16; ++i) { const int e = tid + NTHR * i, row = e >> 5, ch = e & 31; *(LAS u32x4*)(lds + DC_H + row * 512 + ((ch ^ (row & 15)) << 4)) = v[i]; } }
    for (int e = tid; e < 16 * 132; e += NTHR) ((LAS unsigned*)(lds + DC_F))[e] = 0u;
    bf16x8 bfr[8];
    { const bf16_t* tb = F.TC256 + ((size_t)((fr >> 3) * 256 + k0 + (fr & 7))) * 256 + 8 * fq;
#pragma unroll
      for (int s = 0; s < 8; ++s) bfr[s] = *(const bf16x8*)(tb + 32 * s); }
    __syncthreads();
    const int g = wave >> 1, jj = wave & 1, q4 = (lane & 15) >> 2, p4 = lane & 3;
    f32x4 acc[2]; acc[0] = (f32x4){0.f, 0.f, 0.f, 0.f}; acc[1] = acc[0];
#pragma unroll
    for (int s = 0; s < 8; ++s)
#pragma unroll
        for (int mt = 0; mt < 2; ++mt) { const int chunk = 2 * (g * 4 + jj + 2 * mt) + (p4 >> 1); const int r0 = 32 * s + 8 * fq + q4;
            const bf16x4 lo = vtr((lptr)(lds + DC_H + r0 * 512 + ((chunk ^ (r0 & 15)) << 4) + 8 * (p4 & 1)));
            const bf16x4 hi = vtr((lptr)(lds + DC_H + (r0 + 4) * 512 + ((chunk ^ ((r0 + 4) & 15)) << 4) + 8 * (p4 & 1)));
            const bf16x8 av = {lo[0], lo[1], lo[2], lo[3], hi[0], hi[1], hi[2], hi[3]};
            acc[mt] = __builtin_amdgcn_mfma_f32_16x16x32_bf16(av, bfr[s], acc[mt], 0, 0, 0); }
    const int kk = fr & 7; const bool hiLane = fr >= 8;
#pragma unroll
    for (int reg = 0; reg < 4; ++reg) { const int pp = jj * 16 + 4 * fq + reg;
        const float vp = acc[0][reg], vq = acc[1][reg], op = __shfl_xor(vp, 8), oq = __shfl_xor(vq, 8);
        const float c_p = hiLane ? op : vp, c_q = hiLane ? oq : vq, s_q = hiLane ? vq : oq;
        float x; int m;
        if (pp == 0) { m = hiLane ? 32 : 0; x = hiLane ? c_q : c_p; } else { m = hiLane ? 64 - pp : pp; x = hiLane ? c_p - s_q : c_p + s_q; }
        *(LAS bf16_t*)(lds + DC_F + kk * 528 + (g * 64 + m) * 2) = (bf16_t)f2bf(x * (1.0f / 128.0f)); }
    __syncthreads();
    f32x4 o2[1][2]; zero_acc(o2);
    wave_mma<1, 2>(o2, (lptr)(lds + DC_F), 528, (gptr)(F.WFT + (size_t)layer * 65536) + (size_t)(wave * 32) * 512, 512, 8, fr, fq);
    if (fq < 2) {
#pragma unroll
        for (int nt = 0; nt < 2; ++nt)
#pragma unroll
            for (int reg = 0; reg < 4; ++reg) F.CAT[((size_t)MLAT + b * CTXL + k0 + 4 * fq + reg) * DM + wave * 32 + nt * 16 + fr] = (bf16_t)f2bf(o2[0][nt][reg]);
    }
}

#ifndef DUP_PHASE
#define DUP_PHASE 0
#endif
__device__ __forceinline__ void phase_m1(Frame& F, int layer) {
    const int nNA = 1536, nCQ = layer == 0 ? 48 : 0, nR1 = 528, nD1 = 512;
    for (int q = F.vcu; q < nR1; q += F.G) r1_unit(F, layer, q / 264, (q % 264) / 66, q % 66);
#pragma unroll 1
    for (int rep = 0; rep < (DUP_PHASE == 8 ? 2 : 1); ++rep)
        for (int q = F.vcu; q < nD1; q += F.G) d1_unit(F, q >> 8, (q >> 2) & 63, q & 3);
    na_units(F, layer, true, nCQ);
    na_units(F, layer, false, nNA, 0, 1);
}
__device__ __forceinline__ void phase_m2(Frame& F, int layer) {
    r2_scan(F, layer);
    const int nD2 = 256, nDC = layer == 0 ? 64 : 0;
    for (int it = F.vcu; it < nD2; it += F.G) d2_unit(F, layer, it >> 7, it & 127);
    for (int it = F.vcu; it < nDC; it += F.G) dctx_item(F, layer, it);
    F.prof = (layer == 1); na_units(F, layer, false, 1536, 1, 4); F.prof = false;
}
__device__ __forceinline__ void phase_m3(Frame& F, int layer) {
    F.prof = (layer == 1); r3_units(F, layer); F.prof = false;
    na_units(F, layer, false, 1536, 4, 6);
}

struct SgParams {
    const bf16_t* A; int lda; const bf16_t* Bt; int K;
    int mode;
    const float* ssq; const float* shw;
    bf16_t* O;
    const float* src; float* dst; bf16_t* XN; float* ssq_out; const float* gate; const float* sc; const float* g; float gmul;
};
constexpr int SG_A = 0, SG_B = 16384;
template <int NTW>
__device__ __forceinline__ void sg_unit(Frame& F, const SgParams& p, int mblk, int ntile) {
    F.fresh();
    constexpr int NB = NTW, BSTAGE = NTW * 8192, UW = 64 * NTW;
    const int tid = F.tid, lane = F.lane, wave = F.wave, fr = lane & 15, fq = lane >> 4, wr = wave & 1, wc = wave >> 1;
    LAS unsigned char* lds = F.lds;
    const int srow = tid >> 3, sch = tid & 7; const unsigned sdst = (unsigned)(srow * 128 + ((sch ^ (srow & 7)) << 4));
    const bf16_t* ap = p.A + (size_t)(mblk * 64 + srow) * p.lda + sch * 8;
    const bf16_t* bp = p.Bt + (size_t)(ntile * UW + srow) * p.K + sch * 8;
    int boff[NTW];
#pragma unroll
    for (int n = 0; n < NTW; ++n) boff[n] = NTW == 1 ? wc * 16 : (p.mode == 2 ? ((n >> 1) * 128 + wc * 32 + (n & 1) * 16) : (wc * 64 + n * 16));
    const int sw0 = (fq ^ (fr & 7)) << 4, sw1 = ((4 + fq) ^ (fr & 7)) << 4;
    f32x4 acc[2][NTW]; zero_acc(acc);
    const int nk = p.K / 64;
    u32x4 ra0, ra1, rb0[NB], rb1[NB];
#define SG_LOAD(RA, RB, kt) do { RA = *(const u32x4*)(ap + (kt) * 64); _Pragma("unroll") for (int i_ = 0; i_ < NB; ++i_) RB[i_] = *(const u32x4*)(bp + (size_t)(64 * i_) * p.K + (kt) * 64); } while (0)
#define SG_WRITE(RA, RB, buf) do { *(LAS u32x4*)(lds + SG_A + (buf) * 8192 + sdst) = RA; _Pragma("unroll") for (int i_ = 0; i_ < NB; ++i_) *(LAS u32x4*)(lds + SG_B + (buf) * BSTAGE + sdst + i_ * 8192) = RB[i_]; } while (0)
#define SG_MMA(buf) do { lptr Ab_ = (lptr)(lds + SG_A + (buf) * 8192 + (wr * 32 + fr) * 128), Bb_ = (lptr)(lds + SG_B + (buf) * BSTAGE + fr * 128); \
        _Pragma("unroll") for (int s_ = 0; s_ < 2; ++s_) { const int sw_ = s_ ? sw1 : sw0; bf16x8 a_[2], b_[NTW]; \
            _Pragma("unroll") for (int m_ = 0; m_ < 2; ++m_) a_[m_] = ld8(Ab_ + m_ * 16 * 128 + sw_); \
            _Pragma("unroll") for (int n_ = 0; n_ < NTW; ++n_) b_[n_] = ld8(Bb_ + boff[n_] * 128 + sw_); \
            _Pragma("unroll") for (int m_ = 0; m_ < 2; ++m_) _Pragma("unroll") for (int n_ = 0; n_ < NTW; ++n_) acc[m_][n_] = __builtin_amdgcn_mfma_f32_16x16x32_bf16(b_[n_], a_[m_], acc[m_][n_], 0, 0, 0); } } while (0)
    __syncthreads();
    SG_LOAD(ra0, rb0, 0); SG_LOAD(ra1, rb1, 1);
    SG_WRITE(ra0, rb0, 0);
    __syncthreads();
    for (int kt = 0; kt < nk; kt += 2) {
        if (kt + 2 < nk) SG_LOAD(ra0, rb0, kt + 2);
        SG_MMA(0);
        SG_WRITE(ra1, rb1, 1);
        __syncthreads();
        if (kt + 3 < nk) SG_LOAD(ra1, rb1, kt + 3);
        SG_MMA(1);
        if (kt + 2 < nk) SG_WRITE(ra0, rb0, 0);
        __syncthreads();
    }
#undef SG_LOAD
#undef SG_WRITE
#undef SG_MMA
    LAS float* red = (LAS float*)(lds + 98304);
#pragma unroll
    for (int m = 0; m < 2; ++m) { const int rl = mblk * 64 + wr * 32 + m * 16 + fr; const size_t rg = (size_t)MLAT + rl;
        if (p.mode == 0) { const float ri = pg8::row_rinv(p.ssq, (int)rg);
#pragma unroll
            for (int n = 0; n < NTW; ++n) { const int col = ntile * UW + boff[n] + 4 * fq; if (col < PW) { const f32x4 v = acc[m][n] * ri + *(const f32x4*)(p.shw + col);
                u32x2 w; w.x = pk2(v[0], v[1]); w.y = pk2(v[2], v[3]); *(u32x2*)(p.O + rg * PW + col) = w; } }
        } else if (p.mode == 2) { if constexpr (NTW == 4) { const float ri = pg8::row_rinv(p.ssq, (int)rg);
#pragma unroll
            for (int n = 0; n < 2; ++n) { const int wcol = ntile * 256 + boff[n] + 4 * fq, hcol = ntile * 128 + wc * 32 + n * 16 + 4 * fq;
                const f32x4 a = acc[m][n] * ri + *(const f32x4*)(p.shw + wcol), b = acc[m][n + 2] * ri + *(const f32x4*)(p.shw + wcol + 128);
                u32x2 w; w.x = pk2(silu_f(a[0]) * b[0], silu_f(a[1]) * b[1]); w.y = pk2(silu_f(a[2]) * b[2], silu_f(a[3]) * b[3]); *(u32x2*)(p.O + rg * FF + hcol) = w; } }
        } else { float ss = 0.f;
#pragma unroll
            for (int n = 0; n < NTW; ++n) { const int col = ntile * UW + boff[n] + 4 * fq; const size_t ol = (size_t)rl * DM + col;
                const f32x4 x1 = *(const f32x4*)(p.src + ol) + *(const f32x4*)(p.gate + col) * p.gmul * acc[m][n];
                *(f32x4*)(p.dst + ol) = x1; ss += (x1[0] * x1[0] + x1[1] * x1[1]) + (x1[2] * x1[2] + x1[3] * x1[3]);
                if (p.XN) { const f32x4 xn = x1 * (*(const f32x4*)(p.g + col) * (*(const f32x4*)(p.sc + col) + 1.0f)); u32x2 w; w.x = pk2(xn[0], xn[1]); w.y = pk2(xn[2], xn[3]); *(u32x2*)(p.XN + rg * DM + col) = w; } }
            ss += __shfl_xor(ss, 16); ss += __shfl_xor(ss, 32);
            if (NTW == 4) { if (fq == 0) p.ssq_out[rg * 16 + ntile * 4 + wc] = ss; }
            else { if (fq == 0) red[wc * 64 + wr * 32 + m * 16 + fr] = ss; } }
    }
    if (NTW == 1 && p.mode == 1) { __syncthreads(); if (tid < 64) p.ssq_out[((size_t)MLAT + mblk * 64 + tid) * 16 + ntile] = (red[tid] + red[64 + tid]) + (red[128 + tid] + red[192 + tid]); }
}
template <int NTW>
__device__ __forceinline__ void sg_phase(Frame& F, const SgParams& p, int ntiles, int big_units) {
    const int first_free = big_units % F.G, nfree = F.G - first_free, c = (int)blockIdx.x;
    if (c < first_free) return;
    for (int u = c - first_free; u < 8 * ntiles; u += nfree) sg_unit<NTW>(F, p, u % 8, u / 8);
}

#ifndef USE_COOP
#define USE_COOP 1
#endif
#ifndef MK_N_LAUNCHES
#define MK_N_LAUNCHES 1
#endif
constexpr int N_PHASES = 17;
constexpr int RINV_OFF = 133120;
__device__ __forceinline__ void fill_rinv(Frame& F, const pg8::StaticOrder& S) {
    LAS float* t = (LAS float*)(F.lds + RINV_OFF); pg8::Unit u;
    __syncthreads();
    for (int i0 = 0; i0 < 6; i0 += 2) { const int i = i0 + (F.tid >> 8); if (S.next(i, u)) t[i * 256 + (F.tid & 255)] = pg8::row_rinv(F.SSQ, u.pm * 256 + (F.tid & 255)); }
    __syncthreads();
}
struct Args { const float* in[18]; float* out; unsigned char* ws; int ph_lo, ph_hi; };
__global__ void __launch_bounds__(NTHR, 2) hymba_fwd(Args args) {
    extern __shared__ __attribute__((aligned(16))) unsigned char lds_raw[];
    Frame F;
    F.lds = (LAS unsigned char*)lds_raw;
    F.tid = threadIdx.x; F.lane = F.tid & 63; F.wave = __builtin_amdgcn_readfirstlane(F.tid >> 6);
    F.prof = false; F.G = gridDim.x; { const int bx = blockIdx.x; F.vcu = (F.G % 8 == 0) ? (bx % 8) * (F.G / 8) + bx / 8 : bx; }
    F.x = args.in[0]; F.c = args.in[1]; F.ctx = args.in[2]; F.c_ctx = args.in[3]; F.w_ada = args.in[4]; F.b_ada = args.in[5]; F.g_mix = args.in[6]; F.w_in = args.in[7];
    F.dlogit = args.in[8]; F.ret_g = args.in[9]; F.w_four = args.in[10]; F.rpb = args.in[11]; F.w_out = args.in[12]; F.g_ffn = args.in[13]; F.w1 = args.in[14]; F.w3 = args.in[15];
    F.w2 = args.in[16]; F.g_final = args.in[17]; F.out = args.out; F.ws = args.ws;
    unsigned char* ws = args.ws;
    F.MOD = (float*)(ws + WS_MOD); F.SHWIN = (float*)(ws + WS_SHWIN); F.SHW13 = (float*)(ws + WS_SHW13); F.ROPE = (float*)(ws + WS_ROPE); F.LG = (float*)(ws + WS_LG); F.CT256 = (float*)(ws + WS_CT256);
    F.SSQ = (float*)(ws + WS_SSQ); F.XC = (float*)(ws + WS_XC); F.STATE = (bf16_t*)(ws + WS_STATE); F.ADAP = (float*)(ws + WS_PROJ); F.TW8 = (const float*)(ws + WS_TAB + T_TW8);
    F.XN = (bf16_t*)(ws + WS_XN); F.CAT = (bf16_t*)(ws + WS_CAT); F.PROJ = (bf16_t*)(ws + WS_PROJ); F.HID = (bf16_t*)(ws + WS_PROJ);
    F.WFT = (bf16_t*)(ws + WS_TAB + T_WFT); F.TWA = (bf16_t*)(ws + WS_TAB + T_TWA); F.TD2 = (bf16_t*)(ws + WS_TAB + T_TD2); F.TC256 = (bf16_t*)(ws + WS_TAB + T_TC); F.Y = (unsigned*)(ws + WS_XN);
    volatile LAS unsigned* MISC = (volatile LAS unsigned*)(F.lds + MISC_OFF);
    if (F.tid < 64) MISC[F.tid] = 0u;
    __syncthreads();
    const int lo = args.ph_lo, hi = args.ph_hi;
#if MK_N_LAUNCHES == 1
    XcdBarrier bar = xcd_barrier_post((unsigned*)(ws + WS_CTL) + CW_BAR, MISC + 8);
    cg::grid_group grid = cg::this_grid();
#define SEAM(k) do { if (USE_COOP && args.ph_lo < 0) grid.sync();     \
    else { _Pragma("unroll 1") for (int rep_ = 0; rep_ < (DUP_PHASE == 19 ? 5 : 1); ++rep_) xcd_barrier(bar); } } while (0)
#else
#define SEAM(k) do { } while (0)
#endif
#define IN(k) (lo <= (k) && (k) < hi)
#ifndef STAMP_SEL
#define STAMP_SEL -1
#endif
    unsigned long long* stamps = (unsigned long long*)(ws + WS_CTL + 61440);
#define STAMP(k) do { if (STAMP_SEL >= 0 && blockIdx.x == 0 && threadIdx.x == 0) stamps[k] = __builtin_amdgcn_s_memrealtime(); } while (0)
    STAMP(0);
    if (IN(0)) { _Pragma("unroll 1") for (int rep = 0; rep < (DUP_PHASE == 5 ? 2 : 1); ++rep) { __syncthreads(); phase_p0a(F); } if (IN(1)) SEAM(0); } STAMP(1);
    if (IN(1)) { _Pragma("unroll 1") for (int rep = 0; rep < (DUP_PHASE == 21 ? 2 : 1); ++rep) { __syncthreads(); phase_p0b(F); } if (IN(2)) SEAM(1); } STAMP(2);
#pragma unroll 1
    for (int layer = 0; layer < 2; ++layer) {
        const int pb = 2 + 7 * layer; const bool last = layer == 1;
        const float* mod = F.MOD + (size_t)layer * 3 * 6144;
        if (IN(pb + 0)) {
            pg8::Gemm g{F.XN, F.W(layer, W_WIN), MLAT, PWP, DM}; pg8::StaticOrder S; S.init(MLAT, PWP, F.G, (int)blockIdx.x);
            fill_rinv(F, S);
            pg8::EpiProj E{F.PROJ, (const LAS float*)(F.lds + RINV_OFF), F.SHWIN + (size_t)layer * 3 * PWP, 0};
            _Pragma("unroll 1") for (int rep = 0; rep < (DUP_PHASE == 1 ? 2 : 1); ++rep) { __syncthreads(); pg8::gemm_phase<pg8::EpiProj, pg8::StaticOrder, true, true>(F.lds, g, S, E); }
            { SgParams sp{}; sp.A = F.XN + (size_t)MLAT * DM; sp.lda = DM; sp.Bt = F.W(layer, W_WIN); sp.K = DM; sp.mode = 0; sp.ssq = F.SSQ; sp.shw = F.SHWIN + (size_t)(layer * 3 + 2) * PWP; sp.O = F.PROJ;
              _Pragma("unroll 1") for (int rep = 0; rep < (DUP_PHASE == 12 ? 3 : 1); ++rep) sg_phase<1>(F, sp, 46, 768); }
            if (IN(pb + 1)) SEAM(pb);
        }
        STAMP(pb + 1);
        if (IN(pb + 1)) { _Pragma("unroll 1") for (int rep = 0; rep < (DUP_PHASE == 2 ? 2 : 1); ++rep) phase_m1(F, layer); if (IN(pb + 2)) SEAM(pb + 1); } STAMP(pb + 2);
        if (IN(pb + 2)) { phase_m2(F, layer); if (IN(pb + 3)) SEAM(pb + 2); } STAMP(pb + 3);
        if (IN(pb + 3)) { _Pragma("unroll 1") for (int rep = 0; rep < (DUP_PHASE == 3 ? 2 : 1); ++rep) phase_m3(F, layer); if (IN(pb + 4)) SEAM(pb + 3); } STAMP(pb + 4);
        const int Mrows = MLAT;
        if (IN(pb + 4)) {
            pg8::Gemm g{F.CAT, F.W(layer, W_WOUT), Mrows, DM, DM}; pg8::StaticOrder S; S.init(Mrows, DM, F.G, (int)blockIdx.x);
            pg8::EpiResWide E{last ? F.out : F.x, F.out, F.XN, F.SSQ, mod + 2048, mod + 4096, F.g_ffn + layer * DM, 1.0f};
            pg8::gemm_phase<pg8::EpiResWide, pg8::StaticOrder, false, true>(F.lds, g, S, E);
            if (!last) { SgParams sp{}; sp.A = F.CAT + (size_t)MLAT * DM; sp.lda = DM; sp.Bt = F.W(layer, W_WOUT); sp.K = DM; sp.mode = 1; sp.src = F.ctx; sp.dst = F.XC; sp.XN = F.XN; sp.ssq_out = F.SSQ;
              sp.gate = mod + 2048 + 2 * 6144; sp.sc = mod + 4096 + 2 * 6144; sp.g = F.g_ffn + layer * DM; sp.gmul = 1.0f; _Pragma("unroll 1") for (int rep = 0; rep < (DUP_PHASE == 13 ? 3 : 1); ++rep) sg_phase<1>(F, sp, 16, 256); }
            if (IN(pb + 5)) SEAM(pb + 4);
        }
        STAMP(pb + 5);
        if (IN(pb + 5)) {
            pg8::Gemm g{F.XN, F.W(layer, W_W13), Mrows, FF2, DM}; pg8::StaticOrder S; S.init(Mrows, FF2, F.G, (int)blockIdx.x);
            fill_rinv(F, S);
            pg8::EpiSwiGLU E{F.HID, (const LAS float*)(F.lds + RINV_OFF), F.SHW13 + (size_t)layer * 3 * FF2, 0};
            _Pragma("unroll 1") for (int rep = 0; rep < (DUP_PHASE == 4 ? 2 : 1); ++rep) { __syncthreads(); pg8::gemm_phase<pg8::EpiSwiGLU, pg8::StaticOrder, true, true>(F.lds, g, S, E); }
            if (!last) { SgParams sp{}; sp.A = F.XN + (size_t)MLAT * DM; sp.lda = DM; sp.Bt = F.W(layer, W_W13); sp.K = DM; sp.mode = 2; sp.ssq = F.SSQ; sp.shw = F.SHW13 + (size_t)(layer * 3 + 2) * FF2; sp.O = F.HID;
              _Pragma("unroll 1") for (int rep = 0; rep < (DUP_PHASE == 14 ? 3 : 1); ++rep) sg_phase<4>(F, sp, 22, 1408); }
            if (IN(pb + 6)) SEAM(pb + 5);
        }
        STAMP(pb + 6);
        if (IN(pb + 6)) {
            pg8::Gemm g{F.HID, F.W(layer, W_W2), Mrows, DM, FF}; pg8::StaticOrder S; S.init(Mrows, DM, F.G, (int)blockIdx.x);
            pg8::EpiResWide E{F.out, F.out, last ? nullptr : F.XN, F.SSQ, mod + 5120, F.MOD + 3 * 6144 + 1024, F.g_mix + DM, 1.0f};
            pg8::gemm_phase<pg8::EpiResWide, pg8::StaticOrder, false, true>(F.lds, g, S, E);
            if (!last) { SgParams sp{}; sp.A = F.HID + (size_t)MLAT * FF; sp.lda = FF; sp.Bt = F.W(layer, W_W2); sp.K = FF; sp.mode = 1; sp.src = F.XC; sp.dst = F.XC; sp.XN = F.XN; sp.ssq_out = F.SSQ;
              sp.gate = mod + 5120 + 2 * 6144; sp.sc = F.MOD + 3 * 6144 + 1024 + 2 * 6144; sp.g = F.g_mix + DM; _Pragma("unroll 1") for (int rep = 0; rep < (DUP_PHASE == 15 ? 3 : 1); ++rep) { sp.gmul = (DUP_PHASE == 15 && rep < 2) ? 0.0f : 1.0f; sg_phase<1>(F, sp, 16, 256); } }
            if (IN(pb + 7)) SEAM(pb + 6);
        }
        STAMP(pb + 7);
    }
    float delta = 0.f;
    if (STAMP_SEL >= 0) { const unsigned long long t0 = stamps[STAMP_SEL], t1 = stamps[STAMP_SEL + 1]; delta = sqrtf(1e-7f * 0.01f * (float)(t1 - t0)); }
    if (PROF_A >= 0) { const unsigned long long* us = (const unsigned long long*)(ws + WS_CTL + 61440 + 512); delta = sqrtf(1e-6f * 0.01f * (float)(us[PROF_A + 1] - us[PROF_A])); }
    if (PROF_B >= 0 && blockIdx.x == 0 && threadIdx.x == 0) { const unsigned long long* us = (const unsigned long long*)(ws + WS_CTL + 61440 + 512); const unsigned long long d = (us[PROF_B + 1] - us[PROF_B]) * 20ull, t0 = __builtin_amdgcn_s_memrealtime(); while (__builtin_amdgcn_s_memrealtime() - t0 < d) __builtin_amdgcn_s_sleep(8); }
    if (IN(16)) { if (DUP_PHASE == 23) phase_final(F, true); phase_final(F, false, delta); }
#undef IN
#undef SEAM
}

extern "C" void kernel_launch(void* const* d_in, const int* in_sizes, int n_in, void* d_out, int out_size, void* d_ws, size_t ws_size, hipStream_t stream) {
    static int grid = 0;
    if (grid == 0) {
        if (n_in != 18 || in_sizes[0] != MLAT * DM || out_size != MLAT * DM || ws_size < WS_END) {
            fprintf(stderr, "kernel_launch: built for 18 inputs, x/out of %d floats, >= %zu bytes of workspace; got n_in %d, in0 %d, out %d, ws %zu\n", MLAT * DM, (size_t)WS_END, n_in, n_in > 0 ? in_sizes[0] : -1, out_size, ws_size); grid = -1; return; }
        int dev = 0, cus = 0, per_cu = 0;
        if (hipGetDevice(&dev) != hipSuccess || hipDeviceGetAttribute(&cus, hipDeviceAttributeMultiprocessorCount, dev) != hipSuccess) { fprintf(stderr, "kernel_launch: device query failed\n"); grid = -1; return; }
        if (hipFuncSetAttribute((const void*)hymba_fwd, hipFuncAttributeMaxDynamicSharedMemorySize, LDS_BYTES) != hipSuccess) { fprintf(stderr, "kernel_launch: hipFuncSetAttribute failed\n"); grid = -1; return; }
        if (hipOccupancyMaxActiveBlocksPerMultiprocessor(&per_cu, (const void*)hymba_fwd, NTHR, LDS_BYTES) != hipSuccess || per_cu < 1) { fprintf(stderr, "kernel_launch: occupancy query says %d blocks per CU\n", per_cu); (void)hipGetLastError(); grid = -1; return; }
        grid = cus;
        fprintf(stderr, "kernel_launch: grid %d (cus %d, occupancy %d/CU), ws %zu\n", grid, cus, per_cu, ws_size);
    }
    if (grid < 0) return;
    if (hipMemsetAsync((char*)d_ws + WS_CTL, 0, CTL_ZERO_BYTES, stream) != hipSuccess) { fprintf(stderr, "kernel_launch: memset failed\n"); return; }
    Args a{};
    for (int i = 0; i < 18; ++i) a.in[i] = (const float*)d_in[i];
    a.out = (float*)d_out; a.ws = (unsigned char*)d_ws;
#if MK_N_LAUNCHES == 1
    a.ph_lo = 0; a.ph_hi = N_PHASES;
    void* kargs[] = {&a};
    if (DUP_PHASE == 30) { (void)hipLaunchCooperativeKernel((const void*)hymba_fwd, dim3(grid), dim3(NTHR), kargs, LDS_BYTES, stream); (void)hipMemsetAsync((char*)d_ws + WS_CTL, 0, CTL_ZERO_BYTES, stream); }
    hipError_t le = hipSuccess;
    if (USE_COOP) le = hipLaunchCooperativeKernel((const void*)hymba_fwd, dim3(grid), dim3(NTHR), kargs, LDS_BYTES, stream);
    else { hipLaunchKernelGGL(hymba_fwd, dim3(grid), dim3(NTHR), LDS_BYTES, stream, a); le = hipPeekAtLastError(); }
    if (le != hipSuccess) fprintf(stderr, "kernel_launch: cooperative launch failed: %s (grid %d)\n", hipGetErrorString(le), grid);
#else
    for (int p = 0; p < N_PHASES; ++p) { a.ph_lo = p; a.ph_hi = p + 1; hipLaunchKernelGGL(hymba_fwd, dim3(grid), dim3(NTHR), LDS_BYTES, stream, a); }
#endif
}
```
